# Optimizing an MI355X kernel written in HIP

```python
import math
import jax, jax.numpy as jnp
from jax import lax
import numpy as np

D_MODEL = 1024
BATCH = 8
SEQ = 4096
DEPTH = 4

N_A = DEPTH // 2
N_B = DEPTH - N_A
POOL_WINDOWS = (2, 4, 8, 16)
POOL_GROUPS = len(POOL_WINDOWS)
GROUP_W = D_MODEL // POOL_GROUPS
MLA_HEADS = 8
QK_NOPE = 128
QK_ROPE = 64
V_HEAD = 128
Q_RANK = 768
KV_RANK = 256
ROPE_THETA = 10000.0
ATTN_SCALE = 1.0 / math.sqrt(QK_NOPE + QK_ROPE)
Q_BLOCK = 128
PEER_HEADS = 8
N_KEYS = 128
N_EXPERTS = N_KEYS * N_KEYS
PEER_TOPK = 16
PEER_DQ = 256
PEER_DHALF = PEER_DQ // 2
TOKEN_CHUNK = 128
PLE_DIM = 256
EPS = 1e-6

kernel_name = 'yoco_pool_mla_peer_ple_trunk'


def rmsnorm(x, g):
    x32 = x.astype(jnp.float32)
    y = x32 * lax.rsqrt(jnp.mean(x32 * x32, axis=-1, keepdims=True) + EPS)
    return (y * g.astype(jnp.float32)).astype(x.dtype)


def rope_tables(positions, dtype):
    inv = ROPE_THETA ** (-jnp.arange(0, QK_ROPE, 2, dtype=jnp.float32) / QK_ROPE)
    ang = positions.astype(jnp.float32)[..., None] * inv
    return jnp.cos(ang).astype(dtype), jnp.sin(ang).astype(dtype)


def apply_rope(x, cos, sin):
    half = x.shape[-1] // 2
    x1, x2 = x[..., :half], x[..., half:]
    return jnp.concatenate([x1 * cos - x2 * sin, x2 * cos + x1 * sin], axis=-1)


def pool_mixer(h, w_groups, scale):
    B, S, D = h.shape
    h32 = h.astype(jnp.float32)
    cs = jnp.concatenate([jnp.zeros((B, 1, D), jnp.float32), jnp.cumsum(h32, axis=1)], axis=1)
    t = jnp.arange(S)
    outs = []
    for g, w in enumerate(POOL_WINDOWS):
        sl = slice(g * GROUP_W, (g + 1) * GROUP_W)
        win_sum = cs[:, 1:, sl] - cs[:, jnp.maximum(t + 1 - w, 0), sl]
        count = jnp.minimum(t + 1, w).astype(jnp.float32)[None, :, None]
        pooled = (win_sum / count - h32[..., sl]).astype(h.dtype)
        outs.append(pooled @ w_groups[g])
    return jnp.concatenate(outs, axis=-1) * scale


def shared_kv(x, kv_in_norm, w_dkv, kv_norm, w_ukv, cos, sin):
    B, S, _ = x.shape
    h = rmsnorm(x, kv_in_norm)
    ckv_kpe = h @ w_dkv
    c_kv = rmsnorm(ckv_kpe[..., :KV_RANK], kv_norm)
    k_pe = apply_rope(ckv_kpe[..., KV_RANK:], cos, sin)
    kv = (c_kv @ w_ukv).reshape(B, S, MLA_HEADS, QK_NOPE + V_HEAD)
    return kv[..., :QK_NOPE], k_pe, kv[..., QK_NOPE:]


def causal_attention(q_nope, q_pe, k_nope, k_pe, v):
    B, S, H, _ = q_nope.shape
    nb = S // Q_BLOCK
    qn = q_nope.reshape(B, nb, Q_BLOCK, H, QK_NOPE).transpose(1, 0, 2, 3, 4)
    qp = q_pe.reshape(B, nb, Q_BLOCK, H, QK_ROPE).transpose(1, 0, 2, 3, 4)
    kpos = jnp.arange(S)

    def block(args):
        qn_b, qp_b, bi = args
        s = (jnp.einsum('bqhd,bkhd->bhqk', qn_b, k_nope).astype(jnp.float32)
             + jnp.einsum('bqhr,bkr->bhqk', qp_b, k_pe).astype(jnp.float32)) * ATTN_SCALE
        qpos = bi * Q_BLOCK + jnp.arange(Q_BLOCK)
        s = jnp.where(kpos[None, :] <= qpos[:, None], s, -jnp.inf)
        pr = jax.nn.softmax(s, axis=-1).astype(v.dtype)
        return jnp.einsum('bhqk,bkhd->bqhd', pr, v)

    o = lax.map(block, (qn, qp, jnp.arange(nb)))
    return o.transpose(1, 0, 2, 3, 4).reshape(B, S, H * V_HEAD)


def mla_mixer(h, w_dq, q_norm, w_uq, w_o, k_nope, k_pe, v, cos, sin):
    B, S, _ = h.shape
    c_q = rmsnorm(h @ w_dq, q_norm)
    q = (c_q @ w_uq).reshape(B, S, MLA_HEADS, QK_NOPE + QK_ROPE)
    q_nope = q[..., :QK_NOPE]
    q_pe = apply_rope(q[..., QK_NOPE:], cos[:, :, None, :], sin[:, :, None, :])
    return causal_attention(q_nope, q_pe, k_nope, k_pe, v) @ w_o


def peer_mixer(h, w_q, sub_keys, u, v):
    B, S, D = h.shape
    q = (h @ w_q).astype(jnp.float32).reshape(B, S, PEER_HEADS, 2, PEER_DHALF)
    s = jnp.einsum('bshpc,hpnc->bshpn', q, sub_keys.astype(jnp.float32))
    top_s, top_i = lax.top_k(s, PEER_TOPK)
    cand_s = (top_s[..., 0, :, None] + top_s[..., 1, None, :]).reshape(B, S, PEER_HEADS, PEER_TOPK * PEER_TOPK)
    cand_i = (top_i[..., 0, :, None] * N_KEYS + top_i[..., 1, None, :]).reshape(B, S, PEER_HEADS, PEER_TOPK * PEER_TOPK)
    best_s, pos = lax.top_k(cand_s, PEER_TOPK)
    idx = jnp.take_along_axis(cand_i, pos, axis=-1)
    gate = jax.nn.softmax(best_s, axis=-1)
    n_chunks = (B * S) // TOKEN_CHUNK
    hc = h.reshape(n_chunks, TOKEN_CHUNK, D)
    ic = idx.reshape(n_chunks, TOKEN_CHUNK, PEER_HEADS * PEER_TOPK)
    gc = gate.reshape(n_chunks, TOKEN_CHUNK, PEER_HEADS * PEER_TOPK).astype(h.dtype)

    def chunk(args):
        hh, ii, gg = args
        a = jnp.einsum('tkd,td->tk', u[ii], hh)
        w = gg * jax.nn.gelu(a)
        return jnp.einsum('tk,tkd->td', w, v[ii])

    return lax.map(chunk, (hc, ic, gc)).reshape(B, S, D)


def setup_inputs(seed: int = 0) -> dict:
    key = jax.random.key(seed)
    ks = jax.random.split(key, 24)
    f32 = jnp.float32

    def nrm(k, shape, fan_in):
        return jax.random.normal(k, shape, f32) * (fan_in ** -0.5)

    def gain(k, shape):
        return 1.0 + 0.02 * jax.random.normal(k, shape, f32)

    D = D_MODEL
    return {
        'x': jax.random.normal(ks[0], (BATCH, SEQ, D), f32),
        'p': jax.random.normal(ks[1], (DEPTH, BATCH, SEQ, PLE_DIM), f32),
        'positions': jax.random.randint(ks[2], (BATCH, 1), 0, 1024, jnp.int32) + jnp.arange(SEQ, dtype=jnp.int32)[None, :],
        'mix_norm': gain(ks[3], (DEPTH, D)),
        'ffn_norm': gain(ks[4], (DEPTH, D)),
        'pool_w': nrm(ks[5], (N_A, POOL_GROUPS, GROUP_W, GROUP_W), GROUP_W),
        'pool_scale': gain(ks[6], (N_A, D)),
        'kv_in_norm': gain(ks[7], (D,)),
        'w_dkv': nrm(ks[8], (D, KV_RANK + QK_ROPE), D),
        'kv_norm': gain(ks[9], (KV_RANK,)),
        'w_ukv': nrm(ks[10], (KV_RANK, MLA_HEADS * (QK_NOPE + V_HEAD)), KV_RANK),
        'w_dq': nrm(ks[11], (N_B, D, Q_RANK), D),
        'q_norm': gain(ks[12], (N_B, Q_RANK)),
        'w_uq': nrm(ks[13], (N_B, Q_RANK, MLA_HEADS * (QK_NOPE + QK_ROPE)), Q_RANK),
        'w_o': nrm(ks[14], (N_B, MLA_HEADS * V_HEAD, D), MLA_HEADS * V_HEAD),
        'peer_wq': nrm(ks[15], (DEPTH, D, PEER_HEADS * PEER_DQ), D),
        'peer_keys': nrm(ks[16], (DEPTH, PEER_HEADS, 2, N_KEYS, PEER_DHALF), PEER_DHALF),
        'peer_u': nrm(ks[17], (DEPTH, N_EXPERTS, D), D),
        'peer_v': nrm(ks[18], (DEPTH, N_EXPERTS, D), PEER_HEADS),
        'ple_norm': gain(ks[19], (DEPTH, D)),
        'ple_wg': nrm(ks[20], (DEPTH, D, D), D),
        'ple_wp': nrm(ks[21], (DEPTH, PLE_DIM, D), PLE_DIM),
        'final_norm': gain(ks[22], (D,)),
    }


def reference(x, p, positions, mix_norm, ffn_norm, pool_w, pool_scale, kv_in_norm, w_dkv, kv_norm, w_ukv,
              w_dq, q_norm, w_uq, w_o, peer_wq, peer_keys, peer_u, peer_v, ple_norm, ple_wg, ple_wp, final_norm):
    cos, sin = rope_tables(positions, x.dtype)
    k_nope = k_pe = v_sh = None
    for i in range(DEPTH):
        h = rmsnorm(x, mix_norm[i])
        if i < N_A:
            x = x + pool_mixer(h, pool_w[i], pool_scale[i])
        else:
            if i == N_A:
                k_nope, k_pe, v_sh = shared_kv(x, kv_in_norm, w_dkv, kv_norm, w_ukv, cos, sin)
            j = i - N_A
            x = x + mla_mixer(h, w_dq[j], q_norm[j], w_uq[j], w_o[j], k_nope, k_pe, v_sh, cos, sin)
        x = x + peer_mixer(rmsnorm(x, ffn_norm[i]), peer_wq[i], peer_keys[i], peer_u[i], peer_v[i])
        g = jax.nn.sigmoid((rmsnorm(x, ple_norm[i]) @ ple_wg[i]).astype(jnp.float32)).astype(x.dtype)
        x = x + g * (p[i] @ ple_wp[i])
    return rmsnorm(x, final_norm)
```

```cpp
#include <hip/hip_runtime.h>
#include <cstdio>
#include <cstdint>

#ifndef MK_PROBE
#define MK_PROBE 0
#endif
#ifndef MK_ONE_LAUNCH
#define MK_ONE_LAUNCH 1
#endif


__device__ __forceinline__ int lane_id_fresh() { int l; asm volatile("v_mbcnt_lo_u32_b32 %0, -1, 0\n\tv_mbcnt_hi_u32_b32 %0, -1, %0" : "=v"(l)); return l; }
template <int M> __device__ __forceinline__ float shx(float v, int lane) {
    if constexpr (M < 32) return __builtin_bit_cast(float, __builtin_amdgcn_ds_swizzle(__builtin_bit_cast(int, v), (M << 10) | 0x1f));
    else return __builtin_bit_cast(float, __builtin_amdgcn_ds_bpermute((lane ^ 32) << 2, __builtin_bit_cast(int, v)));
}

namespace pg8 {
#define PG8_LAS __attribute__((address_space(3)))
typedef unsigned short bf16_t;
typedef short bf16x8 __attribute__((ext_vector_type(8)));
typedef float f32x4 __attribute__((ext_vector_type(4)));
typedef unsigned u32x4 __attribute__((ext_vector_type(4)));
typedef unsigned u32x2 __attribute__((ext_vector_type(2)));
constexpr int BM = 256, BK = 64, HALF = 128, HTB = HALF * BK * 2, STAGE_BYTES = 8 * HTB, NXCD = 8, WGM = 8;

__host__ __device__ __forceinline__ int lds_byte(int r, int c) { const int st = (r >> 4) * 2 + (c >> 5), rr = r & 15, cc = c & 31, ob = rr * 64 + cc * 2; return st * 1024 + (ob ^ (((ob >> 9) & 1) << 5)); }
__host__ __device__ __forceinline__ void stage_rc(int b, int& R, int& C) { const int st = b / 1024, sb = b % 1024, swz = sb ^ (((sb >> 9) & 1) << 5); R = (st >> 1) * 16 + swz / 64; C = (st & 1) * 32 + (swz % 64) / 2; }
__host__ __device__ __forceinline__ int perm32(int rho) { const int n = rho >> 4, i = rho & 15; return 8 * (i >> 2) + 4 * n + (i & 3); }

struct Unit { int pm, pn; };
struct Gemm { const bf16_t* A; const bf16_t* Bt; int M, N, K, lda, ldb, acs; };

struct StaticOrder {
    int nM, nN, nwg, G, c, skew;
    __host__ __device__ void init(int M, int N, int G_, int c_, int skew_ = 0) { nM = M / BM; nN = N / BM; nwg = nM * nN; G = G_; c = c_; skew = skew_; }
    __host__ __device__ bool next(int i, Unit& u) const {
        long L = (long)i * G + c;
        if (skew && i > 0) { if (2 * c < G) return false; L = (long)G + (long)(i - 1) * (G - G / 2) + (c - G / 2); }
        if (L >= nwg) return false;
        int wgid = (int)L; { const int q = nwg / NXCD, r = nwg % NXCD, xcd = wgid % NXCD, off = wgid / NXCD; wgid = (xcd < r ? xcd * (q + 1) : r * (q + 1) + (xcd - r) * q) + off; }
        const int nig = WGM * nN, gid = wgid / nig, fm = gid * WGM, gsz = (nM - fm) < WGM ? (nM - fm) : WGM;
        u.pm = fm + ((wgid % nig) % gsz); u.pn = (wgid % nig) / gsz; return true;
    }
};

__device__ __forceinline__ unsigned cvt_pk_bf16(float lo, float hi) { unsigned r; asm volatile("v_cvt_pk_bf16_f32 %0, %1, %2" : "=v"(r) : "v"(lo), "v"(hi)); return r; }

template <class Epi>
__device__ __forceinline__ void gemm_phase(PG8_LAS unsigned char* lds, const Gemm g, const StaticOrder& S, const Epi& E, const int wid) {
    const int lane = lane_id_fresh(), tid = wid * 64 + lane;
    const int wr = wid >> 2, wc = wid & 3, fr = lane & 15, fq = lane >> 4;
    const int K = g.K, nt = K / BK;
    unsigned voffA, voffB;
    { int R, C; stage_rc(tid * 16, R, C); const int Rb = Epi::PERM ? ((R & ~31) + perm32(R & 31)) : R;
      voffA = (unsigned)(R * g.lda + C) * 2u; voffB = (unsigned)(Rb * g.ldb + C) * 2u; }
    const unsigned d64A = 64u * g.lda * 2u, d64B = 64u * g.ldb * 2u;
    constexpr unsigned kstep = BK * 2;
    const unsigned hstepA = (unsigned)HALF * g.lda * 2u, hstepB = (unsigned)HALF * g.ldb * 2u;
    const unsigned tstepA = 2u * hstepA, tstepB = 2u * hstepB;
    const unsigned acsb = (unsigned)g.acs * 2u;
    const unsigned ldsw = (unsigned)wid * 1024u, ldsbase = (unsigned)(size_t)lds;
    const int aoff = lds_byte(wr * 64 + fr, fq * 8), boff = lds_byte(wc * 32 + fr, fq * 8);
#define PG8_SA(b, h) (((b) * 2 + (h)) * HTB)
#define PG8_SB(b, h) ((4 + (b) * 2 + (h)) * HTB)
#define PG8_DMA(sbase, voff, ldsdst) do { unsigned _keep; asm volatile("s_mov_b32 %0, m0\n\ts_mov_b32 m0, %3\n\ts_nop 4\n\tglobal_load_lds_dwordx4 %1, %2\n\ts_mov_b32 m0, %0" \
        : "=&s"(_keep) : "v"(voff), "s"(sbase), "s"(ldsdst) : "memory"); } while (0)
#define PG8_STAGE(bufoff, gbase, voff) do { const char* _b0 = (const char*)(gbase); const char* _b1 = _b0 + (&(voff) == &voffA ? d64A : d64B); \
        PG8_DMA(_b0, voff, ldsbase + (unsigned)(bufoff) + ldsw); PG8_DMA(_b1, voff, ldsbase + (unsigned)(bufoff) + ldsw + 8192u); } while (0)
#define PG8_LDA(dst, b, h) do { _Pragma("unroll") for (int m = 0; m < 4; ++m) _Pragma("unroll") for (int k = 0; k < 2; ++k) dst[m][k] = *(const PG8_LAS bf16x8*)(lds + PG8_SA(b, h) + aoff + m * 2048 + k * 1024); } while (0)
#define PG8_LDB(dst, b, h) do { _Pragma("unroll") for (int n = 0; n < 2; ++n) _Pragma("unroll") for (int k = 0; k < 2; ++k) dst[n][k] = *(const PG8_LAS bf16x8*)(lds + PG8_SB(b, h) + boff + n * 2048 + k * 1024); } while (0)
#define PG8_MMA(ai, bj, At, Bt) do { __builtin_amdgcn_s_setprio(1); _Pragma("unroll") for (int m = 0; m < 4; ++m) _Pragma("unroll") for (int n = 0; n < 2; ++n) _Pragma("unroll") for (int k = 0; k < 2; ++k) \
        acc[ai][bj][m][n] = __builtin_amdgcn_mfma_f32_16x16x32_bf16(Bt[n][k], At[m][k], acc[ai][bj][m][n], 0, 0, 0); __builtin_amdgcn_s_setprio(0); } while (0)
#define PG8_WAIT_V(n) asm volatile("s_waitcnt vmcnt(" #n ")" ::: "memory")
#define PG8_WAIT_L(n) asm volatile("s_waitcnt lgkmcnt(" #n ")" ::: "memory")
#define PG8_BAR __builtin_amdgcn_s_barrier()
#define PG8_SCHED __builtin_amdgcn_sched_barrier(0)
    Unit cur, nxt; int ui = 0;
    if (!S.next(0, cur)) return;
    f32x4 acc[2][2][4][2];
#pragma unroll
    for (int a = 0; a < 2; ++a)
#pragma unroll
        for (int b = 0; b < 2; ++b)
#pragma unroll
            for (int m = 0; m < 4; ++m)
#pragma unroll
                for (int n = 0; n < 2; ++n) acc[a][b][m][n] = (f32x4){0.f, 0.f, 0.f, 0.f};
    bf16x8 At[4][2], B0[2][2], B1[2][2];
    const char* cA = (const char*)g.A + ((unsigned)cur.pm * tstepA + (unsigned)cur.pn * acsb); const char* cB = (const char*)g.Bt + (unsigned)cur.pn * tstepB;
    PG8_STAGE(PG8_SB(0, 0), cB, voffB); PG8_STAGE(PG8_SB(0, 1), cB + hstepB, voffB); PG8_STAGE(PG8_SA(0, 0), cA, voffA); PG8_STAGE(PG8_SA(0, 1), cA + hstepA, voffA);
    if (wr == 1) PG8_BAR;
    PG8_WAIT_V(2); PG8_BAR;
    PG8_STAGE(PG8_SB(1, 0), cB + kstep, voffB); PG8_STAGE(PG8_SA(1, 0), cA + kstep, voffA); PG8_STAGE(PG8_SB(1, 1), cB + hstepB + kstep, voffB);
    PG8_WAIT_V(6); PG8_BAR;
    for (;;) {
        const bool has_next = S.next(ui + 1, nxt);
        const char* nA = has_next ? (const char*)g.A + ((unsigned)nxt.pm * tstepA + (unsigned)nxt.pn * acsb) : cA; const char* nB = has_next ? (const char*)g.Bt + (unsigned)nxt.pn * tstepB : cB;
        for (int t = 0; t < nt; t += 2) {
            const bool last = (t == nt - 2);
            const char* a1 = cA + (unsigned)(t + 1) * kstep;
            const char* a2 = last ? nA : cA + (unsigned)(t + 2) * kstep; const char* b2 = last ? nB : cB + (unsigned)(t + 2) * kstep;
            const char* a3 = a2 + kstep; const char* b3 = b2 + kstep;
            PG8_LDB(B0, 0, 0); PG8_LDB(B1, 0, 1); PG8_SCHED; PG8_LDA(At, 0, 0); PG8_STAGE(PG8_SA(1, 1), a1 + hstepA, voffA);
            PG8_WAIT_V(8); PG8_WAIT_L(0); PG8_BAR; PG8_MMA(0, 0, At, B0); PG8_MMA(0, 1, At, B1); PG8_BAR; PG8_SCHED;
            PG8_LDA(At, 0, 1); PG8_STAGE(PG8_SB(0, 0), b2, voffB); PG8_STAGE(PG8_SB(0, 1), b2 + hstepB, voffB); PG8_STAGE(PG8_SA(0, 0), a2, voffA);
            PG8_WAIT_V(8); PG8_WAIT_L(0); PG8_BAR; PG8_MMA(1, 0, At, B0); PG8_MMA(1, 1, At, B1); PG8_BAR; PG8_SCHED;
            PG8_LDB(B0, 1, 0); PG8_LDB(B1, 1, 1); PG8_SCHED; PG8_LDA(At, 1, 0); PG8_STAGE(PG8_SA(0, 1), a2 + hstepA, voffA);
            PG8_WAIT_V(8); PG8_WAIT_L(0); PG8_BAR; PG8_MMA(0, 0, At, B0); PG8_MMA(0, 1, At, B1); PG8_BAR; PG8_SCHED;
            PG8_LDA(At, 1, 1); PG8_STAGE(PG8_SB(1, 0), b3, voffB); PG8_STAGE(PG8_SB(1, 1), b3 + hstepB, voffB); PG8_STAGE(PG8_SA(1, 0), a3, voffA);
            PG8_WAIT_V(8); PG8_WAIT_L(0); PG8_BAR; PG8_MMA(1, 0, At, B0); PG8_MMA(1, 1, At, B1); PG8_BAR; PG8_SCHED;
        }
        if (wr == 0) PG8_BAR;
        { const int l2 = lane_id_fresh(); E(acc, cur, wr, wc, l2 & 15, l2 >> 4); }
        if (!has_next) break;
#pragma unroll
        for (int a = 0; a < 2; ++a)
#pragma unroll
            for (int b = 0; b < 2; ++b)
#pragma unroll
                for (int m = 0; m < 4; ++m)
#pragma unroll
                    for (int n = 0; n < 2; ++n) acc[a][b][m][n] = (f32x4){0.f, 0.f, 0.f, 0.f};
        cur = nxt; cA = nA; cB = nB; ++ui;
        if (wr == 1) PG8_BAR;
    }
    PG8_WAIT_V(0);
    PG8_BAR;
#undef PG8_SA
#undef PG8_SB
#undef PG8_STAGE
#undef PG8_LDA
#undef PG8_LDB
#undef PG8_MMA
#undef PG8_WAIT_V
#undef PG8_WAIT_L
#undef PG8_BAR
#undef PG8_SCHED
}
}

#define GAS __attribute__((address_space(1)))
#define LAS __attribute__((address_space(3)))
typedef unsigned short bf16;
typedef unsigned v4u __attribute__((ext_vector_type(4)));
typedef unsigned v2u __attribute__((ext_vector_type(2)));
typedef float f32x4 __attribute__((ext_vector_type(4)));
typedef float f32x2 __attribute__((ext_vector_type(2)));
typedef float f32x16 __attribute__((ext_vector_type(16)));
typedef short bf16x8 __attribute__((ext_vector_type(8)));
typedef __bf16 bf16x2_t __attribute__((ext_vector_type(2)));
typedef _Float16 half2_t __attribute__((ext_vector_type(2)));
__device__ __forceinline__ unsigned pkh2(float lo, float hi) { f32x2 v = {lo, hi}; half2_t h = __builtin_convertvector(v, half2_t); return __builtin_bit_cast(unsigned, h); }
__device__ __forceinline__ float hlo(unsigned u) { return (float)__builtin_bit_cast(half2_t, u)[0]; }
__device__ __forceinline__ float hhi(unsigned u) { return (float)__builtin_bit_cast(half2_t, u)[1]; }
typedef GAS unsigned gu32;
#define RLX_AGENT __ATOMIC_RELAXED, __HIP_MEMORY_SCOPE_AGENT
#define SWZ(o) (((o) << 10) | 0x1f)
#define LDS_WAIT() asm volatile("s_waitcnt lgkmcnt(0)" ::: "memory")
#define VM_WAIT() asm volatile("s_waitcnt vmcnt(0)" ::: "memory")
__device__ __forceinline__ unsigned pk2(float lo, float hi) { f32x2 v = {lo, hi}; bf16x2_t b = __builtin_convertvector(v, bf16x2_t); return __builtin_bit_cast(unsigned, b); }
__device__ __forceinline__ float bflo(unsigned u) { return __builtin_bit_cast(float, u << 16); }
__device__ __forceinline__ float bfhi(unsigned u) { return __builtin_bit_cast(float, u & 0xffff0000u); }
__device__ __forceinline__ float dot2bf(unsigned a, unsigned b, float acc) { return __builtin_amdgcn_fdot2_f32_bf16(__builtin_bit_cast(bf16x2_t, a), __builtin_bit_cast(bf16x2_t, b), acc, false); }
template <int CTRL> __device__ __forceinline__ float dppf(float v) { return __builtin_bit_cast(float, __builtin_amdgcn_update_dpp(0, __builtin_bit_cast(int, v), CTRL, 0xf, 0xf, true)); }
__device__ __forceinline__ float wave_sum(float v, int lane) {
    v += shx<1>(v, lane); v += shx<2>(v, lane); v += shx<4>(v, lane); v += shx<8>(v, lane); v += shx<16>(v, lane); v += shx<32>(v, lane);
    return v;
}


__device__ __forceinline__ float row_rinv(const float* ssq16, int r, float invdim) {
    const f32x4* p = (const f32x4*)(ssq16 + (size_t)r * 16); const f32x4 a = p[0], b = p[1], c = p[2], d = p[3];
    const float s = ((a[0] + a[1]) + (a[2] + a[3])) + ((b[0] + b[1]) + (b[2] + b[3])) + (((c[0] + c[1]) + (c[2] + c[3])) + ((d[0] + d[1]) + (d[2] + d[3])));
    return __builtin_amdgcn_rsqf(s * invdim + 1e-6f);
}

#define XB_TMO      128
#define XB_XCNT(j)  (256  + 64 * (j))
#define XB_XSUB(j)  (1280 + 64 * (j))
#define XB_XGEN(j)  (2304 + 64 * (j))
#define XB_TOP      3328
#define XB_TOPGEN   3392
#define XCD_BAR_WORDS 3456
#define XB_SPIN_CAP (1u << 18)

__device__ __forceinline__ unsigned xb_ld(unsigned* p)              { return __hip_atomic_load(p, __ATOMIC_RELAXED, __HIP_MEMORY_SCOPE_AGENT); }
__device__ __forceinline__ unsigned xb_add(unsigned* p, unsigned v) { return __hip_atomic_fetch_add(p, v, __ATOMIC_RELAXED, __HIP_MEMORY_SCOPE_AGENT); }
__device__ __forceinline__ unsigned xb_xcc_id() { return (unsigned)__builtin_amdgcn_s_getreg((3 << 11) | 20) & 0xFu; }
#define XB_SPIN(cond, bar) do { unsigned _sp = 0; while (cond) { __builtin_amdgcn_s_sleep(1); \
    if ((++_sp & 255u) == 0u) { if (xb_ld(&(bar)[XB_TMO])) break; if (_sp > XB_SPIN_CAP) { atomicAdd(&(bar)[XB_TMO], 1u); break; } } } } while (0)

struct XcdBarrier {
    unsigned* bar; unsigned x;
    volatile LAS unsigned* st;
};
__device__ __forceinline__ XcdBarrier xcd_barrier_post(unsigned* bar, volatile LAS unsigned* st, bool t0) {
    XcdBarrier b; b.bar = bar; b.x = xb_xcc_id(); b.st = st;
    if (t0) (void)xb_add(&bar[XB_XCNT(b.x)], 1u);
    return b;
}
__device__ __forceinline__ void xcd_barrier_complete(unsigned* bar, unsigned x, unsigned& nloc, unsigned& nx) {
    const unsigned G = gridDim.x * gridDim.y * gridDim.z;
    unsigned sum, cnt, mine, sp = 0u;
    for (;;) {
        sum = 0u; cnt = 0u; mine = 0u;
#pragma unroll
        for (unsigned j = 0; j < 16; ++j) { const unsigned c = xb_ld(&bar[XB_XCNT(j)]); sum += c; cnt += (c > 0u) ? 1u : 0u; mine = (j == x) ? c : mine; }
        if (sum == G) break;
        __builtin_amdgcn_s_sleep(1);
        if ((++sp & 255u) == 0u) { if (xb_ld(&bar[XB_TMO])) break; if (sp > XB_SPIN_CAP) { atomicAdd(&bar[XB_TMO], 1u); break; } }
    }
    nloc = mine > 0u ? mine : 1u; nx = cnt > 0u ? cnt : 1u;
}
__device__ __forceinline__ void xcd_barrier(const XcdBarrier& b, bool t0) {
    asm volatile("s_waitcnt vmcnt(0)" ::: "memory");
    __syncthreads();
    if (t0) {
        unsigned* bar = b.bar;
        __builtin_amdgcn_s_waitcnt(0);
        unsigned nloc = b.st[0], nx = b.st[1];
        if (nloc == 0u) { xcd_barrier_complete(bar, b.x, nloc, nx); b.st[0] = nloc; b.st[1] = nx; }
        const unsigned old = xb_add(&bar[XB_XSUB(b.x)], 1u);
        const unsigned gen = old / nloc;
        if (old + 1u == (gen + 1u) * nloc) {
            __builtin_amdgcn_fence(__ATOMIC_RELEASE, "agent");
            asm volatile("s_waitcnt vmcnt(0)" ::: "memory");
            const unsigned og = xb_add(&bar[XB_TOP], 1u);
            const unsigned tg = og / nx;
            if (og + 1u == (tg + 1u) * nx) xb_add(&bar[XB_TOPGEN], 1u);
            else XB_SPIN(xb_ld(&bar[XB_TOPGEN]) == tg, bar);
            __builtin_amdgcn_fence(__ATOMIC_ACQUIRE, "agent");
            xb_add(&bar[XB_XGEN(b.x)], 1u);
            asm volatile("s_waitcnt vmcnt(0)" ::: "memory");
        } else {
            XB_SPIN(xb_ld(&bar[XB_XGEN(b.x)]) == gen, bar);
            __builtin_amdgcn_fence(__ATOMIC_ACQUIRE, "agent");
            asm volatile("s_waitcnt vmcnt(0)" ::: "memory");
        }
    }
    __syncthreads();
}

constexpr int NWAVES = 8, NTHR = 512;
constexpr int T = 32768, D = 1024, NBATCH = 8, SEQ = 4096, DEPTH = 4;
constexpr int NHEAD = 8, QKN = 128, QKR = 64, DQK = 192, VH = 128, QRANK = 768, KVRANK = 256;
constexpr int NKEYS = 128, NEXP = 16384, PTOPK = 16, PLE = 256;
constexpr float EPS = 1e-6f;
constexpr float C2 = 0.07216878364870322f * 1.4426950408889634f;

constexpr size_t MiB = 1u << 20;
constexpr size_t WS_CTL = 0, CTL_ZERO_BYTES = 64 * 1024;
constexpr size_t WS_SSQ = 840 * MiB;
constexpr size_t WS_COS = 3 * MiB, WS_SIN = 7 * MiB;
constexpr size_t WS_W = 11 * MiB;
constexpr size_t W_WEFF = WS_W;
constexpr size_t W_WG = W_WEFF + 16 * MiB;
constexpr size_t W_WP = W_WG + 8 * MiB;
constexpr size_t W_POOL = W_WP + 2 * MiB;
constexpr size_t W_DOWN2 = W_POOL + 1 * MiB;
constexpr size_t W_DOWN3 = W_DOWN2 + 2560 * 1024;
constexpr size_t W_KNW = W_DOWN3 + 1536 * 1024;
constexpr size_t W_VW = W_KNW + 512 * 1024;
constexpr size_t W_UQ = W_VW + 512 * 1024;
constexpr size_t W_WO = W_UQ + 4608 * 1024;
constexpr size_t WS_WEND = W_WO + 4 * MiB;
constexpr size_t WS_X = 52 * MiB;
constexpr size_t WS_XBA = 180 * MiB, WS_XBB = 244 * MiB;
constexpr size_t WS_UV = 308 * MiB;
constexpr size_t WS_UVS = 340 * MiB;
constexpr size_t WS_UV2 = 52 * MiB, WS_UVS2 = 84 * MiB;
__host__ __device__ constexpr size_t tab_off(int set) { return set ? WS_UV2 : WS_UV; }
__host__ __device__ constexpr size_t tabs_off(int set) { return set ? WS_UVS2 : WS_UVS; }
constexpr size_t WS_PB = 372 * MiB;
constexpr size_t WS_PP = 388 * MiB;
constexpr size_t WS_KN = 452 * MiB;
constexpr size_t WS_VT = 516 * MiB;
constexpr size_t WS_KPE = 580 * MiB;
constexpr size_t WS_R1 = 584 * MiB;
constexpr size_t WS_S = WS_R1;
constexpr size_t WS_POOLED = WS_R1;
constexpr size_t WS_Q = WS_R1;
constexpr size_t WS_AO = WS_R1 + 96 * MiB;
constexpr size_t WS_CQ = WS_R1 + 160 * MiB;
constexpr size_t WS_CKV = WS_R1 + 208 * MiB;
constexpr size_t WS_IDX = 872 * MiB;
constexpr size_t WS_GW = 880 * MiB, WS_MU = 896 * MiB;
constexpr size_t WS_PART = WS_R1;
constexpr size_t WS_WW = WS_R1 + 128 * MiB;
constexpr size_t WS_END = 912 * MiB;
constexpr size_t SSQ_ARR = (size_t)32768 * 16;
static_assert(WS_WEND <= WS_X, "weights");

constexpr int RING_BYTES = 139264;
constexpr int MISC_OFF = RING_BYTES + 320;
constexpr int LDS_BYTES = 147456;

namespace epi {
using pg8::Unit; using pg8::cvt_pk_bf16;
typedef float f32x4 __attribute__((ext_vector_type(4)));
typedef unsigned u32x4 __attribute__((ext_vector_type(4)));
typedef unsigned u32x2 __attribute__((ext_vector_type(2)));
__device__ __forceinline__ float dot4(f32x4 v) { return (v[0] * v[0] + v[1] * v[1]) + (v[2] * v[2] + v[3] * v[3]); }
__device__ __forceinline__ void rinv8(const float* ssq, int rbase, int fr, int fq, float invdim, float (&ri)[8]) {
    f32x4 q[8];
#pragma unroll
    for (int k = 0; k < 8; ++k) q[k] = *(const f32x4*)(ssq + (size_t)(rbase + (k >> 2) * 128 + (k & 3) * 16) * 16 + 4 * fq);
#pragma unroll
    for (int k = 0; k < 8; ++k) { float s = (q[k][0] + q[k][1]) + (q[k][2] + q[k][3]); s += shx<16>(s, fq * 16 + fr); s += shx<32>(s, fq * 16 + fr); ri[k] = __builtin_amdgcn_rsqf(s * invdim + 1e-6f); }
}

struct Resid {
    static constexpr bool PERM = true;
    bf16* XB; float* ssq_out;
    __device__ __forceinline__ void operator()(const f32x4 (&acc)[2][2][4][2], const Unit& u, int wr, int wc, int fr, int fq) const {
        const int col0 = u.pn * 256 + wc * 32 + 8 * fq;
        float sv[8]; u32x4 xo[8][2];
        bf16* const b0 = XB + (size_t)(u.pm * 256 + wr * 64 + fr) * D + col0;
#define EPI_ROW(k) (b0 + (size_t)(((k) >> 2) * 128 + ((k) & 3) * 16) * D)
#define EPI_LOAD(k) do { xo[k][0] = *(const u32x4*)EPI_ROW(k); xo[k][1] = *(const u32x4*)(EPI_ROW(k) + 128); } while (0)
        EPI_LOAD(0); EPI_LOAD(1); EPI_LOAD(2);
#pragma unroll
        for (int k = 0; k < 8; ++k) { const int ai = k >> 2, m = k & 3; float s = 0.f;
            if (k + 3 < 8) EPI_LOAD(k + 3);
#pragma unroll
            for (int bj = 0; bj < 2; ++bj) { const u32x4 x = xo[k][bj];
                const f32x4 v0 = (f32x4){bflo(x.x), bfhi(x.x), bflo(x.y), bfhi(x.y)} + acc[ai][bj][m][0], v1 = (f32x4){bflo(x.z), bfhi(x.z), bflo(x.w), bfhi(x.w)} + acc[ai][bj][m][1];
                u32x4 w; w.x = cvt_pk_bf16(v0[0], v0[1]); w.y = cvt_pk_bf16(v0[2], v0[3]); w.z = cvt_pk_bf16(v1[0], v1[1]); w.w = cvt_pk_bf16(v1[2], v1[3]); *(u32x4*)(EPI_ROW(k) + bj * 128) = w;
                s += dot4(v0) + dot4(v1); }
            s += shx<16>(s, fq * 16 + fr); s += shx<32>(s, fq * 16 + fr); sv[k] = s;
        }
#undef EPI_LOAD
#undef EPI_ROW
        if (fq == 0) {
#pragma unroll
            for (int k = 0; k < 8; ++k) ssq_out[(size_t)(u.pm * 256 + (k >> 2) * 128 + wr * 64 + (k & 3) * 16 + fr) * 16 + u.pn * 4 + wc] = sv[k]; }
    }
};
struct Score {
    static constexpr bool PERM = true;
    unsigned short* S; int ldc; const float* ssq;
    __device__ __forceinline__ void operator()(const f32x4 (&acc)[2][2][4][2], const Unit& u, int wr, int wc, int fr, int fq) const {
        const int col0 = u.pn * 256 + wc * 32 + 8 * fq;
        float ri8[8]; rinv8(ssq, u.pm * 256 + wr * 64 + fr, fr, fq, 1.f / D, ri8);
#pragma unroll
        for (int ai = 0; ai < 2; ++ai)
#pragma unroll
            for (int m = 0; m < 4; ++m) {
                const int r = u.pm * 256 + ai * 128 + wr * 64 + m * 16 + fr; const float ri = ri8[ai * 4 + m];
                unsigned short* sr = S + (size_t)r * ldc + col0;
#pragma unroll
                for (int bj = 0; bj < 2; ++bj) { const f32x4 v0 = acc[ai][bj][m][0] * ri, v1 = acc[ai][bj][m][1] * ri; u32x4 w;
                    w.x = pkh2(v0[0], v0[1]); w.y = pkh2(v0[2], v0[3]); w.z = pkh2(v1[0], v1[1]); w.w = pkh2(v1[2], v1[3]); *(u32x4*)(sr + bj * 128) = w; }
            }
    }
};
struct Bf16Row {
    static constexpr bool PERM = true;
    bf16* O; int ldc; const float* ssq; float invdim;
    __device__ __forceinline__ void operator()(const f32x4 (&acc)[2][2][4][2], const Unit& u, int wr, int wc, int fr, int fq) const {
        const int col0 = u.pn * 256 + wc * 32 + 8 * fq;
        float ri8[8];
        if (ssq) rinv8(ssq, u.pm * 256 + wr * 64 + fr, fr, fq, invdim, ri8);
        else {
#pragma unroll
            for (int k = 0; k < 8; ++k) ri8[k] = 1.f; }
#pragma unroll
        for (int ai = 0; ai < 2; ++ai)
#pragma unroll
            for (int m = 0; m < 4; ++m) {
                const int r = u.pm * 256 + ai * 128 + wr * 64 + m * 16 + fr; const float ri = ri8[ai * 4 + m];
                bf16* orow = O + (size_t)r * ldc + col0;
#pragma unroll
                for (int bj = 0; bj < 2; ++bj) { const f32x4 v0 = acc[ai][bj][m][0] * ri, v1 = acc[ai][bj][m][1] * ri; u32x4 w;
                    w.x = cvt_pk_bf16(v0[0], v0[1]); w.y = cvt_pk_bf16(v0[2], v0[3]); w.z = cvt_pk_bf16(v1[0], v1[1]); w.w = cvt_pk_bf16(v1[2], v1[3]); *(u32x4*)(orow + bj * 128) = w; }
            }
    }
};
struct VTCol {
    static constexpr bool PERM = true;
    bf16* O; const float* ssq; float invdim;
    __device__ __forceinline__ void operator()(const f32x4 (&acc)[2][2][4][2], const Unit& u, int wr, int wc, int fr, int fq) const {
        const int col0 = u.pn * 256 + wc * 32 + 8 * fq;
#pragma unroll
        for (int bj = 0; bj < 2; ++bj) {
            f32x4 sc0, sc1;
#pragma unroll
            for (int j = 0; j < 4; ++j) { sc0[j] = row_rinv(ssq, col0 + bj * 128 + j, invdim); sc1[j] = row_rinv(ssq, col0 + bj * 128 + 4 + j, invdim); }
#pragma unroll
            for (int ai = 0; ai < 2; ++ai)
#pragma unroll
                for (int m = 0; m < 4; ++m) {
                    const int r = u.pm * 256 + ai * 128 + wr * 64 + m * 16 + fr;
                    const f32x4 v0 = acc[ai][bj][m][0] * sc0, v1 = acc[ai][bj][m][1] * sc1; u32x4 w;
                    w.x = cvt_pk_bf16(v0[0], v0[1]); w.y = cvt_pk_bf16(v0[2], v0[3]); w.z = cvt_pk_bf16(v1[0], v1[1]); w.w = cvt_pk_bf16(v1[2], v1[3]);
                    *(u32x4*)(O + (size_t)r * T + col0 + bj * 128) = w;
                }
        }
    }
};
struct Gate {
    static constexpr bool PERM = true;
    const bf16* XBc; bf16* XBn; const bf16* PP; const float* ssq; float* ssq_out;
    __device__ __forceinline__ void operator()(const f32x4 (&acc)[2][2][4][2], const Unit& u, int wr, int wc, int fr, int fq) const {
        const int col0 = u.pn * 256 + wc * 32 + 8 * fq;
        float ri8[8], sv[8]; rinv8(ssq, u.pm * 256 + wr * 64 + fr, fr, fq, 1.f / D, ri8);
        u32x4 xo[8][2], pw[8][2];
        const size_t o0 = (size_t)(u.pm * 256 + wr * 64 + fr) * D + col0;
#define EPI_OFF(k) (o0 + (size_t)(((k) >> 2) * 128 + ((k) & 3) * 16) * D)
#define EPI_LOAD(k) do { xo[k][0] = *(const u32x4*)(XBc + EPI_OFF(k)); pw[k][0] = *(const u32x4*)(PP + EPI_OFF(k)); xo[k][1] = *(const u32x4*)(XBc + EPI_OFF(k) + 128); pw[k][1] = *(const u32x4*)(PP + EPI_OFF(k) + 128); } while (0)
        EPI_LOAD(0); EPI_LOAD(1); EPI_LOAD(2);
#pragma unroll
        for (int k = 0; k < 8; ++k) { const int ai = k >> 2, m = k & 3; const float ri = ri8[k]; float s = 0.f;
            if (k + 3 < 8) EPI_LOAD(k + 3);
#pragma unroll
            for (int bj = 0; bj < 2; ++bj) { const u32x4 x = xo[k][bj], p = pw[k][bj];
                const f32x4 z0 = acc[ai][bj][m][0] * ri, z1 = acc[ai][bj][m][1] * ri; f32x4 g0, g1;
#pragma unroll
                for (int j = 0; j < 4; ++j) { g0[j] = __builtin_amdgcn_rcpf(1.f + __builtin_amdgcn_exp2f(-1.4426950408889634f * z0[j])); g1[j] = __builtin_amdgcn_rcpf(1.f + __builtin_amdgcn_exp2f(-1.4426950408889634f * z1[j])); }
                const f32x4 v0 = (f32x4){bflo(x.x), bfhi(x.x), bflo(x.y), bfhi(x.y)} + g0 * (f32x4){bflo(p.x), bfhi(p.x), bflo(p.y), bfhi(p.y)};
                const f32x4 v1 = (f32x4){bflo(x.z), bfhi(x.z), bflo(x.w), bfhi(x.w)} + g1 * (f32x4){bflo(p.z), bfhi(p.z), bflo(p.w), bfhi(p.w)};
                u32x4 w; w.x = cvt_pk_bf16(v0[0], v0[1]); w.y = cvt_pk_bf16(v0[2], v0[3]); w.z = cvt_pk_bf16(v1[0], v1[1]); w.w = cvt_pk_bf16(v1[2], v1[3]); *(u32x4*)(XBn + EPI_OFF(k) + bj * 128) = w;
                s += dot4(v0) + dot4(v1); }
            s += shx<16>(s, fq * 16 + fr); s += shx<32>(s, fq * 16 + fr); sv[k] = s;
        }
#undef EPI_LOAD
#undef EPI_OFF
        if (fq == 0) {
#pragma unroll
            for (int k = 0; k < 8; ++k) ssq_out[(size_t)(u.pm * 256 + (k >> 2) * 128 + wr * 64 + (k & 3) * 16 + fr) * 16 + u.pn * 4 + wc] = sv[k]; }
    }
};
struct Down {
    static constexpr bool PERM = true;
    bf16* CQ; bf16* CKV; bf16* KPE; const float* ssq; float* ssq_q; float* ssq_kv; const float* COS; const float* SIN;
    __device__ __forceinline__ void operator()(const f32x4 (&acc)[2][2][4][2], const Unit& u, int wr, int wc, int fr, int fq) const {
        const int tc0 = wc * 32 + 8 * fq;
        float ri8[8], sv[8]; rinv8(ssq, u.pm * 256 + wr * 64 + fr, fr, fq, 1.f / D, ri8);
#pragma unroll
        for (int k = 0; k < 8; ++k) sv[k] = 0.f;
#pragma unroll
        for (int ai = 0; ai < 2; ++ai)
#pragma unroll
            for (int m = 0; m < 4; ++m) {
                const int r = u.pm * 256 + ai * 128 + wr * 64 + m * 16 + fr; const float ri = ri8[ai * 4 + m];
                if (u.pn < 4) {
                    bf16* orow = (u.pn < 3) ? CQ + (size_t)r * QRANK + u.pn * 256 + tc0 : CKV + (size_t)r * KVRANK + tc0; float s = 0.f;
#pragma unroll
                    for (int bj = 0; bj < 2; ++bj) { const f32x4 v0 = acc[ai][bj][m][0] * ri, v1 = acc[ai][bj][m][1] * ri; u32x4 w;
                        w.x = cvt_pk_bf16(v0[0], v0[1]); w.y = cvt_pk_bf16(v0[2], v0[3]); w.z = cvt_pk_bf16(v1[0], v1[1]); w.w = cvt_pk_bf16(v1[2], v1[3]); *(u32x4*)(orow + bj * 128) = w;
                        s += dot4(v0) + dot4(v1); }
                    s += shx<16>(s, fq * 16 + fr); s += shx<32>(s, fq * 16 + fr); sv[ai * 4 + m] = s;
                } else if (wc < 2) {
                    const f32x4 cs = *(const f32x4*)(COS + (size_t)r * 32 + wc * 16 + 4 * fq), sn = *(const f32x4*)(SIN + (size_t)r * 32 + wc * 16 + 4 * fq);
                    const f32x4 v0 = acc[ai][0][m][0] * ri, v1 = acc[ai][0][m][1] * ri; u32x4 w;
                    w.x = cvt_pk_bf16(v0[0] * cs[0] - v0[1] * sn[0], v0[1] * cs[0] + v0[0] * sn[0]);
                    w.y = cvt_pk_bf16(v0[2] * cs[1] - v0[3] * sn[1], v0[3] * cs[1] + v0[2] * sn[1]);
                    w.z = cvt_pk_bf16(v1[0] * cs[2] - v1[1] * sn[2], v1[1] * cs[2] + v1[0] * sn[2]);
                    w.w = cvt_pk_bf16(v1[2] * cs[3] - v1[3] * sn[3], v1[3] * cs[3] + v1[2] * sn[3]);
                    *(u32x4*)(KPE + (size_t)r * QKR + tc0) = w;
                }
            }
        if (u.pn < 4 && fq == 0) {
            float* const so = (u.pn < 3) ? ssq_q + u.pn * 4 + wc : ssq_kv + wc;
#pragma unroll
            for (int k = 0; k < 8; ++k) so[(size_t)(u.pm * 256 + (k >> 2) * 128 + wr * 64 + (k & 3) * 16 + fr) * 16] = sv[k]; }
    }
};
struct QUp {
    static constexpr bool PERM = true;
    bf16* Q; const float* ssq_q; const float* COS; const float* SIN;
    __device__ __forceinline__ void operator()(const f32x4 (&acc)[2][2][4][2], const Unit& u, int wr, int wc, int fr, int fq) const {
        float ri8[8]; rinv8(ssq_q, u.pm * 256 + wr * 64 + fr, fr, fq, 1.f / QRANK, ri8);
        const int r0 = u.pm * 256 + wr * 64 + fr;
#pragma unroll
        for (int bj = 0; bj < 2; ++bj) {
            const int c0w = u.pn * 256 + bj * 128 + wc * 32, c8 = c0w + 8 * fq;
            if ((c0w % DQK) >= QKN) {
                const int pb = ((c8 % DQK) - QKN) >> 1;
                f32x4 cs[8], sn[8];
#pragma unroll
                for (int k = 0; k < 8; ++k) { const size_t ro = (size_t)(r0 + (k >> 2) * 128 + (k & 3) * 16) * 32 + pb; cs[k] = *(const f32x4*)(COS + ro); sn[k] = *(const f32x4*)(SIN + ro); }
#pragma unroll
                for (int k = 0; k < 8; ++k) { const int ai = k >> 2, m = k & 3; const float ri = ri8[k];
                    const f32x4 v0 = acc[ai][bj][m][0] * ri, v1 = acc[ai][bj][m][1] * ri; u32x4 w;
                    w.x = cvt_pk_bf16(v0[0] * cs[k][0] - v0[1] * sn[k][0], v0[1] * cs[k][0] + v0[0] * sn[k][0]);
                    w.y = cvt_pk_bf16(v0[2] * cs[k][1] - v0[3] * sn[k][1], v0[3] * cs[k][1] + v0[2] * sn[k][1]);
                    w.z = cvt_pk_bf16(v1[0] * cs[k][2] - v1[1] * sn[k][2], v1[1] * cs[k][2] + v1[0] * sn[k][2]);
                    w.w = cvt_pk_bf16(v1[2] * cs[k][3] - v1[3] * sn[k][3], v1[3] * cs[k][3] + v1[2] * sn[k][3]);
                    *(u32x4*)(Q + (size_t)(r0 + ai * 128 + m * 16) * (NHEAD * DQK) + c8) = w; }
            } else {
#pragma unroll
                for (int k = 0; k < 8; ++k) { const int ai = k >> 2, m = k & 3; const float ri = ri8[k];
                    const f32x4 v0 = acc[ai][bj][m][0] * ri, v1 = acc[ai][bj][m][1] * ri; u32x4 w;
                    w.x = cvt_pk_bf16(v0[0], v0[1]); w.y = cvt_pk_bf16(v0[2], v0[3]); w.z = cvt_pk_bf16(v1[0], v1[1]); w.w = cvt_pk_bf16(v1[2], v1[3]);
                    *(u32x4*)(Q + (size_t)(r0 + ai * 128 + m * 16) * (NHEAD * DQK) + c8) = w; }
            }
        }
    }
};
struct Null {
    static constexpr bool PERM = true;
    float* O;
    __device__ __forceinline__ void operator()(const f32x4 (&acc)[2][2][4][2], const Unit& u, int wr, int wc, int fr, int fq) const {
        f32x4 s = {0.f, 0.f, 0.f, 0.f};
#pragma unroll
        for (int ai = 0; ai < 2; ++ai)
#pragma unroll
            for (int bj = 0; bj < 2; ++bj)
#pragma unroll
                for (int m = 0; m < 4; ++m) s += acc[ai][bj][m][0] + acc[ai][bj][m][1];
        O[(size_t)(u.pm * 8 + u.pn) * 512 + (wr * 4 + wc) * 64 + fq * 16 + fr] = (s[0] + s[1]) + (s[2] + s[3]);
    }
};
}

struct TJob { const float* W; int ldw; int K; int Nout; bf16* out; int mode; const float* rs; const float* cs; float cmul; };
__device__ __forceinline__ int tj_src(int mode, int n) {
    if (mode == 1) { if (n < KVRANK) return n; const int rr = n - KVRANK; return KVRANK + (rr >> 1) + 32 * (rr & 1); }
    if (mode == 2) { const int hd = n / DQK, r = n % DQK; if (r < QKN) return n; const int rr = r - QKN; return hd * DQK + QKN + (rr >> 1) + 32 * (rr & 1); }
    if (mode == 3) return (n >> 7) * 256 + (n & 127);
    if (mode == 4) return (n >> 7) * 256 + 128 + (n & 127);
    return n;
}
__device__ __forceinline__ void transpose_tile(const TJob& j, LAS float* scr, int tile, int tid) {
    const int nkt = j.K >> 6, n0 = (tile / nkt) * 64, k0 = (tile % nkt) * 64;
    { const int nn = tid & 63; const int src = (j.mode == 5) ? -1 : tj_src(j.mode, n0 + nn);
      const float csv = (j.cs ? j.cs[n0 + nn] : 1.f) * j.cmul;
#pragma unroll
      for (int i = 0; i < 8; ++i) { const int kk = (tid >> 6) + 8 * i; float v = 0.f;
          if (src >= 0) v = j.W[(size_t)(k0 + kk) * j.ldw + src] * (j.rs ? j.rs[k0 + kk] : 1.f) * csv;
          scr[kk * 65 + nn] = v; } }
    __syncthreads();
    { const int kk2 = (tid & 31) * 2;
#pragma unroll
      for (int i = 0; i < 4; ++i) { const int nn2 = (tid >> 5) + 16 * i;
          *(unsigned*)(j.out + (size_t)(n0 + nn2) * j.K + k0 + kk2) = pk2(scr[kk2 * 65 + nn2], scr[(kk2 + 1) * 65 + nn2]); } }
    __syncthreads();
}
struct In {
    const float *x, *p; const int* pos; const float *mix_norm, *ffn_norm, *pool_w, *pool_scale, *kv_in_norm, *w_dkv, *kv_norm, *w_ukv, *w_dq, *q_norm, *w_uq, *w_o,
                *peer_wq, *peer_keys, *peer_u, *peer_v, *ple_norm, *ple_wg, *ple_wp, *final_norm;
};
typedef const __attribute__((address_space(4))) In CIn;
__device__ __forceinline__ TJob get_job(int id, CIn& in, unsigned char* ws) {
    TJob j; j.mode = 0; j.rs = nullptr; j.cs = nullptr; j.cmul = 1.f;
    if (id < 4) { j.W = in.ple_wg + (size_t)id * D * D; j.ldw = D; j.K = D; j.Nout = D; j.out = (bf16*)(ws + W_WG) + (size_t)id * D * D; j.rs = in.ple_norm + id * D; }
    else if (id < 8) { const int i = id - 4; j.W = in.ple_wp + (size_t)i * PLE * D; j.ldw = D; j.K = PLE; j.Nout = D; j.out = (bf16*)(ws + W_WP) + (size_t)i * D * PLE; }
    else if (id < 16) { const int i = (id - 8) >> 2, g = (id - 8) & 3; j.W = in.pool_w + (size_t)(i * 4 + g) * 65536; j.ldw = 256; j.K = 256; j.Nout = 256;
        j.out = (bf16*)(ws + W_POOL) + (size_t)(i * 1024 + g * 256) * 256; j.cs = in.pool_scale + i * D + g * 256; }
    else if (id == 16) { j.W = in.w_dq; j.ldw = QRANK; j.K = D; j.Nout = QRANK; j.out = (bf16*)(ws + W_DOWN2); j.rs = in.mix_norm + 2 * D; }
    else if (id == 17) { j.W = in.w_dkv; j.ldw = KVRANK + QKR; j.K = D; j.Nout = KVRANK + QKR; j.out = (bf16*)(ws + W_DOWN2) + (size_t)QRANK * D; j.mode = 1; j.rs = in.kv_in_norm; }
    else if (id == 18) { j.W = in.w_dkv; j.ldw = KVRANK + QKR; j.K = D; j.Nout = 192; j.out = (bf16*)(ws + W_DOWN2) + (size_t)(QRANK + KVRANK + QKR) * D; j.mode = 5; }
    else if (id == 19) { j.W = in.w_dq + (size_t)D * QRANK; j.ldw = QRANK; j.K = D; j.Nout = QRANK; j.out = (bf16*)(ws + W_DOWN3); j.rs = in.mix_norm + 3 * D; }
    else if (id == 20) { j.W = in.w_ukv; j.ldw = 2048; j.K = KVRANK; j.Nout = 1024; j.out = (bf16*)(ws + W_KNW); j.mode = 3; j.rs = in.kv_norm; }
    else if (id == 21) { j.W = in.w_ukv; j.ldw = 2048; j.K = KVRANK; j.Nout = 1024; j.out = (bf16*)(ws + W_VW); j.mode = 4; j.rs = in.kv_norm; }
    else if (id < 24) { const int jj = id - 22; j.W = in.w_uq + (size_t)jj * QRANK * 1536; j.ldw = 1536; j.K = QRANK; j.Nout = 1536; j.out = (bf16*)(ws + W_UQ) + (size_t)jj * 1536 * QRANK;
        j.mode = 2; j.rs = in.q_norm + jj * QRANK; j.cmul = C2; }
    else { const int jj = id - 24; j.W = in.w_o + (size_t)jj * D * D; j.ldw = D; j.K = D; j.Nout = D; j.out = (bf16*)(ws + W_WO) + (size_t)jj * D * D; }
    return j;
}
constexpr int N_TJOBS = 26;

__device__ __forceinline__ void weff_item(const float* wq, const float* keys, const float* gain, bf16* out, int hp, int kt, LAS float* lds, int tid) {
    constexpr int RS = 136;
    LAS unsigned short* Wh = (LAS unsigned short*)lds; LAS unsigned short* Wl = Wh + 64 * RS; LAS unsigned short* Kh = Wl + 64 * RS; LAS unsigned short* Kl = Kh + 128 * RS;
    const int k0 = kt * 64;
#define WEFF_SPLIT(v, ph, pl) do { v2u h_, l_; h_.x = pk2((v)[0], (v)[1]); h_.y = pk2((v)[2], (v)[3]); \
        l_.x = pk2((v)[0] - bflo(h_.x), (v)[1] - bfhi(h_.x)); l_.y = pk2((v)[2] - bflo(h_.y), (v)[3] - bfhi(h_.y)); *(LAS v2u*)(ph) = h_; *(LAS v2u*)(pl) = l_; } while (0)
#pragma unroll
    for (int i = 0; i < 4; ++i) { const int idx = tid + 512 * i, row = idx >> 5, c4 = idx & 31;
        const f32x4 v = *(const f32x4*)(wq + (size_t)(k0 + row) * 2048 + hp * 128 + c4 * 4) * gain[k0 + row]; WEFF_SPLIT(v, Wh + row * RS + c4 * 4, Wl + row * RS + c4 * 4); }
#pragma unroll
    for (int i = 0; i < 8; ++i) { const int idx = tid + 512 * i, row = idx >> 5, c4 = idx & 31;
        const f32x4 v = *(const f32x4*)(keys + (size_t)(hp * 128 + row) * 128 + c4 * 4); WEFF_SPLIT(v, Kh + row * RS + c4 * 4, Kl + row * RS + c4 * 4); }
#undef WEFF_SPLIT
    __syncthreads();
    const int w = tid >> 6, l = tid & 63, tk = w & 1, tn = w >> 1, r32 = l & 31, g = l >> 5;
    f32x16 acc;
#pragma unroll
    for (int r = 0; r < 16; ++r) acc[r] = 0.f;
    const int ao = (32 * tk + r32) * RS + 8 * g, bo = (32 * tn + r32) * RS + 8 * g;
#pragma unroll
    for (int s8 = 0; s8 < 8; ++s8) {
        const bf16x8 ah = *(const LAS bf16x8*)(Wh + ao + 16 * s8), al = *(const LAS bf16x8*)(Wl + ao + 16 * s8);
        const bf16x8 bh = *(const LAS bf16x8*)(Kh + bo + 16 * s8), bl = *(const LAS bf16x8*)(Kl + bo + 16 * s8);
        acc = __builtin_amdgcn_mfma_f32_32x32x16_bf16(ah, bh, acc, 0, 0, 0);
        acc = __builtin_amdgcn_mfma_f32_32x32x16_bf16(ah, bl, acc, 0, 0, 0);
        acc = __builtin_amdgcn_mfma_f32_32x32x16_bf16(al, bh, acc, 0, 0, 0);
    }
#pragma unroll
    for (int gq = 0; gq < 4; ++gq) { v2u o_; o_.x = pk2(acc[4 * gq + 0], acc[4 * gq + 1]); o_.y = pk2(acc[4 * gq + 2], acc[4 * gq + 3]);
        *(v2u*)(out + (size_t)(hp * 128 + 32 * tn + r32) * D + k0 + 32 * tk + 8 * gq + 4 * g) = o_; }
    __syncthreads();
}

__device__ __forceinline__ void p0_prologue(CIn& in, unsigned char* ws, LAS unsigned char* lds, int bid, int G, int wave) {
    const int tid = wave * 64 + lane_id_fresh();
    const int gtid = bid * NTHR + tid, NT = G * NTHR;
    for (int i = gtid + (int)(SSQ_ARR / 4); i < (int)(16 * SSQ_ARR / 4); i += NT) ((f32x4*)(ws + WS_SSQ))[i] = (f32x4){0.f, 0.f, 0.f, 0.f};
    { int g = bid, base = 0;
      for (int id = 0; id < N_TJOBS; ++id) { const TJob j = get_job(id, in, ws); const int nt = (j.K >> 6) * (j.Nout >> 6);
          for (; g < base + nt; g += G) transpose_tile(j, (LAS float*)lds, g - base, tid);
          base += nt; } }
    for (int it = bid; it < 4 * 16 * 16; it += G) { const int l = it >> 8, hp = (it >> 4) & 15, kt = it & 15;
        weff_item(in.peer_wq + (size_t)l * D * 2048, in.peer_keys + (size_t)l * 2048 * 128, in.ffn_norm + l * D, (bf16*)(ws + W_WEFF) + (size_t)l * 2048 * D, hp, kt, (LAS float*)lds, tid); }
    for (int i = gtid; i < T * 32; i += NT) { const int t = i >> 5, c = i & 31;
        double inv = 0.15915494309189535; for (int k = 0; k < c; ++k) inv *= 0.7498942093324559;
        double rd = (double)in.pos[t] * inv; rd -= __builtin_floor(rd); const float rr = (float)rd;
        ((float*)(ws + WS_COS))[i] = __builtin_amdgcn_cosf(rr); ((float*)(ws + WS_SIN))[i] = __builtin_amdgcn_sinf(rr); }
    { const int lane = tid & 63, gw = gtid >> 6, NW = NT >> 6; bf16* XB = (bf16*)(ws + WS_XBA); float* ssq = (float*)(ws + WS_SSQ);
      for (int r = gw; r < T; r += 2 * NW) { const int r2 = (r + NW < T) ? r + NW : r; f32x4 va[4], vb[4];
#pragma unroll
          for (int j = 0; j < 4; ++j) { va[j] = *(const f32x4*)(in.x + (size_t)r * D + j * 256 + 4 * lane); vb[j] = *(const f32x4*)(in.x + (size_t)r2 * D + j * 256 + 4 * lane); }
          float s = 0.f, s2 = 0.f;
#pragma unroll
          for (int j = 0; j < 4; ++j) { const size_t o = (size_t)r * D + j * 256 + 4 * lane, o2 = (size_t)r2 * D + j * 256 + 4 * lane;
              v2u w; w.x = pk2(va[j][0], va[j][1]); w.y = pk2(va[j][2], va[j][3]); *(v2u*)(XB + o) = w; s += (va[j][0] * va[j][0] + va[j][1] * va[j][1]) + (va[j][2] * va[j][2] + va[j][3] * va[j][3]);
              v2u y; y.x = pk2(vb[j][0], vb[j][1]); y.y = pk2(vb[j][2], vb[j][3]); *(v2u*)(XB + o2) = y; s2 += (vb[j][0] * vb[j][0] + vb[j][1] * vb[j][1]) + (vb[j][2] * vb[j][2] + vb[j][3] * vb[j][3]); }
          s = wave_sum(s, lane); s2 = wave_sum(s2, lane);
          if (lane < 16) { ssq[(size_t)r * 16 + lane] = (lane == 0) ? s : 0.f; ssq[(size_t)r2 * 16 + lane] = (lane == 0) ? s2 : 0.f; } } }
}
typedef float f2_t __attribute__((ext_vector_type(2)));
template <int CTRL> __device__ __forceinline__ int dppi(int v) { return __builtin_amdgcn_update_dpp(0, v, CTRL, 0xf, 0xf, true); }
__device__ __forceinline__ unsigned wave_max_dpp(unsigned v) {
    v = max(v, (unsigned)dppi<0xB1>((int)v)); v = max(v, (unsigned)dppi<0x4E>((int)v)); v = max(v, (unsigned)dppi<0x141>((int)v)); v = max(v, (unsigned)dppi<0x140>((int)v));
    { unsigned p = v, q = v; asm volatile("s_nop 1\n\tv_permlane16_swap_b32 %0, %1" : "+v"(p), "+v"(q)); v = max(p, q); }
    { unsigned p = v, q = v; asm volatile("s_nop 1\n\tv_permlane32_swap_b32 %0, %1" : "+v"(p), "+v"(q)); v = max(p, q); }
    return v;
}
__device__ __forceinline__ unsigned pack_i8x4(f32x4 v, float inv) {
    const unsigned y0 = __builtin_bit_cast(unsigned, __builtin_fmaf(v[0], inv, 12582912.f)), y1 = __builtin_bit_cast(unsigned, __builtin_fmaf(v[1], inv, 12582912.f));
    const unsigned y2 = __builtin_bit_cast(unsigned, __builtin_fmaf(v[2], inv, 12582912.f)), y3 = __builtin_bit_cast(unsigned, __builtin_fmaf(v[3], inv, 12582912.f));
    return __builtin_amdgcn_perm(y1, y0, 0x0c0c0400u) | (__builtin_amdgcn_perm(y3, y2, 0x0c0c0400u) << 16);
}
__device__ __forceinline__ void quant_store_i8(const f32x4 (&v)[4], unsigned char* tab, int row, float* scale_out, int lane) {
    unsigned amb = 0u;
#pragma unroll
    for (int j = 0; j < 4; ++j)
#pragma unroll
        for (int i = 0; i < 4; ++i) { const float f_ = v[j][i]; amb = max(amb, __builtin_bit_cast(unsigned, f_) & 0x7fffffffu); }
    const float am = __builtin_bit_cast(float, wave_max_dpp(amb));
    const float inv = am > 0.f ? 126.99f * __builtin_amdgcn_rcpf(am) : 0.f;
    v4u w;
#pragma unroll
    for (int j = 0; j < 4; ++j) w[j] = pack_i8x4(v[j], inv);
    *(v4u*)(tab + (size_t)((unsigned)(lane >> 3) * (unsigned)(NEXP * 128) + (unsigned)row * 128u + (unsigned)(lane & 7) * 16u)) = w;
    *scale_out = am * (1.f / 126.99f);
}
__device__ __forceinline__ void convert_layer(CIn& in, unsigned char* ws, int layer, int bid, int G, int wave) {
    const int set = layer & 1;
    const int lane = lane_id_fresh(), tid = wave * 64 + lane;
    const int gtid = bid * NTHR + tid, NT = G * NTHR, gw = gtid >> 6, NW = NT >> 6;
    const float* u = in.peer_u + (size_t)layer * NEXP * D; const float* v = in.peer_v + (size_t)layer * NEXP * D; const float* gn = in.ffn_norm + layer * D;
    unsigned char* U8 = ws + tab_off(set); unsigned char* V8 = U8 + (size_t)NEXP * D; float* SU = (float*)(ws + tabs_off(set)); float* SV = SU + NEXP;
    f32x4 gv[4];
#pragma unroll
    for (int j = 0; j < 4; ++j) gv[j] = *(const f32x4*)(gn + 16 * lane + 4 * j);
    for (int r = gw; r < NEXP; r += 2 * NW) {
        const int r2 = r + NW; const bool ok2 = r2 < NEXP; const int rb = ok2 ? r2 : r;
        f32x4 ua[4], va[4], ub[4], vb[4];
#pragma unroll
        for (int j = 0; j < 4; ++j) { ua[j] = *(const f32x4*)(u + (size_t)r * D + 16 * lane + 4 * j); va[j] = *(const f32x4*)(v + (size_t)r * D + 16 * lane + 4 * j);
            ub[j] = *(const f32x4*)(u + (size_t)rb * D + 16 * lane + 4 * j); vb[j] = *(const f32x4*)(v + (size_t)rb * D + 16 * lane + 4 * j); }
#pragma unroll
        for (int j = 0; j < 4; ++j) { ua[j] = ua[j] * gv[j]; ub[j] = ub[j] * gv[j]; }
        quant_store_i8(ua, U8, r, SU + r, lane); quant_store_i8(va, V8, r, SV + r, lane);
        if (ok2) { quant_store_i8(ub, U8, r2, SU + r2, lane); quant_store_i8(vb, V8, r2, SV + r2, lane); }
    }
    const float* p = in.p + (size_t)layer * T * PLE; bf16* PB = (bf16*)(ws + WS_PB);
    for (int i = gtid; i < T * PLE / 8; i += NT) { const size_t o = (size_t)i * 8; const f32x4 a0 = *(const f32x4*)(p + o), a1 = *(const f32x4*)(p + o + 4);
        v4u w; w.x = pk2(a0[0], a0[1]); w.y = pk2(a0[2], a0[3]); w.z = pk2(a1[0], a1[1]); w.w = pk2(a1[2], a1[3]); *(v4u*)(PB + o) = w; }
}
template <int W>
__device__ __forceinline__ void pooled_strip(const bf16* XB, const LAS float* rinv, const float* gain, bf16* P, int t0, int s0, int tid) {
    const int c0 = 2 * tid; const f32x2 gv = *(const f32x2*)(gain + c0);
    f32x2 ring[W]; f32x2 sum = {0.f, 0.f};
    { unsigned xw[W];
#pragma unroll
      for (int j = 0; j < W; ++j) xw[j] = (s0 - W + j >= 0) ? *(const unsigned*)(XB + (size_t)(t0 - W + j) * D + c0) : 0u;
#pragma unroll
      for (int j = 0; j < W; ++j) { const float ri = (s0 - W + j >= 0) ? rinv[16 - W + j] : 0.f; const f32x2 hv = (f32x2){bflo(xw[j]), bfhi(xw[j])} * ri * gv; ring[j] = hv; sum += hv; } }
    for (int sb = 0; sb < 64; sb += 16) {
        unsigned xw[16];
#pragma unroll
        for (int j = 0; j < 16; ++j) xw[j] = *(const unsigned*)(XB + (size_t)(t0 + sb + j) * D + c0);
#pragma unroll
        for (int j = 0; j < 16; ++j) { const int t = t0 + sb + j, s = s0 + sb + j; const float ri = rinv[16 + sb + j];
            const f32x2 hv = (f32x2){bflo(xw[j]), bfhi(xw[j])} * ri * gv; sum += hv - ring[j % W]; ring[j % W] = hv;
            const float ic = 1.f / (float)((s + 1 < W) ? s + 1 : W); const f32x2 pv = sum * ic - hv;
            *(unsigned*)(P + (size_t)t * D + c0) = pk2(pv[0], pv[1]); }
    }
}
__device__ __forceinline__ void pooled_phase(const bf16* XB, const float* ssq, const float* gain, bf16* P, LAS unsigned char* lds, int vcu, int G, int wave) {
    const int tid = wave * 64 + lane_id_fresh();
    const int g = wave >> 1;
    LAS float* rinv = (LAS float*)lds;
    for (int strip = vcu; strip < T / 64; strip += G) { const int t0 = strip * 64, s0 = t0 & (SEQ - 1);
        __syncthreads();
        if (tid < 80) { const int t = t0 - 16 + tid; rinv[tid] = (s0 - 16 + tid >= 0) ? row_rinv(ssq, t, 1.f / D) : 0.f; }
        __syncthreads();
        if (g == 0) pooled_strip<2>(XB, rinv, gain, P, t0, s0, tid); else if (g == 1) pooled_strip<4>(XB, rinv, gain, P, t0, s0, tid);
        else if (g == 2) pooled_strip<8>(XB, rinv, gain, P, t0, s0, tid); else pooled_strip<16>(XB, rinv, gain, P, t0, s0, tid); }
}
__device__ __forceinline__ void final_phase(const bf16* XB, const float* ssq, const float* gain, float* out, int bid, int G, int wave) {
    const int tid = wave * 64 + lane_id_fresh();
    const int lane = tid & 63, gw = (bid * NTHR + tid) >> 6, NW = (G * NTHR) >> 6;
    f32x4 gv[4];
#pragma unroll
    for (int j = 0; j < 4; ++j) gv[j] = *(const f32x4*)(gain + j * 256 + 4 * lane);
    int r = gw;
    for (; r + 3 * NW < T; r += 4 * NW) {
        f32x4 sq[4]; v2u xw[4][4];
#pragma unroll
        for (int k = 0; k < 4; ++k) { const int rr = r + k * NW; sq[k] = *(const f32x4*)(ssq + (size_t)rr * 16 + 4 * (lane & 3));
#pragma unroll
            for (int j = 0; j < 4; ++j) xw[k][j] = *(const v2u*)(XB + (size_t)rr * D + j * 256 + 4 * lane); }
#pragma unroll
        for (int k = 0; k < 4; ++k) { const int rr = r + k * NW;
            float sv = (sq[k][0] + sq[k][1]) + (sq[k][2] + sq[k][3]); sv += dppf<0xB1>(sv); sv += dppf<0x4E>(sv);
            const float ri = __builtin_amdgcn_rsqf(sv * (1.f / D) + 1e-6f);
#pragma unroll
            for (int j = 0; j < 4; ++j) *(f32x4*)(out + (size_t)rr * D + j * 256 + 4 * lane) = (f32x4){bflo(xw[k][j].x), bfhi(xw[k][j].x), bflo(xw[k][j].y), bfhi(xw[k][j].y)} * ri * gv[j]; }
    }
    for (; r < T; r += NW) { const float ri = row_rinv(ssq, r, 1.f / D);
#pragma unroll
        for (int j = 0; j < 4; ++j) { const size_t o = (size_t)r * D + j * 256 + 4 * lane; const v2u x1 = *(const v2u*)(XB + o); *(f32x4*)(out + o) = (f32x4){bflo(x1.x), bfhi(x1.x), bflo(x1.y), bfhi(x1.y)} * ri * gv[j]; } }
}

__device__ __forceinline__ unsigned fkey(float f) { const unsigned u = __builtin_bit_cast(unsigned, f); return u ^ ((unsigned)((int)u >> 31) | 0x80000000u); }
__device__ __forceinline__ unsigned mbcnt64(unsigned long long m) { return __builtin_amdgcn_mbcnt_hi((unsigned)(m >> 32), __builtin_amdgcn_mbcnt_lo((unsigned)m, 0u)); }
template <int N>
__device__ __forceinline__ void select16(const unsigned (&key)[N], unsigned (&pos)[N]) {
    unsigned prefix = 0u;
    for (int bit = 31; bit >= 0; --bit) {
        const unsigned cand = prefix | (1u << bit); int cnt = 0;
#pragma unroll
        for (int i = 0; i < N; ++i) cnt += __builtin_popcountll(__ballot(key[i] >= cand));
        if (cnt >= 16) prefix = cand;
        if (cnt == 16) break;
    }
    unsigned long long mg[N], me[N]; int cgt = 0;
#pragma unroll
    for (int i = 0; i < N; ++i) { mg[i] = __ballot(key[i] > prefix); me[i] = __ballot(key[i] == prefix); cgt += __builtin_popcountll(mg[i]); }
    int bg = 0, be = cgt;
#pragma unroll
    for (int i = 0; i < N; ++i) { const unsigned rg = mbcnt64(mg[i]), re = mbcnt64(me[i]);
        pos[i] = (key[i] > prefix) ? (unsigned)bg + rg : ((key[i] == prefix) ? (unsigned)be + re : 64u);
        bg += __builtin_popcountll(mg[i]); be += __builtin_popcountll(me[i]); }
}
__device__ __forceinline__ float gelu_tanh(float a) {
    const float u = 0.7978845608028654f * (a + 0.044715f * a * a * a);
    const float e = __builtin_amdgcn_exp2f(2.885390081777927f * u);
    const float th = 1.f - 2.f * __builtin_amdgcn_rcpf(1.f + e);
    return 0.5f * a * (1.f + th);
}
typedef short s16x2_t __attribute__((ext_vector_type(2)));
__device__ __forceinline__ unsigned hkey2(unsigned w) { const s16x2_t sg = __builtin_bit_cast(s16x2_t, w) >> 15; return w ^ (__builtin_bit_cast(unsigned, sg) | 0x80008000u); }
__device__ __forceinline__ float fkey_inv(unsigned k) { const unsigned u = (k & 0x80000000u) ? (k ^ 0x80000000u) : ~k; return __builtin_bit_cast(float, u); }
__device__ __forceinline__ void bit_transpose32(unsigned (&A)[32]) {
#define BT_STAGE(J, M) _Pragma("unroll") for (int k = 0; k < 32; ++k) if ((k & (J)) == 0) { const unsigned t = (A[k] ^ (A[k + (J)] >> (J))) & (M); A[k] ^= t; A[k + (J)] ^= t << (J); }
    BT_STAGE(16, 0x0000FFFFu) BT_STAGE(8, 0x00FF00FFu) BT_STAGE(4, 0x0F0F0F0Fu) BT_STAGE(2, 0x33333333u) BT_STAGE(1, 0x55555555u)
#undef BT_STAGE
}
template <int GL>
__device__ __forceinline__ void topk_select(unsigned (&key)[32], unsigned& Gm, unsigned& Em, int& ng) {
    bit_transpose32(key);
    unsigned A = 0xFFFFFFFFu, G = 0u; int n = 0;
#pragma unroll
    for (int i = 0; i < 32; ++i) {
        const unsigned x = A & key[i]; int c = __builtin_popcount(x);
        c += dppi<0xB1>(c); c += dppi<0x4E>(c);
        if (GL == 8) c += dppi<0x141>(c);
        const bool take = (n + c >= 16);
        A = take ? x : (A ^ x); G = take ? G : (G | x); n = take ? n : n + c;
    }
    Gm = G; Em = A; ng = n;
}
__device__ __forceinline__ void bit_transpose16x2(unsigned (&A)[16]) {
#define BT_STAGE(J, M) _Pragma("unroll") for (int k = 0; k < 16; ++k) if ((k & (J)) == 0) { const unsigned t = (A[k] ^ (A[k + (J)] >> (J))) & (M); A[k] ^= t; A[k + (J)] ^= t << (J); }
    _Pragma("unroll") for (int k = 0; k < 8; ++k) { const unsigned a = A[k], b = A[k + 8]; A[k] = __builtin_amdgcn_perm(b, a, 0x03070105u); A[k + 8] = __builtin_amdgcn_perm(b, a, 0x02060004u); }
    BT_STAGE(4, 0x0F0F0F0Fu) BT_STAGE(2, 0x33333333u) BT_STAGE(1, 0x55555555u)
#undef BT_STAGE
}
template <int GL>
__device__ __forceinline__ void topk_select16(unsigned (&key)[16], unsigned& Gm, unsigned& Em, int& ng) {
    bit_transpose16x2(key);
    unsigned A = 0xFFFFFFFFu, G = 0u; int n = 0;
#pragma unroll
    for (int i = 0; i < 16; ++i) {
        const unsigned x = A & key[i]; int c = __builtin_popcount(x);
        c += dppi<0xB1>(c); c += dppi<0x4E>(c);
        if (GL == 8) c += dppi<0x141>(c);
        const bool take = (n + c >= 16);
        A = take ? x : (A ^ x); G = take ? G : (G | x); n = take ? n : n + c;
    }
    Gm = G; Em = A; ng = n;
}
__device__ __forceinline__ float rs32(float p, float q) { asm volatile("s_nop 1\n\tv_permlane32_swap_b32 %0, %1" : "+v"(p), "+v"(q)); return p + q; }
__device__ __forceinline__ float rs16(float p, float q) { asm volatile("s_nop 1\n\tv_permlane16_swap_b32 %0, %1" : "+v"(p), "+v"(q)); return p + q; }
__device__ __forceinline__ float wave_sum_dpp(float v) {
    v += dppf<0xB1>(v); v += dppf<0x4E>(v); v += dppf<0x141>(v); v += dppf<0x140>(v); v = rs16(v, v); v = rs32(v, v); return v;
}
struct ConvNext { const float* u; const float* v; const float* gain; const float* p; unsigned char* U8; unsigned char* V8; float* SU; float* SV; bf16* PB; int on; };
template <int GL>
__device__ __forceinline__ void topk_select16x2(unsigned (&kA)[16], unsigned (&kB)[16], unsigned& GmA, unsigned& EmA, int& ngA, unsigned& GmB, unsigned& EmB, int& ngB) {
    bit_transpose16x2(kA); bit_transpose16x2(kB);
    unsigned AA = 0xFFFFFFFFu, GA = 0u, AB = 0xFFFFFFFFu, GB = 0u; int nA = 0, nB = 0;
#pragma unroll
    for (int i = 0; i < 16; ++i) {
        const unsigned xA = AA & kA[i], xB = AB & kB[i]; int cA = __builtin_popcount(xA), cB = __builtin_popcount(xB);
        cA += dppi<0xB1>(cA); cB += dppi<0xB1>(cB); cA += dppi<0x4E>(cA); cB += dppi<0x4E>(cB);
        if (GL == 8) { cA += dppi<0x141>(cA); cB += dppi<0x141>(cB); }
        const bool tA = (nA + cA >= 16), tB = (nB + cB >= 16);
        AA = tA ? xA : (AA ^ xA); GA = tA ? GA : (GA | xA); nA = tA ? nA : nA + cA;
        AB = tB ? xB : (AB ^ xB); GB = tB ? GB : (GB | xB); nB = tB ? nB : nB + cB;
    }
    GmA = GA; EmA = AA; ngA = nA; GmB = GB; EmB = AB; ngB = nB;
}
struct KTok { LAS unsigned char* s1i; LAS unsigned char* s2c; LAS unsigned char* scratch; LAS unsigned short* rowc; };
__device__ __forceinline__ KTok ktok(LAS unsigned char* lw, int lane) { KTok k; k.s1i = lw; k.s2c = lw + 256; k.scratch = lw + 512 + lane; k.rowc = (LAS unsigned short*)(lw + 2048); return k; }
__device__ __forceinline__ void k_compact(unsigned M, LAS unsigned char* wp, LAS unsigned char* scratch, int base) {
    while (__builtin_amdgcn_ballot_w64(M != 0u) != 0ull) {
#pragma unroll
        for (int u4 = 0; u4 < 4; ++u4) { const bool act = M != 0u; const int bp = __builtin_ctz(M | 0x80000000u); M &= M - 1u;
            LAS unsigned char* const p = act ? wp : scratch; *p = (unsigned char)(base + 30 - 2 * (bp & 15) + (bp >> 4)); wp += act ? 1 : 0; }
    }
}
__device__ __forceinline__ unsigned k_trim(unsigned Em, int ke) {
    unsigned Et = Em;
    while (__builtin_amdgcn_ballot_w64(__builtin_popcount(Et) > ke) != 0ull) { if (__builtin_popcount(Et) > ke) Et &= Et - 1u; asm volatile("" : "+v"(Et)); }
    return Et;
}
__device__ __forceinline__ void k_compact2(unsigned MA, LAS unsigned char* wpA, LAS unsigned char* scrA, unsigned MB, LAS unsigned char* wpB, LAS unsigned char* scrB, int base) {
    while (__builtin_amdgcn_ballot_w64((MA | MB) != 0u) != 0ull) {
#pragma unroll
        for (int u4 = 0; u4 < 4; ++u4) {
            { const bool act = MA != 0u; const int bp = __builtin_ctz(MA | 0x80000000u); MA &= MA - 1u;
              LAS unsigned char* const p = act ? wpA : scrA; *p = (unsigned char)(base + 30 - 2 * (bp & 15) + (bp >> 4)); wpA += act ? 1 : 0; }
            { const bool act = MB != 0u; const int bp = __builtin_ctz(MB | 0x80000000u); MB &= MB - 1u;
              LAS unsigned char* const p = act ? wpB : scrB; *p = (unsigned char)(base + 30 - 2 * (bp & 15) + (bp >> 4)); wpB += act ? 1 : 0; } }
    }
}
__device__ __forceinline__ void k_trim2(unsigned& EA, int keA, unsigned& EB, int keB) {
    while (__builtin_amdgcn_ballot_w64(__builtin_popcount(EA) > keA || __builtin_popcount(EB) > keB) != 0ull) {
        if (__builtin_popcount(EA) > keA) EA &= EA - 1u; if (__builtin_popcount(EB) > keB) EB &= EB - 1u; asm volatile("" : "+v"(EA), "+v"(EB)); }
}
__device__ __forceinline__ void k_l1_keys(const v4u (&cw)[4], const KTok& k, int lane, unsigned (&key)[16]) {
#pragma unroll
    for (int q = 0; q < 4; ++q) { const v4u w = cw[q]; *(LAS v4u*)(k.rowc + lane * 32 + q * 8) = w;
#pragma unroll
        for (int c = 0; c < 4; ++c) key[4 * q + c] = hkey2(w[c]); }
}
__device__ __forceinline__ void k_l1_post(unsigned Gm, unsigned Em, int ntot, const KTok& k, int lane) {
    const int g1 = lane >> 2, sub = lane & 3;
    const int neq = __builtin_popcount(Em);
    const int e0 = dppi<0x00>(neq), e1 = dppi<0x55>(neq), e2 = dppi<0xAA>(neq);
    const int pe = ntot + (sub > 0 ? e0 : 0) + (sub > 1 ? e1 : 0) + (sub > 2 ? e2 : 0);
    const unsigned M = Gm | k_trim(Em, min(max(16 - pe, 0), neq));
    const int cnt = __builtin_popcount(M);
    const int c0 = dppi<0x00>(cnt), c1 = dppi<0x55>(cnt), c2 = dppi<0xAA>(cnt);
    k_compact(M, k.s1i + g1 * 16 + (sub > 0 ? c0 : 0) + (sub > 1 ? c1 : 0) + (sub > 2 ? c2 : 0), k.scratch, sub * 32);
}
__device__ __forceinline__ void k_l1_post2(unsigned GmA, unsigned EmA, int ntA, const KTok& kA, unsigned GmB, unsigned EmB, int ntB, const KTok& kB, int lane) {
    const int g1 = lane >> 2, sub = lane & 3;
    const int neqA = __builtin_popcount(EmA), neqB = __builtin_popcount(EmB);
    const int eA0 = dppi<0x00>(neqA), eA1 = dppi<0x55>(neqA), eA2 = dppi<0xAA>(neqA), eB0 = dppi<0x00>(neqB), eB1 = dppi<0x55>(neqB), eB2 = dppi<0xAA>(neqB);
    const int peA = ntA + (sub > 0 ? eA0 : 0) + (sub > 1 ? eA1 : 0) + (sub > 2 ? eA2 : 0), peB = ntB + (sub > 0 ? eB0 : 0) + (sub > 1 ? eB1 : 0) + (sub > 2 ? eB2 : 0);
    unsigned EA = EmA, EB = EmB; k_trim2(EA, min(max(16 - peA, 0), neqA), EB, min(max(16 - peB, 0), neqB));
    const unsigned MA = GmA | EA, MB = GmB | EB;
    const int cntA = __builtin_popcount(MA), cntB = __builtin_popcount(MB);
    const int cA0 = dppi<0x00>(cntA), cA1 = dppi<0x55>(cntA), cA2 = dppi<0xAA>(cntA), cB0 = dppi<0x00>(cntB), cB1 = dppi<0x55>(cntB), cB2 = dppi<0xAA>(cntB);
    k_compact2(MA, kA.s1i + g1 * 16 + (sub > 0 ? cA0 : 0) + (sub > 1 ? cA1 : 0) + (sub > 2 ? cA2 : 0), kA.scratch,
               MB, kB.s1i + g1 * 16 + (sub > 0 ? cB0 : 0) + (sub > 1 ? cB1 : 0) + (sub > 2 ? cB2 : 0), kB.scratch, sub * 32);
}
__device__ __forceinline__ int k_scan8(int v, int sub8) {
    { const int t2 = dppi<0x111>(v); if (sub8 >= 1) v += t2; }
    { const int t2 = dppi<0x112>(v); if (sub8 >= 2) v += t2; }
    { const int t2 = dppi<0x114>(v); if (sub8 >= 4) v += t2; }
    return v;
}
__device__ __forceinline__ void k_l2_post2(unsigned GmA, unsigned EmA, int ntA, const KTok& kA, unsigned GmB, unsigned EmB, int ntB, const KTok& kB, int lane) {
    const int h = lane >> 3, sub8 = lane & 7;
    const int neqA = __builtin_popcount(EmA), neqB = __builtin_popcount(EmB);
    const int peA = ntA + (k_scan8(neqA, sub8) - neqA), peB = ntB + (k_scan8(neqB, sub8) - neqB);
    unsigned EA = EmA, EB = EmB; k_trim2(EA, min(max(16 - peA, 0), neqA), EB, min(max(16 - peB, 0), neqB));
    const unsigned MA = GmA | EA, MB = GmB | EB;
    const int cntA = __builtin_popcount(MA), cntB = __builtin_popcount(MB);
    k_compact2(MA, kA.s2c + h * 16 + (k_scan8(cntA, sub8) - cntA), kA.scratch, MB, kB.s2c + h * 16 + (k_scan8(cntB, sub8) - cntB), kB.scratch, sub8 * 32);
}
__device__ __forceinline__ void k_l2_keys(const KTok& k, int lane, unsigned (&key)[16]) {
    const int h = lane >> 3, sub8 = lane & 7;
    const unsigned aib = *(const LAS unsigned short*)(k.s1i + (2 * h) * 16 + 2 * sub8);
    const v4u bib = *(const LAS v4u*)(k.s1i + (2 * h + 1) * 16);
    LAS const unsigned short* ra = k.rowc + (2 * h) * 128; LAS const unsigned short* rb = ra + 128;
    const unsigned a0 = ra[aib & 0xffu], a1 = ra[aib >> 8];
    const half2_t a0x2 = __builtin_bit_cast(half2_t, a0 | (a0 << 16)), a1x2 = __builtin_bit_cast(half2_t, a1 | (a1 << 16));
    half2_t bp[8];
#pragma unroll
    for (int q = 0; q < 8; ++q) { const unsigned blo = rb[(bib[q >> 1] >> (16 * (q & 1))) & 0xffu], bhi = rb[(bib[q >> 1] >> (16 * (q & 1) + 8)) & 0xffu]; bp[q] = __builtin_bit_cast(half2_t, blo | (bhi << 16)); }
#pragma unroll
    for (int i = 0; i < 16; ++i) key[i] = hkey2(__builtin_bit_cast(unsigned, ((i < 8) ? a0x2 : a1x2) + bp[i & 7]));
}
__device__ __forceinline__ void k_l2_post(unsigned Gm, unsigned Em, int ntot, const KTok& k, int lane) {
    const int h = lane >> 3, sub8 = lane & 7;
    const int neq = __builtin_popcount(Em);
    int se = neq;
    { const int t2 = dppi<0x111>(se); if (sub8 >= 1) se += t2; }
    { const int t2 = dppi<0x112>(se); if (sub8 >= 2) se += t2; }
    { const int t2 = dppi<0x114>(se); if (sub8 >= 4) se += t2; }
    const int pe = ntot + (se - neq);
    const unsigned M = Gm | k_trim(Em, min(max(16 - pe, 0), neq));
    const int cnt = __builtin_popcount(M); int sc = cnt;
    { const int t1 = dppi<0x111>(sc); if (sub8 >= 1) sc += t1; }
    { const int t1 = dppi<0x112>(sc); if (sub8 >= 2) sc += t1; }
    { const int t1 = dppi<0x114>(sc); if (sub8 >= 4) sc += t1; }
    k_compact(M, k.s2c + h * 16 + (sc - cnt), k.scratch, sub8 * 32);
}
__device__ __forceinline__ void k_gates(int t, f32x4 rq, const KTok& k, int lane, const float* SU, const float* SV, unsigned short* IDX, float* GW, float* MU) {
    float rinv; { float sv_ = (rq[0] + rq[1]) + (rq[2] + rq[3]); sv_ += dppf<0xB1>(sv_); sv_ += dppf<0x4E>(sv_); rinv = __builtin_amdgcn_rsqf(sv_ * (1.f / D) + 1e-6f); }
#pragma unroll
    for (int kk = 0; kk < 2; ++kk) { const int kx = lane + 64 * kk, hh = kx >> 4; const unsigned cand = k.s2c[kx];
        const unsigned ia = k.s1i[(2 * hh) * 16 + (cand >> 4)], ib = k.s1i[(2 * hh + 1) * 16 + (cand & 15u)];
        const float sv = hlo((unsigned)k.rowc[(2 * hh) * 128 + ia]) + hlo((unsigned)k.rowc[(2 * hh + 1) * 128 + ib]); float mx = sv;
        mx = fmaxf(mx, dppf<0xB1>(mx)); mx = fmaxf(mx, dppf<0x4E>(mx)); mx = fmaxf(mx, dppf<0x141>(mx)); mx = fmaxf(mx, dppf<0x140>(mx));
        const float ex = __builtin_amdgcn_exp2f((sv - mx) * 1.4426950408889634f); float sum = ex;
        sum += dppf<0xB1>(sum); sum += dppf<0x4E>(sum); sum += dppf<0x141>(sum); sum += dppf<0x140>(sum);
        const unsigned ee = ia * 128u + ib; const size_t o = (size_t)t * 128 + (kx & 7) * 16 + (kx >> 3);
        IDX[o] = (unsigned short)ee; GW[o] = ex * __builtin_amdgcn_rcpf(sum) * SV[ee]; MU[o] = rinv * SU[ee]; }
}
struct KConv { f32x4 cr[4], cg[4], cp0; };
__device__ __forceinline__ void k_conv_load(const ConvNext& cv, int t, int lane, KConv& c) {
    const bool cu = t < NEXP; const float* rp = cu ? cv.u + (size_t)t * D : cv.v + (size_t)(t - NEXP) * D;
#pragma unroll
    for (int j = 0; j < 4; ++j) { c.cr[j] = *(const f32x4*)(rp + 16 * lane + 4 * j); c.cg[j] = *(const f32x4*)(cv.gain + 16 * lane + 4 * j); }
    c.cp0 = *(const f32x4*)(cv.p + ((size_t)t * 64 + lane) * 4);
}
__device__ __forceinline__ void k_conv_store(const ConvNext& cv, int t, int lane, KConv& c) {
    if (t < NEXP) {
#pragma unroll
        for (int j = 0; j < 4; ++j) c.cr[j] = c.cr[j] * c.cg[j];
        quant_store_i8(c.cr, cv.U8, t, cv.SU + t, lane); }
    else quant_store_i8(c.cr, cv.V8, t - NEXP, cv.SV + (t - NEXP), lane);
    { v2u w; w.x = pk2(c.cp0[0], c.cp0[1]); w.y = pk2(c.cp0[2], c.cp0[3]); *(v2u*)(cv.PB + ((size_t)t * 64 + lane) * 4) = w; }
}
__device__ __forceinline__ void peer_topk_phase(const unsigned short* S, const float* ssq_in, const float* SU, const float* SV, unsigned short* IDX, float* GW, float* MU,
                                                const ConvNext cv, LAS unsigned char* lds, int vcu, int G, int wave) {
    const int lane = lane_id_fresh();
    const KTok kA = ktok(lds + wave * 12288, lane), kB = ktok(lds + wave * 12288 + 6144, lane);
    const int gw = vcu * NWAVES + wave, NW = G * NWAVES;
    v4u nxA[4], nxB[4];
#define K_SROW(dst, tt) do { const v4u* sp_ = (const v4u*)(S + (size_t)min((tt), T - 1) * 2048 + lane * 32); _Pragma("unroll") for (int q = 0; q < 4; ++q) dst[q] = sp_[q]; } while (0)
    K_SROW(nxA, gw); K_SROW(nxB, gw + NW);
    for (int t = gw; t < T; t += 2 * NW) {
        const int tB = (t + NW < T) ? t + NW : t;
        v4u cwA[4], cwB[4];
#pragma unroll
        for (int q = 0; q < 4; ++q) { cwA[q] = nxA[q]; cwB[q] = nxB[q]; }
        const f32x4 rqA = *(const f32x4*)(ssq_in + (size_t)t * 16 + 4 * (lane & 3)), rqB = *(const f32x4*)(ssq_in + (size_t)tB * 16 + 4 * (lane & 3));
        K_SROW(nxA, t + 2 * NW); K_SROW(nxB, t + 3 * NW);
        KConv cA, cB; if (cv.on) { k_conv_load(cv, t, lane, cA); k_conv_load(cv, tB, lane, cB); }
        { unsigned keyA[16], keyB[16]; k_l1_keys(cwA, kA, lane, keyA); k_l1_keys(cwB, kB, lane, keyB);
          unsigned GmA, EmA, GmB, EmB; int nA, nB; topk_select16x2<4>(keyA, keyB, GmA, EmA, nA, GmB, EmB, nB);
          k_l1_post2(GmA, EmA, nA, kA, GmB, EmB, nB, kB, lane); }
        LDS_WAIT();
        { unsigned keyA[16], keyB[16]; k_l2_keys(kA, lane, keyA); k_l2_keys(kB, lane, keyB);
          unsigned GmA, EmA, GmB, EmB; int nA, nB; topk_select16x2<8>(keyA, keyB, GmA, EmA, nA, GmB, EmB, nB);
          k_l2_post2(GmA, EmA, nA, kA, GmB, EmB, nB, kB, lane); }
        LDS_WAIT();
        k_gates(t, rqA, kA, lane, SU, SV, IDX, GW, MU); k_gates(tB, rqB, kB, lane, SU, SV, IDX, GW, MU);
        if (cv.on) {
            if ((t < NEXP) == (tB < NEXP)) {
                if (t < NEXP) {
#pragma unroll
                    for (int j = 0; j < 4; ++j) { cA.cr[j] = cA.cr[j] * cA.cg[j]; cB.cr[j] = cB.cr[j] * cB.cg[j]; }
                    quant_store_i8(cA.cr, cv.U8, t, cv.SU + t, lane); quant_store_i8(cB.cr, cv.U8, tB, cv.SU + tB, lane); }
                else { quant_store_i8(cA.cr, cv.V8, t - NEXP, cv.SV + (t - NEXP), lane); quant_store_i8(cB.cr, cv.V8, tB - NEXP, cv.SV + (tB - NEXP), lane); }
                { v2u w; w.x = pk2(cA.cp0[0], cA.cp0[1]); w.y = pk2(cA.cp0[2], cA.cp0[3]); *(v2u*)(cv.PB + ((size_t)t * 64 + lane) * 4) = w; }
                { v2u w; w.x = pk2(cB.cp0[0], cB.cp0[1]); w.y = pk2(cB.cp0[2], cB.cp0[3]); *(v2u*)(cv.PB + ((size_t)tB * 64 + lane) * 4) = w; }
            } else { k_conv_store(cv, t, lane, cA); k_conv_store(cv, tB, lane, cB); } }
        LDS_WAIT();
    }
#undef K_SROW
}
__device__ __forceinline__ int dot4_first(int a, int b) { int r; asm("v_dot4_i32_i8 %0, %1, %2, 0" : "=v"(r) : "v"(a), "v"(b)); return r; }
__device__ __forceinline__ unsigned peer_off_lo(unsigned w, unsigned m, unsigned a) { unsigned r; asm("v_mad_u32_u16 %0, %1, %2, %3" : "=v"(r) : "v"(w), "s"(m), "v"(a)); return r; }
__device__ __forceinline__ unsigned peer_off_hi(unsigned w, unsigned m, unsigned a) { unsigned r; asm("v_mad_u32_u16 %0, %1, %2, %3 op_sel:[1,0,0,0]" : "=v"(r) : "v"(w), "s"(m), "v"(a)); return r; }
#define PEER_ISSUE8(buf, o, idw, TAB) do { _Pragma("unroll") for (int b = 0; b < 8; ++b) { \
        const unsigned off = (b & 1) ? peer_off_hi((idw)[b >> 1], 128u, taboff) : peer_off_lo((idw)[b >> 1], 128u, taboff); \
        buf[(o) + b] = *(const v4u*)((TAB) + (size_t)off); } } while (0)
#define PEER_ISSUE16(buf, i0, i1, TAB) do { PEER_ISSUE8(buf, 0, i0, TAB); PEER_ISSUE8(buf, 8, i1, TAB); } while (0)
template <int M> __device__ __forceinline__ unsigned swz8(unsigned v) { return (unsigned)__builtin_amdgcn_ds_swizzle((int)v, 0x18 | (M << 5)); }
#define SWZ8(v, m) swz8<m>(v)
#define PEER_ISSUE_U1(buf, iw, TAB, p) do { const unsigned w_ = swz8<p>(iw); \
        buf[2 * (p)] = *(const v4u*)((TAB) + (size_t)peer_off_lo(w_, 128u, taboff)); buf[2 * (p) + 1] = *(const v4u*)((TAB) + (size_t)peer_off_hi(w_, 128u, taboff)); } while (0)
#define PEER_ISSUE_U(buf, iw, TAB) do { PEER_ISSUE_U1(buf, iw, TAB, 0); PEER_ISSUE_U1(buf, iw, TAB, 1); PEER_ISSUE_U1(buf, iw, TAB, 2); PEER_ISSUE_U1(buf, iw, TAB, 3); \
        PEER_ISSUE_U1(buf, iw, TAB, 4); PEER_ISSUE_U1(buf, iw, TAB, 5); PEER_ISSUE_U1(buf, iw, TAB, 6); PEER_ISSUE_U1(buf, iw, TAB, 7); } while (0)
#define PEER_ISSUE_V1(buf, r, TAB, m) do { const unsigned w0_ = swz8<m>((r).x), w1_ = swz8<m>((r).y); \
        buf[4 * (m)] = *(const v4u*)((TAB) + (size_t)peer_off_lo(w0_, 128u, taboff)); buf[4 * (m) + 1] = *(const v4u*)((TAB) + (size_t)peer_off_hi(w0_, 128u, taboff)); \
        buf[4 * (m) + 2] = *(const v4u*)((TAB) + (size_t)peer_off_lo(w1_, 128u, taboff)); buf[4 * (m) + 3] = *(const v4u*)((TAB) + (size_t)peer_off_hi(w1_, 128u, taboff)); } while (0)
#define PEER_ISSUE_V(buf, r, TAB) do { PEER_ISSUE_V1(buf, r, TAB, 0); PEER_ISSUE_V1(buf, r, TAB, 1); PEER_ISSUE_V1(buf, r, TAB, 2); PEER_ISSUE_V1(buf, r, TAB, 3); } while (0)
#define PEER_PIN4(v) asm volatile("" : "+v"((v).x), "+v"((v).y), "+v"((v).z), "+v"((v).w))
#define VPTR(base, rowbytes, tt, off) ((const char*)(base) + (size_t)(tt) * (rowbytes) + (off))
template <int LIGHT>
__device__ __forceinline__ void peer_u_phase(const unsigned short* IDX, const bf16* XB, const unsigned char* U8, unsigned short* PART, int bid, int G, int wave) {
    const int lane = lane_id_fresh(), j = lane >> 3, c = lane & 7;
    const int NS = G < 8 ? G : 8, rank = bid / NS, nrank = (G - (bid % NS) + NS - 1) / NS;
    for (int s = bid % NS; s < 8; s += NS) {
        const unsigned coloff = (unsigned)(s * 128 + c * 16), taboff = (unsigned)(s * (NEXP * 128) + c * 16);
        const int stride = nrank * NWAVES;
        unsigned short* part = PART + (size_t)s * T * 128;
        unsigned o_idx = (unsigned)(j * 32 + c * 4), o_x = coloff * 2u + (unsigned)((j & 1) * 16), o_p = (unsigned)(j * 32 + c * 4); const bool xhalf = (j & 1) != 0;
#define PEER_U_TOKEN(buf, xh, tt) do { \
              \
            v4u xa, xb; { v4u ph; _Pragma("unroll") for (int k = 0; k < 4; ++k) ph[k] = (unsigned)dppi<0x128>((int)(xh)[k]); \
                _Pragma("unroll") for (int k = 0; k < 4; ++k) { xa[k] = xhalf ? ph[k] : (xh)[k]; xb[k] = xhalf ? (xh)[k] : ph[k]; } } \
            const float xv[16] = {bflo(xa.x), bfhi(xa.x), bflo(xa.y), bfhi(xa.y), bflo(xa.z), bfhi(xa.z), bflo(xa.w), bfhi(xa.w), bflo(xb.x), bfhi(xb.x), bflo(xb.y), bfhi(xb.y), bflo(xb.z), bfhi(xb.z), bflo(xb.w), bfhi(xb.w)}; \
              \
            float am = 0.f; _Pragma("unroll") for (int i = 0; i < 16; ++i) am = fmaxf(am, fabsf(xv[i])); \
            { unsigned ab = __builtin_bit_cast(unsigned, am); ab = max(ab, (unsigned)dppi<0xB1>((int)ab)); ab = max(ab, (unsigned)dppi<0x4E>((int)ab)); ab = max(ab, (unsigned)dppi<0x141>((int)ab)); am = __builtin_bit_cast(float, ab); }   \
            const float xinv = am > 0.f ? 127.f / am : 0.f, xsc = am * (0.015625f / 127.f)  ; \
            int xq[4]; _Pragma("unroll") for (int q = 0; q < 4; ++q) xq[q] = (int)pack_i8x4((f32x4){xv[4 * q], xv[4 * q + 1], xv[4 * q + 2], xv[4 * q + 3]}, xinv); \
            int dd[16]; \
            _Pragma("unroll") for (int b = 0; b < 16; ++b) { PEER_PIN4(buf[b]); \
                if (LIGHT) { dd[b] = (int)((buf[b].x ^ buf[b].y) ^ (buf[b].z ^ buf[b].w)) + xq[b & 3]; continue; } \
                int d = dot4_first((int)buf[b].x, xq[0]); d = __builtin_amdgcn_sdot4((int)buf[b].y, xq[1], d, false); \
                d = __builtin_amdgcn_sdot4((int)buf[b].z, xq[2], d, false); dd[b] = __builtin_amdgcn_sdot4((int)buf[b].w, xq[3], d, false); } \
              \
            const bool cb2 = (c & 4) != 0, cb1 = (c & 2) != 0, cb0 = (c & 1) != 0; \
            int e8[8], e4[4], e2[2]; \
            _Pragma("unroll") for (int k = 0; k < 8; ++k) { const int keep = cb2 ? dd[8 + k] : dd[k], send = cb2 ? dd[k] : dd[8 + k]; e8[k] = keep + dppi<0x141>(send); } \
            _Pragma("unroll") for (int k = 0; k < 4; ++k) { const int keep = cb1 ? e8[4 + k] : e8[k], send = cb1 ? e8[k] : e8[4 + k]; e4[k] = keep + dppi<0x1B>(send); } \
            _Pragma("unroll") for (int k = 0; k < 2; ++k) { const int keep = cb0 ? e4[2 + k] : e4[k], send = cb0 ? e4[k] : e4[2 + k]; e2[k] = keep + dppi<0xB1>(send); } \
            *(unsigned*)VPTR(part, 256, tt, o_p) = pkh2((float)e2[0] * xsc, (float)e2[1] * xsc); } while (0)
        v4u bufA[16], bufB[16], xA, xB; unsigned iA = 0u, iB = 0u;
        xA = xB = (v4u){0u, 0u, 0u, 0u};
        int t = rank * NWAVES + wave;
        if (t + 3 * stride < T) {
            { iA = *(const unsigned*)VPTR(IDX, 256, t, o_idx); xA = *(const v4u*)VPTR(XB, 2048, t, o_x); }
            { iB = *(const unsigned*)VPTR(IDX, 256, t + stride, o_idx); }
            PEER_ISSUE_U(bufA, iA, U8);
        do {
            asm volatile("" : "+v"(o_idx), "+v"(o_x), "+v"(o_p));
            const int t1 = t + stride, t2 = t1 + stride, t3 = t2 + stride;
            { iA = *(const unsigned*)VPTR(IDX, 256, t2, o_idx); }
            PEER_ISSUE_U(bufB, iB, U8);
            { xB = *(const v4u*)VPTR(XB, 2048, t1, o_x); }
            PEER_U_TOKEN(bufA, xA, t);
            { iB = *(const unsigned*)VPTR(IDX, 256, t3, o_idx); }
            PEER_ISSUE_U(bufA, iA, U8);
            { xA = *(const v4u*)VPTR(XB, 2048, t2, o_x); }
            PEER_U_TOKEN(bufB, xB, t1);
            t = t2;
        } while (t + 3 * stride < T);
        } else {
        if (t < T) { iA = *(const unsigned*)VPTR(IDX, 256, t, o_idx); xA = *(const v4u*)VPTR(XB, 2048, t, o_x); }
        if (t + stride < T) { iB = *(const unsigned*)VPTR(IDX, 256, t + stride, o_idx); }
        if (t < T) PEER_ISSUE_U(bufA, iA, U8);
        }
        while (t < T) {
            asm volatile("" : "+v"(o_idx), "+v"(o_x), "+v"(o_p));
            const int t1 = t + stride, t2 = t1 + stride, t3 = t2 + stride;
            if (t1 < T) { PEER_ISSUE_U(bufB, iB, U8); xB = *(const v4u*)VPTR(XB, 2048, t1, o_x); }
            if (t2 < T) { iA = *(const unsigned*)VPTR(IDX, 256, t2, o_idx); }
            PEER_U_TOKEN(bufA, xA, t);
            if (t1 < T) {
                if (t2 < T) { PEER_ISSUE_U(bufA, iA, U8); xA = *(const v4u*)VPTR(XB, 2048, t2, o_x); }
                if (t3 < T) { iB = *(const unsigned*)VPTR(IDX, 256, t3, o_idx); }
                PEER_U_TOKEN(bufB, xB, t1);
            }
            t = t2;
        }
#undef PEER_U_TOKEN
    }
}
__device__ __forceinline__ void peer_w_phase(const unsigned short* PART, const float* GW, const float* MU, const unsigned short* IDX, unsigned* VREC, int bid, int G, int wave) {
    const int tid = wave * 64 + lane_id_fresh(), gtid = bid * NTHR + tid, NT = G * NTHR;
    for (int i = gtid; i < T * 16; i += NT) { const size_t o = (size_t)i * 8;
        v4u p[8];
#pragma unroll
        for (int s = 0; s < 8; ++s) p[s] = *(const v4u*)(PART + (size_t)s * T * 128 + o);
        const f32x4 mu0 = *(const f32x4*)(MU + o), mu1 = *(const f32x4*)(MU + o + 4), gw0 = *(const f32x4*)(GW + o), gw1 = *(const f32x4*)(GW + o + 4); const v4u ids = *(const v4u*)(IDX + o);
        f32x4 a0 = {0.f, 0.f, 0.f, 0.f}, a1 = {0.f, 0.f, 0.f, 0.f}, w0, w1;
#pragma unroll
        for (int s = 0; s < 8; ++s) { a0 += (f32x4){hlo(p[s].x), hhi(p[s].x), hlo(p[s].y), hhi(p[s].y)}; a1 += (f32x4){hlo(p[s].z), hhi(p[s].z), hlo(p[s].w), hhi(p[s].w)}; }
#pragma unroll
        for (int q = 0; q < 4; ++q) { w0[q] = gw0[q] * gelu_tanh(a0[q] * 64.f * mu0[q]); w1[q] = gw1[q] * gelu_tanh(a1[q] * 64.f * mu1[q]); }
        float am = fmaxf(fmaxf(fmaxf(fabsf(w0[0]), fabsf(w0[1])), fmaxf(fabsf(w0[2]), fabsf(w0[3]))), fmaxf(fmaxf(fabsf(w1[0]), fabsf(w1[1])), fmaxf(fabsf(w1[2]), fabsf(w1[3]))));
        { unsigned ab = __builtin_bit_cast(unsigned, am); ab = max(ab, (unsigned)dppi<0xB1>((int)ab)); ab = max(ab, (unsigned)dppi<0x4E>((int)ab)); ab = max(ab, (unsigned)dppi<0x141>((int)ab)); ab = max(ab, (unsigned)dppi<0x140>((int)ab));
          am = __builtin_bit_cast(float, ab); }
        const float winv = am > 0.f ? 127.f / am : 0.f; const unsigned sc = __builtin_bit_cast(unsigned, am * (1.f / 127.f));
        unsigned* rec = VREC + (size_t)(i >> 1) * 16; const int h8 = i & 1;
        *(v4u*)(rec + 4 * h8) = ids; *(v2u*)(rec + 8 + 2 * h8) = (v2u){pack_i8x4(w0, winv), pack_i8x4(w1, winv)}; *(v2u*)(rec + 12 + 2 * h8) = (v2u){sc, sc}; }
}
__device__ __forceinline__ void peer_v_phase(const unsigned* VREC, const unsigned char* V8, const bf16* XB, bf16* XBo, float* ssq_out, int bid, int G, int wave) {
    const int lane = lane_id_fresh(), j = lane >> 3, c = lane & 7;
    const int NS = G < 8 ? G : 8, rank = bid / NS, nrank = (G - (bid % NS) + NS - 1) / NS;
    for (int s = bid % NS; s < 8; s += NS) {
        const unsigned coloff = (unsigned)(s * 128 + c * 16), taboff = (unsigned)(s * (NEXP * 128) + c * 16);
        const int stride = nrank * NWAVES;
        unsigned o_rec = (unsigned)(j * 64 + c * 8), o_xb = (coloff + 2u * j) * 2u;
#define PEER_V_TOKEN(buf, w, xr, tt) do { \
              \
            const float wsc = __builtin_bit_cast(float, SWZ8((w).x, 6)); const int wq[4] = {(int)SWZ8((w).x, 4), (int)SWZ8((w).y, 4), (int)SWZ8((w).x, 5), (int)SWZ8((w).y, 5)}; \
            int ia[16]; \
            _Pragma("unroll") for (int B = 0; B < 4; ++B) { PEER_PIN4(buf[4 * B]); PEER_PIN4(buf[4 * B + 1]); PEER_PIN4(buf[4 * B + 2]); PEER_PIN4(buf[4 * B + 3]); \
                _Pragma("unroll") for (int q = 0; q < 4; ++q) { const unsigned D0 = buf[4 * B][q], D1 = buf[4 * B + 1][q], D2 = buf[4 * B + 2][q], D3 = buf[4 * B + 3][q]; \
                    const unsigned P0 = __builtin_amdgcn_perm(D1, D0, 0x05010400u), P1 = __builtin_amdgcn_perm(D1, D0, 0x07030602u), Q0 = __builtin_amdgcn_perm(D3, D2, 0x05010400u), Q1 = __builtin_amdgcn_perm(D3, D2, 0x07030602u); \
                    ia[4 * q + 0] = (B == 0) ? dot4_first((int)__builtin_amdgcn_perm(Q0, P0, 0x05040100u), wq[0]) : __builtin_amdgcn_sdot4((int)__builtin_amdgcn_perm(Q0, P0, 0x05040100u), wq[B], ia[4 * q + 0], false); \
                    ia[4 * q + 1] = (B == 0) ? dot4_first((int)__builtin_amdgcn_perm(Q0, P0, 0x07060302u), wq[0]) : __builtin_amdgcn_sdot4((int)__builtin_amdgcn_perm(Q0, P0, 0x07060302u), wq[B], ia[4 * q + 1], false); \
                    ia[4 * q + 2] = (B == 0) ? dot4_first((int)__builtin_amdgcn_perm(Q1, P1, 0x05040100u), wq[0]) : __builtin_amdgcn_sdot4((int)__builtin_amdgcn_perm(Q1, P1, 0x05040100u), wq[B], ia[4 * q + 2], false); \
                    ia[4 * q + 3] = (B == 0) ? dot4_first((int)__builtin_amdgcn_perm(Q1, P1, 0x07060302u), wq[0]) : __builtin_amdgcn_sdot4((int)__builtin_amdgcn_perm(Q1, P1, 0x07060302u), wq[B], ia[4 * q + 3], false); } } \
              \
            int e2a, e2b, e2c, e2d; const bool b3 = (lane & 8) != 0; \
            { int p0 = ia[0], q0 = ia[8], p1 = ia[1], q1 = ia[9], p2 = ia[2], q2 = ia[10], p3 = ia[3], q3 = ia[11], p4 = ia[4], q4 = ia[12], p5 = ia[5], q5 = ia[13], p6 = ia[6], q6 = ia[14], p7 = ia[7], q7 = ia[15]; \
              asm volatile("s_nop 1\n\tv_permlane32_swap_b32 %0, %1\n\tv_permlane32_swap_b32 %2, %3\n\tv_permlane32_swap_b32 %4, %5\n\tv_permlane32_swap_b32 %6, %7\n\t" \
                           "v_permlane32_swap_b32 %8, %9\n\tv_permlane32_swap_b32 %10, %11\n\tv_permlane32_swap_b32 %12, %13\n\tv_permlane32_swap_b32 %14, %15" \
                           : "+v"(p0), "+v"(q0), "+v"(p1), "+v"(q1), "+v"(p2), "+v"(q2), "+v"(p3), "+v"(q3), "+v"(p4), "+v"(q4), "+v"(p5), "+v"(q5), "+v"(p6), "+v"(q6), "+v"(p7), "+v"(q7)); \
              int s0 = p0 + q0, s1 = p1 + q1, s2 = p2 + q2, s3 = p3 + q3, s4_ = p4 + q4, s5 = p5 + q5, s6 = p6 + q6, s7 = p7 + q7; \
              asm volatile("s_nop 1\n\tv_permlane16_swap_b32 %0, %1\n\tv_permlane16_swap_b32 %2, %3\n\tv_permlane16_swap_b32 %4, %5\n\tv_permlane16_swap_b32 %6, %7" \
                           : "+v"(s0), "+v"(s4_), "+v"(s1), "+v"(s5), "+v"(s2), "+v"(s6), "+v"(s3), "+v"(s7)); \
              e2a = s0 + s4_; e2b = s1 + s5; e2c = s2 + s6; e2d = s3 + s7; } \
            int r1x, r1y; { const int kx = b3 ? e2c : e2a, ky = b3 ? e2d : e2b, sx = b3 ? e2a : e2c, sy = b3 ? e2b : e2d; r1x = kx + dppi<0x128>(sx); r1y = ky + dppi<0x128>(sy); } \
            struct { float x, y; } r1 = {(float)r1x * wsc, (float)r1y * wsc}; \
            f32x2 xn = {bflo(xr) + r1.x, bfhi(xr) + r1.y}; \
            *(unsigned*)VPTR(XBo, 2048, tt, o_xb) = pk2(xn[0], xn[1]); \
            const float sq = wave_sum_dpp(xn[0] * xn[0] + xn[1] * xn[1]); SQOUT(sq, tt); } while (0)
        v4u bufA[16], bufB[16]; v2u rA = {0u, 0u}, rB = {0u, 0u}, rC = {0u, 0u};
        unsigned xrA = 0u, xrB = 0u;
#define PEER_V_REC(tt) (*(const v2u*)VPTR(VREC, 512, tt, o_rec))
#define PEER_V_XR(tt) (*(const unsigned*)VPTR(XB, 2048, tt, o_xb))
        int t = rank * NWAVES + wave;
        if (t + 3 * stride < T) {
            rA = PEER_V_REC(t); xrA = PEER_V_XR(t); rB = PEER_V_REC(t + stride);
            PEER_ISSUE_V(bufA, rA, V8);
        float sqA = 0.f;
#define SQOUT(v, tt) do { if ((tt) == t) sqA = (v); else if (lane < 2) ssq_out[(size_t)(lane ? (tt) : t) * 16 + s] = lane ? (v) : sqA; } while (0)
        do {
            asm volatile("" : "+v"(o_rec), "+v"(o_xb));
            const int t1 = t + stride, t2 = t1 + stride, t3 = t2 + stride;
            rC = PEER_V_REC(t2);
            PEER_ISSUE_V(bufB, rB, V8); xrB = PEER_V_XR(t1);
            PEER_V_TOKEN(bufA, rA, xrA, t);
            rA = rC; rC = PEER_V_REC(t3);
            PEER_ISSUE_V(bufA, rA, V8); xrA = PEER_V_XR(t2);
            PEER_V_TOKEN(bufB, rB, xrB, t1);
            rB = rC;
            t = t2;
        } while (t + 3 * stride < T);
#undef SQOUT
        } else {
        if (t < T) { rA = PEER_V_REC(t); xrA = PEER_V_XR(t); }
        if (t + stride < T) rB = PEER_V_REC(t + stride);
        if (t < T) PEER_ISSUE_V(bufA, rA, V8);
        }
#define SQOUT(v, tt) do { if (lane == 0) ssq_out[(size_t)(tt) * 16 + s] = (v); } while (0)
        while (t < T) {
            asm volatile("" : "+v"(o_rec), "+v"(o_xb));
            const int t1 = t + stride, t2 = t1 + stride, t3 = t2 + stride;
            if (t2 < T) rC = PEER_V_REC(t2);
            if (t1 < T) { PEER_ISSUE_V(bufB, rB, V8); xrB = PEER_V_XR(t1); }
            PEER_V_TOKEN(bufA, rA, xrA, t);
            if (t1 < T) {
                rA = rC; if (t3 < T) rC = PEER_V_REC(t3);
                if (t2 < T) { PEER_ISSUE_V(bufA, rA, V8); xrA = PEER_V_XR(t2); }
                PEER_V_TOKEN(bufB, rB, xrB, t1);
                rB = rC;
            }
            t = t2;
        }
#undef SQOUT
#undef PEER_V_REC
#undef PEER_V_XR
#undef PEER_V_TOKEN
    }
}
#undef PEER_ISSUE8
#undef PEER_ISSUE16
#undef PEER_PIN4
#undef VPTR

constexpr int AT_KST = 24576, AT_KPE = 16384, AT_VBASE = 3 * AT_KST, AT_VST = 16384;
constexpr int ATTN_LDS = AT_VBASE + 4 * AT_VST;
__device__ __forceinline__ void attn_phase(const bf16* Q, const bf16* KN, const bf16* KPE, const bf16* VT, bf16* AO, LAS unsigned char* lds, int vcu, int G, int wave) {
    const int lane = lane_id_fresh(), tid = wave * 64 + lane;
    const int rho = lane & 31, hh = lane >> 5;
    const int krow = (rho & 0x13) | ((rho & 4) << 1) | ((rho & 8) >> 1);
    const bool lag = wave >= 4;
    for (int it = vcu; it < 1024; it += G) {
        const int c = it & 255, kq = it >> 8, bh = c >> 2, q4 = c & 3;
        const int qb = (kq == 0) ? 15 - q4 : (kq == 1) ? q4 : (kq == 2) ? 8 + q4 : 7 - q4;
        const int b = bh >> 3, h = bh & 7;
        const int q0 = qb * 256, qlo = q0 + wave * 32, trow0 = b * SEQ + qlo;
        f32x16 o[4];
#pragma unroll
        for (int d = 0; d < 4; ++d)
#pragma unroll
            for (int r = 0; r < 16; ++r) o[d][r] = 0.f;
        float m_run = -1e30f, l_run = 0.f;
        const int nkt = 4 * (qb + 1);
        unsigned vk[2], vp, vv[2];
#pragma unroll
        for (int i = 0; i < 2; ++i) { const int id = tid + 512 * i; { const int row = id >> 4, cc = (id & 15) ^ (row & 15); vk[i] = (unsigned)(row * (D * 2) + cc * 16); }
            { const int row = id >> 3, cc = (id & 7) ^ ((row >> 1) & 7); vv[i] = (unsigned)row * (unsigned)(T * 2) + (unsigned)(cc * 16); } }
        { const int row = tid >> 3, cc = (tid & 7) ^ ((row >> 1) & 7); vp = (unsigned)(row * (QKR * 2) + cc * 16); }
        const unsigned ldsb = (unsigned)(size_t)lds + (unsigned)wave * 1024u;
#define AT_DMA(sbase, voff, ldsdst) do { unsigned _keep; asm volatile("s_mov_b32 %0, m0\n\ts_mov_b32 m0, %3\n\ts_nop 4\n\tglobal_load_lds_dwordx4 %1, %2\n\ts_mov_b32 m0, %0" \
            : "=&s"(_keep) : "v"(voff), "s"(sbase), "s"(ldsdst) : "memory"); } while (0)
#define AT_STAGE_TILE(kt, ks, vs) do { const int tk0 = b * SEQ + (kt) * 64; const unsigned kb2 = ldsb + (unsigned)(ks) * AT_KST, vb2 = ldsb + AT_VBASE + (unsigned)(vs) * AT_VST; \
            const bf16* kb_ = KN + (size_t)tk0 * D + h * QKN; const bf16* pb_ = KPE + (size_t)tk0 * QKR; const bf16* vb_ = VT + (size_t)(h * VH) * T + tk0; \
            AT_DMA(kb_, vk[0], kb2); AT_DMA(kb_, vk[1], kb2 + 8192u); AT_DMA(pb_, vp, kb2 + AT_KPE); AT_DMA(vb_, vv[0], vb2); AT_DMA(vb_, vv[1], vb2 + 8192u); } while (0)
#define AT_SYNC() asm volatile("s_waitcnt vmcnt(0) lgkmcnt(0)\n\ts_barrier" ::: "memory")
#define AT_SYNC5() asm volatile("s_waitcnt vmcnt(5) lgkmcnt(0)\n\ts_barrier" ::: "memory")
#define AT_KADDR(kb, s) ((s) < 8 ? st + ((kb) * 32 + krow) * 256 + (((2 * (s) + hh) ^ (krow & 15)) << 4) : st + AT_KPE + ((kb) * 32 + krow) * 128 + (((2 * ((s) - 8) + hh) ^ ((((kb) * 32 + krow) >> 1) & 7)) << 4))
#define AT_KREAD(dst, kb, s0) do { _Pragma("unroll") for (int i = 0; i < 6; ++i) dst[i] = *(const LAS bf16x8*)AT_KADDR(kb, (s0) + i); } while (0)
#define AT_KMMA(src_, kb, s0) do { _Pragma("unroll") for (int i = 0; i < 6; ++i) sacc[kb] = __builtin_amdgcn_mfma_f32_32x32x16_bf16(src_[i], qf[(s0) + i], sacc[kb], 0, 0, 0); } while (0)
#define AT_QK(ks) do { const LAS unsigned char* st = lds + (ks) * AT_KST; bf16x8 fx[6], fy[6]; \
            _Pragma("unroll") for (int kb = 0; kb < 2; ++kb) _Pragma("unroll") for (int r = 0; r < 16; ++r) sacc[kb][r] = 0.f; \
            AT_KREAD(fx, 0, 0); AT_KREAD(fy, 0, 6); \
            AT_KMMA(fx, 0, 0); __builtin_amdgcn_sched_barrier(0); AT_KREAD(fx, 1, 0); \
            AT_KMMA(fy, 0, 6); __builtin_amdgcn_sched_barrier(0); AT_KREAD(fy, 1, 6); \
            AT_KMMA(fx, 1, 0); AT_KMMA(fy, 1, 6); } while (0)
#define AT_SM(key0v) do { \
            if ((key0v) + 63 > qlo) { const int qpos = qlo + rho; \
                _Pragma("unroll") for (int kb = 0; kb < 2; ++kb) \
                    _Pragma("unroll") for (int r = 0; r < 16; ++r) { const int kpos = (key0v) + 32 * kb + (r & 3) + 4 * ((r >> 2) & 1) + 8 * hh + 16 * (r >> 3); if (kpos > qpos) sacc[kb][r] = -1e30f; } } \
            AT_SM_NM(); } while (0)
#define AT_SM_NM() do { \
            float mx = sacc[0][0]; \
            _Pragma("unroll") for (int kb = 0; kb < 2; ++kb) \
                _Pragma("unroll") for (int r = 0; r < 16; ++r) mx = fmaxf(mx, sacc[kb][r]); \
            { float p_ = mx, q_ = mx; asm("s_nop 1\n\tv_permlane32_swap_b32 %0, %1" : "+v"(p_), "+v"(q_)); mx = fmaxf(p_, q_); }   \
            const float m_new = fmaxf(m_run, mx), alpha = __builtin_amdgcn_exp2f(m_run - m_new); m_run = m_new; \
            float lsum = 0.f; \
            _Pragma("unroll") for (int kb = 0; kb < 2; ++kb) \
                _Pragma("unroll") for (int r = 0; r < 16; ++r) { const float p = __builtin_amdgcn_exp2f(sacc[kb][r] - m_new); sacc[kb][r] = p; lsum += p; } \
            l_run = l_run * alpha + lsum; \
            _Pragma("unroll") for (int d = 0; d < 4; ++d) \
                _Pragma("unroll") for (int r = 0; r < 16; ++r) o[d][r] *= alpha; \
            _Pragma("unroll") for (int s2 = 0; s2 < 4; ++s2) { const int kb = s2 >> 1, r0 = 8 * (s2 & 1); v4u w; \
                w.x = pk2(sacc[kb][r0 + 0], sacc[kb][r0 + 1]); w.y = pk2(sacc[kb][r0 + 2], sacc[kb][r0 + 3]); w.z = pk2(sacc[kb][r0 + 4], sacc[kb][r0 + 5]); w.w = pk2(sacc[kb][r0 + 6], sacc[kb][r0 + 7]); \
                pf[s2] = __builtin_bit_cast(bf16x8, w); } } while (0)
#define AT_VREAD(dst, d) do { const int row = (d) * 32 + rho; _Pragma("unroll") for (int s2 = 0; s2 < 4; ++s2) dst[s2] = *(const LAS bf16x8*)(sv + row * 128 + (((2 * s2 + hh) ^ ((row >> 1) & 7)) << 4)); } while (0)
#define AT_VMMA(src_, d) do { _Pragma("unroll") for (int s2 = 0; s2 < 4; ++s2) o[d] = __builtin_amdgcn_mfma_f32_32x32x16_bf16(src_[s2], pf[s2], o[d], 0, 0, 0); } while (0)
#define AT_PV(vs) do { const LAS unsigned char* sv = lds + AT_VBASE + (vs) * AT_VST; bf16x8 gx[4], gy[4]; \
            AT_VREAD(gx, 0); AT_VREAD(gy, 1); \
            AT_VMMA(gx, 0); __builtin_amdgcn_sched_barrier(0); AT_VREAD(gx, 2); \
            AT_VMMA(gy, 1); __builtin_amdgcn_sched_barrier(0); AT_VREAD(gy, 3); \
            AT_VMMA(gx, 2); AT_VMMA(gy, 3); } while (0)
        AT_SYNC();
        AT_STAGE_TILE(0, 0, 0); AT_STAGE_TILE(1, 1, 1);
        bf16x8 qf[12];
        { const bf16* qp = Q + (size_t)(trow0 + rho) * (NHEAD * DQK) + h * DQK + hh * 8;
#pragma unroll
          for (int s = 0; s < 12; ++s) qf[s] = *(const bf16x8*)(qp + 16 * s);
#pragma unroll
          for (int s = 0; s < 12; ++s) asm volatile("" : "+v"(qf[s])); }
        AT_SYNC5();
        bf16x8 pf[4];
#pragma unroll
        for (int s2 = 0; s2 < 4; ++s2) pf[s2] = (bf16x8){0, 0, 0, 0, 0, 0, 0, 0};
        int ks = 0, vs = 0;
        bool have = false; int pvs = 0;
        int kt = 0;
        const int nfull = 4 * qb;
        if (!lag) {
            for (; kt < nfull; ++kt) {
                AT_STAGE_TILE(kt + 2, (ks == 0 ? 2 : ks - 1), ((vs + 2) & 3));
                { f32x16 sacc[2]; AT_QK(ks); AT_SM_NM(); }
                AT_PV(vs);
                AT_SYNC5();
                ks = (ks == 2) ? 0 : ks + 1; vs = (vs + 1) & 3;
            }
        } else if (nfull > 0) {
            { AT_STAGE_TILE(2, 2, 2); { f32x16 sacc[2]; AT_QK(0); AT_SM_NM(); } have = true; pvs = 0; AT_SYNC5(); ks = 1; vs = 1; kt = 1; }
            for (; kt < nfull; ++kt) {
                AT_STAGE_TILE(kt + 2, (ks == 0 ? 2 : ks - 1), ((vs + 2) & 3));
                AT_PV(pvs);
                { f32x16 sacc[2]; AT_QK(ks); AT_SM_NM(); }
                pvs = vs;
                AT_SYNC5();
                ks = (ks == 2) ? 0 : ks + 1; vs = (vs + 1) & 3;
            }
        }
        for (; kt < nkt; ++kt) {
            if (kt + 2 < nkt) AT_STAGE_TILE(kt + 2, (ks == 0 ? 2 : ks - 1), ((vs + 2) & 3));
            const int key0 = kt * 64;
            const bool vis = key0 <= qlo + 31;
            if (have) AT_PV(pvs);
            if (vis) { f32x16 sacc[2]; AT_QK(ks); AT_SM(key0); }
            if (lag) { have = vis; pvs = vs; } else if (vis) AT_PV(vs);
            if (kt + 2 < nkt) AT_SYNC5(); else AT_SYNC();
            ks = (ks == 2) ? 0 : ks + 1; vs = (vs + 1) & 3;
        }
        if (lag && have) AT_PV(pvs);
#undef AT_DMA
#undef AT_STAGE_TILE
#undef AT_SYNC
#undef AT_SYNC5
#undef AT_QK
#undef AT_SM
#undef AT_SM_NM
#undef AT_PV
#undef AT_KADDR
#undef AT_KREAD
#undef AT_KMMA
#undef AT_VREAD
#undef AT_VMMA
        const float ltot = l_run + shx<32>(l_run, lane), inv = 1.f / ltot;
        bf16* orow = AO + (size_t)(trow0 + rho) * D + h * VH + 8 * hh;
#pragma unroll
        for (int d = 0; d < 4; ++d)
#pragma unroll
            for (int k = 0; k < 2; ++k) {
                unsigned ax = pk2(o[d][8 * k + 0] * inv, o[d][8 * k + 1] * inv), ay = pk2(o[d][8 * k + 2] * inv, o[d][8 * k + 3] * inv);
                unsigned bx = pk2(o[d][8 * k + 4] * inv, o[d][8 * k + 5] * inv), by = pk2(o[d][8 * k + 6] * inv, o[d][8 * k + 7] * inv);
                asm volatile("s_nop 1\n\tv_permlane32_swap_b32 %0, %1" : "+v"(ax), "+v"(bx)); asm volatile("s_nop 1\n\tv_permlane32_swap_b32 %0, %1" : "+v"(ay), "+v"(by));
                *(v4u*)(orow + 32 * d + 16 * k) = (v4u){ax, ay, bx, by}; }
    }
}

constexpr int N_PHASES = 42;
struct Args { In in; float* out; unsigned char* ws; int ph_lo, ph_hi; };
__global__ void __launch_bounds__(NTHR, 2) mk_fwd(Args a) {
    extern __shared__ __attribute__((aligned(16))) unsigned char lds_raw[];
    LAS unsigned char* lds = (LAS unsigned char*)lds_raw;
    const int wave = __builtin_amdgcn_readfirstlane(threadIdx.x >> 6);
    const int G = gridDim.x, bid = blockIdx.x, vcu = (G % 8 == 0) ? (bid % 8) * (G / 8) + bid / 8 : bid;
    typedef const __attribute__((address_space(4))) Args* KArgs;
#define KARGS(q) KArgs q = (KArgs)__builtin_amdgcn_kernarg_segment_ptr(); asm volatile("" : "+s"(q))
    const int lo = a.ph_lo, hi = a.ph_hi;
    { volatile LAS unsigned* MISC0 = (volatile LAS unsigned*)(lds + MISC_OFF); if (threadIdx.x < 32) MISC0[threadIdx.x] = 0u; }
    __syncthreads();
    XcdBarrier bar; bar.bar = (unsigned*)(a.ws + WS_CTL); bar.x = 0; bar.st = nullptr;
    if (hi - lo > 1) bar = xcd_barrier_post((unsigned*)(a.ws + WS_CTL), (volatile LAS unsigned*)(lds + MISC_OFF) + 8, threadIdx.x == 0);
#ifndef MK_MASK
#define MK_MASK 0xFFFF
#endif
#define IN_PH(k) (lo <= (k) && (k) < hi)
#define EN(b) ((MK_MASK >> (b)) & 1)
#if MK_PROBE & 256
#define PHASE_END(k) do { if ((k) + 1 < hi) { xcd_barrier(bar, wave == 0 && lane_id_fresh() == 0); xcd_barrier(bar, wave == 0 && lane_id_fresh() == 0); } } while (0)
#else
#define PHASE_END(k) do { if ((k) + 1 < hi) xcd_barrier(bar, wave == 0 && lane_id_fresh() == 0); } while (0)
#endif
#define PH_VARS KARGS(q); unsigned char* ws = q->ws; CIn& in = q->in; float* ssq = (float*)(ws + WS_SSQ); \
    const float* COS = (const float*)(ws + WS_COS); const float* SIN = (const float*)(ws + WS_SIN); (void)in; (void)ssq; (void)COS; (void)SIN

    if (EN(0) && IN_PH(0)) { PH_VARS;
#if MK_PROBE & 8
        p0_prologue(in, ws, lds, bid, G, wave); __syncthreads();
#endif
        p0_prologue(in, ws, lds, bid, G, wave); PHASE_END(0); }

#pragma unroll 1
    for (int layer = 0; layer < DEPTH; ++layer) {
        const int base = 1 + 10 * layer, v0 = 3 * layer;
#define XB_VARS bf16* XBc = (bf16*)(ws + ((layer & 1) ? WS_XBB : WS_XBA)); bf16* XBn = (bf16*)(ws + ((layer & 1) ? WS_XBA : WS_XBB)); pg8::StaticOrder SO; (void)XBc; (void)XBn; (void)SO
        if (EN(1) && IN_PH(base + 0)) { PH_VARS; XB_VARS;
#if MK_PROBE & 4096
#pragma unroll 1
            for (int rep = 0; rep < 2; ++rep)
#endif
            {
            if (layer == 0) convert_layer(in, ws, layer, bid, G, wave);
            if (layer < 2) pooled_phase(XBc, ssq + (size_t)v0 * SSQ_ARR, in.mix_norm + layer * D, (bf16*)(ws + WS_POOLED), lds, vcu, G, wave);
            else {
                const int N = (layer == 2) ? 1280 : 768;
                pg8::Gemm g{XBc, (const bf16*)(ws + ((layer == 2) ? W_DOWN2 : W_DOWN3)), T, N, D, D, D, 0}; SO.init(T, N, G, bid);
                epi::Down E{(bf16*)(ws + WS_CQ), (bf16*)(ws + WS_CKV), (bf16*)(ws + WS_KPE), ssq + (size_t)v0 * SSQ_ARR, ssq + (size_t)(13 + layer - 2) * SSQ_ARR, ssq + (size_t)15 * SSQ_ARR, COS, SIN};
                pg8::gemm_phase<epi::Down>(lds, g, SO, E, wave);
                if (G % 2 == 0 && ((T / 256) * (N / 256)) % G == G / 2) {
                    pg8::Gemm gp{(const bf16*)(ws + WS_PB), (const bf16*)(ws + W_WP) + (size_t)layer * D * PLE, T, D, PLE, PLE, PLE, 0}; SO.init(T, D, G, bid, 1);
                    epi::Bf16Row EP{(bf16*)(ws + WS_PP), D, nullptr, 0.f};
                    pg8::gemm_phase<epi::Bf16Row>(lds, gp, SO, EP, wave);
                }
            }
            }
            PHASE_END(base + 0);
        }
        if (EN(2) && IN_PH(base + 1)) { PH_VARS; XB_VARS;
#if MK_PROBE & 16
            if (layer < 2) {
                pg8::Gemm g{(const bf16*)(ws + WS_POOLED), (const bf16*)(ws + W_POOL) + (size_t)layer * 1024 * 256, T, D, 256, D, 256, 256}; SO.init(T, D, G, bid);
                epi::Resid E{(bf16*)(ws + WS_END), (float*)(ws + WS_END + 64 * MiB)};
                pg8::gemm_phase<epi::Resid>(lds, g, SO, E, wave);
            } else {
                pg8::Gemm g{(const bf16*)(ws + WS_CQ), (const bf16*)(ws + W_UQ) + (size_t)(layer - 2) * 1536 * QRANK, T, 1536, QRANK, QRANK, QRANK, 0}; SO.init(T, 1536, G, bid);
                epi::QUp E{(bf16*)(ws + WS_Q), ssq + (size_t)(13 + layer - 2) * SSQ_ARR, COS, SIN};
                pg8::gemm_phase<epi::QUp>(lds, g, SO, E, wave);
            }
#endif
            if (layer < 2) {
                pg8::Gemm g{(const bf16*)(ws + WS_POOLED), (const bf16*)(ws + W_POOL) + (size_t)layer * 1024 * 256, T, D, 256, D, 256, 256}; SO.init(T, D, G, bid);
                epi::Resid E{XBc, ssq + (size_t)(v0 + 1) * SSQ_ARR};
                pg8::gemm_phase<epi::Resid>(lds, g, SO, E, wave);
            } else {
                if (layer == 2) {
                    { pg8::Gemm g{(const bf16*)(ws + WS_CKV), (const bf16*)(ws + W_KNW), T, 1024, KVRANK, KVRANK, KVRANK, 0}; SO.init(T, 1024, G, bid);
                      epi::Bf16Row E{(bf16*)(ws + WS_KN), 1024, ssq + (size_t)15 * SSQ_ARR, 1.f / KVRANK};
                      pg8::gemm_phase<epi::Bf16Row>(lds, g, SO, E, wave); }
                    { pg8::Gemm g{(const bf16*)(ws + W_VW), (const bf16*)(ws + WS_CKV), 1024, T, KVRANK, KVRANK, KVRANK, 0}; SO.init(1024, T, G, bid);
                      epi::VTCol E{(bf16*)(ws + WS_VT), ssq + (size_t)15 * SSQ_ARR, 1.f / KVRANK};
                      pg8::gemm_phase<epi::VTCol>(lds, g, SO, E, wave); }
                }
                pg8::Gemm g{(const bf16*)(ws + WS_CQ), (const bf16*)(ws + W_UQ) + (size_t)(layer - 2) * 1536 * QRANK, T, 1536, QRANK, QRANK, QRANK, 0}; SO.init(T, 1536, G, bid);
                epi::QUp E{(bf16*)(ws + WS_Q), ssq + (size_t)(13 + layer - 2) * SSQ_ARR, COS, SIN};
                pg8::gemm_phase<epi::QUp>(lds, g, SO, E, wave);
            }
            PHASE_END(base + 1);
        }
        if (EN(3) && layer >= 2 && IN_PH(base + 2)) { PH_VARS; XB_VARS;
#if MK_PROBE & 2
            attn_phase((const bf16*)(ws + WS_Q), (const bf16*)(ws + WS_KN), (const bf16*)(ws + WS_KPE), (const bf16*)(ws + WS_VT), (bf16*)(ws + WS_AO), lds, vcu, G, wave);
#endif
            attn_phase((const bf16*)(ws + WS_Q), (const bf16*)(ws + WS_KN), (const bf16*)(ws + WS_KPE), (const bf16*)(ws + WS_VT), (bf16*)(ws + WS_AO), lds, vcu, G, wave);
            PHASE_END(base + 2);
        }
        if (EN(4) && layer >= 2 && IN_PH(base + 3)) { PH_VARS; XB_VARS;
            pg8::Gemm g{(const bf16*)(ws + WS_AO), (const bf16*)(ws + W_WO) + (size_t)(layer - 2) * D * D, T, D, D, D, D, 0}; SO.init(T, D, G, bid);
#if MK_PROBE & 16384
            { epi::Resid E2{(bf16*)(ws + WS_END), (float*)(ws + WS_END + 64 * MiB)}; pg8::gemm_phase<epi::Resid>(lds, g, SO, E2, wave); SO.init(T, D, G, bid); }
#endif
            epi::Resid E{XBc, ssq + (size_t)(v0 + 1) * SSQ_ARR};
            pg8::gemm_phase<epi::Resid>(lds, g, SO, E, wave);
            PHASE_END(base + 3);
        }
        if (EN(5) && IN_PH(base + 4)) { PH_VARS; XB_VARS;
#if MK_PROBE & 4
            { pg8::Gemm g{XBc, (const bf16*)(ws + W_WEFF) + (size_t)layer * 2048 * D, T, 2048, D, D, D, 0}; SO.init(T, 2048, G, bid);
              epi::Score E{(unsigned short*)(ws + WS_S), 2048, ssq + (size_t)(v0 + 1) * SSQ_ARR};
              pg8::gemm_phase<epi::Score>(lds, g, SO, E, wave); }
#endif
#if MK_PROBE & 65536
            { pg8::Gemm g{(const bf16*)(ws + WS_PB), (const bf16*)(ws + W_WP) + (size_t)layer * D * PLE, T, D, PLE, PLE, PLE, 0}; SO.init(T, D, G, bid);
              epi::Bf16Row E{(bf16*)(ws + WS_PP), D, nullptr, 0.f};
              pg8::gemm_phase<epi::Bf16Row>(lds, g, SO, E, wave); }
#endif
            {
            { pg8::Gemm g{XBc, (const bf16*)(ws + W_WEFF) + (size_t)layer * 2048 * D, T, 2048, D, D, D, 0}; SO.init(T, 2048, G, bid);
              epi::Score E{(unsigned short*)(ws + WS_S), 2048, ssq + (size_t)(v0 + 1) * SSQ_ARR};
              pg8::gemm_phase<epi::Score>(lds, g, SO, E, wave); }
            if (!(layer >= 2 && G % 2 == 0 && ((T / 256) * (((layer == 2) ? 1280 : 768) / 256)) % G == G / 2))
            { pg8::Gemm g{(const bf16*)(ws + WS_PB), (const bf16*)(ws + W_WP) + (size_t)layer * D * PLE, T, D, PLE, PLE, PLE, 0}; SO.init(T, D, G, bid);
              epi::Bf16Row E{(bf16*)(ws + WS_PP), D, nullptr, 0.f};
              pg8::gemm_phase<epi::Bf16Row>(lds, g, SO, E, wave); }
            }
            PHASE_END(base + 4);
        }
        if (EN(6) && EN(9) && IN_PH(base + 5)) { PH_VARS; XB_VARS;
            const int nl = layer + 1 < DEPTH ? layer + 1 : layer, ns = nl & 1;
            const ConvNext cvn{in.peer_u + (size_t)nl * NEXP * D, in.peer_v + (size_t)nl * NEXP * D, in.ffn_norm + nl * D, in.p + (size_t)nl * T * PLE,
                               ws + tab_off(ns), ws + tab_off(ns) + (size_t)NEXP * D, (float*)(ws + tabs_off(ns)), (float*)(ws + tabs_off(ns)) + NEXP, (bf16*)(ws + WS_PB), layer + 1 < DEPTH ? 1 : 0};
#if MK_PROBE & 64
            peer_topk_phase((const unsigned short*)(ws + WS_S), ssq + (size_t)(v0 + 1) * SSQ_ARR, (const float*)(ws + tabs_off(layer & 1)), (const float*)(ws + tabs_off(layer & 1)) + NEXP,
                            (unsigned short*)(ws + WS_IDX), (float*)(ws + WS_GW), (float*)(ws + WS_MU), cvn, lds, vcu, G, wave);
#endif
            peer_topk_phase((const unsigned short*)(ws + WS_S), ssq + (size_t)(v0 + 1) * SSQ_ARR, (const float*)(ws + tabs_off(layer & 1)), (const float*)(ws + tabs_off(layer & 1)) + NEXP,
                            (unsigned short*)(ws + WS_IDX), (float*)(ws + WS_GW), (float*)(ws + WS_MU), cvn, lds, vcu, G, wave);
            PHASE_END(base + 5);
        }
        if (EN(6) && EN(10) && IN_PH(base + 6)) { PH_VARS; XB_VARS;
#if MK_PROBE & 32
            peer_u_phase<0>((const unsigned short*)(ws + WS_IDX), XBc, ws + tab_off(layer & 1), (unsigned short*)(ws + WS_PART), bid, G, wave);
#endif
#if MK_PROBE & 128
            peer_u_phase<1>((const unsigned short*)(ws + WS_IDX), XBc, ws + tab_off(layer & 1), (unsigned short*)(ws + WS_WW), bid, G, wave);
#endif
            peer_u_phase<0>((const unsigned short*)(ws + WS_IDX), XBc, ws + tab_off(layer & 1), (unsigned short*)(ws + WS_PART), bid, G, wave);
            PHASE_END(base + 6);
        }
        if (EN(6) && EN(11) && IN_PH(base + 7)) { PH_VARS; XB_VARS;
#if MK_PROBE & 2048
            peer_w_phase((const unsigned short*)(ws + WS_PART), (const float*)(ws + WS_GW), (const float*)(ws + WS_MU), (const unsigned short*)(ws + WS_IDX), (unsigned*)(ws + WS_WW), bid, G, wave);
#endif
            peer_w_phase((const unsigned short*)(ws + WS_PART), (const float*)(ws + WS_GW), (const float*)(ws + WS_MU), (const unsigned short*)(ws + WS_IDX), (unsigned*)(ws + WS_WW), bid, G, wave);
            PHASE_END(base + 7);
        }
        if (EN(6) && EN(12) && IN_PH(base + 8)) { PH_VARS; XB_VARS;
#if MK_PROBE & 1024
            peer_v_phase((const unsigned*)(ws + WS_WW), ws + tab_off(layer & 1) + (size_t)NEXP * D, XBc, (bf16*)(ws + WS_END), (float*)(ws + WS_END + 64 * MiB), bid, G, wave);
#endif
            peer_v_phase((const unsigned*)(ws + WS_WW), ws + tab_off(layer & 1) + (size_t)NEXP * D, XBc, XBc, ssq + (size_t)(v0 + 2) * SSQ_ARR, bid, G, wave);
            PHASE_END(base + 8);
        }
        if (EN(7) && IN_PH(base + 9)) { PH_VARS; XB_VARS;
            pg8::Gemm g{XBc, (const bf16*)(ws + W_WG) + (size_t)layer * D * D, T, D, D, D, D, 0}; SO.init(T, D, G, bid);
#if MK_PROBE & 512
            { epi::Null EN_{(float*)(ws + WS_END)}; pg8::gemm_phase<epi::Null>(lds, g, SO, EN_, wave); }
#endif
#if MK_PROBE & 8192
            { epi::Gate E2{XBc, XBn, (const bf16*)(ws + WS_PP), ssq + (size_t)(v0 + 2) * SSQ_ARR, ssq + (size_t)(v0 + 3) * SSQ_ARR}; pg8::gemm_phase<epi::Gate>(lds, g, SO, E2, wave); SO.init(T, D, G, bid); }
#endif
            epi::Gate E{XBc, XBn, (const bf16*)(ws + WS_PP), ssq + (size_t)(v0 + 2) * SSQ_ARR, ssq + (size_t)(v0 + 3) * SSQ_ARR};
            pg8::gemm_phase<epi::Gate>(lds, g, SO, E, wave);
            PHASE_END(base + 9);
        }
    }
#if MK_PROBE & 32768
    if (EN(8) && IN_PH(41)) { PH_VARS; final_phase((const bf16*)(ws + WS_XBA), ssq + (size_t)12 * SSQ_ARR, in.final_norm, q->out, bid, G, wave); }
#endif
    if (EN(8) && IN_PH(41)) { PH_VARS; final_phase((const bf16*)(ws + WS_XBA), ssq + (size_t)12 * SSQ_ARR, in.final_norm, q->out, bid, G, wave); }
#undef IN_PH
#undef PHASE_END
}

extern "C" void kernel_launch(void* const* d_in, const int* in_sizes, int n_in, void* d_out, int out_size, void* d_ws, size_t ws_size, hipStream_t stream) {
    static int grid = 0;
    if (grid == 0) {
        if (n_in != 23 || out_size != T * D || ws_size < WS_END) { fprintf(stderr, "kernel_launch: unexpected problem (n_in %d, out %d, ws %zu < %zu)\n", n_in, out_size, ws_size, (size_t)WS_END); grid = -1; return; }
        int dev = 0, cus = 0, per_cu = 0;
        if (hipGetDevice(&dev) != hipSuccess || hipDeviceGetAttribute(&cus, hipDeviceAttributeMultiprocessorCount, dev) != hipSuccess) { grid = -1; return; }
        if (hipFuncSetAttribute((const void*)mk_fwd, hipFuncAttributeMaxDynamicSharedMemorySize, LDS_BYTES) != hipSuccess) { fprintf(stderr, "kernel_launch: hipFuncSetAttribute failed\n"); grid = -1; return; }
        if (hipOccupancyMaxActiveBlocksPerMultiprocessor(&per_cu, (const void*)mk_fwd, NTHR, LDS_BYTES) != hipSuccess || per_cu < 1) { fprintf(stderr, "kernel_launch: occupancy query says %d\n", per_cu); }
        (void)hipGetLastError();
        grid = cus;
    }
    if (grid < 0) return;
    (void)hipMemsetAsync((char*)d_ws + WS_CTL, 0, CTL_ZERO_BYTES, stream);
    Args a{};
    const void** ip = (const void**)&a.in;
    for (int i = 0; i < 23; ++i) ip[i] = d_in[i];
    a.out = (float*)d_out; a.ws = (unsigned char*)d_ws;
#if MK_ONE_LAUNCH
    a.ph_lo = 0; a.ph_hi = N_PHASES;
    hipLaunchKernelGGL(mk_fwd, dim3(grid), dim3(NTHR), LDS_BYTES, stream, a);
#else
    for (int k = 0; k < N_PHASES; ++k) {
        if (k >= 1 && k <= 40) { const int layer = (k - 1) / 10, slot = (k - 1) % 10; if (layer < 2 && (slot == 2 || slot == 3)) continue; }
        a.ph_lo = k; a.ph_hi = k + 1;
        hipLaunchKernelGGL(mk_fwd, dim3(grid), dim3(NTHR), LDS_BYTES, stream, a);
    }
#endif
}
```

```cpp
#include <hip/hip_runtime.h>
#include <cstdio>
#include <cstdint>

#ifndef MK_PROBE
#define MK_PROBE 0
#endif
#ifndef MK_ONE_LAUNCH
#define MK_ONE_LAUNCH 1
#endif


__device__ __forceinline__ int lane_id_fresh() { int l; asm volatile("v_mbcnt_lo_u32_b32 %0, -1, 0\n\tv_mbcnt_hi_u32_b32 %0, -1, %0" : "=v"(l)); return l; }
template <int M> __device__ __forceinline__ float shx(float v, int lane) {
    if constexpr (M < 32) return __builtin_bit_cast(float, __builtin_amdgcn_ds_swizzle(__builtin_bit_cast(int, v), (M << 10) | 0x1f));
    else return __builtin_bit_cast(float, __builtin_amdgcn_ds_bpermute((lane ^ 32) << 2, __builtin_bit_cast(int, v)));
}

namespace pg8 {
#define PG8_LAS __attribute__((address_space(3)))
typedef unsigned short bf16_t;
typedef short bf16x8 __attribute__((ext_vector_type(8)));
typedef float f32x4 __attribute__((ext_vector_type(4)));
typedef unsigned u32x4 __attribute__((ext_vector_type(4)));
typedef unsigned u32x2 __attribute__((ext_vector_type(2)));
constexpr int BM = 256, BK = 64, HALF = 128, HTB = HALF * BK * 2, STAGE_BYTES = 8 * HTB, NXCD = 8, WGM = 8;

__host__ __device__ __forceinline__ int lds_byte(int r, int c) { const int st = (r >> 4) * 2 + (c >> 5), rr = r & 15, cc = c & 31, ob = rr * 64 + cc * 2; return st * 1024 + (ob ^ (((ob >> 9) & 1) << 5)); }
__host__ __device__ __forceinline__ void stage_rc(int b, int& R, int& C) { const int st = b / 1024, sb = b % 1024, swz = sb ^ (((sb >> 9) & 1) << 5); R = (st >> 1) * 16 + swz / 64; C = (st & 1) * 32 + (swz % 64) / 2; }
__host__ __device__ __forceinline__ int perm32(int rho) { const int n = rho >> 4, i = rho & 15; return 8 * (i >> 2) + 4 * n + (i & 3); }

struct Unit { int pm, pn; };
struct Gemm { const bf16_t* A; const bf16_t* Bt; int M, N, K, lda, ldb, acs; };

struct StaticOrder {
    int nM, nN, nwg, G, c, skew;
    __host__ __device__ void init(int M, int N, int G_, int c_, int skew_ = 0) { nM = M / BM; nN = N / BM; nwg = nM * nN; G = G_; c = c_; skew = skew_; }
    __host__ __device__ bool next(int i, Unit& u) const {
        long L = (long)i * G + c;
        if (skew && i > 0) { if (2 * c < G) return false; L = (long)G + (long)(i - 1) * (G - G / 2) + (c - G / 2); }
        if (L >= nwg) return false;
        int wgid = (int)L; { const int q = nwg / NXCD, r = nwg % NXCD, xcd = wgid % NXCD, off = wgid / NXCD; wgid = (xcd < r ? xcd * (q + 1) : r * (q + 1) + (xcd - r) * q) + off; }
        const int nig = WGM * nN, gid = wgid / nig, fm = gid * WGM, gsz = (nM - fm) < WGM ? (nM - fm) : WGM;
        u.pm = fm + ((wgid % nig) % gsz); u.pn = (wgid % nig) / gsz; return true;
    }
};

__device__ __forceinline__ unsigned cvt_pk_bf16(float lo, float hi) { unsigned r; asm volatile("v_cvt_pk_bf16_f32 %0, %1, %2" : "=v"(r) : "v"(lo), "v"(hi)); return r; }

template <class Epi>
__device__ __forceinline__ void gemm_phase(PG8_LAS unsigned char* lds, const Gemm g, const StaticOrder& S, const Epi& E, const int wid) {
    const int lane = lane_id_fresh(), tid = wid * 64 + lane;
    const int wr = wid >> 2, wc = wid & 3, fr = lane & 15, fq = lane >> 4;
    const int K = g.K, nt = K / BK;
    unsigned voffA, voffB;
    { int R, C; stage_rc(tid * 16, R, C); const int Rb = Epi::PERM ? ((R & ~31) + perm32(R & 31)) : R;
      voffA = (unsigned)(R * g.lda + C) * 2u; voffB = (unsigned)(Rb * g.ldb + C) * 2u; }
    const unsigned d64A = 64u * g.lda * 2u, d64B = 64u * g.ldb * 2u;
    constexpr unsigned kstep = BK * 2;
    const unsigned hstepA = (unsigned)HALF * g.lda * 2u, hstepB = (unsigned)HALF * g.ldb * 2u;
    const unsigned tstepA = 2u * hstepA, tstepB = 2u * hstepB;
    const unsigned acsb = (unsigned)g.acs * 2u;
    const unsigned ldsw = (unsigned)wid * 1024u, ldsbase = (unsigned)(size_t)lds;
    const int aoff = lds_byte(wr * 64 + fr, fq * 8), boff = lds_byte(wc * 32 + fr, fq * 8);
#define PG8_SA(b, h) (((b) * 2 + (h)) * HTB)
#define PG8_SB(b, h) ((4 + (b) * 2 + (h)) * HTB)
#define PG8_DMA(sbase, voff, ldsdst) do { unsigned _keep; asm volatile("s_mov_b32 %0, m0\n\ts_mov_b32 m0, %3\n\ts_nop 4\n\tglobal_load_lds_dwordx4 %1, %2\n\ts_mov_b32 m0, %0" \
        : "=&s"(_keep) : "v"(voff), "s"(sbase), "s"(ldsdst) : "memory"); } while (0)
#define PG8_STAGE(bufoff, gbase, voff) do { const char* _b0 = (const char*)(gbase); const char* _b1 = _b0 + (&(voff) == &voffA ? d64A : d64B); \
        PG8_DMA(_b0, voff, ldsbase + (unsigned)(bufoff) + ldsw); PG8_DMA(_b1, voff, ldsbase + (unsigned)(bufoff) + ldsw + 8192u); } while (0)
#define PG8_LDA(dst, b, h) do { _Pragma("unroll") for (int m = 0; m < 4; ++m) _Pragma("unroll") for (int k = 0; k < 2; ++k) dst[m][k] = *(const PG8_LAS bf16x8*)(lds + PG8_SA(b, h) + aoff + m * 2048 + k * 1024); } while (0)
#define PG8_LDB(dst, b, h) do { _Pragma("unroll") for (int n = 0; n < 2; ++n) _Pragma("unroll") for (int k = 0; k < 2; ++k) dst[n][k] = *(const PG8_LAS bf16x8*)(lds + PG8_SB(b, h) + boff + n * 2048 + k * 1024); } while (0)
#define PG8_MMA(ai, bj, At, Bt) do { __builtin_amdgcn_s_setprio(1); _Pragma("unroll") for (int m = 0; m < 4; ++m) _Pragma("unroll") for (int n = 0; n < 2; ++n) _Pragma("unroll") for (int k = 0; k < 2; ++k) \
        acc[ai][bj][m][n] = __builtin_amdgcn_mfma_f32_16x16x32_bf16(Bt[n][k], At[m][k], acc[ai][bj][m][n], 0, 0, 0); __builtin_amdgcn_s_setprio(0); } while (0)
#define PG8_WAIT_V(n) asm volatile("s_waitcnt vmcnt(" #n ")" ::: "memory")
#define PG8_WAIT_L(n) asm volatile("s_waitcnt lgkmcnt(" #n ")" ::: "memory")
#define PG8_BAR __builtin_amdgcn_s_barrier()
#define PG8_SCHED __builtin_amdgcn_sched_barrier(0)
    Unit cur, nxt; int ui = 0;
    if (!S.next(0, cur)) return;
    f32x4 acc[2][2][4][2];
#pragma unroll
    for (int a = 0; a < 2; ++a)
#pragma unroll
        for (int b = 0; b < 2; ++b)
#pragma unroll
            for (int m = 0; m < 4; ++m)
#pragma unroll
                for (int n = 0; n < 2; ++n) acc[a][b][m][n] = (f32x4){0.f, 0.f, 0.f, 0.f};
    bf16x8 At[4][2], B0[2][2], B1[2][2];
    const char* cA = (const char*)g.A + ((unsigned)cur.pm * tstepA + (unsigned)cur.pn * acsb); const char* cB = (const char*)g.Bt + (unsigned)cur.pn * tstepB;
    PG8_STAGE(PG8_SB(0, 0), cB, voffB); PG8_STAGE(PG8_SB(0, 1), cB + hstepB, voffB); PG8_STAGE(PG8_SA(0, 0), cA, voffA); PG8_STAGE(PG8_SA(0, 1), cA + hstepA, voffA);
    if (wr == 1) PG8_BAR;
    PG8_WAIT_V(2); PG8_BAR;
    PG8_STAGE(PG8_SB(1, 0), cB + kstep, voffB); PG8_STAGE(PG8_SA(1, 0), cA + kstep, voffA); PG8_STAGE(PG8_SB(1, 1), cB + hstepB + kstep, voffB);
    PG8_WAIT_V(6); PG8_BAR;
    for (;;) {
        const bool has_next = S.next(ui + 1, nxt);
        const char* nA = has_next ? (const char*)g.A + ((unsigned)nxt.pm * tstepA + (unsigned)nxt.pn * acsb) : cA; const char* nB = has_next ? (const char*)g.Bt + (unsigned)nxt.pn * tstepB : cB;
        for (int t = 0; t < nt; t += 2) {
            const bool last = (t == nt - 2);
            const char* a1 = cA + (unsigned)(t + 1) * kstep;
            const char* a2 = last ? nA : cA + (unsigned)(t + 2) * kstep; const char* b2 = last ? nB : cB + (unsigned)(t + 2) * kstep;
            const char* a3 = a2 + kstep; const char* b3 = b2 + kstep;
            PG8_LDB(B0, 0, 0); PG8_LDB(B1, 0, 1); PG8_SCHED; PG8_LDA(At, 0, 0); PG8_STAGE(PG8_SA(1, 1), a1 + hstepA, voffA);
            PG8_WAIT_V(8); PG8_WAIT_L(0); PG8_BAR; PG8_MMA(0, 0, At, B0); PG8_MMA(0, 1, At, B1); PG8_BAR; PG8_SCHED;
            PG8_LDA(At, 0, 1); PG8_STAGE(PG8_SB(0, 0), b2, voffB); PG8_STAGE(PG8_SB(0, 1), b2 + hstepB, voffB); PG8_STAGE(PG8_SA(0, 0), a2, voffA);
            PG8_WAIT_V(8); PG8_WAIT_L(0); PG8_BAR; PG8_MMA(1, 0, At, B0); PG8_MMA(1, 1, At, B1); PG8_BAR; PG8_SCHED;
            PG8_LDB(B0, 1, 0); PG8_LDB(B1, 1, 1); PG8_SCHED; PG8_LDA(At, 1, 0); PG8_STAGE(PG8_SA(0, 1), a2 + hstepA, voffA);
            PG8_WAIT_V(8); PG8_WAIT_L(0); PG8_BAR; PG8_MMA(0, 0, At, B0); PG8_MMA(0, 1, At, B1); PG8_BAR; PG8_SCHED;
            PG8_LDA(At, 1, 1); PG8_STAGE(PG8_SB(1, 0), b3, voffB); PG8_STAGE(PG8_SB(1, 1), b3 + hstepB, voffB); PG8_STAGE(PG8_SA(1, 0), a3, voffA);
            PG8_WAIT_V(8); PG8_WAIT_L(0); PG8_BAR; PG8_MMA(1, 0, At, B0); PG8_MMA(1, 1, At, B1); PG8_BAR; PG8_SCHED;
        }
        if (wr == 0) PG8_BAR;
        { const int l2 = lane_id_fresh(); E(acc, cur, wr, wc, l2 & 15, l2 >> 4); }
        if (!has_next) break;
#pragma unroll
        for (int a = 0; a < 2; ++a)
#pragma unroll
            for (int b = 0; b < 2; ++b)
#pragma unroll
                for (int m = 0; m < 4; ++m)
#pragma unroll
                    for (int n = 0; n < 2; ++n) acc[a][b][m][n] = (f32x4){0.f, 0.f, 0.f, 0.f};
        cur = nxt; cA = nA; cB = nB; ++ui;
        if (wr == 1) PG8_BAR;
    }
    PG8_WAIT_V(0);
    PG8_BAR;
#undef PG8_SA
#undef PG8_SB
#undef PG8_STAGE
#undef PG8_LDA
#undef PG8_LDB
#undef PG8_MMA
#undef PG8_WAIT_V
#undef PG8_WAIT_L
#undef PG8_BAR
#undef PG8_SCHED
}
}

#define GAS __attribute__((address_space(1)))
#define LAS __attribute__((address_space(3)))
typedef unsigned short bf16;
typedef unsigned v4u __attribute__((ext_vector_type(4)));
typedef unsigned v2u __attribute__((ext_vector_type(2)));
typedef float f32x4 __attribute__((ext_vector_type(4)));
typedef float f32x2 __attribute__((ext_vector_type(2)));
typedef float f32x16 __attribute__((ext_vector_type(16)));
typedef short bf16x8 __attribute__((ext_vector_type(8)));
typedef __bf16 bf16x2_t __attribute__((ext_vector_type(2)));
typedef _Float16 half2_t __attribute__((ext_vector_type(2)));
__device__ __forceinline__ unsigned pkh2(float lo, float hi) { f32x2 v = {lo, hi}; half2_t h = __builtin_convertvector(v, half2_t); return __builtin_bit_cast(unsigned, h); }
__device__ __forceinline__ float hlo(unsigned u) { return (float)__builtin_bit_cast(half2_t, u)[0]; }
__device__ __forceinline__ float hhi(unsigned u) { return (float)__builtin_bit_cast(half2_t, u)[1]; }
typedef GAS unsigned gu32;
#define RLX_AGENT __ATOMIC_RELAXED, __HIP_MEMORY_SCOPE_AGENT
#define SWZ(o) (((o) << 10) | 0x1f)
#define LDS_WAIT() asm volatile("s_waitcnt lgkmcnt(0)" ::: "memory")
#define VM_WAIT() asm volatile("s_waitcnt vmcnt(0)" ::: "memory")
__device__ __forceinline__ unsigned pk2(float lo, float hi) { f32x2 v = {lo, hi}; bf16x2_t b = __builtin_convertvector(v, bf16x2_t); return __builtin_bit_cast(unsigned, b); }
__device__ __forceinline__ float bflo(unsigned u) { return __builtin_bit_cast(float, u << 16); }
__device__ __forceinline__ float bfhi(unsigned u) { return __builtin_bit_cast(float, u & 0xffff0000u); }
__device__ __forceinline__ float dot2bf(unsigned a, unsigned b, float acc) { return __builtin_amdgcn_fdot2_f32_bf16(__builtin_bit_cast(bf16x2_t, a), __builtin_bit_cast(bf16x2_t, b), acc, false); }
template <int CTRL> __device__ __forceinline__ float dppf(float v) { return __builtin_bit_cast(float, __builtin_amdgcn_update_dpp(0, __builtin_bit_cast(int, v), CTRL, 0xf, 0xf, true)); }
__device__ __forceinline__ float wave_sum(float v, int lane) {
    v += shx<1>(v, lane); v += shx<2>(v, lane); v += shx<4>(v, lane); v += shx<8>(v, lane); v += shx<16>(v, lane); v += shx<32>(v, lane);
    return v;
}


__device__ __forceinline__ float row_rinv(const float* ssq16, int r, float invdim) {
    const f32x4* p = (const f32x4*)(ssq16 + (size_t)r * 16); const f32x4 a = p[0], b = p[1], c = p[2], d = p[3];
    const float s = ((a[0] + a[1]) + (a[2] + a[3])) + ((b[0] + b[1]) + (b[2] + b[3])) + (((c[0] + c[1]) + (c[2] + c[3])) + ((d[0] + d[1]) + (d[2] + d[3])));
    return __builtin_amdgcn_rsqf(s * invdim + 1e-6f);
}

#define XB_TMO      128
#define XB_XCNT(j)  (256  + 64 * (j))
#define XB_XSUB(j)  (1280 + 64 * (j))
#define XB_XGEN(j)  (2304 + 64 * (j))
#define XB_TOP      3328
#define XB_TOPGEN   3392
#define XCD_BAR_WORDS 3456
#define XB_SPIN_CAP (1u << 18)

__device__ __forceinline__ unsigned xb_ld(unsigned* p)              { return __hip_atomic_load(p, __ATOMIC_RELAXED, __HIP_MEMORY_SCOPE_AGENT); }
__device__ __forceinline__ unsigned xb_add(unsigned* p, unsigned v) { return __hip_atomic_fetch_add(p, v, __ATOMIC_RELAXED, __HIP_MEMORY_SCOPE_AGENT); }
__device__ __forceinline__ unsigned xb_xcc_id() { return (unsigned)__builtin_amdgcn_s_getreg((3 << 11) | 20) & 0xFu; }
#define XB_SPIN(cond, bar) do { unsigned _sp = 0; while (cond) { __builtin_amdgcn_s_sleep(1); \
    if ((++_sp & 255u) == 0u) { if (xb_ld(&(bar)[XB_TMO])) break; if (_sp > XB_SPIN_CAP) { atomicAdd(&(bar)[XB_TMO], 1u); break; } } } } while (0)

struct XcdBarrier {
    unsigned* bar; unsigned x;
    volatile LAS unsigned* st;
};
__device__ __forceinline__ XcdBarrier xcd_barrier_post(unsigned* bar, volatile LAS unsigned* st, bool t0) {
    XcdBarrier b; b.bar = bar; b.x = xb_xcc_id(); b.st = st;
    if (t0) (void)xb_add(&bar[XB_XCNT(b.x)], 1u);
    return b;
}
__device__ __forceinline__ void xcd_barrier_complete(unsigned* bar, unsigned x, unsigned& nloc, unsigned& nx) {
    const unsigned G = gridDim.x * gridDim.y * gridDim.z;
    unsigned sum, cnt, mine, sp = 0u;
    for (;;) {
        sum = 0u; cnt = 0u; mine = 0u;
#pragma unroll
        for (unsigned j = 0; j < 16; ++j) { const unsigned c = xb_ld(&bar[XB_XCNT(j)]); sum += c; cnt += (c > 0u) ? 1u : 0u; mine = (j == x) ? c : mine; }
        if (sum == G) break;
        __builtin_amdgcn_s_sleep(1);
        if ((++sp & 255u) == 0u) { if (xb_ld(&bar[XB_TMO])) break; if (sp > XB_SPIN_CAP) { atomicAdd(&bar[XB_TMO], 1u); break; } }
    }
    nloc = mine > 0u ? mine : 1u; nx = cnt > 0u ? cnt : 1u;
}
__device__ __forceinline__ void xcd_barrier(const XcdBarrier& b, bool t0) {
    asm volatile("s_waitcnt vmcnt(0)" ::: "memory");
    __syncthreads();
    if (t0) {
        unsigned* bar = b.bar;
        __builtin_amdgcn_s_waitcnt(0);
        unsigned nloc = b.st[0], nx = b.st[1];
        if (nloc == 0u) { xcd_barrier_complete(bar, b.x, nloc, nx); b.st[0] = nloc; b.st[1] = nx; }
        const unsigned old = xb_add(&bar[XB_XSUB(b.x)], 1u);
        const unsigned gen = old / nloc;
        if (old + 1u == (gen + 1u) * nloc) {
            __builtin_amdgcn_fence(__ATOMIC_RELEASE, "agent");
            asm volatile("s_waitcnt vmcnt(0)" ::: "memory");
            const unsigned og = xb_add(&bar[XB_TOP], 1u);
            const unsigned tg = og / nx;
            if (og + 1u == (tg + 1u) * nx) xb_add(&bar[XB_TOPGEN], 1u);
            else XB_SPIN(xb_ld(&bar[XB_TOPGEN]) == tg, bar);
            __builtin_amdgcn_fence(__ATOMIC_ACQUIRE, "agent");
            xb_add(&bar[XB_XGEN(b.x)], 1u);
            asm volatile("s_waitcnt vmcnt(0)" ::: "memory");
        } else {
            XB_SPIN(xb_ld(&bar[XB_XGEN(b.x)]) == gen, bar);
            __builtin_amdgcn_fence(__ATOMIC_ACQUIRE, "agent");
            asm volatile("s_waitcnt vmcnt(0)" ::: "memory");
        }
    }
    __syncthreads();
}

constexpr int NWAVES = 8, NTHR = 512;
constexpr int T = 32768, D = 1024, NBATCH = 8, SEQ = 4096, DEPTH = 4;
constexpr int NHEAD = 8, QKN = 128, QKR = 64, DQK = 192, VH = 128, QRANK = 768, KVRANK = 256;
constexpr int NKEYS = 128, NEXP = 16384, PTOPK = 16, PLE = 256;
constexpr float EPS = 1e-6f;
constexpr float C2 = 0.07216878364870322f * 1.4426950408889634f;

constexpr size_t MiB = 1u << 20;
constexpr size_t WS_CTL = 0, CTL_ZERO_BYTES = 64 * 1024;
constexpr size_t WS_SSQ = 840 * MiB;
constexpr size_t WS_COS = 3 * MiB, WS_SIN = 7 * MiB;
constexpr size_t WS_W = 11 * MiB;
constexpr size_t W_WEFF = WS_W;
constexpr size_t W_WG = W_WEFF + 16 * MiB;
constexpr size_t W_WP = W_WG + 8 * MiB;
constexpr size_t W_POOL = W_WP + 2 * MiB;
constexpr size_t W_DOWN2 = W_POOL + 1 * MiB;
constexpr size_t W_DOWN3 = W_DOWN2 + 2560 * 1024;
constexpr size_t W_KNW = W_DOWN3 + 1536 * 1024;
constexpr size_t W_VW = W_KNW + 512 * 1024;
constexpr size_t W_UQ = W_VW + 512 * 1024;
constexpr size_t W_WO = W_UQ + 4608 * 1024;
constexpr size_t WS_WEND = W_WO + 4 * MiB;
constexpr size_t WS_X = 52 * MiB;
constexpr size_t WS_XBA = 180 * MiB, WS_XBB = 244 * MiB;
constexpr size_t WS_UV = 308 * MiB;
constexpr size_t WS_UVS = 340 * MiB;
constexpr size_t WS_UV2 = 52 * MiB, WS_UVS2 = 84 * MiB;
__host__ __device__ constexpr size_t tab_off(int set) { return set ? WS_UV2 : WS_UV; }
__host__ __device__ constexpr size_t tabs_off(int set) { return set ? WS_UVS2 : WS_UVS; }
constexpr size_t WS_PB = 372 * MiB;
constexpr size_t WS_PP = 388 * MiB;
constexpr size_t WS_KN = 452 * MiB;
constexpr size_t WS_VT = 516 * MiB;
constexpr size_t WS_KPE = 580 * MiB;
constexpr size_t WS_R1 = 584 * MiB;
constexpr size_t WS_S = WS_R1;
constexpr size_t WS_POOLED = WS_R1;
constexpr size_t WS_Q = WS_R1;
constexpr size_t WS_AO = WS_R1 + 96 * MiB;
constexpr size_t WS_CQ = WS_R1 + 160 * MiB;
constexpr size_t WS_CKV = WS_R1 + 208 * MiB;
constexpr size_t WS_IDX = 872 * MiB;
constexpr size_t WS_GW = 880 * MiB, WS_MU = 896 * MiB;
constexpr size_t WS_PART = WS_R1;
constexpr size_t WS_WW = WS_R1 + 128 * MiB;
constexpr size_t WS_END = 912 * MiB;
constexpr size_t SSQ_ARR = (size_t)32768 * 16;
static_assert(WS_WEND <= WS_X, "weights");

constexpr int RING_BYTES = 139264;
constexpr int MISC_OFF = RING_BYTES + 320;
constexpr int LDS_BYTES = 147456;

namespace epi {
using pg8::Unit; using pg8::cvt_pk_bf16;
typedef float f32x4 __attribute__((ext_vector_type(4)));
typedef unsigned u32x4 __attribute__((ext_vector_type(4)));
typedef unsigned u32x2 __attribute__((ext_vector_type(2)));
__device__ __forceinline__ float dot4(f32x4 v) { return (v[0] * v[0] + v[1] * v[1]) + (v[2] * v[2] + v[3] * v[3]); }
__device__ __forceinline__ void rinv8(const float* ssq, int rbase, int fr, int fq, float invdim, float (&ri)[8]) {
    f32x4 q[8];
#pragma unroll
    for (int k = 0; k < 8; ++k) q[k] = *(const f32x4*)(ssq + (size_t)(rbase + (k >> 2) * 128 + (k & 3) * 16) * 16 + 4 * fq);
#pragma unroll
    for (int k = 0; k < 8; ++k) { float s = (q[k][0] + q[k][1]) + (q[k][2] + q[k][3]); s += shx<16>(s, fq * 16 + fr); s += shx<32>(s, fq * 16 + fr); ri[k] = __builtin_amdgcn_rsqf(s * invdim + 1e-6f); }
}

struct Resid {
    static constexpr bool PERM = true;
    bf16* XB; float* ssq_out;
    __device__ __forceinline__ void operator()(const f32x4 (&acc)[2][2][4][2], const Unit& u, int wr, int wc, int fr, int fq) const {
        const int col0 = u.pn * 256 + wc * 32 + 8 * fq;
        float sv[8]; u32x4 xo[8][2];
        bf16* const b0 = XB + (size_t)(u.pm * 256 + wr * 64 + fr) * D + col0;
#define EPI_ROW(k) (b0 + (size_t)(((k) >> 2) * 128 + ((k) & 3) * 16) * D)
#define EPI_LOAD(k) do { xo[k][0] = *(const u32x4*)EPI_ROW(k); xo[k][1] = *(const u32x4*)(EPI_ROW(k) + 128); } while (0)
        EPI_LOAD(0); EPI_LOAD(1); EPI_LOAD(2);
#pragma unroll
        for (int k = 0; k < 8; ++k) { const int ai = k >> 2, m = k & 3; float s = 0.f;
            if (k + 3 < 8) EPI_LOAD(k + 3);
#pragma unroll
            for (int bj = 0; bj < 2; ++bj) { const u32x4 x = xo[k][bj];
                const f32x4 v0 = (f32x4){bflo(x.x), bfhi(x.x), bflo(x.y), bfhi(x.y)} + acc[ai][bj][m][0], v1 = (f32x4){bflo(x.z), bfhi(x.z), bflo(x.w), bfhi(x.w)} + acc[ai][bj][m][1];
                u32x4 w; w.x = cvt_pk_bf16(v0[0], v0[1]); w.y = cvt_pk_bf16(v0[2], v0[3]); w.z = cvt_pk_bf16(v1[0], v1[1]); w.w = cvt_pk_bf16(v1[2], v1[3]); *(u32x4*)(EPI_ROW(k) + bj * 128) = w;
                s += dot4(v0) + dot4(v1); }
            s += shx<16>(s, fq * 16 + fr); s += shx<32>(s, fq * 16 + fr); sv[k] = s;
        }
#undef EPI_LOAD
#undef EPI_ROW
        if (fq == 0) {
#pragma unroll
            for (int k = 0; k < 8; ++k) ssq_out[(size_t)(u.pm * 256 + (k >> 2) * 128 + wr * 64 + (k & 3) * 16 + fr) * 16 + u.pn * 4 + wc] = sv[k]; }
    }
};
struct Score {
    static constexpr bool PERM = true;
    unsigned short* S; int ldc; const float* ssq;
    __device__ __forceinline__ void operator()(const f32x4 (&acc)[2][2][4][2], const Unit& u, int wr, int wc, int fr, int fq) const {
        const int col0 = u.pn * 256 + wc * 32 + 8 * fq;
        float ri8[8]; rinv8(ssq, u.pm * 256 + wr * 64 + fr, fr, fq, 1.f / D, ri8);
#pragma unroll
        for (int ai = 0; ai < 2; ++ai)
#pragma unroll
            for (int m = 0; m < 4; ++m) {
                const int r = u.pm * 256 + ai * 128 + wr * 64 + m * 16 + fr; const float ri = ri8[ai * 4 + m];
                unsigned short* sr = S + (size_t)r * ldc + col0;
#pragma unroll
                for (int bj = 0; bj < 2; ++bj) { const f32x4 v0 = acc[ai][bj][m][0] * ri, v1 = acc[ai][bj][m][1] * ri; u32x4 w;
                    w.x = pkh2(v0[0], v0[1]); w.y = pkh2(v0[2], v0[3]); w.z = pkh2(v1[0], v1[1]); w.w = pkh2(v1[2], v1[3]); *(u32x4*)(sr + bj * 128) = w; }
            }
    }
};
struct Bf16Row {
    static constexpr bool PERM = true;
    bf16* O; int ldc; const float* ssq; float invdim;
    __device__ __forceinline__ void operator()(const f32x4 (&acc)[2][2][4][2], const Unit& u, int wr, int wc, int fr, int fq) const {
        const int col0 = u.pn * 256 + wc * 32 + 8 * fq;
        float ri8[8];
        if (ssq) rinv8(ssq, u.pm * 256 + wr * 64 + fr, fr, fq, invdim, ri8);
        else {
#pragma unroll
            for (int k = 0; k < 8; ++k) ri8[k] = 1.f; }
#pragma unroll
        for (int ai = 0; ai < 2; ++ai)
#pragma unroll
            for (int m = 0; m < 4; ++m) {
                const int r = u.pm * 256 + ai * 128 + wr * 64 + m * 16 + fr; const float ri = ri8[ai * 4 + m];
                bf16* orow = O + (size_t)r * ldc + col0;
#pragma unroll
                for (int bj = 0; bj < 2; ++bj) { const f32x4 v0 = acc[ai][bj][m][0] * ri, v1 = acc[ai][bj][m][1] * ri; u32x4 w;
                    w.x = cvt_pk_bf16(v0[0], v0[1]); w.y = cvt_pk_bf16(v0[2], v0[3]); w.z = cvt_pk_bf16(v1[0], v1[1]); w.w = cvt_pk_bf16(v1[2], v1[3]); *(u32x4*)(orow + bj * 128) = w; }
            }
    }
};
struct VTCol {
    static constexpr bool PERM = true;
    bf16* O; const float* ssq; float invdim;
    __device__ __forceinline__ void operator()(const f32x4 (&acc)[2][2][4][2], const Unit& u, int wr, int wc, int fr, int fq) const {
        const int col0 = u.pn * 256 + wc * 32 + 8 * fq;
#pragma unroll
        for (int bj = 0; bj < 2; ++bj) {
            f32x4 sc0, sc1;
#pragma unroll
            for (int j = 0; j < 4; ++j) { sc0[j] = row_rinv(ssq, col0 + bj * 128 + j, invdim); sc1[j] = row_rinv(ssq, col0 + bj * 128 + 4 + j, invdim); }
#pragma unroll
            for (int ai = 0; ai < 2; ++ai)
#pragma unroll
                for (int m = 0; m < 4; ++m) {
                    const int r = u.pm * 256 + ai * 128 + wr * 64 + m * 16 + fr;
                    const f32x4 v0 = acc[ai][bj][m][0] * sc0, v1 = acc[ai][bj][m][1] * sc1; u32x4 w;
                    w.x = cvt_pk_bf16(v0[0], v0[1]); w.y = cvt_pk_bf16(v0[2], v0[3]); w.z = cvt_pk_bf16(v1[0], v1[1]); w.w = cvt_pk_bf16(v1[2], v1[3]);
                    *(u32x4*)(O + (size_t)r * T + col0 + bj * 128) = w;
                }
        }
    }
};
struct Gate {
    static constexpr bool PERM = true;
    const bf16* XBc; bf16* XBn; const bf16* PP; const float* ssq; float* ssq_out;
    __device__ __forceinline__ void operator()(const f32x4 (&acc)[2][2][4][2], const Unit& u, int wr, int wc, int fr, int fq) const {
        const int col0 = u.pn * 256 + wc * 32 + 8 * fq;
        float ri8[8], sv[8]; rinv8(ssq, u.pm * 256 + wr * 64 + fr, fr, fq, 1.f / D, ri8);
        u32x4 xo[8][2], pw[8][2];
        const size_t o0 = (size_t)(u.pm * 256 + wr * 64 + fr) * D + col0;
#define EPI_OFF(k) (o0 + (size_t)(((k) >> 2) * 128 + ((k) & 3) * 16) * D)
#define EPI_LOAD(k) do { xo[k][0] = *(const u32x4*)(XBc + EPI_OFF(k)); pw[k][0] = *(const u32x4*)(PP + EPI_OFF(k)); xo[k][1] = *(const u32x4*)(XBc + EPI_OFF(k) + 128); pw[k][1] = *(const u32x4*)(PP + EPI_OFF(k) + 128); } while (0)
        EPI_LOAD(0); EPI_LOAD(1); EPI_LOAD(2);
#pragma unroll
        for (int k = 0; k < 8; ++k) { const int ai = k >> 2, m = k & 3; const float ri = ri8[k]; float s = 0.f;
            if (k + 3 < 8) EPI_LOAD(k + 3);
#pragma unroll
            for (int bj = 0; bj < 2; ++bj) { const u32x4 x = xo[k][bj], p = pw[k][bj];
                const f32x4 z0 = acc[ai][bj][m][0] * ri, z1 = acc[ai][bj][m][1] * ri; f32x4 g0, g1;
#pragma unroll
                for (int j = 0; j < 4; ++j) { g0[j] = __builtin_amdgcn_rcpf(1.f + __builtin_amdgcn_exp2f(-1.4426950408889634f * z0[j])); g1[j] = __builtin_amdgcn_rcpf(1.f + __builtin_amdgcn_exp2f(-1.4426950408889634f * z1[j])); }
                const f32x4 v0 = (f32x4){bflo(x.x), bfhi(x.x), bflo(x.y), bfhi(x.y)} + g0 * (f32x4){bflo(p.x), bfhi(p.x), bflo(p.y), bfhi(p.y)};
                const f32x4 v1 = (f32x4){bflo(x.z), bfhi(x.z), bflo(x.w), bfhi(x.w)} + g1 * (f32x4){bflo(p.z), bfhi(p.z), bflo(p.w), bfhi(p.w)};
                u32x4 w; w.x = cvt_pk_bf16(v0[0], v0[1]); w.y = cvt_pk_bf16(v0[2], v0[3]); w.z = cvt_pk_bf16(v1[0], v1[1]); w.w = cvt_pk_bf16(v1[2], v1[3]); *(u32x4*)(XBn + EPI_OFF(k) + bj * 128) = w;
                s += dot4(v0) + dot4(v1); }
            s += shx<16>(s, fq * 16 + fr); s += shx<32>(s, fq * 16 + fr); sv[k] = s;
        }
#undef EPI_LOAD
#undef EPI_OFF
        if (fq == 0) {
#pragma unroll
            for (int k = 0; k < 8; ++k) ssq_out[(size_t)(u.pm * 256 + (k >> 2) * 128 + wr * 64 + (k & 3) * 16 + fr) * 16 + u.pn * 4 + wc] = sv[k]; }
    }
};
struct Down {
    static constexpr bool PERM = true;
    bf16* CQ; bf16* CKV; bf16* KPE; const float* ssq; float* ssq_q; float* ssq_kv; const float* COS; const float* SIN;
    __device__ __forceinline__ void operator()(const f32x4 (&acc)[2][2][4][2], const Unit& u, int wr, int wc, int fr, int fq) const {
        const int tc0 = wc * 32 + 8 * fq;
        float ri8[8], sv[8]; rinv8(ssq, u.pm * 256 + wr * 64 + fr, fr, fq, 1.f / D, ri8);
#pragma unroll
        for (int k = 0; k < 8; ++k) sv[k] = 0.f;
#pragma unroll
        for (int ai = 0; ai < 2; ++ai)
#pragma unroll
            for (int m = 0; m < 4; ++m) {
                const int r = u.pm * 256 + ai * 128 + wr * 64 + m * 16 + fr; const float ri = ri8[ai * 4 + m];
                if (u.pn < 4) {
                    bf16* orow = (u.pn < 3) ? CQ + (size_t)r * QRANK + u.pn * 256 + tc0 : CKV + (size_t)r * KVRANK + tc0; float s = 0.f;
#pragma unroll
                    for (int bj = 0; bj < 2; ++bj) { const f32x4 v0 = acc[ai][bj][m][0] * ri, v1 = acc[ai][bj][m][1] * ri; u32x4 w;
                        w.x = cvt_pk_bf16(v0[0], v0[1]); w.y = cvt_pk_bf16(v0[2], v0[3]); w.z = cvt_pk_bf16(v1[0], v1[1]); w.w = cvt_pk_bf16(v1[2], v1[3]); *(u32x4*)(orow + bj * 128) = w;
                        s += dot4(v0) + dot4(v1); }
                    s += shx<16>(s, fq * 16 + fr); s += shx<32>(s, fq * 16 + fr); sv[ai * 4 + m] = s;
                } else if (wc < 2) {
                    const f32x4 cs = *(const f32x4*)(COS + (size_t)r * 32 + wc * 16 + 4 * fq), sn = *(const f32x4*)(SIN + (size_t)r * 32 + wc * 16 + 4 * fq);
                    const f32x4 v0 = acc[ai][0][m][0] * ri, v1 = acc[ai][0][m][1] * ri; u32x4 w;
                    w.x = cvt_pk_bf16(v0[0] * cs[0] - v0[1] * sn[0], v0[1] * cs[0] + v0[0] * sn[0]);
                    w.y = cvt_pk_bf16(v0[2] * cs[1] - v0[3] * sn[1], v0[3] * cs[1] + v0[2] * sn[1]);
                    w.z = cvt_pk_bf16(v1[0] * cs[2] - v1[1] * sn[2], v1[1] * cs[2] + v1[0] * sn[2]);
                    w.w = cvt_pk_bf16(v1[2] * cs[3] - v1[3] * sn[3], v1[3] * cs[3] + v1[2] * sn[3]);
                    *(u32x4*)(KPE + (size_t)r * QKR + tc0) = w;
                }
            }
        if (u.pn < 4 && fq == 0) {
            float* const so = (u.pn < 3) ? ssq_q + u.pn * 4 + wc : ssq_kv + wc;
#pragma unroll
            for (int k = 0; k < 8; ++k) so[(size_t)(u.pm * 256 + (k >> 2) * 128 + wr * 64 + (k & 3) * 16 + fr) * 16] = sv[k]; }
    }
};
struct QUp {
    static constexpr bool PERM = true;
    bf16* Q; const float* ssq_q; const float* COS; const float* SIN;
    __device__ __forceinline__ void operator()(const f32x4 (&acc)[2][2][4][2], const Unit& u, int wr, int wc, int fr, int fq) const {
        float ri8[8]; rinv8(ssq_q, u.pm * 256 + wr * 64 + fr, fr, fq, 1.f / QRANK, ri8);
        const int r0 = u.pm * 256 + wr * 64 + fr;
#pragma unroll
        for (int bj = 0; bj < 2; ++bj) {
            const int c0w = u.pn * 256 + bj * 128 + wc * 32, c8 = c0w + 8 * fq;
            if ((c0w % DQK) >= QKN) {
                const int pb = ((c8 % DQK) - QKN) >> 1;
                f32x4 cs[8], sn[8];
#pragma unroll
                for (int k = 0; k < 8; ++k) { const size_t ro = (size_t)(r0 + (k >> 2) * 128 + (k & 3) * 16) * 32 + pb; cs[k] = *(const f32x4*)(COS + ro); sn[k] = *(const f32x4*)(SIN + ro); }
#pragma unroll
                for (int k = 0; k < 8; ++k) { const int ai = k >> 2, m = k & 3; const float ri = ri8[k];
                    const f32x4 v0 = acc[ai][bj][m][0] * ri, v1 = acc[ai][bj][m][1] * ri; u32x4 w;
                    w.x = cvt_pk_bf16(v0[0] * cs[k][0] - v0[1] * sn[k][0], v0[1] * cs[k][0] + v0[0] * sn[k][0]);
                    w.y = cvt_pk_bf16(v0[2] * cs[k][1] - v0[3] * sn[k][1], v0[3] * cs[k][1] + v0[2] * sn[k][1]);
                    w.z = cvt_pk_bf16(v1[0] * cs[k][2] - v1[1] * sn[k][2], v1[1] * cs[k][2] + v1[0] * sn[k][2]);
                    w.w = cvt_pk_bf16(v1[2] * cs[k][3] - v1[3] * sn[k][3], v1[3] * cs[k][3] + v1[2] * sn[k][3]);
                    *(u32x4*)(Q + (size_t)(r0 + ai * 128 + m * 16) * (NHEAD * DQK) + c8) = w; }
            } else {
#pragma unroll
                for (int k = 0; k < 8; ++k) { const int ai = k >> 2, m = k & 3; const float ri = ri8[k];
                    const f32x4 v0 = acc[ai][bj][m][0] * ri, v1 = acc[ai][bj][m][1] * ri; u32x4 w;
                    w.x = cvt_pk_bf16(v0[0], v0[1]); w.y = cvt_pk_bf16(v0[2], v0[3]); w.z = cvt_pk_bf16(v1[0], v1[1]); w.w = cvt_pk_bf16(v1[2], v1[3]);
                    *(u32x4*)(Q + (size_t)(r0 + ai * 128 + m * 16) * (NHEAD * DQK) + c8) = w; }
            }
        }
    }
};
struct Null {
    static constexpr bool PERM = true;
    float* O;
    __device__ __forceinline__ void operator()(const f32x4 (&acc)[2][2][4][2], const Unit& u, int wr, int wc, int fr, int fq) const {
        f32x4 s = {0.f, 0.f, 0.f, 0.f};
#pragma unroll
        for (int ai = 0; ai < 2; ++ai)
#pragma unroll
            for (int bj = 0; bj < 2; ++bj)
#pragma unroll
                for (int m = 0; m < 4; ++m) s += acc[ai][bj][m][0] + acc[ai][bj][m][1];
        O[(size_t)(u.pm * 8 + u.pn) * 512 + (wr * 4 + wc) * 64 + fq * 16 + fr] = (s[0] + s[1]) + (s[2] + s[3]);
    }
};
}

struct TJob { const float* W; int ldw; int K; int Nout; bf16* out; int mode; const float* rs; const float* cs; float cmul; };
__device__ __forceinline__ int tj_src(int mode, int n) {
    if (mode == 1) { if (n < KVRANK) return n; const int rr = n - KVRANK; return KVRANK + (rr >> 1) + 32 * (rr & 1); }
    if (mode == 2) { const int hd = n / DQK, r = n % DQK; if (r < QKN) return n; const int rr = r - QKN; return hd * DQK + QKN + (rr >> 1) + 32 * (rr & 1); }
    if (mode == 3) return (n >> 7) * 256 + (n & 127);
    if (mode == 4) return (n >> 7) * 256 + 128 + (n & 127);
    return n;
}
__device__ __forceinline__ void transpose_tile(const TJob& j, LAS float* scr, int tile, int tid) {
    const int nkt = j.K >> 6, n0 = (tile / nkt) * 64, k0 = (tile % nkt) * 64;
    { const int nn = tid & 63; const int src = (j.mode == 5) ? -1 : tj_src(j.mode, n0 + nn);
      const float csv = (j.cs ? j.cs[n0 + nn] : 1.f) * j.cmul;
#pragma unroll
      for (int i = 0; i < 8; ++i) { const int kk = (tid >> 6) + 8 * i; float v = 0.f;
          if (src >= 0) v = j.W[(size_t)(k0 + kk) * j.ldw + src] * (j.rs ? j.rs[k0 + kk] : 1.f) * csv;
          scr[kk * 65 + nn] = v; } }
    __syncthreads();
    { const int kk2 = (tid & 31) * 2;
#pragma unroll
      for (int i = 0; i < 4; ++i) { const int nn2 = (tid >> 5) + 16 * i;
          *(unsigned*)(j.out + (size_t)(n0 + nn2) * j.K + k0 + kk2) = pk2(scr[kk2 * 65 + nn2], scr[(kk2 + 1) * 65 + nn2]); } }
    __syncthreads();
}
__device__ __forceinline__ void transpose_tile2(const TJob& ja, int tileA, const TJob& jb, int tileB, LAS float* scr, int tid) {
    LAS float* scr2 = scr + 64 * 65 + 32;
    const int nkA = ja.K >> 6, nkB = jb.K >> 6;
    const int nA = (tileA / nkA) * 64, kA = (tileA % nkA) * 64, nB = (tileB / nkB) * 64, kB = (tileB % nkB) * 64;
    { const int nn = tid & 63; const bool zA = ja.mode == 5, zB = jb.mode == 5; const int sA = zA ? 0 : tj_src(ja.mode, nA + nn), sB = zB ? 0 : tj_src(jb.mode, nB + nn);
      const float cA = zA ? 0.f : (ja.cs ? ja.cs[nA + nn] : 1.f) * ja.cmul, cB = zB ? 0.f : (jb.cs ? jb.cs[nB + nn] : 1.f) * jb.cmul;
      float va[8], vb[8], ra[8], rb[8];
#pragma unroll
      for (int i = 0; i < 8; ++i) { const int kk = (tid >> 6) + 8 * i; va[i] = ja.W[(size_t)(kA + kk) * ja.ldw + sA]; vb[i] = jb.W[(size_t)(kB + kk) * jb.ldw + sB];
          ra[i] = ja.rs ? ja.rs[kA + kk] : 1.f; rb[i] = jb.rs ? jb.rs[kB + kk] : 1.f; }
#pragma unroll
      for (int i = 0; i < 8; ++i) { const int kk = (tid >> 6) + 8 * i; scr[kk * 65 + nn] = va[i] * ra[i] * cA; scr2[kk * 65 + nn] = vb[i] * rb[i] * cB; } }
    __syncthreads();
    { const int kk2 = (tid & 31) * 2;
#pragma unroll
      for (int i = 0; i < 4; ++i) { const int nn2 = (tid >> 5) + 16 * i;
          *(unsigned*)(ja.out + (size_t)(nA + nn2) * ja.K + kA + kk2) = pk2(scr[kk2 * 65 + nn2], scr[(kk2 + 1) * 65 + nn2]);
          *(unsigned*)(jb.out + (size_t)(nB + nn2) * jb.K + kB + kk2) = pk2(scr2[kk2 * 65 + nn2], scr2[(kk2 + 1) * 65 + nn2]); } }
    __syncthreads();
}
struct In {
    const float *x, *p; const int* pos; const float *mix_norm, *ffn_norm, *pool_w, *pool_scale, *kv_in_norm, *w_dkv, *kv_norm, *w_ukv, *w_dq, *q_norm, *w_uq, *w_o,
                *peer_wq, *peer_keys, *peer_u, *peer_v, *ple_norm, *ple_wg, *ple_wp, *final_norm;
};
typedef const __attribute__((address_space(4))) In CIn;
__device__ __forceinline__ TJob get_job(int id, CIn& in, unsigned char* ws) {
    TJob j; j.mode = 0; j.rs = nullptr; j.cs = nullptr; j.cmul = 1.f;
    if (id < 4) { j.W = in.ple_wg + (size_t)id * D * D; j.ldw = D; j.K = D; j.Nout = D; j.out = (bf16*)(ws + W_WG) + (size_t)id * D * D; j.rs = in.ple_norm + id * D; }
    else if (id < 8) { const int i = id - 4; j.W = in.ple_wp + (size_t)i * PLE * D; j.ldw = D; j.K = PLE; j.Nout = D; j.out = (bf16*)(ws + W_WP) + (size_t)i * D * PLE; }
    else if (id < 16) { const int i = (id - 8) >> 2, g = (id - 8) & 3; j.W = in.pool_w + (size_t)(i * 4 + g) * 65536; j.ldw = 256; j.K = 256; j.Nout = 256;
        j.out = (bf16*)(ws + W_POOL) + (size_t)(i * 1024 + g * 256) * 256; j.cs = in.pool_scale + i * D + g * 256; }
    else if (id == 16) { j.W = in.w_dq; j.ldw = QRANK; j.K = D; j.Nout = QRANK; j.out = (bf16*)(ws + W_DOWN2); j.rs = in.mix_norm + 2 * D; }
    else if (id == 17) { j.W = in.w_dkv; j.ldw = KVRANK + QKR; j.K = D; j.Nout = KVRANK + QKR; j.out = (bf16*)(ws + W_DOWN2) + (size_t)QRANK * D; j.mode = 1; j.rs = in.kv_in_norm; }
    else if (id == 18) { j.W = in.w_dkv; j.ldw = KVRANK + QKR; j.K = D; j.Nout = 192; j.out = (bf16*)(ws + W_DOWN2) + (size_t)(QRANK + KVRANK + QKR) * D; j.mode = 5; }
    else if (id == 19) { j.W = in.w_dq + (size_t)D * QRANK; j.ldw = QRANK; j.K = D; j.Nout = QRANK; j.out = (bf16*)(ws + W_DOWN3); j.rs = in.mix_norm + 3 * D; }
    else if (id == 20) { j.W = in.w_ukv; j.ldw = 2048; j.K = KVRANK; j.Nout = 1024; j.out = (bf16*)(ws + W_KNW); j.mode = 3; j.rs = in.kv_norm; }
    else if (id == 21) { j.W = in.w_ukv; j.ldw = 2048; j.K = KVRANK; j.Nout = 1024; j.out = (bf16*)(ws + W_VW); j.mode = 4; j.rs = in.kv_norm; }
    else if (id < 24) { const int jj = id - 22; j.W = in.w_uq + (size_t)jj * QRANK * 1536; j.ldw = 1536; j.K = QRANK; j.Nout = 1536; j.out = (bf16*)(ws + W_UQ) + (size_t)jj * 1536 * QRANK;
        j.mode = 2; j.rs = in.q_norm + jj * QRANK; j.cmul = C2; }
    else { const int jj = id - 24; j.W = in.w_o + (size_t)jj * D * D; j.ldw = D; j.K = D; j.Nout = D; j.out = (bf16*)(ws + W_WO) + (size_t)jj * D * D; }
    return j;
}
constexpr int N_TJOBS = 26;
__host__ __device__ constexpr int tj_tiles(int id) {
    return id < 4 ? (D >> 6) * (D >> 6) : id < 8 ? (PLE >> 6) * (D >> 6) : id < 16 ? 16 : id == 16 ? (D >> 6) * (QRANK >> 6) : id == 17 ? (D >> 6) * ((KVRANK + QKR) >> 6)
         : id == 18 ? (D >> 6) * 3 : id == 19 ? (D >> 6) * (QRANK >> 6) : id < 22 ? (KVRANK >> 6) * 16 : id < 24 ? (QRANK >> 6) * 24 : (D >> 6) * (D >> 6);
}

__device__ __forceinline__ void weff_item(const float* wq, const float* keys, const float* gain, bf16* out, int hp, int kt, LAS float* lds, int tid) {
    constexpr int RS = 136;
    LAS unsigned short* Wh = (LAS unsigned short*)lds; LAS unsigned short* Wl = Wh + 64 * RS; LAS unsigned short* Kh = Wl + 64 * RS; LAS unsigned short* Kl = Kh + 128 * RS;
    const int k0 = kt * 64;
#define WEFF_SPLIT(v, ph, pl) do { v2u h_, l_; h_.x = pk2((v)[0], (v)[1]); h_.y = pk2((v)[2], (v)[3]); \
        l_.x = pk2((v)[0] - bflo(h_.x), (v)[1] - bfhi(h_.x)); l_.y = pk2((v)[2] - bflo(h_.y), (v)[3] - bfhi(h_.y)); *(LAS v2u*)(ph) = h_; *(LAS v2u*)(pl) = l_; } while (0)
#pragma unroll
    for (int i = 0; i < 4; ++i) { const int idx = tid + 512 * i, row = idx >> 5, c4 = idx & 31;
        const f32x4 v = *(const f32x4*)(wq + (size_t)(k0 + row) * 2048 + hp * 128 + c4 * 4) * gain[k0 + row]; WEFF_SPLIT(v, Wh + row * RS + c4 * 4, Wl + row * RS + c4 * 4); }
#pragma unroll
    for (int i = 0; i < 8; ++i) { const int idx = tid + 512 * i, row = idx >> 5, c4 = idx & 31;
        const f32x4 v = *(const f32x4*)(keys + (size_t)(hp * 128 + row) * 128 + c4 * 4); WEFF_SPLIT(v, Kh + row * RS + c4 * 4, Kl + row * RS + c4 * 4); }
#undef WEFF_SPLIT
    __syncthreads();
    const int w = tid >> 6, l = tid & 63, tk = w & 1, tn = w >> 1, r32 = l & 31, g = l >> 5;
    f32x16 acc;
#pragma unroll
    for (int r = 0; r < 16; ++r) acc[r] = 0.f;
    const int ao = (32 * tk + r32) * RS + 8 * g, bo = (32 * tn + r32) * RS + 8 * g;
#pragma unroll
    for (int s8 = 0; s8 < 8; ++s8) {
        const bf16x8 ah = *(const LAS bf16x8*)(Wh + ao + 16 * s8), al = *(const LAS bf16x8*)(Wl + ao + 16 * s8);
        const bf16x8 bh = *(const LAS bf16x8*)(Kh + bo + 16 * s8), bl = *(const LAS bf16x8*)(Kl + bo + 16 * s8);
        acc = __builtin_amdgcn_mfma_f32_32x32x16_bf16(ah, bh, acc, 0, 0, 0);
        acc = __builtin_amdgcn_mfma_f32_32x32x16_bf16(ah, bl, acc, 0, 0, 0);
        acc = __builtin_amdgcn_mfma_f32_32x32x16_bf16(al, bh, acc, 0, 0, 0);
    }
#pragma unroll
    for (int gq = 0; gq < 4; ++gq) { v2u o_; o_.x = pk2(acc[4 * gq + 0], acc[4 * gq + 1]); o_.y = pk2(acc[4 * gq + 2], acc[4 * gq + 3]);
        *(v2u*)(out + (size_t)(hp * 128 + 32 * tn + r32) * D + k0 + 32 * tk + 8 * gq + 4 * g) = o_; }
    __syncthreads();
}

__device__ __forceinline__ void p0_prologue(CIn& in, unsigned char* ws, LAS unsigned char* lds, int bid, int G, int wave) {
    const int tid = wave * 64 + lane_id_fresh();
    const int gtid = bid * NTHR + tid, NT = G * NTHR;
    for (int i = gtid + (int)(SSQ_ARR / 4); i < (int)(16 * SSQ_ARR / 4); i += NT) ((f32x4*)(ws + WS_SSQ))[i] = (f32x4){0.f, 0.f, 0.f, 0.f};
    {
      int total = 0;
#pragma unroll
      for (int id = 0; id < N_TJOBS; ++id) total += tj_tiles(id);
      for (int g = bid; g < total; g += 2 * G) {
          int idA = 0, tA = g; while (tA >= tj_tiles(idA)) { tA -= tj_tiles(idA); ++idA; }
          const TJob ja = get_job(idA, in, ws);
          if (g + G < total) { int idB = idA, tB = tA + G; while (tB >= tj_tiles(idB)) { tB -= tj_tiles(idB); ++idB; }
              const TJob jb = get_job(idB, in, ws); transpose_tile2(ja, tA, jb, tB, (LAS float*)lds, tid); }
          else transpose_tile(ja, (LAS float*)lds, tA, tid); } }
    for (int it = bid; it < 4 * 16 * 16; it += G) { const int l = it >> 8, hp = (it >> 4) & 15, kt = it & 15;
        weff_item(in.peer_wq + (size_t)l * D * 2048, in.peer_keys + (size_t)l * 2048 * 128, in.ffn_norm + l * D, (bf16*)(ws + W_WEFF) + (size_t)l * 2048 * D, hp, kt, (LAS float*)lds, tid); }
    for (int i = gtid; i < T * 32; i += NT) { const int t = i >> 5, c = i & 31;
        double inv = 0.15915494309189535; for (int k = 0; k < c; ++k) inv *= 0.7498942093324559;
        double rd = (double)in.pos[t] * inv; rd -= __builtin_floor(rd); const float rr = (float)rd;
        ((float*)(ws + WS_COS))[i] = __builtin_amdgcn_cosf(rr); ((float*)(ws + WS_SIN))[i] = __builtin_amdgcn_sinf(rr); }
    { const int lane = tid & 63, gw = gtid >> 6, NW = NT >> 6; bf16* XB = (bf16*)(ws + WS_XBA); float* ssq = (float*)(ws + WS_SSQ);
      for (int r = gw; r < T; r += 2 * NW) { const int r2 = (r + NW < T) ? r + NW : r; f32x4 va[4], vb[4];
#pragma unroll
          for (int j = 0; j < 4; ++j) { va[j] = *(const f32x4*)(in.x + (size_t)r * D + j * 256 + 4 * lane); vb[j] = *(const f32x4*)(in.x + (size_t)r2 * D + j * 256 + 4 * lane); }
          float s = 0.f, s2 = 0.f;
#pragma unroll
          for (int j = 0; j < 4; ++j) { const size_t o = (size_t)r * D + j * 256 + 4 * lane, o2 = (size_t)r2 * D + j * 256 + 4 * lane;
              v2u w; w.x = pk2(va[j][0], va[j][1]); w.y = pk2(va[j][2], va[j][3]); *(v2u*)(XB + o) = w; s += (va[j][0] * va[j][0] + va[j][1] * va[j][1]) + (va[j][2] * va[j][2] + va[j][3] * va[j][3]);
              v2u y; y.x = pk2(vb[j][0], vb[j][1]); y.y = pk2(vb[j][2], vb[j][3]); *(v2u*)(XB + o2) = y; s2 += (vb[j][0] * vb[j][0] + vb[j][1] * vb[j][1]) + (vb[j][2] * vb[j][2] + vb[j][3] * vb[j][3]); }
          s = wave_sum(s, lane); s2 = wave_sum(s2, lane);
          if (lane < 16) { ssq[(size_t)r * 16 + lane] = (lane == 0) ? s : 0.f; ssq[(size_t)r2 * 16 + lane] = (lane == 0) ? s2 : 0.f; } } }
}
typedef float f2_t __attribute__((ext_vector_type(2)));
template <int CTRL> __device__ __forceinline__ int dppi(int v) { return __builtin_amdgcn_update_dpp(0, v, CTRL, 0xf, 0xf, true); }
__device__ __forceinline__ unsigned wave_max_dpp(unsigned v) {
    v = max(v, (unsigned)dppi<0xB1>((int)v)); v = max(v, (unsigned)dppi<0x4E>((int)v)); v = max(v, (unsigned)dppi<0x141>((int)v)); v = max(v, (unsigned)dppi<0x140>((int)v));
    { unsigned p = v, q = v; asm volatile("s_nop 1\n\tv_permlane16_swap_b32 %0, %1" : "+v"(p), "+v"(q)); v = max(p, q); }
    { unsigned p = v, q = v; asm volatile("s_nop 1\n\tv_permlane32_swap_b32 %0, %1" : "+v"(p), "+v"(q)); v = max(p, q); }
    return v;
}
__device__ __forceinline__ unsigned pack_i8x4(f32x4 v, float inv) {
    const unsigned y0 = __builtin_bit_cast(unsigned, __builtin_fmaf(v[0], inv, 12582912.f)), y1 = __builtin_bit_cast(unsigned, __builtin_fmaf(v[1], inv, 12582912.f));
    const unsigned y2 = __builtin_bit_cast(unsigned, __builtin_fmaf(v[2], inv, 12582912.f)), y3 = __builtin_bit_cast(unsigned, __builtin_fmaf(v[3], inv, 12582912.f));
    return __builtin_amdgcn_perm(y1, y0, 0x0c0c0400u) | (__builtin_amdgcn_perm(y3, y2, 0x0c0c0400u) << 16);
}
__device__ __forceinline__ void quant_store_i8(const f32x4 (&v)[4], unsigned char* tab, int row, float* scale_out, int lane) {
    unsigned amb = 0u;
#pragma unroll
    for (int j = 0; j < 4; ++j)
#pragma unroll
        for (int i = 0; i < 4; ++i) { const float f_ = v[j][i]; amb = max(amb, __builtin_bit_cast(unsigned, f_) & 0x7fffffffu); }
    const float am = __builtin_bit_cast(float, wave_max_dpp(amb));
    const float inv = am > 0.f ? 126.99f * __builtin_amdgcn_rcpf(am) : 0.f;
    v4u w;
#pragma unroll
    for (int j = 0; j < 4; ++j) w[j] = pack_i8x4(v[j], inv);
    *(v4u*)(tab + (size_t)((unsigned)(lane >> 3) * (unsigned)(NEXP * 128) + (unsigned)row * 128u + (unsigned)(lane & 7) * 16u)) = w;
    *scale_out = am * (1.f / 126.99f);
}
__device__ __forceinline__ void convert_layer(CIn& in, unsigned char* ws, int layer, int bid, int G, int wave) {
    const int set = layer & 1;
    const int lane = lane_id_fresh(), tid = wave * 64 + lane;
    const int gtid = bid * NTHR + tid, NT = G * NTHR, gw = gtid >> 6, NW = NT >> 6;
    const float* u = in.peer_u + (size_t)layer * NEXP * D; const float* v = in.peer_v + (size_t)layer * NEXP * D; const float* gn = in.ffn_norm + layer * D;
    unsigned char* U8 = ws + tab_off(set); unsigned char* V8 = U8 + (size_t)NEXP * D; float* SU = (float*)(ws + tabs_off(set)); float* SV = SU + NEXP;
    f32x4 gv[4];
#pragma unroll
    for (int j = 0; j < 4; ++j) gv[j] = *(const f32x4*)(gn + 16 * lane + 4 * j);
    for (int r = gw; r < NEXP; r += 2 * NW) {
        const int r2 = r + NW; const bool ok2 = r2 < NEXP; const int rb = ok2 ? r2 : r;
        f32x4 ua[4], va[4], ub[4], vb[4];
#pragma unroll
        for (int j = 0; j < 4; ++j) { ua[j] = *(const f32x4*)(u + (size_t)r * D + 16 * lane + 4 * j); va[j] = *(const f32x4*)(v + (size_t)r * D + 16 * lane + 4 * j);
            ub[j] = *(const f32x4*)(u + (size_t)rb * D + 16 * lane + 4 * j); vb[j] = *(const f32x4*)(v + (size_t)rb * D + 16 * lane + 4 * j); }
#pragma unroll
        for (int j = 0; j < 4; ++j) { ua[j] = ua[j] * gv[j]; ub[j] = ub[j] * gv[j]; }
        quant_store_i8(ua, U8, r, SU + r, lane); quant_store_i8(va, V8, r, SV + r, lane);
        if (ok2) { quant_store_i8(ub, U8, r2, SU + r2, lane); quant_store_i8(vb, V8, r2, SV + r2, lane); }
    }
    const float* p = in.p + (size_t)layer * T * PLE; bf16* PB = (bf16*)(ws + WS_PB);
    for (int i = gtid; i < T * PLE / 8; i += NT) { const size_t o = (size_t)i * 8; const f32x4 a0 = *(const f32x4*)(p + o), a1 = *(const f32x4*)(p + o + 4);
        v4u w; w.x = pk2(a0[0], a0[1]); w.y = pk2(a0[2], a0[3]); w.z = pk2(a1[0], a1[1]); w.w = pk2(a1[2], a1[3]); *(v4u*)(PB + o) = w; }
}
template <int W>
__device__ __forceinline__ void pooled_strip(const bf16* XB, const LAS float* rinv, const float* gain, bf16* P, int t0, int s0, int tid) {
    const int c0 = 2 * tid; const f32x2 gv = *(const f32x2*)(gain + c0);
    f32x2 ring[W]; f32x2 sum = {0.f, 0.f};
    { unsigned xw[W];
#pragma unroll
      for (int j = 0; j < W; ++j) xw[j] = (s0 - W + j >= 0) ? *(const unsigned*)(XB + (size_t)(t0 - W + j) * D + c0) : 0u;
#pragma unroll
      for (int j = 0; j < W; ++j) { const float ri = (s0 - W + j >= 0) ? rinv[16 - W + j] : 0.f; const f32x2 hv = (f32x2){bflo(xw[j]), bfhi(xw[j])} * ri * gv; ring[j] = hv; sum += hv; } }
    for (int sb = 0; sb < 64; sb += 16) {
        unsigned xw[16];
#pragma unroll
        for (int j = 0; j < 16; ++j) xw[j] = *(const unsigned*)(XB + (size_t)(t0 + sb + j) * D + c0);
#pragma unroll
        for (int j = 0; j < 16; ++j) { const int t = t0 + sb + j, s = s0 + sb + j; const float ri = rinv[16 + sb + j];
            const f32x2 hv = (f32x2){bflo(xw[j]), bfhi(xw[j])} * ri * gv; sum += hv - ring[j % W]; ring[j % W] = hv;
            const float ic = 1.f / (float)((s + 1 < W) ? s + 1 : W); const f32x2 pv = sum * ic - hv;
            *(unsigned*)(P + (size_t)t * D + c0) = pk2(pv[0], pv[1]); }
    }
}
__device__ __forceinline__ void pooled_phase(const bf16* XB, const float* ssq, const float* gain, bf16* P, LAS unsigned char* lds, int vcu, int G, int wave) {
    const int tid = wave * 64 + lane_id_fresh();
    const int g = wave >> 1;
    LAS float* rinv = (LAS float*)lds;
    for (int strip = vcu; strip < T / 64; strip += G) { const int t0 = strip * 64, s0 = t0 & (SEQ - 1);
        __syncthreads();
        if (tid < 80) { const int t = t0 - 16 + tid; rinv[tid] = (s0 - 16 + tid >= 0) ? row_rinv(ssq, t, 1.f / D) : 0.f; }
        __syncthreads();
        if (g == 0) pooled_strip<2>(XB, rinv, gain, P, t0, s0, tid); else if (g == 1) pooled_strip<4>(XB, rinv, gain, P, t0, s0, tid);
        else if (g == 2) pooled_strip<8>(XB, rinv, gain, P, t0, s0, tid); else pooled_strip<16>(XB, rinv, gain, P, t0, s0, tid); }
}
__device__ __forceinline__ void final_phase(const bf16* XB, const float* ssq, const float* gain, float* out, int bid, int G, int wave) {
    const int tid = wave * 64 + lane_id_fresh();
    const int lane = tid & 63, gw = (bid * NTHR + tid) >> 6, NW = (G * NTHR) >> 6;
    f32x4 gv[4];
#pragma unroll
    for (int j = 0; j < 4; ++j) gv[j] = *(const f32x4*)(gain + j * 256 + 4 * lane);
    int r = gw;
    for (; r + 3 * NW < T; r += 4 * NW) {
        f32x4 sq[4]; v2u xw[4][4];
#pragma unroll
        for (int k = 0; k < 4; ++k) { const int rr = r + k * NW; sq[k] = *(const f32x4*)(ssq + (size_t)rr * 16 + 4 * (lane & 3));
#pragma unroll
            for (int j = 0; j < 4; ++j) xw[k][j] = *(const v2u*)(XB + (size_t)rr * D + j * 256 + 4 * lane); }
#pragma unroll
        for (int k = 0; k < 4; ++k) { const int rr = r + k * NW;
            float sv = (sq[k][0] + sq[k][1]) + (sq[k][2] + sq[k][3]); sv += dppf<0xB1>(sv); sv += dppf<0x4E>(sv);
            const float ri = __builtin_amdgcn_rsqf(sv * (1.f / D) + 1e-6f);
#pragma unroll
            for (int j = 0; j < 4; ++j) *(f32x4*)(out + (size_t)rr * D + j * 256 + 4 * lane) = (f32x4){bflo(xw[k][j].x), bfhi(xw[k][j].x), bflo(xw[k][j].y), bfhi(xw[k][j].y)} * ri * gv[j]; }
    }
    for (; r < T; r += NW) { const float ri = row_rinv(ssq, r, 1.f / D);
#pragma unroll
        for (int j = 0; j < 4; ++j) { const size_t o = (size_t)r * D + j * 256 + 4 * lane; const v2u x1 = *(const v2u*)(XB + o); *(f32x4*)(out + o) = (f32x4){bflo(x1.x), bfhi(x1.x), bflo(x1.y), bfhi(x1.y)} * ri * gv[j]; } }
}

__device__ __forceinline__ unsigned fkey(float f) { const unsigned u = __builtin_bit_cast(unsigned, f); return u ^ ((unsigned)((int)u >> 31) | 0x80000000u); }
__device__ __forceinline__ unsigned mbcnt64(unsigned long long m) { return __builtin_amdgcn_mbcnt_hi((unsigned)(m >> 32), __builtin_amdgcn_mbcnt_lo((unsigned)m, 0u)); }
template <int N>
__device__ __forceinline__ void select16(const unsigned (&key)[N], unsigned (&pos)[N]) {
    unsigned prefix = 0u;
    for (int bit = 31; bit >= 0; --bit) {
        const unsigned cand = prefix | (1u << bit); int cnt = 0;
#pragma unroll
        for (int i = 0; i < N; ++i) cnt += __builtin_popcountll(__ballot(key[i] >= cand));
        if (cnt >= 16) prefix = cand;
        if (cnt == 16) break;
    }
    unsigned long long mg[N], me[N]; int cgt = 0;
#pragma unroll
    for (int i = 0; i < N; ++i) { mg[i] = __ballot(key[i] > prefix); me[i] = __ballot(key[i] == prefix); cgt += __builtin_popcountll(mg[i]); }
    int bg = 0, be = cgt;
#pragma unroll
    for (int i = 0; i < N; ++i) { const unsigned rg = mbcnt64(mg[i]), re = mbcnt64(me[i]);
        pos[i] = (key[i] > prefix) ? (unsigned)bg + rg : ((key[i] == prefix) ? (unsigned)be + re : 64u);
        bg += __builtin_popcountll(mg[i]); be += __builtin_popcountll(me[i]); }
}
__device__ __forceinline__ float gelu_tanh(float a) {
    const float u = 0.7978845608028654f * (a + 0.044715f * a * a * a);
    const float e = __builtin_amdgcn_exp2f(2.885390081777927f * u);
    const float th = 1.f - 2.f * __builtin_amdgcn_rcpf(1.f + e);
    return 0.5f * a * (1.f + th);
}
typedef short s16x2_t __attribute__((ext_vector_type(2)));
__device__ __forceinline__ unsigned hkey2(unsigned w) { const s16x2_t sg = __builtin_bit_cast(s16x2_t, w) >> 15; return w ^ (__builtin_bit_cast(unsigned, sg) | 0x80008000u); }
__device__ __forceinline__ float fkey_inv(unsigned k) { const unsigned u = (k & 0x80000000u) ? (k ^ 0x80000000u) : ~k; return __builtin_bit_cast(float, u); }
__device__ __forceinline__ void bit_transpose32(unsigned (&A)[32]) {
#define BT_STAGE(J, M) _Pragma("unroll") for (int k = 0; k < 32; ++k) if ((k & (J)) == 0) { const unsigned t = (A[k] ^ (A[k + (J)] >> (J))) & (M); A[k] ^= t; A[k + (J)] ^= t << (J); }
    BT_STAGE(16, 0x0000FFFFu) BT_STAGE(8, 0x00FF00FFu) BT_STAGE(4, 0x0F0F0F0Fu) BT_STAGE(2, 0x33333333u) BT_STAGE(1, 0x55555555u)
#undef BT_STAGE
}
template <int GL>
__device__ __forceinline__ void topk_select(unsigned (&key)[32], unsigned& Gm, unsigned& Em, int& ng) {
    bit_transpose32(key);
    unsigned A = 0xFFFFFFFFu, G = 0u; int n = 0;
#pragma unroll
    for (int i = 0; i < 32; ++i) {
        const unsigned x = A & key[i]; int c = __builtin_popcount(x);
        c += dppi<0xB1>(c); c += dppi<0x4E>(c);
        if (GL == 8) c += dppi<0x141>(c);
        const bool take = (n + c >= 16);
        A = take ? x : (A ^ x); G = take ? G : (G | x); n = take ? n : n + c;
    }
    Gm = G; Em = A; ng = n;
}
__device__ __forceinline__ void bit_transpose16x2(unsigned (&A)[16]) {
#define BT_STAGE(J, M) _Pragma("unroll") for (int k = 0; k < 16; ++k) if ((k & (J)) == 0) { const unsigned t = (A[k] ^ (A[k + (J)] >> (J))) & (M); A[k] ^= t; A[k + (J)] ^= t << (J); }
    _Pragma("unroll") for (int k = 0; k < 8; ++k) { const unsigned a = A[k], b = A[k + 8]; A[k] = __builtin_amdgcn_perm(b, a, 0x03070105u); A[k + 8] = __builtin_amdgcn_perm(b, a, 0x02060004u); }
    BT_STAGE(4, 0x0F0F0F0Fu) BT_STAGE(2, 0x33333333u) BT_STAGE(1, 0x55555555u)
#undef BT_STAGE
}
template <int GL>
__device__ __forceinline__ void topk_select16(unsigned (&key)[16], unsigned& Gm, unsigned& Em, int& ng) {
    bit_transpose16x2(key);
    unsigned A = 0xFFFFFFFFu, G = 0u; int n = 0;
#pragma unroll
    for (int i = 0; i < 16; ++i) {
        const unsigned x = A & key[i]; int c = __builtin_popcount(x);
        c += dppi<0xB1>(c); c += dppi<0x4E>(c);
        if (GL == 8) c += dppi<0x141>(c);
        const bool take = (n + c >= 16);
        A = take ? x : (A ^ x); G = take ? G : (G | x); n = take ? n : n + c;
    }
    Gm = G; Em = A; ng = n;
}
__device__ __forceinline__ float rs32(float p, float q) { asm volatile("s_nop 1\n\tv_permlane32_swap_b32 %0, %1" : "+v"(p), "+v"(q)); return p + q; }
__device__ __forceinline__ float rs16(float p, float q) { asm volatile("s_nop 1\n\tv_permlane16_swap_b32 %0, %1" : "+v"(p), "+v"(q)); return p + q; }
__device__ __forceinline__ float wave_sum_dpp(float v) {
    v += dppf<0xB1>(v); v += dppf<0x4E>(v); v += dppf<0x141>(v); v += dppf<0x140>(v); v = rs16(v, v); v = rs32(v, v); return v;
}
struct ConvNext { const float* u; const float* v; const float* gain; const float* p; unsigned char* U8; unsigned char* V8; float* SU; float* SV; bf16* PB; int on; };
template <int GL>
__device__ __forceinline__ void topk_select16x2(unsigned (&kA)[16], unsigned (&kB)[16], unsigned& GmA, unsigned& EmA, int& ngA, unsigned& GmB, unsigned& EmB, int& ngB) {
    bit_transpose16x2(kA); bit_transpose16x2(kB);
    unsigned AA = 0xFFFFFFFFu, GA = 0u, AB = 0xFFFFFFFFu, GB = 0u; int nA = 0, nB = 0;
#pragma unroll
    for (int i = 0; i < 16; ++i) {
        const unsigned xA = AA & kA[i], xB = AB & kB[i]; int cA = __builtin_popcount(xA), cB = __builtin_popcount(xB);
        cA += dppi<0xB1>(cA); cB += dppi<0xB1>(cB); cA += dppi<0x4E>(cA); cB += dppi<0x4E>(cB);
        if (GL == 8) { cA += dppi<0x141>(cA); cB += dppi<0x141>(cB); }
        const bool tA = (nA + cA >= 16), tB = (nB + cB >= 16);
        AA = tA ? xA : (AA ^ xA); GA = tA ? GA : (GA | xA); nA = tA ? nA : nA + cA;
        AB = tB ? xB : (AB ^ xB); GB = tB ? GB : (GB | xB); nB = tB ? nB : nB + cB;
    }
    GmA = GA; EmA = AA; ngA = nA; GmB = GB; EmB = AB; ngB = nB;
}
struct KTok { LAS unsigned char* s1i; LAS unsigned char* s2c; LAS unsigned char* scratch; LAS unsigned short* rowc; };
__device__ __forceinline__ KTok ktok(LAS unsigned char* lw, int lane) { KTok k; k.s1i = lw; k.s2c = lw + 256; k.scratch = lw + 512 + lane; k.rowc = (LAS unsigned short*)(lw + 2048); return k; }
__device__ __forceinline__ void k_compact(unsigned M, LAS unsigned char* wp, LAS unsigned char* scratch, int base) {
    while (__builtin_amdgcn_ballot_w64(M != 0u) != 0ull) {
#pragma unroll
        for (int u4 = 0; u4 < 4; ++u4) { const bool act = M != 0u; const int bp = __builtin_ctz(M | 0x80000000u); M &= M - 1u;
            LAS unsigned char* const p = act ? wp : scratch; *p = (unsigned char)(base + 30 - 2 * (bp & 15) + (bp >> 4)); wp += act ? 1 : 0; }
    }
}
__device__ __forceinline__ unsigned k_trim(unsigned Em, int ke) {
    unsigned Et = Em;
    while (__builtin_amdgcn_ballot_w64(__builtin_popcount(Et) > ke) != 0ull) { if (__builtin_popcount(Et) > ke) Et &= Et - 1u; asm volatile("" : "+v"(Et)); }
    return Et;
}
__device__ __forceinline__ void k_compact2(unsigned MA, LAS unsigned char* wpA, LAS unsigned char* scrA, unsigned MB, LAS unsigned char* wpB, LAS unsigned char* scrB, int base) {
    while (__builtin_amdgcn_ballot_w64((MA | MB) != 0u) != 0ull) {
#pragma unroll
        for (int u4 = 0; u4 < 4; ++u4) {
            { const bool act = MA != 0u; const int bp = __builtin_ctz(MA | 0x80000000u); MA &= MA - 1u;
              LAS unsigned char* const p = act ? wpA : scrA; *p = (unsigned char)(base + 30 - 2 * (bp & 15) + (bp >> 4)); wpA += act ? 1 : 0; }
            { const bool act = MB != 0u; const int bp = __builtin_ctz(MB | 0x80000000u); MB &= MB - 1u;
              LAS unsigned char* const p = act ? wpB : scrB; *p = (unsigned char)(base + 30 - 2 * (bp & 15) + (bp >> 4)); wpB += act ? 1 : 0; } }
    }
}
__device__ __forceinline__ void k_trim2(unsigned& EA, int keA, unsigned& EB, int keB) {
    while (__builtin_amdgcn_ballot_w64(__builtin_popcount(EA) > keA || __builtin_popcount(EB) > keB) != 0ull) {
        if (__builtin_popcount(EA) > keA) EA &= EA - 1u; if (__builtin_popcount(EB) > keB) EB &= EB - 1u; asm volatile("" : "+v"(EA), "+v"(EB)); }
}
__device__ __forceinline__ void k_l1_keys(const v4u (&cw)[4], const KTok& k, int lane, unsigned (&key)[16]) {
#pragma unroll
    for (int q = 0; q < 4; ++q) { const v4u w = cw[q]; *(LAS v4u*)(k.rowc + lane * 32 + q * 8) = w;
#pragma unroll
        for (int c = 0; c < 4; ++c) key[4 * q + c] = hkey2(w[c]); }
}
__device__ __forceinline__ void k_l1_post(unsigned Gm, unsigned Em, int ntot, const KTok& k, int lane) {
    const int g1 = lane >> 2, sub = lane & 3;
    const int neq = __builtin_popcount(Em);
    const int e0 = dppi<0x00>(neq), e1 = dppi<0x55>(neq), e2 = dppi<0xAA>(neq);
    const int pe = ntot + (sub > 0 ? e0 : 0) + (sub > 1 ? e1 : 0) + (sub > 2 ? e2 : 0);
    const unsigned M = Gm | k_trim(Em, min(max(16 - pe, 0), neq));
    const int cnt = __builtin_popcount(M);
    const int c0 = dppi<0x00>(cnt), c1 = dppi<0x55>(cnt), c2 = dppi<0xAA>(cnt);
    k_compact(M, k.s1i + g1 * 16 + (sub > 0 ? c0 : 0) + (sub > 1 ? c1 : 0) + (sub > 2 ? c2 : 0), k.scratch, sub * 32);
}
__device__ __forceinline__ void k_l1_post2(unsigned GmA, unsigned EmA, int ntA, const KTok& kA, unsigned GmB, unsigned EmB, int ntB, const KTok& kB, int lane) {
    const int g1 = lane >> 2, sub = lane & 3;
    const int neqA = __builtin_popcount(EmA), neqB = __builtin_popcount(EmB);
    const int eA0 = dppi<0x00>(neqA), eA1 = dppi<0x55>(neqA), eA2 = dppi<0xAA>(neqA), eB0 = dppi<0x00>(neqB), eB1 = dppi<0x55>(neqB), eB2 = dppi<0xAA>(neqB);
    const int peA = ntA + (sub > 0 ? eA0 : 0) + (sub > 1 ? eA1 : 0) + (sub > 2 ? eA2 : 0), peB = ntB + (sub > 0 ? eB0 : 0) + (sub > 1 ? eB1 : 0) + (sub > 2 ? eB2 : 0);
    unsigned EA = EmA, EB = EmB; k_trim2(EA, min(max(16 - peA, 0), neqA), EB, min(max(16 - peB, 0), neqB));
    const unsigned MA = GmA | EA, MB = GmB | EB;
    const int cntA = __builtin_popcount(MA), cntB = __builtin_popcount(MB);
    const int cA0 = dppi<0x00>(cntA), cA1 = dppi<0x55>(cntA), cA2 = dppi<0xAA>(cntA), cB0 = dppi<0x00>(cntB), cB1 = dppi<0x55>(cntB), cB2 = dppi<0xAA>(cntB);
    k_compact2(MA, kA.s1i + g1 * 16 + (sub > 0 ? cA0 : 0) + (sub > 1 ? cA1 : 0) + (sub > 2 ? cA2 : 0), kA.scratch,
               MB, kB.s1i + g1 * 16 + (sub > 0 ? cB0 : 0) + (sub > 1 ? cB1 : 0) + (sub > 2 ? cB2 : 0), kB.scratch, sub * 32);
}
__device__ __forceinline__ int k_scan8(int v, int sub8) {
    { const int t2 = dppi<0x111>(v); if (sub8 >= 1) v += t2; }
    { const int t2 = dppi<0x112>(v); if (sub8 >= 2) v += t2; }
    { const int t2 = dppi<0x114>(v); if (sub8 >= 4) v += t2; }
    return v;
}
__device__ __forceinline__ void k_l2_post2(unsigned GmA, unsigned EmA, int ntA, const KTok& kA, unsigned GmB, unsigned EmB, int ntB, const KTok& kB, int lane) {
    const int h = lane >> 3, sub8 = lane & 7;
    const int neqA = __builtin_popcount(EmA), neqB = __builtin_popcount(EmB);
    const int peA = ntA + (k_scan8(neqA, sub8) - neqA), peB = ntB + (k_scan8(neqB, sub8) - neqB);
    unsigned EA = EmA, EB = EmB; k_trim2(EA, min(max(16 - peA, 0), neqA), EB, min(max(16 - peB, 0), neqB));
    const unsigned MA = GmA | EA, MB = GmB | EB;
    const int cntA = __builtin_popcount(MA), cntB = __builtin_popcount(MB);
    k_compact2(MA, kA.s2c + h * 16 + (k_scan8(cntA, sub8) - cntA), kA.scratch, MB, kB.s2c + h * 16 + (k_scan8(cntB, sub8) - cntB), kB.scratch, sub8 * 32);
}
__device__ __forceinline__ void k_l2_keys(const KTok& k, int lane, unsigned (&key)[16]) {
    const int h = lane >> 3, sub8 = lane & 7;
    const unsigned aib = *(const LAS unsigned short*)(k.s1i + (2 * h) * 16 + 2 * sub8);
    const v4u bib = *(const LAS v4u*)(k.s1i + (2 * h + 1) * 16);
    LAS const unsigned short* ra = k.rowc + (2 * h) * 128; LAS const unsigned short* rb = ra + 128;
    const unsigned a0 = ra[aib & 0xffu], a1 = ra[aib >> 8];
    const half2_t a0x2 = __builtin_bit_cast(half2_t, a0 | (a0 << 16)), a1x2 = __builtin_bit_cast(half2_t, a1 | (a1 << 16));
    half2_t bp[8];
#pragma unroll
    for (int q = 0; q < 8; ++q) { const unsigned blo = rb[(bib[q >> 1] >> (16 * (q & 1))) & 0xffu], bhi = rb[(bib[q >> 1] >> (16 * (q & 1) + 8)) & 0xffu]; bp[q] = __builtin_bit_cast(half2_t, blo | (bhi << 16)); }
#pragma unroll
    for (int i = 0; i < 16; ++i) key[i] = hkey2(__builtin_bit_cast(unsigned, ((i < 8) ? a0x2 : a1x2) + bp[i & 7]));
}
__device__ __forceinline__ void k_l2_post(unsigned Gm, unsigned Em, int ntot, const KTok& k, int lane) {
    const int h = lane >> 3, sub8 = lane & 7;
    const int neq = __builtin_popcount(Em);
    int se = neq;
    { const int t2 = dppi<0x111>(se); if (sub8 >= 1) se += t2; }
    { const int t2 = dppi<0x112>(se); if (sub8 >= 2) se += t2; }
    { const int t2 = dppi<0x114>(se); if (sub8 >= 4) se += t2; }
    const int pe = ntot + (se - neq);
    const unsigned M = Gm | k_trim(Em, min(max(16 - pe, 0), neq));
    const int cnt = __builtin_popcount(M); int sc = cnt;
    { const int t1 = dppi<0x111>(sc); if (sub8 >= 1) sc += t1; }
    { const int t1 = dppi<0x112>(sc); if (sub8 >= 2) sc += t1; }
    { const int t1 = dppi<0x114>(sc); if (sub8 >= 4) sc += t1; }
    k_compact(M, k.s2c + h * 16 + (sc - cnt), k.scratch, sub8 * 32);
}
__device__ __forceinline__ void k_gates(int t, f32x4 rq, const KTok& k, int lane, const float* SU, const float* SV, unsigned short* IDX, float* GW, float* MU) {
    float rinv; { float sv_ = (rq[0] + rq[1]) + (rq[2] + rq[3]); sv_ += dppf<0xB1>(sv_); sv_ += dppf<0x4E>(sv_); rinv = __builtin_amdgcn_rsqf(sv_ * (1.f / D) + 1e-6f); }
#pragma unroll
    for (int kk = 0; kk < 2; ++kk) { const int kx = lane + 64 * kk, hh = kx >> 4; const unsigned cand = k.s2c[kx];
        const unsigned ia = k.s1i[(2 * hh) * 16 + (cand >> 4)], ib = k.s1i[(2 * hh + 1) * 16 + (cand & 15u)];
        const float sv = hlo((unsigned)k.rowc[(2 * hh) * 128 + ia]) + hlo((unsigned)k.rowc[(2 * hh + 1) * 128 + ib]); float mx = sv;
        mx = fmaxf(mx, dppf<0xB1>(mx)); mx = fmaxf(mx, dppf<0x4E>(mx)); mx = fmaxf(mx, dppf<0x141>(mx)); mx = fmaxf(mx, dppf<0x140>(mx));
        const float ex = __builtin_amdgcn_exp2f((sv - mx) * 1.4426950408889634f); float sum = ex;
        sum += dppf<0xB1>(sum); sum += dppf<0x4E>(sum); sum += dppf<0x141>(sum); sum += dppf<0x140>(sum);
        const unsigned ee = ia * 128u + ib; const size_t o = (size_t)t * 128 + (kx & 7) * 16 + (kx >> 3);
        IDX[o] = (unsigned short)ee; GW[o] = ex * __builtin_amdgcn_rcpf(sum) * SV[ee]; MU[o] = rinv * SU[ee]; }
}
struct KConv { f32x4 cr[4], cg[4], cp0; };
__device__ __forceinline__ void k_conv_load(const ConvNext& cv, int t, int lane, KConv& c) {
    const bool cu = t < NEXP; const float* rp = cu ? cv.u + (size_t)t * D : cv.v + (size_t)(t - NEXP) * D;
#pragma unroll
    for (int j = 0; j < 4; ++j) { c.cr[j] = *(const f32x4*)(rp + 16 * lane + 4 * j); c.cg[j] = *(const f32x4*)(cv.gain + 16 * lane + 4 * j); }
    c.cp0 = *(const f32x4*)(cv.p + ((size_t)t * 64 + lane) * 4);
}
__device__ __forceinline__ void k_conv_store(const ConvNext& cv, int t, int lane, KConv& c) {
    if (t < NEXP) {
#pragma unroll
        for (int j = 0; j < 4; ++j) c.cr[j] = c.cr[j] * c.cg[j];
        quant_store_i8(c.cr, cv.U8, t, cv.SU + t, lane); }
    else quant_store_i8(c.cr, cv.V8, t - NEXP, cv.SV + (t - NEXP), lane);
    { v2u w; w.x = pk2(c.cp0[0], c.cp0[1]); w.y = pk2(c.cp0[2], c.cp0[3]); *(v2u*)(cv.PB + ((size_t)t * 64 + lane) * 4) = w; }
}
__device__ __forceinline__ void peer_topk_phase(const unsigned short* S, const float* ssq_in, const float* SU, const float* SV, unsigned short* IDX, float* GW, float* MU,
                                                const ConvNext cv, LAS unsigned char* lds, int vcu, int G, int wave) {
    const int lane = lane_id_fresh();
    const KTok kA = ktok(lds + wave * 12288, lane), kB = ktok(lds + wave * 12288 + 6144, lane);
    const int gw = vcu * NWAVES + wave, NW = G * NWAVES;
    v4u nxA[4], nxB[4];
#define K_SROW(dst, tt) do { const v4u* sp_ = (const v4u*)(S + (size_t)min((tt), T - 1) * 2048 + lane * 32); _Pragma("unroll") for (int q = 0; q < 4; ++q) dst[q] = sp_[q]; } while (0)
    K_SROW(nxA, gw); K_SROW(nxB, gw + NW);
    for (int t = gw; t < T; t += 2 * NW) {
        const int tB = (t + NW < T) ? t + NW : t;
        v4u cwA[4], cwB[4];
#pragma unroll
        for (int q = 0; q < 4; ++q) { cwA[q] = nxA[q]; cwB[q] = nxB[q]; }
        const f32x4 rqA = *(const f32x4*)(ssq_in + (size_t)t * 16 + 4 * (lane & 3)), rqB = *(const f32x4*)(ssq_in + (size_t)tB * 16 + 4 * (lane & 3));
        K_SROW(nxA, t + 2 * NW); K_SROW(nxB, t + 3 * NW);
        KConv cA, cB; if (cv.on) { k_conv_load(cv, t, lane, cA); k_conv_load(cv, tB, lane, cB); }
        { unsigned keyA[16], keyB[16]; k_l1_keys(cwA, kA, lane, keyA); k_l1_keys(cwB, kB, lane, keyB);
          unsigned GmA, EmA, GmB, EmB; int nA, nB; topk_select16x2<4>(keyA, keyB, GmA, EmA, nA, GmB, EmB, nB);
          k_l1_post2(GmA, EmA, nA, kA, GmB, EmB, nB, kB, lane); }
        LDS_WAIT();
        { unsigned keyA[16], keyB[16]; k_l2_keys(kA, lane, keyA); k_l2_keys(kB, lane, keyB);
          unsigned GmA, EmA, GmB, EmB; int nA, nB; topk_select16x2<8>(keyA, keyB, GmA, EmA, nA, GmB, EmB, nB);
          k_l2_post2(GmA, EmA, nA, kA, GmB, EmB, nB, kB, lane); }
        LDS_WAIT();
        k_gates(t, rqA, kA, lane, SU, SV, IDX, GW, MU); k_gates(tB, rqB, kB, lane, SU, SV, IDX, GW, MU);
        if (cv.on) {
            if ((t < NEXP) == (tB < NEXP)) {
                if (t < NEXP) {
#pragma unroll
                    for (int j = 0; j < 4; ++j) { cA.cr[j] = cA.cr[j] * cA.cg[j]; cB.cr[j] = cB.cr[j] * cB.cg[j]; }
                    quant_store_i8(cA.cr, cv.U8, t, cv.SU + t, lane); quant_store_i8(cB.cr, cv.U8, tB, cv.SU + tB, lane); }
                else { quant_store_i8(cA.cr, cv.V8, t - NEXP, cv.SV + (t - NEXP), lane); quant_store_i8(cB.cr, cv.V8, tB - NEXP, cv.SV + (tB - NEXP), lane); }
                { v2u w; w.x = pk2(cA.cp0[0], cA.cp0[1]); w.y = pk2(cA.cp0[2], cA.cp0[3]); *(v2u*)(cv.PB + ((size_t)t * 64 + lane) * 4) = w; }
                { v2u w; w.x = pk2(cB.cp0[0], cB.cp0[1]); w.y = pk2(cB.cp0[2], cB.cp0[3]); *(v2u*)(cv.PB + ((size_t)tB * 64 + lane) * 4) = w; }
            } else { k_conv_store(cv, t, lane, cA); k_conv_store(cv, tB, lane, cB); } }
        LDS_WAIT();
    }
#undef K_SROW
}
__device__ __forceinline__ int dot4_first(int a, int b) { int r; asm("v_dot4_i32_i8 %0, %1, %2, 0" : "=v"(r) : "v"(a), "v"(b)); return r; }
__device__ __forceinline__ unsigned peer_off_lo(unsigned w, unsigned m, unsigned a) { unsigned r; asm("v_mad_u32_u16 %0, %1, %2, %3" : "=v"(r) : "v"(w), "s"(m), "v"(a)); return r; }
__device__ __forceinline__ unsigned peer_off_hi(unsigned w, unsigned m, unsigned a) { unsigned r; asm("v_mad_u32_u16 %0, %1, %2, %3 op_sel:[1,0,0,0]" : "=v"(r) : "v"(w), "s"(m), "v"(a)); return r; }
#define PEER_ISSUE8(buf, o, idw, TAB) do { _Pragma("unroll") for (int b = 0; b < 8; ++b) { \
        const unsigned off = (b & 1) ? peer_off_hi((idw)[b >> 1], 128u, taboff) : peer_off_lo((idw)[b >> 1], 128u, taboff); \
        buf[(o) + b] = *(const v4u*)((TAB) + (size_t)off); } } while (0)
#define PEER_ISSUE16(buf, i0, i1, TAB) do { PEER_ISSUE8(buf, 0, i0, TAB); PEER_ISSUE8(buf, 8, i1, TAB); } while (0)
template <int M> __device__ __forceinline__ unsigned swz8(unsigned v) { return (unsigned)__builtin_amdgcn_ds_swizzle((int)v, 0x18 | (M << 5)); }
#define SWZ8(v, m) swz8<m>(v)
#define PEER_ISSUE_U1(buf, iw, TAB, p) do { const unsigned w_ = swz8<p>(iw); \
        buf[2 * (p)] = *(const v4u*)((TAB) + (size_t)peer_off_lo(w_, 128u, taboff)); buf[2 * (p) + 1] = *(const v4u*)((TAB) + (size_t)peer_off_hi(w_, 128u, taboff)); } while (0)
#define PEER_ISSUE_U(buf, iw, TAB) do { PEER_ISSUE_U1(buf, iw, TAB, 0); PEER_ISSUE_U1(buf, iw, TAB, 1); PEER_ISSUE_U1(buf, iw, TAB, 2); PEER_ISSUE_U1(buf, iw, TAB, 3); \
        PEER_ISSUE_U1(buf, iw, TAB, 4); PEER_ISSUE_U1(buf, iw, TAB, 5); PEER_ISSUE_U1(buf, iw, TAB, 6); PEER_ISSUE_U1(buf, iw, TAB, 7); } while (0)
#define PEER_ISSUE_V1(buf, r, TAB, m) do { const unsigned w0_ = swz8<m>((r).x), w1_ = swz8<m>((r).y); \
        buf[4 * (m)] = *(const v4u*)((TAB) + (size_t)peer_off_lo(w0_, 128u, taboff)); buf[4 * (m) + 1] = *(const v4u*)((TAB) + (size_t)peer_off_hi(w0_, 128u, taboff)); \
        buf[4 * (m) + 2] = *(const v4u*)((TAB) + (size_t)peer_off_lo(w1_, 128u, taboff)); buf[4 * (m) + 3] = *(const v4u*)((TAB) + (size_t)peer_off_hi(w1_, 128u, taboff)); } while (0)
#define PEER_ISSUE_V(buf, r, TAB) do { PEER_ISSUE_V1(buf, r, TAB, 0); PEER_ISSUE_V1(buf, r, TAB, 1); PEER_ISSUE_V1(buf, r, TAB, 2); PEER_ISSUE_V1(buf, r, TAB, 3); } while (0)
#define PEER_PIN4(v) asm volatile("" : "+v"((v).x), "+v"((v).y), "+v"((v).z), "+v"((v).w))
#define VPTR(base, rowbytes, tt, off) ((const char*)(base) + (size_t)(tt) * (rowbytes) + (off))
template <int LIGHT>
__device__ __forceinline__ void peer_u_phase(const unsigned short* IDX, const bf16* XB, const unsigned char* U8, unsigned short* PART, int bid, int G, int wave) {
    const int lane = lane_id_fresh(), j = lane >> 3, c = lane & 7;
    const int NS = G < 8 ? G : 8, rank = bid / NS, nrank = (G - (bid % NS) + NS - 1) / NS;
    for (int s = bid % NS; s < 8; s += NS) {
        const unsigned coloff = (unsigned)(s * 128 + c * 16), taboff = (unsigned)(s * (NEXP * 128) + c * 16);
        const int stride = nrank * NWAVES;
        unsigned short* part = PART + (size_t)s * T * 128;
        unsigned o_idx = (unsigned)(j * 32 + c * 4), o_x = coloff * 2u + (unsigned)((j & 1) * 16), o_p = (unsigned)(j * 32 + c * 4); const bool xhalf = (j & 1) != 0;
#define PEER_U_TOKEN(buf, xh, tt) do { \
              \
            v4u xa, xb; { v4u ph; _Pragma("unroll") for (int k = 0; k < 4; ++k) ph[k] = (unsigned)dppi<0x128>((int)(xh)[k]); \
                _Pragma("unroll") for (int k = 0; k < 4; ++k) { xa[k] = xhalf ? ph[k] : (xh)[k]; xb[k] = xhalf ? (xh)[k] : ph[k]; } } \
            const float xv[16] = {bflo(xa.x), bfhi(xa.x), bflo(xa.y), bfhi(xa.y), bflo(xa.z), bfhi(xa.z), bflo(xa.w), bfhi(xa.w), bflo(xb.x), bfhi(xb.x), bflo(xb.y), bfhi(xb.y), bflo(xb.z), bfhi(xb.z), bflo(xb.w), bfhi(xb.w)}; \
              \
            float am = 0.f; _Pragma("unroll") for (int i = 0; i < 16; ++i) am = fmaxf(am, fabsf(xv[i])); \
            { unsigned ab = __builtin_bit_cast(unsigned, am); ab = max(ab, (unsigned)dppi<0xB1>((int)ab)); ab = max(ab, (unsigned)dppi<0x4E>((int)ab)); ab = max(ab, (unsigned)dppi<0x141>((int)ab)); am = __builtin_bit_cast(float, ab); }   \
            const float xinv = am > 0.f ? 127.f / am : 0.f, xsc = am * (0.015625f / 127.f)  ; \
            int xq[4]; _Pragma("unroll") for (int q = 0; q < 4; ++q) xq[q] = (int)pack_i8x4((f32x4){xv[4 * q], xv[4 * q + 1], xv[4 * q + 2], xv[4 * q + 3]}, xinv); \
            int dd[16]; \
            _Pragma("unroll") for (int b = 0; b < 16; ++b) { PEER_PIN4(buf[b]); \
                if (LIGHT) { dd[b] = (int)((buf[b].x ^ buf[b].y) ^ (buf[b].z ^ buf[b].w)) + xq[b & 3]; continue; } \
                int d = dot4_first((int)buf[b].x, xq[0]); d = __builtin_amdgcn_sdot4((int)buf[b].y, xq[1], d, false); \
                d = __builtin_amdgcn_sdot4((int)buf[b].z, xq[2], d, false); dd[b] = __builtin_amdgcn_sdot4((int)buf[b].w, xq[3], d, false); } \
              \
            const bool cb2 = (c & 4) != 0, cb1 = (c & 2) != 0, cb0 = (c & 1) != 0; \
            int e8[8], e4[4], e2[2]; \
            _Pragma("unroll") for (int k = 0; k < 8; ++k) { const int keep = cb2 ? dd[8 + k] : dd[k], send = cb2 ? dd[k] : dd[8 + k]; e8[k] = keep + dppi<0x141>(send); } \
            _Pragma("unroll") for (int k = 0; k < 4; ++k) { const int keep = cb1 ? e8[4 + k] : e8[k], send = cb1 ? e8[k] : e8[4 + k]; e4[k] = keep + dppi<0x1B>(send); } \
            _Pragma("unroll") for (int k = 0; k < 2; ++k) { const int keep = cb0 ? e4[2 + k] : e4[k], send = cb0 ? e4[k] : e4[2 + k]; e2[k] = keep + dppi<0xB1>(send); } \
            *(unsigned*)VPTR(part, 256, tt, o_p) = pkh2((float)e2[0] * xsc, (float)e2[1] * xsc); } while (0)
        v4u bufA[16], bufB[16], xA, xB; unsigned iA = 0u, iB = 0u;
        xA = xB = (v4u){0u, 0u, 0u, 0u};
        int t = rank * NWAVES + wave;
        if (t + 3 * stride < T) {
            { iA = *(const unsigned*)VPTR(IDX, 256, t, o_idx); xA = *(const v4u*)VPTR(XB, 2048, t, o_x); }
            { iB = *(const unsigned*)VPTR(IDX, 256, t + stride, o_idx); }
            PEER_ISSUE_U(bufA, iA, U8);
        do {
            asm volatile("" : "+v"(o_idx), "+v"(o_x), "+v"(o_p));
            const int t1 = t + stride, t2 = t1 + stride, t3 = t2 + stride;
            { iA = *(const unsigned*)VPTR(IDX, 256, t2, o_idx); }
            PEER_ISSUE_U(bufB, iB, U8);
            { xB = *(const v4u*)VPTR(XB, 2048, t1, o_x); }
            PEER_U_TOKEN(bufA, xA, t);
            { iB = *(const unsigned*)VPTR(IDX, 256, t3, o_idx); }
            PEER_ISSUE_U(bufA, iA, U8);
            { xA = *(const v4u*)VPTR(XB, 2048, t2, o_x); }
            PEER_U_TOKEN(bufB, xB, t1);
            t = t2;
        } while (t + 3 * stride < T);
        } else {
        if (t < T) { iA = *(const unsigned*)VPTR(IDX, 256, t, o_idx); xA = *(const v4u*)VPTR(XB, 2048, t, o_x); }
        if (t + stride < T) { iB = *(const unsigned*)VPTR(IDX, 256, t + stride, o_idx); }
        if (t < T) PEER_ISSUE_U(bufA, iA, U8);
        }
        while (t < T) {
            asm volatile("" : "+v"(o_idx), "+v"(o_x), "+v"(o_p));
            const int t1 = t + stride, t2 = t1 + stride, t3 = t2 + stride;
            if (t1 < T) { PEER_ISSUE_U(bufB, iB, U8); xB = *(const v4u*)VPTR(XB, 2048, t1, o_x); }
            if (t2 < T) { iA = *(const unsigned*)VPTR(IDX, 256, t2, o_idx); }
            PEER_U_TOKEN(bufA, xA, t);
            if (t1 < T) {
                if (t2 < T) { PEER_ISSUE_U(bufA, iA, U8); xA = *(const v4u*)VPTR(XB, 2048, t2, o_x); }
                if (t3 < T) { iB = *(const unsigned*)VPTR(IDX, 256, t3, o_idx); }
                PEER_U_TOKEN(bufB, xB, t1);
            }
            t = t2;
        }
#undef PEER_U_TOKEN
    }
}
__device__ __forceinline__ void peer_w_phase(const unsigned short* PART, const float* GW, const float* MU, const unsigned short* IDX, unsigned* VREC, int bid, int G, int wave) {
    const int tid = wave * 64 + lane_id_fresh(), gtid = bid * NTHR + tid, NT = G * NTHR;
    for (int i = gtid; i < T * 16; i += NT) { const size_t o = (size_t)i * 8;
        v4u p[8];
#pragma unroll
        for (int s = 0; s < 8; ++s) p[s] = *(const v4u*)(PART + (size_t)s * T * 128 + o);
        const f32x4 mu0 = *(const f32x4*)(MU + o), mu1 = *(const f32x4*)(MU + o + 4), gw0 = *(const f32x4*)(GW + o), gw1 = *(const f32x4*)(GW + o + 4); const v4u ids = *(const v4u*)(IDX + o);
        f32x4 a0 = {0.f, 0.f, 0.f, 0.f}, a1 = {0.f, 0.f, 0.f, 0.f}, w0, w1;
#pragma unroll
        for (int s = 0; s < 8; ++s) { a0 += (f32x4){hlo(p[s].x), hhi(p[s].x), hlo(p[s].y), hhi(p[s].y)}; a1 += (f32x4){hlo(p[s].z), hhi(p[s].z), hlo(p[s].w), hhi(p[s].w)}; }
#pragma unroll
        for (int q = 0; q < 4; ++q) { w0[q] = gw0[q] * gelu_tanh(a0[q] * 64.f * mu0[q]); w1[q] = gw1[q] * gelu_tanh(a1[q] * 64.f * mu1[q]); }
        float am = fmaxf(fmaxf(fmaxf(fabsf(w0[0]), fabsf(w0[1])), fmaxf(fabsf(w0[2]), fabsf(w0[3]))), fmaxf(fmaxf(fabsf(w1[0]), fabsf(w1[1])), fmaxf(fabsf(w1[2]), fabsf(w1[3]))));
        { unsigned ab = __builtin_bit_cast(unsigned, am); ab = max(ab, (unsigned)dppi<0xB1>((int)ab)); ab = max(ab, (unsigned)dppi<0x4E>((int)ab)); ab = max(ab, (unsigned)dppi<0x141>((int)ab)); ab = max(ab, (unsigned)dppi<0x140>((int)ab));
          am = __builtin_bit_cast(float, ab); }
        const float winv = am > 0.f ? 127.f / am : 0.f; const unsigned sc = __builtin_bit_cast(unsigned, am * (1.f / 127.f));
        unsigned* rec = VREC + (size_t)(i >> 1) * 16; const int h8 = i & 1;
        *(v4u*)(rec + 4 * h8) = ids; *(v2u*)(rec + 8 + 2 * h8) = (v2u){pack_i8x4(w0, winv), pack_i8x4(w1, winv)}; *(v2u*)(rec + 12 + 2 * h8) = (v2u){sc, sc}; }
}
__device__ __forceinline__ void peer_v_phase(const unsigned* VREC, const unsigned char* V8, const bf16* XB, bf16* XBo, float* ssq_out, int bid, int G, int wave) {
    const int lane = lane_id_fresh(), j = lane >> 3, c = lane & 7;
    const int NS = G < 8 ? G : 8, rank = bid / NS, nrank = (G - (bid % NS) + NS - 1) / NS;
    for (int s = bid % NS; s < 8; s += NS) {
        const unsigned coloff = (unsigned)(s * 128 + c * 16), taboff = (unsigned)(s * (NEXP * 128) + c * 16);
        const int stride = nrank * NWAVES;
        unsigned o_rec = (unsigned)(j * 64 + c * 8), o_xb = (coloff + 2u * j) * 2u;
#define PEER_V_TOKEN(buf, w, xr, tt) do { \
              \
            const float wsc = __builtin_bit_cast(float, SWZ8((w).x, 6)); const int wq[4] = {(int)SWZ8((w).x, 4), (int)SWZ8((w).y, 4), (int)SWZ8((w).x, 5), (int)SWZ8((w).y, 5)}; \
            int ia[16]; \
            _Pragma("unroll") for (int B = 0; B < 4; ++B) { PEER_PIN4(buf[4 * B]); PEER_PIN4(buf[4 * B + 1]); PEER_PIN4(buf[4 * B + 2]); PEER_PIN4(buf[4 * B + 3]); \
                _Pragma("unroll") for (int q = 0; q < 4; ++q) { const unsigned D0 = buf[4 * B][q], D1 = buf[4 * B + 1][q], D2 = buf[4 * B + 2][q], D3 = buf[4 * B + 3][q]; \
                    const unsigned P0 = __builtin_amdgcn_perm(D1, D0, 0x05010400u), P1 = __builtin_amdgcn_perm(D1, D0, 0x07030602u), Q0 = __builtin_amdgcn_perm(D3, D2, 0x05010400u), Q1 = __builtin_amdgcn_perm(D3, D2, 0x07030602u); \
                    ia[4 * q + 0] = (B == 0) ? dot4_first((int)__builtin_amdgcn_perm(Q0, P0, 0x05040100u), wq[0]) : __builtin_amdgcn_sdot4((int)__builtin_amdgcn_perm(Q0, P0, 0x05040100u), wq[B], ia[4 * q + 0], false); \
                    ia[4 * q + 1] = (B == 0) ? dot4_first((int)__builtin_amdgcn_perm(Q0, P0, 0x07060302u), wq[0]) : __builtin_amdgcn_sdot4((int)__builtin_amdgcn_perm(Q0, P0, 0x07060302u), wq[B], ia[4 * q + 1], false); \
                    ia[4 * q + 2] = (B == 0) ? dot4_first((int)__builtin_amdgcn_perm(Q1, P1, 0x05040100u), wq[0]) : __builtin_amdgcn_sdot4((int)__builtin_amdgcn_perm(Q1, P1, 0x05040100u), wq[B], ia[4 * q + 2], false); \
                    ia[4 * q + 3] = (B == 0) ? dot4_first((int)__builtin_amdgcn_perm(Q1, P1, 0x07060302u), wq[0]) : __builtin_amdgcn_sdot4((int)__builtin_amdgcn_perm(Q1, P1, 0x07060302u), wq[B], ia[4 * q + 3], false); } } \
              \
            int e2a, e2b, e2c, e2d; const bool b3 = (lane & 8) != 0; \
            { int p0 = ia[0], q0 = ia[8], p1 = ia[1], q1 = ia[9], p2 = ia[2], q2 = ia[10], p3 = ia[3], q3 = ia[11], p4 = ia[4], q4 = ia[12], p5 = ia[5], q5 = ia[13], p6 = ia[6], q6 = ia[14], p7 = ia[7], q7 = ia[15]; \
              asm volatile("s_nop 1\n\tv_permlane32_swap_b32 %0, %1\n\tv_permlane32_swap_b32 %2, %3\n\tv_permlane32_swap_b32 %4, %5\n\tv_permlane32_swap_b32 %6, %7\n\t" \
                           "v_permlane32_swap_b32 %8, %9\n\tv_permlane32_swap_b32 %10, %11\n\tv_permlane32_swap_b32 %12, %13\n\tv_permlane32_swap_b32 %14, %15" \
                           : "+v"(p0), "+v"(q0), "+v"(p1), "+v"(q1), "+v"(p2), "+v"(q2), "+v"(p3), "+v"(q3), "+v"(p4), "+v"(q4), "+v"(p5), "+v"(q5), "+v"(p6), "+v"(q6), "+v"(p7), "+v"(q7)); \
              int s0 = p0 + q0, s1 = p1 + q1, s2 = p2 + q2, s3 = p3 + q3, s4_ = p4 + q4, s5 = p5 + q5, s6 = p6 + q6, s7 = p7 + q7; \
              asm volatile("s_nop 1\n\tv_permlane16_swap_b32 %0, %1\n\tv_permlane16_swap_b32 %2, %3\n\tv_permlane16_swap_b32 %4, %5\n\tv_permlane16_swap_b32 %6, %7" \
                           : "+v"(s0), "+v"(s4_), "+v"(s1), "+v"(s5), "+v"(s2), "+v"(s6), "+v"(s3), "+v"(s7)); \
              e2a = s0 + s4_; e2b = s1 + s5; e2c = s2 + s6; e2d = s3 + s7; } \
            int r1x, r1y; { const int kx = b3 ? e2c : e2a, ky = b3 ? e2d : e2b, sx = b3 ? e2a : e2c, sy = b3 ? e2b : e2d; r1x = kx + dppi<0x128>(sx); r1y = ky + dppi<0x128>(sy); } \
            struct { float x, y; } r1 = {(float)r1x * wsc, (float)r1y * wsc}; \
            f32x2 xn = {bflo(xr) + r1.x, bfhi(xr) + r1.y}; \
            *(unsigned*)VPTR(XBo, 2048, tt, o_xb) = pk2(xn[0], xn[1]); \
            const float sq = wave_sum_dpp(xn[0] * xn[0] + xn[1] * xn[1]); SQOUT(sq, tt); } while (0)
        v4u bufA[16], bufB[16]; v2u rA = {0u, 0u}, rB = {0u, 0u}, rC = {0u, 0u};
        unsigned xrA = 0u, xrB = 0u;
#define PEER_V_REC(tt) (*(const v2u*)VPTR(VREC, 512, tt, o_rec))
#define PEER_V_XR(tt) (*(const unsigned*)VPTR(XB, 2048, tt, o_xb))
        int t = rank * NWAVES + wave;
        if (t + 3 * stride < T) {
            rA = PEER_V_REC(t); xrA = PEER_V_XR(t); rB = PEER_V_REC(t + stride);
            PEER_ISSUE_V(bufA, rA, V8);
        float sqA = 0.f;
#define SQOUT(v, tt) do { if ((tt) == t) sqA = (v); else if (lane < 2) ssq_out[(size_t)(lane ? (tt) : t) * 16 + s] = lane ? (v) : sqA; } while (0)
        do {
            asm volatile("" : "+v"(o_rec), "+v"(o_xb));
            const int t1 = t + stride, t2 = t1 + stride, t3 = t2 + stride;
            rC = PEER_V_REC(t2);
            PEER_ISSUE_V(bufB, rB, V8); xrB = PEER_V_XR(t1);
            PEER_V_TOKEN(bufA, rA, xrA, t);
            rA = rC; rC = PEER_V_REC(t3);
            PEER_ISSUE_V(bufA, rA, V8); xrA = PEER_V_XR(t2);
            PEER_V_TOKEN(bufB, rB, xrB, t1);
            rB = rC;
            t = t2;
        } while (t + 3 * stride < T);
#undef SQOUT
        } else {
        if (t < T) { rA = PEER_V_REC(t); xrA = PEER_V_XR(t); }
        if (t + stride < T) rB = PEER_V_REC(t + stride);
        if (t < T) PEER_ISSUE_V(bufA, rA, V8);
        }
#define SQOUT(v, tt) do { if (lane == 0) ssq_out[(size_t)(tt) * 16 + s] = (v); } while (0)
        while (t < T) {
            asm volatile("" : "+v"(o_rec), "+v"(o_xb));
            const int t1 = t + stride, t2 = t1 + stride, t3 = t2 + stride;
            if (t2 < T) rC = PEER_V_REC(t2);
            if (t1 < T) { PEER_ISSUE_V(bufB, rB, V8); xrB = PEER_V_XR(t1); }
            PEER_V_TOKEN(bufA, rA, xrA, t);
            if (t1 < T) {
                rA = rC; if (t3 < T) rC = PEER_V_REC(t3);
                if (t2 < T) { PEER_ISSUE_V(bufA, rA, V8); xrA = PEER_V_XR(t2); }
                PEER_V_TOKEN(bufB, rB, xrB, t1);
                rB = rC;
            }
            t = t2;
        }
#undef SQOUT
#undef PEER_V_REC
#undef PEER_V_XR
#undef PEER_V_TOKEN
    }
}
#undef PEER_ISSUE8
#undef PEER_ISSUE16
#undef PEER_PIN4
#undef VPTR

constexpr int AT_KST = 24576, AT_KPE = 16384, AT_VBASE = 3 * AT_KST, AT_VST = 16384;
constexpr int ATTN_LDS = AT_VBASE + 4 * AT_VST;
__device__ __forceinline__ void attn_phase(const bf16* Q, const bf16* KN, const bf16* KPE, const bf16* VT, bf16* AO, LAS unsigned char* lds, int vcu, int G, int wave) {
    const int lane = lane_id_fresh(), tid = wave * 64 + lane;
    const int rho = lane & 31, hh = lane >> 5;
    const int krow = (rho & 0x13) | ((rho & 4) << 1) | ((rho & 8) >> 1);
    const bool lag = wave >= 4;
    for (int it = vcu; it < 1024; it += G) {
        const int c = it & 255, kq = it >> 8, bh = c >> 2, q4 = c & 3;
        const int qb = (kq == 0) ? 15 - q4 : (kq == 1) ? q4 : (kq == 2) ? 8 + q4 : 7 - q4;
        const int b = bh >> 3, h = bh & 7;
        const int q0 = qb * 256, qlo = q0 + wave * 32, trow0 = b * SEQ + qlo;
        f32x16 o[4];
#pragma unroll
        for (int d = 0; d < 4; ++d)
#pragma unroll
            for (int r = 0; r < 16; ++r) o[d][r] = 0.f;
        float m_run = -1e30f, l_run = 0.f;
        const int nkt = 4 * (qb + 1);
        unsigned vk[2], vp, vv[2];
#pragma unroll
        for (int i = 0; i < 2; ++i) { const int id = tid + 512 * i; { const int row = id >> 4, cc = (id & 15) ^ (row & 15); vk[i] = (unsigned)(row * (D * 2) + cc * 16); }
            { const int row = id >> 3, cc = (id & 7) ^ ((row >> 1) & 7); vv[i] = (unsigned)row * (unsigned)(T * 2) + (unsigned)(cc * 16); } }
        { const int row = tid >> 3, cc = (tid & 7) ^ ((row >> 1) & 7); vp = (unsigned)(row * (QKR * 2) + cc * 16); }
        const unsigned ldsb = (unsigned)(size_t)lds + (unsigned)wave * 1024u;
#define AT_DMA(sbase, voff, ldsdst) do { unsigned _keep; asm volatile("s_mov_b32 %0, m0\n\ts_mov_b32 m0, %3\n\ts_nop 4\n\tglobal_load_lds_dwordx4 %1, %2\n\ts_mov_b32 m0, %0" \
            : "=&s"(_keep) : "v"(voff), "s"(sbase), "s"(ldsdst) : "memory"); } while (0)
#define AT_STAGE_TILE(kt, ks, vs) do { const int tk0 = b * SEQ + (kt) * 64; const unsigned kb2 = ldsb + (unsigned)(ks) * AT_KST, vb2 = ldsb + AT_VBASE + (unsigned)(vs) * AT_VST; \
            const bf16* kb_ = KN + (size_t)tk0 * D + h * QKN; const bf16* pb_ = KPE + (size_t)tk0 * QKR; const bf16* vb_ = VT + (size_t)(h * VH) * T + tk0; \
            AT_DMA(kb_, vk[0], kb2); AT_DMA(kb_, vk[1], kb2 + 8192u); AT_DMA(pb_, vp, kb2 + AT_KPE); AT_DMA(vb_, vv[0], vb2); AT_DMA(vb_, vv[1], vb2 + 8192u); } while (0)
#define AT_SYNC() asm volatile("s_waitcnt vmcnt(0) lgkmcnt(0)\n\ts_barrier" ::: "memory")
#define AT_SYNC5() asm volatile("s_waitcnt vmcnt(5) lgkmcnt(0)\n\ts_barrier" ::: "memory")
#define AT_KADDR(kb, s) ((s) < 8 ? st + ((kb) * 32 + krow) * 256 + (((2 * (s) + hh) ^ (krow & 15)) << 4) : st + AT_KPE + ((kb) * 32 + krow) * 128 + (((2 * ((s) - 8) + hh) ^ ((((kb) * 32 + krow) >> 1) & 7)) << 4))
#define AT_KREAD(dst, kb, s0) do { _Pragma("unroll") for (int i = 0; i < 6; ++i) dst[i] = *(const LAS bf16x8*)AT_KADDR(kb, (s0) + i); } while (0)
#define AT_KMMA(src_, kb, s0) do { _Pragma("unroll") for (int i = 0; i < 6; ++i) sacc[kb] = __builtin_amdgcn_mfma_f32_32x32x16_bf16(src_[i], qf[(s0) + i], sacc[kb], 0, 0, 0); } while (0)
#define AT_QK(ks) do { const LAS unsigned char* st = lds + (ks) * AT_KST; bf16x8 fx[6], fy[6]; \
            _Pragma("unroll") for (int kb = 0; kb < 2; ++kb) _Pragma("unroll") for (int r = 0; r < 16; ++r) sacc[kb][r] = 0.f; \
            AT_KREAD(fx, 0, 0); AT_KREAD(fy, 0, 6); \
            AT_KMMA(fx, 0, 0); __builtin_amdgcn_sched_barrier(0); AT_KREAD(fx, 1, 0); \
            AT_KMMA(fy, 0, 6); __builtin_amdgcn_sched_barrier(0); AT_KREAD(fy, 1, 6); \
            AT_KMMA(fx, 1, 0); AT_KMMA(fy, 1, 6); } while (0)
#define AT_SM(key0v) do { \
            if ((key0v) + 63 > qlo) { const int qpos = qlo + rho; \
                _Pragma("unroll") for (int kb = 0; kb < 2; ++kb) \
                    _Pragma("unroll") for (int r = 0; r < 16; ++r) { const int kpos = (key0v) + 32 * kb + (r & 3) + 4 * ((r >> 2) & 1) + 8 * hh + 16 * (r >> 3); if (kpos > qpos) sacc[kb][r] = -1e30f; } } \
            AT_SM_NM(); } while (0)
#define AT_SM_NM() do { \
            float mx = sacc[0][0]; \
            _Pragma("unroll") for (int kb = 0; kb < 2; ++kb) \
                _Pragma("unroll") for (int r = 0; r < 16; ++r) mx = fmaxf(mx, sacc[kb][r]); \
            mx = fmaxf(mx, shx<32>(mx, lane)); \
            const float m_new = fmaxf(m_run, mx), alpha = __builtin_amdgcn_exp2f(m_run - m_new); m_run = m_new; \
            float lsum = 0.f; \
            _Pragma("unroll") for (int kb = 0; kb < 2; ++kb) \
                _Pragma("unroll") for (int r = 0; r < 16; ++r) { const float p = __builtin_amdgcn_exp2f(sacc[kb][r] - m_new); sacc[kb][r] = p; lsum += p; } \
            l_run = l_run * alpha + lsum; \
            _Pragma("unroll") for (int d = 0; d < 4; ++d) \
                _Pragma("unroll") for (int r = 0; r < 16; ++r) o[d][r] *= alpha; \
            _Pragma("unroll") for (int s2 = 0; s2 < 4; ++s2) { const int kb = s2 >> 1, r0 = 8 * (s2 & 1); v4u w; \
                w.x = pk2(sacc[kb][r0 + 0], sacc[kb][r0 + 1]); w.y = pk2(sacc[kb][r0 + 2], sacc[kb][r0 + 3]); w.z = pk2(sacc[kb][r0 + 4], sacc[kb][r0 + 5]); w.w = pk2(sacc[kb][r0 + 6], sacc[kb][r0 + 7]); \
                pf[s2] = __builtin_bit_cast(bf16x8, w); } } while (0)
#define AT_VREAD(dst, d) do { const int row = (d) * 32 + rho; _Pragma("unroll") for (int s2 = 0; s2 < 4; ++s2) dst[s2] = *(const LAS bf16x8*)(sv + row * 128 + (((2 * s2 + hh) ^ ((row >> 1) & 7)) << 4)); } while (0)
#define AT_VMMA(src_, d) do { _Pragma("unroll") for (int s2 = 0; s2 < 4; ++s2) o[d] = __builtin_amdgcn_mfma_f32_32x32x16_bf16(src_[s2], pf[s2], o[d], 0, 0, 0); } while (0)
#define AT_PV(vs) do { const LAS unsigned char* sv = lds + AT_VBASE + (vs) * AT_VST; bf16x8 gx[4], gy[4]; \
            AT_VREAD(gx, 0); AT_VREAD(gy, 1); \
            AT_VMMA(gx, 0); __builtin_amdgcn_sched_barrier(0); AT_VREAD(gx, 2); \
            AT_VMMA(gy, 1); __builtin_amdgcn_sched_barrier(0); AT_VREAD(gy, 3); \
            AT_VMMA(gx, 2); AT_VMMA(gy, 3); } while (0)
        AT_SYNC();
        AT_STAGE_TILE(0, 0, 0); AT_STAGE_TILE(1, 1, 1);
        bf16x8 qf[12];
        { const bf16* qp = Q + (size_t)(trow0 + rho) * (NHEAD * DQK) + h * DQK + hh * 8;
#pragma unroll
          for (int s = 0; s < 12; ++s) qf[s] = *(const bf16x8*)(qp + 16 * s);
#pragma unroll
          for (int s = 0; s < 12; ++s) asm volatile("" : "+v"(qf[s])); }
        AT_SYNC5();
        bf16x8 pf[4];
#pragma unroll
        for (int s2 = 0; s2 < 4; ++s2) pf[s2] = (bf16x8){0, 0, 0, 0, 0, 0, 0, 0};
        int ks = 0, vs = 0;
        bool have = false; int pvs = 0;
        int kt = 0;
        const int nfull = 4 * qb;
        if (!lag) {
            for (; kt < nfull; ++kt) {
                AT_STAGE_TILE(kt + 2, (ks == 0 ? 2 : ks - 1), ((vs + 2) & 3));
                { f32x16 sacc[2]; AT_QK(ks); AT_SM_NM(); }
                AT_PV(vs);
                AT_SYNC5();
                ks = (ks == 2) ? 0 : ks + 1; vs = (vs + 1) & 3;
            }
        } else if (nfull > 0) {
            { AT_STAGE_TILE(2, 2, 2); { f32x16 sacc[2]; AT_QK(0); AT_SM_NM(); } have = true; pvs = 0; AT_SYNC5(); ks = 1; vs = 1; kt = 1; }
            for (; kt < nfull; ++kt) {
                AT_STAGE_TILE(kt + 2, (ks == 0 ? 2 : ks - 1), ((vs + 2) & 3));
                AT_PV(pvs);
                { f32x16 sacc[2]; AT_QK(ks); AT_SM_NM(); }
                pvs = vs;
                AT_SYNC5();
                ks = (ks == 2) ? 0 : ks + 1; vs = (vs + 1) & 3;
            }
        }
        for (; kt < nkt; ++kt) {
            if (kt + 2 < nkt) AT_STAGE_TILE(kt + 2, (ks == 0 ? 2 : ks - 1), ((vs + 2) & 3));
            const int key0 = kt * 64;
            const bool vis = key0 <= qlo + 31;
            if (have) AT_PV(pvs);
            if (vis) { f32x16 sacc[2]; AT_QK(ks); AT_SM(key0); }
            if (lag) { have = vis; pvs = vs; } else if (vis) AT_PV(vs);
            if (kt + 2 < nkt) AT_SYNC5(); else AT_SYNC();
            ks = (ks == 2) ? 0 : ks + 1; vs = (vs + 1) & 3;
        }
        if (lag && have) AT_PV(pvs);
#undef AT_DMA
#undef AT_STAGE_TILE
#undef AT_SYNC
#undef AT_SYNC5
#undef AT_QK
#undef AT_SM
#undef AT_SM_NM
#undef AT_PV
#undef AT_KADDR
#undef AT_KREAD
#undef AT_KMMA
#undef AT_VREAD
#undef AT_VMMA
        const float ltot = l_run + shx<32>(l_run, lane), inv = 1.f / ltot;
        bf16* orow = AO + (size_t)(trow0 + rho) * D + h * VH + 8 * hh;
#pragma unroll
        for (int d = 0; d < 4; ++d)
#pragma unroll
            for (int k = 0; k < 2; ++k) {
                unsigned ax = pk2(o[d][8 * k + 0] * inv, o[d][8 * k + 1] * inv), ay = pk2(o[d][8 * k + 2] * inv, o[d][8 * k + 3] * inv);
                unsigned bx = pk2(o[d][8 * k + 4] * inv, o[d][8 * k + 5] * inv), by = pk2(o[d][8 * k + 6] * inv, o[d][8 * k + 7] * inv);
                asm volatile("s_nop 1\n\tv_permlane32_swap_b32 %0, %1" : "+v"(ax), "+v"(bx)); asm volatile("s_nop 1\n\tv_permlane32_swap_b32 %0, %1" : "+v"(ay), "+v"(by));
                *(v4u*)(orow + 32 * d + 16 * k) = (v4u){ax, ay, bx, by}; }
    }
}

constexpr int N_PHASES = 42;
struct Args { In in; float* out; unsigned char* ws; int ph_lo, ph_hi; };
__global__ void __launch_bounds__(NTHR, 2) mk_fwd(Args a) {
    extern __shared__ __attribute__((aligned(16))) unsigned char lds_raw[];
    LAS unsigned char* lds = (LAS unsigned char*)lds_raw;
    const int wave = __builtin_amdgcn_readfirstlane(threadIdx.x >> 6);
    const int G = gridDim.x, bid = blockIdx.x, vcu = (G % 8 == 0) ? (bid % 8) * (G / 8) + bid / 8 : bid;
    typedef const __attribute__((address_space(4))) Args* KArgs;
#define KARGS(q) KArgs q = (KArgs)__builtin_amdgcn_kernarg_segment_ptr(); asm volatile("" : "+s"(q))
    const int lo = a.ph_lo, hi = a.ph_hi;
    { volatile LAS unsigned* MISC0 = (volatile LAS unsigned*)(lds + MISC_OFF); if (threadIdx.x < 32) MISC0[threadIdx.x] = 0u; }
    __syncthreads();
    XcdBarrier bar; bar.bar = (unsigned*)(a.ws + WS_CTL); bar.x = 0; bar.st = nullptr;
    if (hi - lo > 1) bar = xcd_barrier_post((unsigned*)(a.ws + WS_CTL), (volatile LAS unsigned*)(lds + MISC_OFF) + 8, threadIdx.x == 0);
#ifndef MK_MASK
#define MK_MASK 0xFFFF
#endif
#define IN_PH(k) (lo <= (k) && (k) < hi)
#define EN(b) ((MK_MASK >> (b)) & 1)
#if MK_PROBE & 256
#define PHASE_END(k) do { if ((k) + 1 < hi) { xcd_barrier(bar, wave == 0 && lane_id_fresh() == 0); xcd_barrier(bar, wave == 0 && lane_id_fresh() == 0); } } while (0)
#else
#define PHASE_END(k) do { if ((k) + 1 < hi) xcd_barrier(bar, wave == 0 && lane_id_fresh() == 0); } while (0)
#endif
#define PH_VARS KARGS(q); unsigned char* ws = q->ws; CIn& in = q->in; float* ssq = (float*)(ws + WS_SSQ); \
    const float* COS = (const float*)(ws + WS_COS); const float* SIN = (const float*)(ws + WS_SIN); (void)in; (void)ssq; (void)COS; (void)SIN

    if (EN(0) && IN_PH(0)) { PH_VARS;
#if MK_PROBE & 8
        p0_prologue(in, ws, lds, bid, G, wave); __syncthreads();
#endif
        p0_prologue(in, ws, lds, bid, G, wave); PHASE_END(0); }

#pragma unroll 1
    for (int layer = 0; layer < DEPTH; ++layer) {
        const int base = 1 + 10 * layer, v0 = 3 * layer;
#define XB_VARS bf16* XBc = (bf16*)(ws + ((layer & 1) ? WS_XBB : WS_XBA)); bf16* XBn = (bf16*)(ws + ((layer & 1) ? WS_XBA : WS_XBB)); pg8::StaticOrder SO; (void)XBc; (void)XBn; (void)SO
        if (EN(1) && IN_PH(base + 0)) { PH_VARS; XB_VARS;
#if MK_PROBE & 4096
#pragma unroll 1
            for (int rep = 0; rep < 2; ++rep)
#endif
            {
            if (layer == 0) convert_layer(in, ws, layer, bid, G, wave);
            if (layer < 2) pooled_phase(XBc, ssq + (size_t)v0 * SSQ_ARR, in.mix_norm + layer * D, (bf16*)(ws + WS_POOLED), lds, vcu, G, wave);
            else {
                const int N = (layer == 2) ? 1280 : 768;
                pg8::Gemm g{XBc, (const bf16*)(ws + ((layer == 2) ? W_DOWN2 : W_DOWN3)), T, N, D, D, D, 0}; SO.init(T, N, G, bid);
                epi::Down E{(bf16*)(ws + WS_CQ), (bf16*)(ws + WS_CKV), (bf16*)(ws + WS_KPE), ssq + (size_t)v0 * SSQ_ARR, ssq + (size_t)(13 + layer - 2) * SSQ_ARR, ssq + (size_t)15 * SSQ_ARR, COS, SIN};
                pg8::gemm_phase<epi::Down>(lds, g, SO, E, wave);
                if (G % 2 == 0 && ((T / 256) * (N / 256)) % G == G / 2) {
                    pg8::Gemm gp{(const bf16*)(ws + WS_PB), (const bf16*)(ws + W_WP) + (size_t)layer * D * PLE, T, D, PLE, PLE, PLE, 0}; SO.init(T, D, G, bid, 1);
                    epi::Bf16Row EP{(bf16*)(ws + WS_PP), D, nullptr, 0.f};
                    pg8::gemm_phase<epi::Bf16Row>(lds, gp, SO, EP, wave);
                }
            }
            }
            PHASE_END(base + 0);
        }
        if (EN(2) && IN_PH(base + 1)) { PH_VARS; XB_VARS;
#if MK_PROBE & 16
            if (layer < 2) {
                pg8::Gemm g{(const bf16*)(ws + WS_POOLED), (const bf16*)(ws + W_POOL) + (size_t)layer * 1024 * 256, T, D, 256, D, 256, 256}; SO.init(T, D, G, bid);
                epi::Resid E{(bf16*)(ws + WS_END), (float*)(ws + WS_END + 64 * MiB)};
                pg8::gemm_phase<epi::Resid>(lds, g, SO, E, wave);
            } else {
                pg8::Gemm g{(const bf16*)(ws + WS_CQ), (const bf16*)(ws + W_UQ) + (size_t)(layer - 2) * 1536 * QRANK, T, 1536, QRANK, QRANK, QRANK, 0}; SO.init(T, 1536, G, bid);
                epi::QUp E{(bf16*)(ws + WS_Q), ssq + (size_t)(13 + layer - 2) * SSQ_ARR, COS, SIN};
                pg8::gemm_phase<epi::QUp>(lds, g, SO, E, wave);
            }
#endif
            if (layer < 2) {
                pg8::Gemm g{(const bf16*)(ws + WS_POOLED), (const bf16*)(ws + W_POOL) + (size_t)layer * 1024 * 256, T, D, 256, D, 256, 256}; SO.init(T, D, G, bid);
                epi::Resid E{XBc, ssq + (size_t)(v0 + 1) * SSQ_ARR};
                pg8::gemm_phase<epi::Resid>(lds, g, SO, E, wave);
            } else {
                if (layer == 2) {
                    { pg8::Gemm g{(const bf16*)(ws + WS_CKV), (const bf16*)(ws + W_KNW), T, 1024, KVRANK, KVRANK, KVRANK, 0}; SO.init(T, 1024, G, bid);
                      epi::Bf16Row E{(bf16*)(ws + WS_KN), 1024, ssq + (size_t)15 * SSQ_ARR, 1.f / KVRANK};
                      pg8::gemm_phase<epi::Bf16Row>(lds, g, SO, E, wave); }
                    { pg8::Gemm g{(const bf16*)(ws + W_VW), (const bf16*)(ws + WS_CKV), 1024, T, KVRANK, KVRANK, KVRANK, 0}; SO.init(1024, T, G, bid);
                      epi::VTCol E{(bf16*)(ws + WS_VT), ssq + (size_t)15 * SSQ_ARR, 1.f / KVRANK};
                      pg8::gemm_phase<epi::VTCol>(lds, g, SO, E, wave); }
                }
                pg8::Gemm g{(const bf16*)(ws + WS_CQ), (const bf16*)(ws + W_UQ) + (size_t)(layer - 2) * 1536 * QRANK, T, 1536, QRANK, QRANK, QRANK, 0}; SO.init(T, 1536, G, bid);
                epi::QUp E{(bf16*)(ws + WS_Q), ssq + (size_t)(13 + layer - 2) * SSQ_ARR, COS, SIN};
                pg8::gemm_phase<epi::QUp>(lds, g, SO, E, wave);
            }
            PHASE_END(base + 1);
        }
        if (EN(3) && layer >= 2 && IN_PH(base + 2)) { PH_VARS; XB_VARS;
#if MK_PROBE & 2
            attn_phase((const bf16*)(ws + WS_Q), (const bf16*)(ws + WS_KN), (const bf16*)(ws + WS_KPE), (const bf16*)(ws + WS_VT), (bf16*)(ws + WS_AO), lds, vcu, G, wave);
#endif
            attn_phase((const bf16*)(ws + WS_Q), (const bf16*)(ws + WS_KN), (const bf16*)(ws + WS_KPE), (const bf16*)(ws + WS_VT), (bf16*)(ws + WS_AO), lds, vcu, G, wave);
            PHASE_END(base + 2);
        }
        if (EN(4) && layer >= 2 && IN_PH(base + 3)) { PH_VARS; XB_VARS;
            pg8::Gemm g{(const bf16*)(ws + WS_AO), (const bf16*)(ws + W_WO) + (size_t)(layer - 2) * D * D, T, D, D, D, D, 0}; SO.init(T, D, G, bid);
#if MK_PROBE & 16384
            { epi::Resid E2{(bf16*)(ws + WS_END), (float*)(ws + WS_END + 64 * MiB)}; pg8::gemm_phase<epi::Resid>(lds, g, SO, E2, wave); SO.init(T, D, G, bid); }
#endif
            epi::Resid E{XBc, ssq + (size_t)(v0 + 1) * SSQ_ARR};
            pg8::gemm_phase<epi::Resid>(lds, g, SO, E, wave);
            PHASE_END(base + 3);
        }
        if (EN(5) && IN_PH(base + 4)) { PH_VARS; XB_VARS;
#if MK_PROBE & 4
            { pg8::Gemm g{XBc, (const bf16*)(ws + W_WEFF) + (size_t)layer * 2048 * D, T, 2048, D, D, D, 0}; SO.init(T, 2048, G, bid);
              epi::Score E{(unsigned short*)(ws + WS_S), 2048, ssq + (size_t)(v0 + 1) * SSQ_ARR};
              pg8::gemm_phase<epi::Score>(lds, g, SO, E, wave); }
#endif
#if MK_PROBE & 65536
            { pg8::Gemm g{(const bf16*)(ws + WS_PB), (const bf16*)(ws + W_WP) + (size_t)layer * D * PLE, T, D, PLE, PLE, PLE, 0}; SO.init(T, D, G, bid);
              epi::Bf16Row E{(bf16*)(ws + WS_PP), D, nullptr, 0.f};
              pg8::gemm_phase<epi::Bf16Row>(lds, g, SO, E, wave); }
#endif
            {
            { pg8::Gemm g{XBc, (const bf16*)(ws + W_WEFF) + (size_t)layer * 2048 * D, T, 2048, D, D, D, 0}; SO.init(T, 2048, G, bid);
              epi::Score E{(unsigned short*)(ws + WS_S), 2048, ssq + (size_t)(v0 + 1) * SSQ_ARR};
              pg8::gemm_phase<epi::Score>(lds, g, SO, E, wave); }
            if (!(layer >= 2 && G % 2 == 0 && ((T / 256) * (((layer == 2) ? 1280 : 768) / 256)) % G == G / 2))
            { pg8::Gemm g{(const bf16*)(ws + WS_PB), (const bf16*)(ws + W_WP) + (size_t)layer * D * PLE, T, D, PLE, PLE, PLE, 0}; SO.init(T, D, G, bid);
              epi::Bf16Row E{(bf16*)(ws + WS_PP), D, nullptr, 0.f};
              pg8::gemm_phase<epi::Bf16Row>(lds, g, SO, E, wave); }
            }
            PHASE_END(base + 4);
        }
        if (EN(6) && EN(9) && IN_PH(base + 5)) { PH_VARS; XB_VARS;
            const int nl = layer + 1 < DEPTH ? layer + 1 : layer, ns = nl & 1;
            const ConvNext cvn{in.peer_u + (size_t)nl * NEXP * D, in.peer_v + (size_t)nl * NEXP * D, in.ffn_norm + nl * D, in.p + (size_t)nl * T * PLE,
                               ws + tab_off(ns), ws + tab_off(ns) + (size_t)NEXP * D, (float*)(ws + tabs_off(ns)), (float*)(ws + tabs_off(ns)) + NEXP, (bf16*)(ws + WS_PB), layer + 1 < DEPTH ? 1 : 0};
#if MK_PROBE & 64
            peer_topk_phase((const unsigned short*)(ws + WS_S), ssq + (size_t)(v0 + 1) * SSQ_ARR, (const float*)(ws + tabs_off(layer & 1)), (const float*)(ws + tabs_off(layer & 1)) + NEXP,
                            (unsigned short*)(ws + WS_IDX), (float*)(ws + WS_GW), (float*)(ws + WS_MU), cvn, lds, vcu, G, wave);
#endif
            peer_topk_phase((const unsigned short*)(ws + WS_S), ssq + (size_t)(v0 + 1) * SSQ_ARR, (const float*)(ws + tabs_off(layer & 1)), (const float*)(ws + tabs_off(layer & 1)) + NEXP,
                            (unsigned short*)(ws + WS_IDX), (float*)(ws + WS_GW), (float*)(ws + WS_MU), cvn, lds, vcu, G, wave);
            PHASE_END(base + 5);
        }
        if (EN(6) && EN(10) && IN_PH(base + 6)) { PH_VARS; XB_VARS;
#if MK_PROBE & 32
            peer_u_phase<0>((const unsigned short*)(ws + WS_IDX), XBc, ws + tab_off(layer & 1), (unsigned short*)(ws + WS_PART), bid, G, wave);
#endif
#if MK_PROBE & 128
            peer_u_phase<1>((const unsigned short*)(ws + WS_IDX), XBc, ws + tab_off(layer & 1), (unsigned short*)(ws + WS_WW), bid, G, wave);
#endif
            peer_u_phase<0>((const unsigned short*)(ws + WS_IDX), XBc, ws + tab_off(layer & 1), (unsigned short*)(ws + WS_PART), bid, G, wave);
            PHASE_END(base + 6);
        }
        if (EN(6) && EN(11) && IN_PH(base + 7)) { PH_VARS; XB_VARS;
#if MK_PROBE & 2048
            peer_w_phase((const unsigned short*)(ws + WS_PART), (const float*)(ws + WS_GW), (const float*)(ws + WS_MU), (const unsigned short*)(ws + WS_IDX), (unsigned*)(ws + WS_WW), bid, G, wave);
#endif
            peer_w_phase((const unsigned short*)(ws + WS_PART), (const float*)(ws + WS_GW), (const float*)(ws + WS_MU), (const unsigned short*)(ws + WS_IDX), (unsigned*)(ws + WS_WW), bid, G, wave);
            PHASE_END(base + 7);
        }
        if (EN(6) && EN(12) && IN_PH(base + 8)) { PH_VARS; XB_VARS;
#if MK_PROBE & 1024
            peer_v_phase((const unsigned*)(ws + WS_WW), ws + tab_off(layer & 1) + (size_t)NEXP * D, XBc, (bf16*)(ws + WS_END), (float*)(ws + WS_END + 64 * MiB), bid, G, wave);
#endif
            peer_v_phase((const unsigned*)(ws + WS_WW), ws + tab_off(layer & 1) + (size_t)NEXP * D, XBc, XBc, ssq + (size_t)(v0 + 2) * SSQ_ARR, bid, G, wave);
            PHASE_END(base + 8);
        }
        if (EN(7) && IN_PH(base + 9)) { PH_VARS; XB_VARS;
            pg8::Gemm g{XBc, (const bf16*)(ws + W_WG) + (size_t)layer * D * D, T, D, D, D, D, 0}; SO.init(T, D, G, bid);
#if MK_PROBE & 512
            { epi::Null EN_{(float*)(ws + WS_END)}; pg8::gemm_phase<epi::Null>(lds, g, SO, EN_, wave); }
#endif
#if MK_PROBE & 8192
            { epi::Gate E2{XBc, XBn, (const bf16*)(ws + WS_PP), ssq + (size_t)(v0 + 2) * SSQ_ARR, ssq + (size_t)(v0 + 3) * SSQ_ARR}; pg8::gemm_phase<epi::Gate>(lds, g, SO, E2, wave); SO.init(T, D, G, bid); }
#endif
            epi::Gate E{XBc, XBn, (const bf16*)(ws + WS_PP), ssq + (size_t)(v0 + 2) * SSQ_ARR, ssq + (size_t)(v0 + 3) * SSQ_ARR};
            pg8::gemm_phase<epi::Gate>(lds, g, SO, E, wave);
            PHASE_END(base + 9);
        }
    }
#if MK_PROBE & 32768
    if (EN(8) && IN_PH(41)) { PH_VARS; final_phase((const bf16*)(ws + WS_XBA), ssq + (size_t)12 * SSQ_ARR, in.final_norm, q->out, bid, G, wave); }
#endif
    if (EN(8) && IN_PH(41)) { PH_VARS; final_phase((const bf16*)(ws + WS_XBA), ssq + (size_t)12 * SSQ_ARR, in.final_norm, q->out, bid, G, wave); }
#undef IN_PH
#undef PHASE_END
}

extern "C" void kernel_launch(void* const* d_in, const int* in_sizes, int n_in, void* d_out, int out_size, void* d_ws, size_t ws_size, hipStream_t stream) {
    static int grid = 0;
    if (grid == 0) {
        if (n_in != 23 || out_size != T * D || ws_size < WS_END) { fprintf(stderr, "kernel_launch: unexpected problem (n_in %d, out %d, ws %zu < %zu)\n", n_in, out_size, ws_size, (size_t)WS_END); grid = -1; return; }
        int dev = 0, cus = 0, per_cu = 0;
        if (hipGetDevice(&dev) != hipSuccess || hipDeviceGetAttribute(&cus, hipDeviceAttributeMultiprocessorCount, dev) != hipSuccess) { grid = -1; return; }
        if (hipFuncSetAttribute((const void*)mk_fwd, hipFuncAttributeMaxDynamicSharedMemorySize, LDS_BYTES) != hipSuccess) { fprintf(stderr, "kernel_launch: hipFuncSetAttribute failed\n"); grid = -1; return; }
        if (hipOccupancyMaxActiveBlocksPerMultiprocessor(&per_cu, (const void*)mk_fwd, NTHR, LDS_BYTES) != hipSuccess || per_cu < 1) { fprintf(stderr, "kernel_launch: occupancy query says %d\n", per_cu); }
        (void)hipGetLastError();
        grid = cus;
    }
    if (grid < 0) return;
    (void)hipMemsetAsync((char*)d_ws + WS_CTL, 0, CTL_ZERO_BYTES, stream);
    Args a{};
    const void** ip = (const void**)&a.in;
    for (int i = 0; i < 23; ++i) ip[i] = d_in[i];
    a.out = (float*)d_out; a.ws = (unsigned char*)d_ws;
#if MK_ONE_LAUNCH
    a.ph_lo = 0; a.ph_hi = N_PHASES;
    hipLaunchKernelGGL(mk_fwd, dim3(grid), dim3(NTHR), LDS_BYTES, stream, a);
#else
    for (int k = 0; k < N_PHASES; ++k) {
        if (k >= 1 && k <= 40) { const int layer = (k - 1) / 10, slot = (k - 1) % 10; if (layer < 2 && (slot == 2 || slot == 3)) continue; }
        a.ph_lo = k; a.ph_hi = k + 1;
        hipLaunchKernelGGL(mk_fwd, dim3(grid), dim3(NTHR), LDS_BYTES, stream, a);
    }
#endif
}
```

```cpp
#include <hip/hip_runtime.h>
#include <cstdio>
#include <cstdint>

#ifndef MK_PROBE
#define MK_PROBE 0
#endif
#ifndef MK_ONE_LAUNCH
#define MK_ONE_LAUNCH 1
#endif


__device__ __forceinline__ int lane_id_fresh() { int l; asm volatile("v_mbcnt_lo_u32_b32 %0, -1, 0\n\tv_mbcnt_hi_u32_b32 %0, -1, %0" : "=v"(l)); return l; }
template <int M> __device__ __forceinline__ float shx(float v, int lane) {
    if constexpr (M < 32) return __builtin_bit_cast(float, __builtin_amdgcn_ds_swizzle(__builtin_bit_cast(int, v), (M << 10) | 0x1f));
    else return __builtin_bit_cast(float, __builtin_amdgcn_ds_bpermute((lane ^ 32) << 2, __builtin_bit_cast(int, v)));
}

namespace pg8 {
#define PG8_LAS __attribute__((address_space(3)))
typedef unsigned short bf16_t;
typedef short bf16x8 __attribute__((ext_vector_type(8)));
typedef float f32x4 __attribute__((ext_vector_type(4)));
typedef unsigned u32x4 __attribute__((ext_vector_type(4)));
typedef unsigned u32x2 __attribute__((ext_vector_type(2)));
constexpr int BM = 256, BK = 64, HALF = 128, HTB = HALF * BK * 2, STAGE_BYTES = 8 * HTB, NXCD = 8, WGM = 8;

__host__ __device__ __forceinline__ int lds_byte(int r, int c) { const int st = (r >> 4) * 2 + (c >> 5), rr = r & 15, cc = c & 31, ob = rr * 64 + cc * 2; return st * 1024 + (ob ^ (((ob >> 9) & 1) << 5)); }
__host__ __device__ __forceinline__ void stage_rc(int b, int& R, int& C) { const int st = b / 1024, sb = b % 1024, swz = sb ^ (((sb >> 9) & 1) << 5); R = (st >> 1) * 16 + swz / 64; C = (st & 1) * 32 + (swz % 64) / 2; }
__host__ __device__ __forceinline__ int perm32(int rho) { const int n = rho >> 4, i = rho & 15; return 8 * (i >> 2) + 4 * n + (i & 3); }

struct Unit { int pm, pn; };
struct Gemm { const bf16_t* A; const bf16_t* Bt; int M, N, K, lda, ldb, acs; };

struct StaticOrder {
    int nM, nN, nwg, G, c, skew;
    __host__ __device__ void init(int M, int N, int G_, int c_, int skew_ = 0) { nM = M / BM; nN = N / BM; nwg = nM * nN; G = G_; c = c_; skew = skew_; }
    __host__ __device__ bool next(int i, Unit& u) const {
        long L = (long)i * G + c;
        if (skew && i > 0) { if (2 * c < G) return false; L = (long)G + (long)(i - 1) * (G - G / 2) + (c - G / 2); }
        if (L >= nwg) return false;
        int wgid = (int)L; { const int q = nwg / NXCD, r = nwg % NXCD, xcd = wgid % NXCD, off = wgid / NXCD; wgid = (xcd < r ? xcd * (q + 1) : r * (q + 1) + (xcd - r) * q) + off; }
        const int nig = WGM * nN, gid = wgid / nig, fm = gid * WGM, gsz = (nM - fm) < WGM ? (nM - fm) : WGM;
        u.pm = fm + ((wgid % nig) % gsz); u.pn = (wgid % nig) / gsz; return true;
    }
};

__device__ __forceinline__ unsigned cvt_pk_bf16(float lo, float hi) { unsigned r; asm volatile("v_cvt_pk_bf16_f32 %0, %1, %2" : "=v"(r) : "v"(lo), "v"(hi)); return r; }

template <class Epi>
__device__ __forceinline__ void gemm_phase(PG8_LAS unsigned char* lds, const Gemm g, const StaticOrder& S, const Epi& E, const int wid) {
    const int lane = lane_id_fresh(), tid = wid * 64 + lane;
    const int wr = wid >> 2, wc = wid & 3, fr = lane & 15, fq = lane >> 4;
    const int K = g.K, nt = K / BK;
    unsigned voffA, voffB;
    { int R, C; stage_rc(tid * 16, R, C); const int Rb = Epi::PERM ? ((R & ~31) + perm32(R & 31)) : R;
      voffA = (unsigned)(R * g.lda + C) * 2u; voffB = (unsigned)(Rb * g.ldb + C) * 2u; }
    const unsigned d64A = 64u * g.lda * 2u, d64B = 64u * g.ldb * 2u;
    constexpr unsigned kstep = BK * 2;
    const unsigned hstepA = (unsigned)HALF * g.lda * 2u, hstepB = (unsigned)HALF * g.ldb * 2u;
    const unsigned tstepA = 2u * hstepA, tstepB = 2u * hstepB;
    const unsigned acsb = (unsigned)g.acs * 2u;
    const unsigned ldsw = (unsigned)wid * 1024u, ldsbase = (unsigned)(size_t)lds;
    const int aoff = lds_byte(wr * 64 + fr, fq * 8), boff = lds_byte(wc * 32 + fr, fq * 8);
#define PG8_SA(b, h) (((b) * 2 + (h)) * HTB)
#define PG8_SB(b, h) ((4 + (b) * 2 + (h)) * HTB)
#define PG8_DMA(sbase, voff, ldsdst) do { unsigned _keep; asm volatile("s_mov_b32 %0, m0\n\ts_mov_b32 m0, %3\n\ts_nop 4\n\tglobal_load_lds_dwordx4 %1, %2\n\ts_mov_b32 m0, %0" \
        : "=&s"(_keep) : "v"(voff), "s"(sbase), "s"(ldsdst) : "memory"); } while (0)
#define PG8_STAGE(bufoff, gbase, voff) do { const char* _b0 = (const char*)(gbase); const char* _b1 = _b0 + (&(voff) == &voffA ? d64A : d64B); \
        PG8_DMA(_b0, voff, ldsbase + (unsigned)(bufoff) + ldsw); PG8_DMA(_b1, voff, ldsbase + (unsigned)(bufoff) + ldsw + 8192u); } while (0)
#define PG8_LDA(dst, b, h) do { _Pragma("unroll") for (int m = 0; m < 4; ++m) _Pragma("unroll") for (int k = 0; k < 2; ++k) dst[m][k] = *(const PG8_LAS bf16x8*)(lds + PG8_SA(b, h) + aoff + m * 2048 + k * 1024); } while (0)
#define PG8_LDB(dst, b, h) do { _Pragma("unroll") for (int n = 0; n < 2; ++n) _Pragma("unroll") for (int k = 0; k < 2; ++k) dst[n][k] = *(const PG8_LAS bf16x8*)(lds + PG8_SB(b, h) + boff + n * 2048 + k * 1024); } while (0)
#define PG8_MMA(ai, bj, At, Bt) do { __builtin_amdgcn_s_setprio(1); _Pragma("unroll") for (int m = 0; m < 4; ++m) _Pragma("unroll") for (int n = 0; n < 2; ++n) _Pragma("unroll") for (int k = 0; k < 2; ++k) \
        acc[ai][bj][m][n] = __builtin_amdgcn_mfma_f32_16x16x32_bf16(Bt[n][k], At[m][k], acc[ai][bj][m][n], 0, 0, 0); __builtin_amdgcn_s_setprio(0); } while (0)
#define PG8_WAIT_V(n) asm volatile("s_waitcnt vmcnt(" #n ")" ::: "memory")
#define PG8_WAIT_L(n) asm volatile("s_waitcnt lgkmcnt(" #n ")" ::: "memory")
#define PG8_BAR __builtin_amdgcn_s_barrier()
#define PG8_SCHED __builtin_amdgcn_sched_barrier(0)
    Unit cur, nxt; int ui = 0;
    if (!S.next(0, cur)) return;
    f32x4 acc[2][2][4][2];
#pragma unroll
    for (int a = 0; a < 2; ++a)
#pragma unroll
        for (int b = 0; b < 2; ++b)
#pragma unroll
            for (int m = 0; m < 4; ++m)
#pragma unroll
                for (int n = 0; n < 2; ++n) acc[a][b][m][n] = (f32x4){0.f, 0.f, 0.f, 0.f};
    bf16x8 At[4][2], B0[2][2], B1[2][2];
    const char* cA = (const char*)g.A + ((unsigned)cur.pm * tstepA + (unsigned)cur.pn * acsb); const char* cB = (const char*)g.Bt + (unsigned)cur.pn * tstepB;
    PG8_STAGE(PG8_SB(0, 0), cB, voffB); PG8_STAGE(PG8_SB(0, 1), cB + hstepB, voffB); PG8_STAGE(PG8_SA(0, 0), cA, voffA); PG8_STAGE(PG8_SA(0, 1), cA + hstepA, voffA);
    if (wr == 1) PG8_BAR;
    PG8_WAIT_V(2); PG8_BAR;
    PG8_STAGE(PG8_SB(1, 0), cB + kstep, voffB); PG8_STAGE(PG8_SA(1, 0), cA + kstep, voffA); PG8_STAGE(PG8_SB(1, 1), cB + hstepB + kstep, voffB);
    PG8_WAIT_V(6); PG8_BAR;
    for (;;) {
        const bool has_next = S.next(ui + 1, nxt);
        const char* nA = has_next ? (const char*)g.A + ((unsigned)nxt.pm * tstepA + (unsigned)nxt.pn * acsb) : cA; const char* nB = has_next ? (const char*)g.Bt + (unsigned)nxt.pn * tstepB : cB;
        for (int t = 0; t < nt; t += 2) {
            const bool last = (t == nt - 2);
            const char* a1 = cA + (unsigned)(t + 1) * kstep;
            const char* a2 = last ? nA : cA + (unsigned)(t + 2) * kstep; const char* b2 = last ? nB : cB + (unsigned)(t + 2) * kstep;
            const char* a3 = a2 + kstep; const char* b3 = b2 + kstep;
            PG8_LDB(B0, 0, 0); PG8_LDB(B1, 0, 1); PG8_SCHED; PG8_LDA(At, 0, 0); PG8_STAGE(PG8_SA(1, 1), a1 + hstepA, voffA);
            PG8_WAIT_V(8); PG8_WAIT_L(0); PG8_BAR; PG8_MMA(0, 0, At, B0); PG8_MMA(0, 1, At, B1); PG8_BAR; PG8_SCHED;
            PG8_LDA(At, 0, 1); PG8_STAGE(PG8_SB(0, 0), b2, voffB); PG8_STAGE(PG8_SB(0, 1), b2 + hstepB, voffB); PG8_STAGE(PG8_SA(0, 0), a2, voffA);
            PG8_WAIT_V(8); PG8_WAIT_L(0); PG8_BAR; PG8_MMA(1, 0, At, B0); PG8_MMA(1, 1, At, B1); PG8_BAR; PG8_SCHED;
            PG8_LDB(B0, 1, 0); PG8_LDB(B1, 1, 1); PG8_SCHED; PG8_LDA(At, 1, 0); PG8_STAGE(PG8_SA(0, 1), a2 + hstepA, voffA);
            PG8_WAIT_V(8); PG8_WAIT_L(0); PG8_BAR; PG8_MMA(0, 0, At, B0); PG8_MMA(0, 1, At, B1); PG8_BAR; PG8_SCHED;
            PG8_LDA(At, 1, 1); PG8_STAGE(PG8_SB(1, 0), b3, voffB); PG8_STAGE(PG8_SB(1, 1), b3 + hstepB, voffB); PG8_STAGE(PG8_SA(1, 0), a3, voffA);
            PG8_WAIT_V(8); PG8_WAIT_L(0); PG8_BAR; PG8_MMA(1, 0, At, B0); PG8_MMA(1, 1, At, B1); PG8_BAR; PG8_SCHED;
        }
        if (wr == 0) PG8_BAR;
        { const int l2 = lane_id_fresh(); E(acc, cur, wr, wc, l2 & 15, l2 >> 4); }
        if (!has_next) break;
#pragma unroll
        for (int a = 0; a < 2; ++a)
#pragma unroll
            for (int b = 0; b < 2; ++b)
#pragma unroll
                for (int m = 0; m < 4; ++m)
#pragma unroll
                    for (int n = 0; n < 2; ++n) acc[a][b][m][n] = (f32x4){0.f, 0.f, 0.f, 0.f};
        cur = nxt; cA = nA; cB = nB; ++ui;
        if (wr == 1) PG8_BAR;
    }
    PG8_WAIT_V(0);
    PG8_BAR;
#undef PG8_SA
#undef PG8_SB
#undef PG8_STAGE
#undef PG8_LDA
#undef PG8_LDB
#undef PG8_MMA
#undef PG8_WAIT_V
#undef PG8_WAIT_L
#undef PG8_BAR
#undef PG8_SCHED
}
}

#define GAS __attribute__((address_space(1)))
#define LAS __attribute__((address_space(3)))
typedef unsigned short bf16;
typedef unsigned v4u __attribute__((ext_vector_type(4)));
typedef unsigned v2u __attribute__((ext_vector_type(2)));
typedef float f32x4 __attribute__((ext_vector_type(4)));
typedef float f32x2 __attribute__((ext_vector_type(2)));
typedef float f32x16 __attribute__((ext_vector_type(16)));
typedef short bf16x8 __attribute__((ext_vector_type(8)));
typedef __bf16 bf16x2_t __attribute__((ext_vector_type(2)));
typedef _Float16 half2_t __attribute__((ext_vector_type(2)));
__device__ __forceinline__ unsigned pkh2(float lo, float hi) { f32x2 v = {lo, hi}; half2_t h = __builtin_convertvector(v, half2_t); return __builtin_bit_cast(unsigned, h); }
__device__ __forceinline__ float hlo(unsigned u) { return (float)__builtin_bit_cast(half2_t, u)[0]; }
__device__ __forceinline__ float hhi(unsigned u) { return (float)__builtin_bit_cast(half2_t, u)[1]; }
typedef GAS unsigned gu32;
#define RLX_AGENT __ATOMIC_RELAXED, __HIP_MEMORY_SCOPE_AGENT
#define SWZ(o) (((o) << 10) | 0x1f)
#define LDS_WAIT() asm volatile("s_waitcnt lgkmcnt(0)" ::: "memory")
#define VM_WAIT() asm volatile("s_waitcnt vmcnt(0)" ::: "memory")
__device__ __forceinline__ unsigned pk2(float lo, float hi) { f32x2 v = {lo, hi}; bf16x2_t b = __builtin_convertvector(v, bf16x2_t); return __builtin_bit_cast(unsigned, b); }
__device__ __forceinline__ float bflo(unsigned u) { return __builtin_bit_cast(float, u << 16); }
__device__ __forceinline__ float bfhi(unsigned u) { return __builtin_bit_cast(float, u & 0xffff0000u); }
__device__ __forceinline__ float dot2bf(unsigned a, unsigned b, float acc) { return __builtin_amdgcn_fdot2_f32_bf16(__builtin_bit_cast(bf16x2_t, a), __builtin_bit_cast(bf16x2_t, b), acc, false); }
template <int CTRL> __device__ __forceinline__ float dppf(float v) { return __builtin_bit_cast(float, __builtin_amdgcn_update_dpp(0, __builtin_bit_cast(int, v), CTRL, 0xf, 0xf, true)); }
__device__ __forceinline__ float wave_sum(float v, int lane) {
    v += shx<1>(v, lane); v += shx<2>(v, lane); v += shx<4>(v, lane); v += shx<8>(v, lane); v += shx<16>(v, lane); v += shx<32>(v, lane);
    return v;
}


__device__ __forceinline__ float row_rinv(const float* ssq16, int r, float invdim) {
    const f32x4* p = (const f32x4*)(ssq16 + (size_t)r * 16); const f32x4 a = p[0], b = p[1], c = p[2], d = p[3];
    const float s = ((a[0] + a[1]) + (a[2] + a[3])) + ((b[0] + b[1]) + (b[2] + b[3])) + (((c[0] + c[1]) + (c[2] + c[3])) + ((d[0] + d[1]) + (d[2] + d[3])));
    return __builtin_amdgcn_rsqf(s * invdim + 1e-6f);
}

#define XB_TMO      128
#define XB_XCNT(j)  (256  + 64 * (j))
#define XB_XSUB(j)  (1280 + 64 * (j))
#define XB_XGEN(j)  (2304 + 64 * (j))
#define XB_TOP      3328
#define XB_TOPGEN   3392
#define XCD_BAR_WORDS 3456
#define XB_SPIN_CAP (1u << 18)

__device__ __forceinline__ unsigned xb_ld(unsigned* p)              { return __hip_atomic_load(p, __ATOMIC_RELAXED, __HIP_MEMORY_SCOPE_AGENT); }
__device__ __forceinline__ unsigned xb_add(unsigned* p, unsigned v) { return __hip_atomic_fetch_add(p, v, __ATOMIC_RELAXED, __HIP_MEMORY_SCOPE_AGENT); }
__device__ __forceinline__ unsigned xb_xcc_id() { return (unsigned)__builtin_amdgcn_s_getreg((3 << 11) | 20) & 0xFu; }
#define XB_SPIN(cond, bar) do { unsigned _sp = 0; while (cond) { __builtin_amdgcn_s_sleep(1); \
    if ((++_sp & 255u) == 0u) { if (xb_ld(&(bar)[XB_TMO])) break; if (_sp > XB_SPIN_CAP) { atomicAdd(&(bar)[XB_TMO], 1u); break; } } } } while (0)

struct XcdBarrier {
    unsigned* bar; unsigned x;
    volatile LAS unsigned* st;
};
__device__ __forceinline__ XcdBarrier xcd_barrier_post(unsigned* bar, volatile LAS unsigned* st, bool t0) {
    XcdBarrier b; b.bar = bar; b.x = xb_xcc_id(); b.st = st;
    if (t0) (void)xb_add(&bar[XB_XCNT(b.x)], 1u);
    return b;
}
__device__ __forceinline__ void xcd_barrier_complete(unsigned* bar, unsigned x, unsigned& nloc, unsigned& nx) {
    const unsigned G = gridDim.x * gridDim.y * gridDim.z;
    unsigned sum, cnt, mine, sp = 0u;
    for (;;) {
        sum = 0u; cnt = 0u; mine = 0u;
#pragma unroll
        for (unsigned j = 0; j < 16; ++j) { const unsigned c = xb_ld(&bar[XB_XCNT(j)]); sum += c; cnt += (c > 0u) ? 1u : 0u; mine = (j == x) ? c : mine; }
        if (sum == G) break;
        __builtin_amdgcn_s_sleep(1);
        if ((++sp & 255u) == 0u) { if (xb_ld(&bar[XB_TMO])) break; if (sp > XB_SPIN_CAP) { atomicAdd(&bar[XB_TMO], 1u); break; } }
    }
    nloc = mine > 0u ? mine : 1u; nx = cnt > 0u ? cnt : 1u;
}
__device__ __forceinline__ void xcd_barrier(const XcdBarrier& b, bool t0) {
    asm volatile("s_waitcnt vmcnt(0)" ::: "memory");
    __syncthreads();
    if (t0) {
        unsigned* bar = b.bar;
        __builtin_amdgcn_s_waitcnt(0);
        unsigned nloc = b.st[0], nx = b.st[1];
        if (nloc == 0u) { xcd_barrier_complete(bar, b.x, nloc, nx); b.st[0] = nloc; b.st[1] = nx; }
        const unsigned old = xb_add(&bar[XB_XSUB(b.x)], 1u);
        const unsigned gen = old / nloc;
        if (old + 1u == (gen + 1u) * nloc) {
            __builtin_amdgcn_fence(__ATOMIC_RELEASE, "agent");
            asm volatile("s_waitcnt vmcnt(0)" ::: "memory");
            const unsigned og = xb_add(&bar[XB_TOP], 1u);
            const unsigned tg = og / nx;
            if (og + 1u == (tg + 1u) * nx) xb_add(&bar[XB_TOPGEN], 1u);
            else XB_SPIN(xb_ld(&bar[XB_TOPGEN]) == tg, bar);
            __builtin_amdgcn_fence(__ATOMIC_ACQUIRE, "agent");
            xb_add(&bar[XB_XGEN(b.x)], 1u);
            asm volatile("s_waitcnt vmcnt(0)" ::: "memory");
        } else {
            XB_SPIN(xb_ld(&bar[XB_XGEN(b.x)]) == gen, bar);
            __builtin_amdgcn_fence(__ATOMIC_ACQUIRE, "agent");
            asm volatile("s_waitcnt vmcnt(0)" ::: "memory");
        }
    }
    __syncthreads();
}

constexpr int NWAVES = 8, NTHR = 512;
constexpr int T = 32768, D = 1024, NBATCH = 8, SEQ = 4096, DEPTH = 4;
constexpr int NHEAD = 8, QKN = 128, QKR = 64, DQK = 192, VH = 128, QRANK = 768, KVRANK = 256;
constexpr int NKEYS = 128, NEXP = 16384, PTOPK = 16, PLE = 256;
constexpr float EPS = 1e-6f;
constexpr float C2 = 0.07216878364870322f * 1.4426950408889634f;

constexpr size_t MiB = 1u << 20;
constexpr size_t WS_CTL = 0, CTL_ZERO_BYTES = 64 * 1024;
constexpr size_t WS_SSQ = 840 * MiB;
constexpr size_t WS_COS = 3 * MiB, WS_SIN = 7 * MiB;
constexpr size_t WS_W = 11 * MiB;
constexpr size_t W_WEFF = WS_W;
constexpr size_t W_WG = W_WEFF + 16 * MiB;
constexpr size_t W_WP = W_WG + 8 * MiB;
constexpr size_t W_POOL = W_WP + 2 * MiB;
constexpr size_t W_DOWN2 = W_POOL + 1 * MiB;
constexpr size_t W_DOWN3 = W_DOWN2 + 2560 * 1024;
constexpr size_t W_KNW = W_DOWN3 + 1536 * 1024;
constexpr size_t W_VW = W_KNW + 512 * 1024;
constexpr size_t W_UQ = W_VW + 512 * 1024;
constexpr size_t W_WO = W_UQ + 4608 * 1024;
constexpr size_t WS_WEND = W_WO + 4 * MiB;
constexpr size_t WS_X = 52 * MiB;
constexpr size_t WS_XBA = 180 * MiB, WS_XBB = 244 * MiB;
constexpr size_t WS_UV = 308 * MiB;
constexpr size_t WS_UVS = 340 * MiB;
constexpr size_t WS_UV2 = 52 * MiB, WS_UVS2 = 84 * MiB;
__host__ __device__ constexpr size_t tab_off(int set) { return set ? WS_UV2 : WS_UV; }
__host__ __device__ constexpr size_t tabs_off(int set) { return set ? WS_UVS2 : WS_UVS; }
constexpr size_t WS_PB = 372 * MiB;
constexpr size_t WS_PP = 388 * MiB;
constexpr size_t WS_KN = 452 * MiB;
constexpr size_t WS_VT = 516 * MiB;
constexpr size_t WS_KPE = 580 * MiB;
constexpr size_t WS_R1 = 584 * MiB;
constexpr size_t WS_S = WS_R1;
constexpr size_t WS_POOLED = WS_R1;
constexpr size_t WS_Q = WS_R1;
constexpr size_t WS_AO = WS_R1 + 96 * MiB;
constexpr size_t WS_CQ = WS_R1 + 160 * MiB;
constexpr size_t WS_CKV = WS_R1 + 208 * MiB;
constexpr size_t WS_IDX = 872 * MiB;
constexpr size_t WS_GW = 880 * MiB, WS_MU = 896 * MiB;
constexpr size_t WS_PART = WS_R1;
constexpr size_t WS_WW = WS_R1 + 128 * MiB;
constexpr size_t WS_END = 912 * MiB;
constexpr size_t SSQ_ARR = (size_t)32768 * 16;
static_assert(WS_WEND <= WS_X, "weights");

constexpr int RING_BYTES = 139264;
constexpr int MISC_OFF = RING_BYTES + 320;
constexpr int LDS_BYTES = 147456;

namespace epi {
using pg8::Unit; using pg8::cvt_pk_bf16;
typedef float f32x4 __attribute__((ext_vector_type(4)));
typedef unsigned u32x4 __attribute__((ext_vector_type(4)));
typedef unsigned u32x2 __attribute__((ext_vector_type(2)));
__device__ __forceinline__ float dot4(f32x4 v) { return (v[0] * v[0] + v[1] * v[1]) + (v[2] * v[2] + v[3] * v[3]); }
__device__ __forceinline__ void rinv8(const float* ssq, int rbase, int fr, int fq, float invdim, float (&ri)[8]) {
    f32x4 q[8];
#pragma unroll
    for (int k = 0; k < 8; ++k) q[k] = *(const f32x4*)(ssq + (size_t)(rbase + (k >> 2) * 128 + (k & 3) * 16) * 16 + 4 * fq);
#pragma unroll
    for (int k = 0; k < 8; ++k) { float s = (q[k][0] + q[k][1]) + (q[k][2] + q[k][3]); s += shx<16>(s, fq * 16 + fr); s += shx<32>(s, fq * 16 + fr); ri[k] = __builtin_amdgcn_rsqf(s * invdim + 1e-6f); }
}

struct Resid {
    static constexpr bool PERM = true;
    bf16* XB; float* ssq_out;
    __device__ __forceinline__ void operator()(const f32x4 (&acc)[2][2][4][2], const Unit& u, int wr, int wc, int fr, int fq) const {
        const int col0 = u.pn * 256 + wc * 32 + 8 * fq;
        float sv[8]; u32x4 xo[8][2];
        bf16* const b0 = XB + (size_t)(u.pm * 256 + wr * 64 + fr) * D + col0;
#define EPI_ROW(k) (b0 + (size_t)(((k) >> 2) * 128 + ((k) & 3) * 16) * D)
#define EPI_LOAD(k) do { xo[k][0] = *(const u32x4*)EPI_ROW(k); xo[k][1] = *(const u32x4*)(EPI_ROW(k) + 128); } while (0)
        EPI_LOAD(0); EPI_LOAD(1); EPI_LOAD(2);
#pragma unroll
        for (int k = 0; k < 8; ++k) { const int ai = k >> 2, m = k & 3; float s = 0.f;
            if (k + 3 < 8) EPI_LOAD(k + 3);
#pragma unroll
            for (int bj = 0; bj < 2; ++bj) { const u32x4 x = xo[k][bj];
                const f32x4 v0 = (f32x4){bflo(x.x), bfhi(x.x), bflo(x.y), bfhi(x.y)} + acc[ai][bj][m][0], v1 = (f32x4){bflo(x.z), bfhi(x.z), bflo(x.w), bfhi(x.w)} + acc[ai][bj][m][1];
                u32x4 w; w.x = cvt_pk_bf16(v0[0], v0[1]); w.y = cvt_pk_bf16(v0[2], v0[3]); w.z = cvt_pk_bf16(v1[0], v1[1]); w.w = cvt_pk_bf16(v1[2], v1[3]); *(u32x4*)(EPI_ROW(k) + bj * 128) = w;
                s += dot4(v0) + dot4(v1); }
            s += shx<16>(s, fq * 16 + fr); s += shx<32>(s, fq * 16 + fr); sv[k] = s;
        }
#undef EPI_LOAD
#undef EPI_ROW
        if (fq == 0) {
#pragma unroll
            for (int k = 0; k < 8; ++k) ssq_out[(size_t)(u.pm * 256 + (k >> 2) * 128 + wr * 64 + (k & 3) * 16 + fr) * 16 + u.pn * 4 + wc] = sv[k]; }
    }
};
struct Score {
    static constexpr bool PERM = true;
    unsigned short* S; int ldc; const float* ssq;
    __device__ __forceinline__ void operator()(const f32x4 (&acc)[2][2][4][2], const Unit& u, int wr, int wc, int fr, int fq) const {
        const int col0 = u.pn * 256 + wc * 32 + 8 * fq;
        float ri8[8]; rinv8(ssq, u.pm * 256 + wr * 64 + fr, fr, fq, 1.f / D, ri8);
#pragma unroll
        for (int ai = 0; ai < 2; ++ai)
#pragma unroll
            for (int m = 0; m < 4; ++m) {
                const int r = u.pm * 256 + ai * 128 + wr * 64 + m * 16 + fr; const float ri = ri8[ai * 4 + m];
                unsigned short* sr = S + (size_t)r * ldc + col0;
#pragma unroll
                for (int bj = 0; bj < 2; ++bj) { const f32x4 v0 = acc[ai][bj][m][0] * ri, v1 = acc[ai][bj][m][1] * ri; u32x4 w;
                    w.x = pkh2(v0[0], v0[1]); w.y = pkh2(v0[2], v0[3]); w.z = pkh2(v1[0], v1[1]); w.w = pkh2(v1[2], v1[3]); *(u32x4*)(sr + bj * 128) = w; }
            }
    }
};
struct Bf16Row {
    static constexpr bool PERM = true;
    bf16* O; int ldc; const float* ssq; float invdim;
    __device__ __forceinline__ void operator()(const f32x4 (&acc)[2][2][4][2], const Unit& u, int wr, int wc, int fr, int fq) const {
        const int col0 = u.pn * 256 + wc * 32 + 8 * fq;
        float ri8[8];
        if (ssq) rinv8(ssq, u.pm * 256 + wr * 64 + fr, fr, fq, invdim, ri8);
        else {
#pragma unroll
            for (int k = 0; k < 8; ++k) ri8[k] = 1.f; }
#pragma unroll
        for (int ai = 0; ai < 2; ++ai)
#pragma unroll
            for (int m = 0; m < 4; ++m) {
                const int r = u.pm * 256 + ai * 128 + wr * 64 + m * 16 + fr; const float ri = ri8[ai * 4 + m];
                bf16* orow = O + (size_t)r * ldc + col0;
#pragma unroll
                for (int bj = 0; bj < 2; ++bj) { const f32x4 v0 = acc[ai][bj][m][0] * ri, v1 = acc[ai][bj][m][1] * ri; u32x4 w;
                    w.x = cvt_pk_bf16(v0[0], v0[1]); w.y = cvt_pk_bf16(v0[2], v0[3]); w.z = cvt_pk_bf16(v1[0], v1[1]); w.w = cvt_pk_bf16(v1[2], v1[3]); *(u32x4*)(orow + bj * 128) = w; }
            }
    }
};
struct VTCol {
    static constexpr bool PERM = true;
    bf16* O; const float* ssq; float invdim;
    __device__ __forceinline__ void operator()(const f32x4 (&acc)[2][2][4][2], const Unit& u, int wr, int wc, int fr, int fq) const {
        const int col0 = u.pn * 256 + wc * 32 + 8 * fq;
#pragma unroll
        for (int bj = 0; bj < 2; ++bj) {
            f32x4 sc0, sc1;
#pragma unroll
            for (int j = 0; j < 4; ++j) { sc0[j] = row_rinv(ssq, col0 + bj * 128 + j, invdim); sc1[j] = row_rinv(ssq, col0 + bj * 128 + 4 + j, invdim); }
#pragma unroll
            for (int ai = 0; ai < 2; ++ai)
#pragma unroll
                for (int m = 0; m < 4; ++m) {
                    const int r = u.pm * 256 + ai * 128 + wr * 64 + m * 16 + fr;
                    const f32x4 v0 = acc[ai][bj][m][0] * sc0, v1 = acc[ai][bj][m][1] * sc1; u32x4 w;
                    w.x = cvt_pk_bf16(v0[0], v0[1]); w.y = cvt_pk_bf16(v0[2], v0[3]); w.z = cvt_pk_bf16(v1[0], v1[1]); w.w = cvt_pk_bf16(v1[2], v1[3]);
                    *(u32x4*)(O + (size_t)r * T + col0 + bj * 128) = w;
                }
        }
    }
};
struct Gate {
    static constexpr bool PERM = true;
    const bf16* XBc; bf16* XBn; const bf16* PP; const float* ssq; float* ssq_out;
    __device__ __forceinline__ void operator()(const f32x4 (&acc)[2][2][4][2], const Unit& u, int wr, int wc, int fr, int fq) const {
        const int col0 = u.pn * 256 + wc * 32 + 8 * fq;
        float ri8[8], sv[8]; rinv8(ssq, u.pm * 256 + wr * 64 + fr, fr, fq, 1.f / D, ri8);
        u32x4 xo[8][2], pw[8][2];
        const size_t o0 = (size_t)(u.pm * 256 + wr * 64 + fr) * D + col0;
#define EPI_OFF(k) (o0 + (size_t)(((k) >> 2) * 128 + ((k) & 3) * 16) * D)
#define EPI_LOAD(k) do { xo[k][0] = *(const u32x4*)(XBc + EPI_OFF(k)); pw[k][0] = *(const u32x4*)(PP + EPI_OFF(k)); xo[k][1] = *(const u32x4*)(XBc + EPI_OFF(k) + 128); pw[k][1] = *(const u32x4*)(PP + EPI_OFF(k) + 128); } while (0)
        EPI_LOAD(0); EPI_LOAD(1); EPI_LOAD(2);
#pragma unroll
        for (int k = 0; k < 8; ++k) { const int ai = k >> 2, m = k & 3; const float ri = ri8[k]; float s = 0.f;
            if (k + 3 < 8) EPI_LOAD(k + 3);
#pragma unroll
            for (int bj = 0; bj < 2; ++bj) { const u32x4 x = xo[k][bj], p = pw[k][bj];
                const f32x4 z0 = acc[ai][bj][m][0] * ri, z1 = acc[ai][bj][m][1] * ri; f32x4 g0, g1;
#pragma unroll
                for (int j = 0; j < 4; ++j) { g0[j] = __builtin_amdgcn_rcpf(1.f + __builtin_amdgcn_exp2f(-1.4426950408889634f * z0[j])); g1[j] = __builtin_amdgcn_rcpf(1.f + __builtin_amdgcn_exp2f(-1.4426950408889634f * z1[j])); }
                const f32x4 v0 = (f32x4){bflo(x.x), bfhi(x.x), bflo(x.y), bfhi(x.y)} + g0 * (f32x4){bflo(p.x), bfhi(p.x), bflo(p.y), bfhi(p.y)};
                const f32x4 v1 = (f32x4){bflo(x.z), bfhi(x.z), bflo(x.w), bfhi(x.w)} + g1 * (f32x4){bflo(p.z), bfhi(p.z), bflo(p.w), bfhi(p.w)};
                u32x4 w; w.x = cvt_pk_bf16(v0[0], v0[1]); w.y = cvt_pk_bf16(v0[2], v0[3]); w.z = cvt_pk_bf16(v1[0], v1[1]); w.w = cvt_pk_bf16(v1[2], v1[3]); *(u32x4*)(XBn + EPI_OFF(k) + bj * 128) = w;
                s += dot4(v0) + dot4(v1); }
            s += shx<16>(s, fq * 16 + fr); s += shx<32>(s, fq * 16 + fr); sv[k] = s;
        }
#undef EPI_LOAD
#undef EPI_OFF
        if (fq == 0) {
#pragma unroll
            for (int k = 0; k < 8; ++k) ssq_out[(size_t)(u.pm * 256 + (k >> 2) * 128 + wr * 64 + (k & 3) * 16 + fr) * 16 + u.pn * 4 + wc] = sv[k]; }
    }
};
struct Down {
    static constexpr bool PERM = true;
    bf16* CQ; bf16* CKV; bf16* KPE; const float* ssq; float* ssq_q; float* ssq_kv; const float* COS; const float* SIN;
    __device__ __forceinline__ void operator()(const f32x4 (&acc)[2][2][4][2], const Unit& u, int wr, int wc, int fr, int fq) const {
        const int tc0 = wc * 32 + 8 * fq;
        float ri8[8], sv[8]; rinv8(ssq, u.pm * 256 + wr * 64 + fr, fr, fq, 1.f / D, ri8);
#pragma unroll
        for (int k = 0; k < 8; ++k) sv[k] = 0.f;
#pragma unroll
        for (int ai = 0; ai < 2; ++ai)
#pragma unroll
            for (int m = 0; m < 4; ++m) {
                const int r = u.pm * 256 + ai * 128 + wr * 64 + m * 16 + fr; const float ri = ri8[ai * 4 + m];
                if (u.pn < 4) {
                    bf16* orow = (u.pn < 3) ? CQ + (size_t)r * QRANK + u.pn * 256 + tc0 : CKV + (size_t)r * KVRANK + tc0; float s = 0.f;
#pragma unroll
                    for (int bj = 0; bj < 2; ++bj) { const f32x4 v0 = acc[ai][bj][m][0] * ri, v1 = acc[ai][bj][m][1] * ri; u32x4 w;
                        w.x = cvt_pk_bf16(v0[0], v0[1]); w.y = cvt_pk_bf16(v0[2], v0[3]); w.z = cvt_pk_bf16(v1[0], v1[1]); w.w = cvt_pk_bf16(v1[2], v1[3]); *(u32x4*)(orow + bj * 128) = w;
                        s += dot4(v0) + dot4(v1); }
                    s += shx<16>(s, fq * 16 + fr); s += shx<32>(s, fq * 16 + fr); sv[ai * 4 + m] = s;
                } else if (wc < 2) {
                    const f32x4 cs = *(const f32x4*)(COS + (size_t)r * 32 + wc * 16 + 4 * fq), sn = *(const f32x4*)(SIN + (size_t)r * 32 + wc * 16 + 4 * fq);
                    const f32x4 v0 = acc[ai][0][m][0] * ri, v1 = acc[ai][0][m][1] * ri; u32x4 w;
                    w.x = cvt_pk_bf16(v0[0] * cs[0] - v0[1] * sn[0], v0[1] * cs[0] + v0[0] * sn[0]);
                    w.y = cvt_pk_bf16(v0[2] * cs[1] - v0[3] * sn[1], v0[3] * cs[1] + v0[2] * sn[1]);
                    w.z = cvt_pk_bf16(v1[0] * cs[2] - v1[1] * sn[2], v1[1] * cs[2] + v1[0] * sn[2]);
                    w.w = cvt_pk_bf16(v1[2] * cs[3] - v1[3] * sn[3], v1[3] * cs[3] + v1[2] * sn[3]);
                    *(u32x4*)(KPE + (size_t)r * QKR + tc0) = w;
                }
            }
        if (u.pn < 4 && fq == 0) {
            float* const so = (u.pn < 3) ? ssq_q + u.pn * 4 + wc : ssq_kv + wc;
#pragma unroll
            for (int k = 0; k < 8; ++k) so[(size_t)(u.pm * 256 + (k >> 2) * 128 + wr * 64 + (k & 3) * 16 + fr) * 16] = sv[k]; }
    }
};
struct QUp {
    static constexpr bool PERM = true;
    bf16* Q; const float* ssq_q; const float* COS; const float* SIN;
    __device__ __forceinline__ void operator()(const f32x4 (&acc)[2][2][4][2], const Unit& u, int wr, int wc, int fr, int fq) const {
        float ri8[8]; rinv8(ssq_q, u.pm * 256 + wr * 64 + fr, fr, fq, 1.f / QRANK, ri8);
        const int r0 = u.pm * 256 + wr * 64 + fr;
#pragma unroll
        for (int bj = 0; bj < 2; ++bj) {
            const int c0w = u.pn * 256 + bj * 128 + wc * 32, c8 = c0w + 8 * fq;
            if ((c0w % DQK) >= QKN) {
                const int pb = ((c8 % DQK) - QKN) >> 1;
                f32x4 cs[8], sn[8];
#pragma unroll
                for (int k = 0; k < 8; ++k) { const size_t ro = (size_t)(r0 + (k >> 2) * 128 + (k & 3) * 16) * 32 + pb; cs[k] = *(const f32x4*)(COS + ro); sn[k] = *(const f32x4*)(SIN + ro); }
#pragma unroll
                for (int k = 0; k < 8; ++k) { const int ai = k >> 2, m = k & 3; const float ri = ri8[k];
                    const f32x4 v0 = acc[ai][bj][m][0] * ri, v1 = acc[ai][bj][m][1] * ri; u32x4 w;
                    w.x = cvt_pk_bf16(v0[0] * cs[k][0] - v0[1] * sn[k][0], v0[1] * cs[k][0] + v0[0] * sn[k][0]);
                    w.y = cvt_pk_bf16(v0[2] * cs[k][1] - v0[3] * sn[k][1], v0[3] * cs[k][1] + v0[2] * sn[k][1]);
                    w.z = cvt_pk_bf16(v1[0] * cs[k][2] - v1[1] * sn[k][2], v1[1] * cs[k][2] + v1[0] * sn[k][2]);
                    w.w = cvt_pk_bf16(v1[2] * cs[k][3] - v1[3] * sn[k][3], v1[3] * cs[k][3] + v1[2] * sn[k][3]);
                    *(u32x4*)(Q + (size_t)(r0 + ai * 128 + m * 16) * (NHEAD * DQK) + c8) = w; }
            } else {
#pragma unroll
                for (int k = 0; k < 8; ++k) { const int ai = k >> 2, m = k & 3; const float ri = ri8[k];
                    const f32x4 v0 = acc[ai][bj][m][0] * ri, v1 = acc[ai][bj][m][1] * ri; u32x4 w;
                    w.x = cvt_pk_bf16(v0[0], v0[1]); w.y = cvt_pk_bf16(v0[2], v0[3]); w.z = cvt_pk_bf16(v1[0], v1[1]); w.w = cvt_pk_bf16(v1[2], v1[3]);
                    *(u32x4*)(Q + (size_t)(r0 + ai * 128 + m * 16) * (NHEAD * DQK) + c8) = w; }
            }
        }
    }
};
struct Null {
    static constexpr bool PERM = true;
    float* O;
    __device__ __forceinline__ void operator()(const f32x4 (&acc)[2][2][4][2], const Unit& u, int wr, int wc, int fr, int fq) const {
        f32x4 s = {0.f, 0.f, 0.f, 0.f};
#pragma unroll
        for (int ai = 0; ai < 2; ++ai)
#pragma unroll
            for (int bj = 0; bj < 2; ++bj)
#pragma unroll
                for (int m = 0; m < 4; ++m) s += acc[ai][bj][m][0] + acc[ai][bj][m][1];
        O[(size_t)(u.pm * 8 + u.pn) * 512 + (wr * 4 + wc) * 64 + fq * 16 + fr] = (s[0] + s[1]) + (s[2] + s[3]);
    }
};
}

struct TJob { const float* W; int ldw; int K; int Nout; bf16* out; int mode; const float* rs; const float* cs; float cmul; };
__device__ __forceinline__ int tj_src(int mode, int n) {
    if (mode == 1) { if (n < KVRANK) return n; const int rr = n - KVRANK; return KVRANK + (rr >> 1) + 32 * (rr & 1); }
    if (mode == 2) { const int hd = n / DQK, r = n % DQK; if (r < QKN) return n; const int rr = r - QKN; return hd * DQK + QKN + (rr >> 1) + 32 * (rr & 1); }
    if (mode == 3) return (n >> 7) * 256 + (n & 127);
    if (mode == 4) return (n >> 7) * 256 + 128 + (n & 127);
    return n;
}
__device__ __forceinline__ void transpose_tile(const TJob& j, LAS float* scr, int tile, int tid) {
    const int nkt = j.K >> 6, n0 = (tile / nkt) * 64, k0 = (tile % nkt) * 64;
    { const int nn = tid & 63; const int src = (j.mode == 5) ? -1 : tj_src(j.mode, n0 + nn);
      const float csv = (j.cs ? j.cs[n0 + nn] : 1.f) * j.cmul;
#pragma unroll
      for (int i = 0; i < 8; ++i) { const int kk = (tid >> 6) + 8 * i; float v = 0.f;
          if (src >= 0) v = j.W[(size_t)(k0 + kk) * j.ldw + src] * (j.rs ? j.rs[k0 + kk] : 1.f) * csv;
          scr[kk * 65 + nn] = v; } }
    __syncthreads();
    { const int kk2 = (tid & 31) * 2;
#pragma unroll
      for (int i = 0; i < 4; ++i) { const int nn2 = (tid >> 5) + 16 * i;
          *(unsigned*)(j.out + (size_t)(n0 + nn2) * j.K + k0 + kk2) = pk2(scr[kk2 * 65 + nn2], scr[(kk2 + 1) * 65 + nn2]); } }
    __syncthreads();
}
__device__ __forceinline__ void transpose_tile2(const TJob& ja, int tileA, const TJob& jb, int tileB, LAS float* scr, int tid) {
    LAS float* scr2 = scr + 64 * 65 + 32;
    const int nkA = ja.K >> 6, nkB = jb.K >> 6;
    const int nA = (tileA / nkA) * 64, kA = (tileA % nkA) * 64, nB = (tileB / nkB) * 64, kB = (tileB % nkB) * 64;
    { const int nn = tid & 63; const bool zA = ja.mode == 5, zB = jb.mode == 5; const int sA = zA ? 0 : tj_src(ja.mode, nA + nn), sB = zB ? 0 : tj_src(jb.mode, nB + nn);
      const float cA = zA ? 0.f : (ja.cs ? ja.cs[nA + nn] : 1.f) * ja.cmul, cB = zB ? 0.f : (jb.cs ? jb.cs[nB + nn] : 1.f) * jb.cmul;
      float va[8], vb[8], ra[8], rb[8];
#pragma unroll
      for (int i = 0; i < 8; ++i) { const int kk = (tid >> 6) + 8 * i; va[i] = ja.W[(size_t)(kA + kk) * ja.ldw + sA]; vb[i] = jb.W[(size_t)(kB + kk) * jb.ldw + sB];
          ra[i] = ja.rs ? ja.rs[kA + kk] : 1.f; rb[i] = jb.rs ? jb.rs[kB + kk] : 1.f; }
#pragma unroll
      for (int i = 0; i < 8; ++i) { const int kk = (tid >> 6) + 8 * i; scr[kk * 65 + nn] = va[i] * ra[i] * cA; scr2[kk * 65 + nn] = vb[i] * rb[i] * cB; } }
    __syncthreads();
    { const int kk2 = (tid & 31) * 2;
#pragma unroll
      for (int i = 0; i < 4; ++i) { const int nn2 = (tid >> 5) + 16 * i;
          *(unsigned*)(ja.out + (size_t)(nA + nn2) * ja.K + kA + kk2) = pk2(scr[kk2 * 65 + nn2], scr[(kk2 + 1) * 65 + nn2]);
          *(unsigned*)(jb.out + (size_t)(nB + nn2) * jb.K + kB + kk2) = pk2(scr2[kk2 * 65 + nn2], scr2[(kk2 + 1) * 65 + nn2]); } }
    __syncthreads();
}
struct In {
    const float *x, *p; const int* pos; const float *mix_norm, *ffn_norm, *pool_w, *pool_scale, *kv_in_norm, *w_dkv, *kv_norm, *w_ukv, *w_dq, *q_norm, *w_uq, *w_o,
                *peer_wq, *peer_keys, *peer_u, *peer_v, *ple_norm, *ple_wg, *ple_wp, *final_norm;
};
typedef const __attribute__((address_space(4))) In CIn;
__device__ __forceinline__ TJob get_job(int id, CIn& in, unsigned char* ws) {
    TJob j; j.mode = 0; j.rs = nullptr; j.cs = nullptr; j.cmul = 1.f;
    if (id < 4) { j.W = in.ple_wg + (size_t)id * D * D; j.ldw = D; j.K = D; j.Nout = D; j.out = (bf16*)(ws + W_WG) + (size_t)id * D * D; j.rs = in.ple_norm + id * D; }
    else if (id < 8) { const int i = id - 4; j.W = in.ple_wp + (size_t)i * PLE * D; j.ldw = D; j.K = PLE; j.Nout = D; j.out = (bf16*)(ws + W_WP) + (size_t)i * D * PLE; }
    else if (id < 16) { const int i = (id - 8) >> 2, g = (id - 8) & 3; j.W = in.pool_w + (size_t)(i * 4 + g) * 65536; j.ldw = 256; j.K = 256; j.Nout = 256;
        j.out = (bf16*)(ws + W_POOL) + (size_t)(i * 1024 + g * 256) * 256; j.cs = in.pool_scale + i * D + g * 256; }
    else if (id == 16) { j.W = in.w_dq; j.ldw = QRANK; j.K = D; j.Nout = QRANK; j.out = (bf16*)(ws + W_DOWN2); j.rs = in.mix_norm + 2 * D; }
    else if (id == 17) { j.W = in.w_dkv; j.ldw = KVRANK + QKR; j.K = D; j.Nout = KVRANK + QKR; j.out = (bf16*)(ws + W_DOWN2) + (size_t)QRANK * D; j.mode = 1; j.rs = in.kv_in_norm; }
    else if (id == 18) { j.W = in.w_dkv; j.ldw = KVRANK + QKR; j.K = D; j.Nout = 192; j.out = (bf16*)(ws + W_DOWN2) + (size_t)(QRANK + KVRANK + QKR) * D; j.mode = 5; }
    else if (id == 19) { j.W = in.w_dq + (size_t)D * QRANK; j.ldw = QRANK; j.K = D; j.Nout = QRANK; j.out = (bf16*)(ws + W_DOWN3); j.rs = in.mix_norm + 3 * D; }
    else if (id == 20) { j.W = in.w_ukv; j.ldw = 2048; j.K = KVRANK; j.Nout = 1024; j.out = (bf16*)(ws + W_KNW); j.mode = 3; j.rs = in.kv_norm; }
    else if (id == 21) { j.W = in.w_ukv; j.ldw = 2048; j.K = KVRANK; j.Nout = 1024; j.out = (bf16*)(ws + W_VW); j.mode = 4; j.rs = in.kv_norm; }
    else if (id < 24) { const int jj = id - 22; j.W = in.w_uq + (size_t)jj * QRANK * 1536; j.ldw = 1536; j.K = QRANK; j.Nout = 1536; j.out = (bf16*)(ws + W_UQ) + (size_t)jj * 1536 * QRANK;
        j.mode = 2; j.rs = in.q_norm + jj * QRANK; j.cmul = C2; }
    else { const int jj = id - 24; j.W = in.w_o + (size_t)jj * D * D; j.ldw = D; j.K = D; j.Nout = D; j.out = (bf16*)(ws + W_WO) + (size_t)jj * D * D; }
    return j;
}
constexpr int N_TJOBS = 26;
__host__ __device__ constexpr int tj_tiles(int id) {
    return id < 4 ? (D >> 6) * (D >> 6) : id < 8 ? (PLE >> 6) * (D >> 6) : id < 16 ? 16 : id == 16 ? (D >> 6) * (QRANK >> 6) : id == 17 ? (D >> 6) * ((KVRANK + QKR) >> 6)
         : id == 18 ? (D >> 6) * 3 : id == 19 ? (D >> 6) * (QRANK >> 6) : id < 22 ? (KVRANK >> 6) * 16 : id < 24 ? (QRANK >> 6) * 24 : (D >> 6) * (D >> 6);
}

__device__ __forceinline__ void weff_item(const float* wq, const float* keys, const float* gain, bf16* out, int hp, int kt, LAS float* lds, int tid) {
    constexpr int RS = 136;
    LAS unsigned short* Wh = (LAS unsigned short*)lds; LAS unsigned short* Wl = Wh + 64 * RS; LAS unsigned short* Kh = Wl + 64 * RS; LAS unsigned short* Kl = Kh + 128 * RS;
    const int k0 = kt * 64;
#define WEFF_SPLIT(v, ph, pl) do { v2u h_, l_; h_.x = pk2((v)[0], (v)[1]); h_.y = pk2((v)[2], (v)[3]); \
        l_.x = pk2((v)[0] - bflo(h_.x), (v)[1] - bfhi(h_.x)); l_.y = pk2((v)[2] - bflo(h_.y), (v)[3] - bfhi(h_.y)); *(LAS v2u*)(ph) = h_; *(LAS v2u*)(pl) = l_; } while (0)
#pragma unroll
    for (int i = 0; i < 4; ++i) { const int idx = tid + 512 * i, row = idx >> 5, c4 = idx & 31;
        const f32x4 v = *(const f32x4*)(wq + (size_t)(k0 + row) * 2048 + hp * 128 + c4 * 4) * gain[k0 + row]; WEFF_SPLIT(v, Wh + row * RS + c4 * 4, Wl + row * RS + c4 * 4); }
#pragma unroll
    for (int i = 0; i < 8; ++i) { const int idx = tid + 512 * i, row = idx >> 5, c4 = idx & 31;
        const f32x4 v = *(const f32x4*)(keys + (size_t)(hp * 128 + row) * 128 + c4 * 4); WEFF_SPLIT(v, Kh + row * RS + c4 * 4, Kl + row * RS + c4 * 4); }
#undef WEFF_SPLIT
    __syncthreads();
    const int w = tid >> 6, l = tid & 63, tk = w & 1, tn = w >> 1, r32 = l & 31, g = l >> 5;
    f32x16 acc;
#pragma unroll
    for (int r = 0; r < 16; ++r) acc[r] = 0.f;
    const int ao = (32 * tk + r32) * RS + 8 * g, bo = (32 * tn + r32) * RS + 8 * g;
#pragma unroll
    for (int s8 = 0; s8 < 8; ++s8) {
        const bf16x8 ah = *(const LAS bf16x8*)(Wh + ao + 16 * s8), al = *(const LAS bf16x8*)(Wl + ao + 16 * s8);
        const bf16x8 bh = *(const LAS bf16x8*)(Kh + bo + 16 * s8), bl = *(const LAS bf16x8*)(Kl + bo + 16 * s8);
        acc = __builtin_amdgcn_mfma_f32_32x32x16_bf16(ah, bh, acc, 0, 0, 0);
        acc = __builtin_amdgcn_mfma_f32_32x32x16_bf16(ah, bl, acc, 0, 0, 0);
        acc = __builtin_amdgcn_mfma_f32_32x32x16_bf16(al, bh, acc, 0, 0, 0);
    }
#pragma unroll
    for (int gq = 0; gq < 4; ++gq) { v2u o_; o_.x = pk2(acc[4 * gq + 0], acc[4 * gq + 1]); o_.y = pk2(acc[4 * gq + 2], acc[4 * gq + 3]);
        *(v2u*)(out + (size_t)(hp * 128 + 32 * tn + r32) * D + k0 + 32 * tk + 8 * gq + 4 * g) = o_; }
    __syncthreads();
}

__device__ __forceinline__ void p0_prologue(CIn& in, unsigned char* ws, LAS unsigned char* lds, int bid, int G, int wave) {
    const int tid = wave * 64 + lane_id_fresh();
    const int gtid = bid * NTHR + tid, NT = G * NTHR;
    for (int i = gtid + (int)(SSQ_ARR / 4); i < (int)(16 * SSQ_ARR / 4); i += NT) ((f32x4*)(ws + WS_SSQ))[i] = (f32x4){0.f, 0.f, 0.f, 0.f};
    {
      int total = 0;
#pragma unroll
      for (int id = 0; id < N_TJOBS; ++id) total += tj_tiles(id);
      for (int g = bid; g < total; g += 2 * G) {
          int idA = 0, tA = g; while (tA >= tj_tiles(idA)) { tA -= tj_tiles(idA); ++idA; }
          const TJob ja = get_job(idA, in, ws);
          if (g + G < total) { int idB = idA, tB = tA + G; while (tB >= tj_tiles(idB)) { tB -= tj_tiles(idB); ++idB; }
              const TJob jb = get_job(idB, in, ws); transpose_tile2(ja, tA, jb, tB, (LAS float*)lds, tid); }
          else transpose_tile(ja, (LAS float*)lds, tA, tid); } }
    for (int it = bid; it < 4 * 16 * 16; it += G) { const int l = it >> 8, hp = (it >> 4) & 15, kt = it & 15;
        weff_item(in.peer_wq + (size_t)l * D * 2048, in.peer_keys + (size_t)l * 2048 * 128, in.ffn_norm + l * D, (bf16*)(ws + W_WEFF) + (size_t)l * 2048 * D, hp, kt, (LAS float*)lds, tid); }
    for (int i = gtid; i < T * 32; i += NT) { const int t = i >> 5, c = i & 31;
        double inv = 0.15915494309189535; for (int k = 0; k < c; ++k) inv *= 0.7498942093324559;
        double rd = (double)in.pos[t] * inv; rd -= __builtin_floor(rd); const float rr = (float)rd;
        ((float*)(ws + WS_COS))[i] = __builtin_amdgcn_cosf(rr); ((float*)(ws + WS_SIN))[i] = __builtin_amdgcn_sinf(rr); }
    { const int lane = tid & 63, gw = gtid >> 6, NW = NT >> 6; bf16* XB = (bf16*)(ws + WS_XBA); float* ssq = (float*)(ws + WS_SSQ);
      for (int r = gw; r < T; r += 2 * NW) { const int r2 = (r + NW < T) ? r + NW : r; f32x4 va[4], vb[4];
#pragma unroll
          for (int j = 0; j < 4; ++j) { va[j] = *(const f32x4*)(in.x + (size_t)r * D + j * 256 + 4 * lane); vb[j] = *(const f32x4*)(in.x + (size_t)r2 * D + j * 256 + 4 * lane); }
          float s = 0.f, s2 = 0.f;
#pragma unroll
          for (int j = 0; j < 4; ++j) { const size_t o = (size_t)r * D + j * 256 + 4 * lane, o2 = (size_t)r2 * D + j * 256 + 4 * lane;
              v2u w; w.x = pk2(va[j][0], va[j][1]); w.y = pk2(va[j][2], va[j][3]); *(v2u*)(XB + o) = w; s += (va[j][0] * va[j][0] + va[j][1] * va[j][1]) + (va[j][2] * va[j][2] + va[j][3] * va[j][3]);
              v2u y; y.x = pk2(vb[j][0], vb[j][1]); y.y = pk2(vb[j][2], vb[j][3]); *(v2u*)(XB + o2) = y; s2 += (vb[j][0] * vb[j][0] + vb[j][1] * vb[j][1]) + (vb[j][2] * vb[j][2] + vb[j][3] * vb[j][3]); }
          s = wave_sum(s, lane); s2 = wave_sum(s2, lane);
          if (lane < 16) { ssq[(size_t)r * 16 + lane] = (lane == 0) ? s : 0.f; ssq[(size_t)r2 * 16 + lane] = (lane == 0) ? s2 : 0.f; } } }
}
typedef float f2_t __attribute__((ext_vector_type(2)));
template <int CTRL> __device__ __forceinline__ int dppi(int v) { return __builtin_amdgcn_update_dpp(0, v, CTRL, 0xf, 0xf, true); }
__device__ __forceinline__ unsigned wave_max_dpp(unsigned v) {
    v = max(v, (unsigned)dppi<0xB1>((int)v)); v = max(v, (unsigned)dppi<0x4E>((int)v)); v = max(v, (unsigned)dppi<0x141>((int)v)); v = max(v, (unsigned)dppi<0x140>((int)v));
    { unsigned p = v, q = v; asm volatile("s_nop 1\n\tv_permlane16_swap_b32 %0, %1" : "+v"(p), "+v"(q)); v = max(p, q); }
    { unsigned p = v, q = v; asm volatile("s_nop 1\n\tv_permlane32_swap_b32 %0, %1" : "+v"(p), "+v"(q)); v = max(p, q); }
    return v;
}
__device__ __forceinline__ unsigned pack_i8x4(f32x4 v, float inv) {
    const unsigned y0 = __builtin_bit_cast(unsigned, __builtin_fmaf(v[0], inv, 12582912.f)), y1 = __builtin_bit_cast(unsigned, __builtin_fmaf(v[1], inv, 12582912.f));
    const unsigned y2 = __builtin_bit_cast(unsigned, __builtin_fmaf(v[2], inv, 12582912.f)), y3 = __builtin_bit_cast(unsigned, __builtin_fmaf(v[3], inv, 12582912.f));
    return __builtin_amdgcn_perm(y1, y0, 0x0c0c0400u) | (__builtin_amdgcn_perm(y3, y2, 0x0c0c0400u) << 16);
}
__device__ __forceinline__ void quant_store_i8(const f32x4 (&v)[4], unsigned char* tab, int row, float* scale_out, int lane) {
    unsigned amb = 0u;
#pragma unroll
    for (int j = 0; j < 4; ++j)
#pragma unroll
        for (int i = 0; i < 4; ++i) { const float f_ = v[j][i]; amb = max(amb, __builtin_bit_cast(unsigned, f_) & 0x7fffffffu); }
    const float am = __builtin_bit_cast(float, wave_max_dpp(amb));
    const float inv = am > 0.f ? 126.99f * __builtin_amdgcn_rcpf(am) : 0.f;
    v4u w;
#pragma unroll
    for (int j = 0; j < 4; ++j) w[j] = pack_i8x4(v[j], inv);
    *(v4u*)(tab + (size_t)((unsigned)(lane >> 3) * (unsigned)(NEXP * 128) + (unsigned)row * 128u + (unsigned)(lane & 7) * 16u)) = w;
    *scale_out = am * (1.f / 126.99f);
}
__device__ __forceinline__ void convert_layer(CIn& in, unsigned char* ws, int layer, int bid, int G, int wave) {
    const int set = layer & 1;
    const int lane = lane_id_fresh(), tid = wave * 64 + lane;
    const int gtid = bid * NTHR + tid, NT = G * NTHR, gw = gtid >> 6, NW = NT >> 6;
    const float* u = in.peer_u + (size_t)layer * NEXP * D; const float* v = in.peer_v + (size_t)layer * NEXP * D; const float* gn = in.ffn_norm + layer * D;
    unsigned char* U8 = ws + tab_off(set); unsigned char* V8 = U8 + (size_t)NEXP * D; float* SU = (float*)(ws + tabs_off(set)); float* SV = SU + NEXP;
    f32x4 gv[4];
#pragma unroll
    for (int j = 0; j < 4; ++j) gv[j] = *(const f32x4*)(gn + 16 * lane + 4 * j);
    for (int r = gw; r < NEXP; r += 2 * NW) {
        const int r2 = r + NW; const bool ok2 = r2 < NEXP; const int rb = ok2 ? r2 : r;
        f32x4 ua[4], va[4], ub[4], vb[4];
#pragma unroll
        for (int j = 0; j < 4; ++j) { ua[j] = *(const f32x4*)(u + (size_t)r * D + 16 * lane + 4 * j); va[j] = *(const f32x4*)(v + (size_t)r * D + 16 * lane + 4 * j);
            ub[j] = *(const f32x4*)(u + (size_t)rb * D + 16 * lane + 4 * j); vb[j] = *(const f32x4*)(v + (size_t)rb * D + 16 * lane + 4 * j); }
#pragma unroll
        for (int j = 0; j < 4; ++j) { ua[j] = ua[j] * gv[j]; ub[j] = ub[j] * gv[j]; }
        quant_store_i8(ua, U8, r, SU + r, lane); quant_store_i8(va, V8, r, SV + r, lane);
        if (ok2) { quant_store_i8(ub, U8, r2, SU + r2, lane); quant_store_i8(vb, V8, r2, SV + r2, lane); }
    }
    const float* p = in.p + (size_t)layer * T * PLE; bf16* PB = (bf16*)(ws + WS_PB);
    for (int i = gtid; i < T * PLE / 8; i += NT) { const size_t o = (size_t)i * 8; const f32x4 a0 = *(const f32x4*)(p + o), a1 = *(const f32x4*)(p + o + 4);
        v4u w; w.x = pk2(a0[0], a0[1]); w.y = pk2(a0[2], a0[3]); w.z = pk2(a1[0], a1[1]); w.w = pk2(a1[2], a1[3]); *(v4u*)(PB + o) = w; }
}
template <int W>
__device__ __forceinline__ void pooled_strip(const bf16* XB, const LAS float* rinv, const float* gain, bf16* P, int t0, int s0, int tid) {
    const int c0 = 2 * tid; const f32x2 gv = *(const f32x2*)(gain + c0);
    f32x2 ring[W]; f32x2 sum = {0.f, 0.f};
    { unsigned xw[W];
#pragma unroll
      for (int j = 0; j < W; ++j) xw[j] = (s0 - W + j >= 0) ? *(const unsigned*)(XB + (size_t)(t0 - W + j) * D + c0) : 0u;
#pragma unroll
      for (int j = 0; j < W; ++j) { const float ri = (s0 - W + j >= 0) ? rinv[16 - W + j] : 0.f; const f32x2 hv = (f32x2){bflo(xw[j]), bfhi(xw[j])} * ri * gv; ring[j] = hv; sum += hv; } }
    for (int sb = 0; sb < 64; sb += 16) {
        unsigned xw[16];
#pragma unroll
        for (int j = 0; j < 16; ++j) xw[j] = *(const unsigned*)(XB + (size_t)(t0 + sb + j) * D + c0);
#pragma unroll
        for (int j = 0; j < 16; ++j) { const int t = t0 + sb + j, s = s0 + sb + j; const float ri = rinv[16 + sb + j];
            const f32x2 hv = (f32x2){bflo(xw[j]), bfhi(xw[j])} * ri * gv; sum += hv - ring[j % W]; ring[j % W] = hv;
            const float ic = 1.f / (float)((s + 1 < W) ? s + 1 : W); const f32x2 pv = sum * ic - hv;
            *(unsigned*)(P + (size_t)t * D + c0) = pk2(pv[0], pv[1]); }
    }
}
__device__ __forceinline__ void pooled_phase(const bf16* XB, const float* ssq, const float* gain, bf16* P, LAS unsigned char* lds, int vcu, int G, int wave) {
    const int tid = wave * 64 + lane_id_fresh();
    const int g = wave >> 1;
    LAS float* rinv = (LAS float*)lds;
    for (int strip = vcu; strip < T / 64; strip += G) { const int t0 = strip * 64, s0 = t0 & (SEQ - 1);
        __syncthreads();
        if (tid < 80) { const int t = t0 - 16 + tid; rinv[tid] = (s0 - 16 + tid >= 0) ? row_rinv(ssq, t, 1.f / D) : 0.f; }
        __syncthreads();
        if (g == 0) pooled_strip<2>(XB, rinv, gain, P, t0, s0, tid); else if (g == 1) pooled_strip<4>(XB, rinv, gain, P, t0, s0, tid);
        else if (g == 2) pooled_strip<8>(XB, rinv, gain, P, t0, s0, tid); else pooled_strip<16>(XB, rinv, gain, P, t0, s0, tid); }
}
__device__ __forceinline__ void final_phase(const bf16* XB, const float* ssq, const float* gain, float* out, int bid, int G, int wave) {
    const int tid = wave * 64 + lane_id_fresh();
    const int lane = tid & 63, gw = (bid * NTHR + tid) >> 6, NW = (G * NTHR) >> 6;
    f32x4 gv[4];
#pragma unroll
    for (int j = 0; j < 4; ++j) gv[j] = *(const f32x4*)(gain + j * 256 + 4 * lane);
    int r = gw;
    for (; r + 3 * NW < T; r += 4 * NW) {
        f32x4 sq[4]; v2u xw[4][4];
#pragma unroll
        for (int k = 0; k < 4; ++k) { const int rr = r + k * NW; sq[k] = *(const f32x4*)(ssq + (size_t)rr * 16 + 4 * (lane & 3));
#pragma unroll
            for (int j = 0; j < 4; ++j) xw[k][j] = *(const v2u*)(XB + (size_t)rr * D + j * 256 + 4 * lane); }
#pragma unroll
        for (int k = 0; k < 4; ++k) { const int rr = r + k * NW;
            float sv = (sq[k][0] + sq[k][1]) + (sq[k][2] + sq[k][3]); sv += dppf<0xB1>(sv); sv += dppf<0x4E>(sv);
            const float ri = __builtin_amdgcn_rsqf(sv * (1.f / D) + 1e-6f);
#pragma unroll
            for (int j = 0; j < 4; ++j) *(f32x4*)(out + (size_t)rr * D + j * 256 + 4 * lane) = (f32x4){bflo(xw[k][j].x), bfhi(xw[k][j].x), bflo(xw[k][j].y), bfhi(xw[k][j].y)} * ri * gv[j]; }
    }
    for (; r < T; r += NW) { const float ri = row_rinv(ssq, r, 1.f / D);
#pragma unroll
        for (int j = 0; j < 4; ++j) { const size_t o = (size_t)r * D + j * 256 + 4 * lane; const v2u x1 = *(const v2u*)(XB + o); *(f32x4*)(out + o) = (f32x4){bflo(x1.x), bfhi(x1.x), bflo(x1.y), bfhi(x1.y)} * ri * gv[j]; } }
}

__device__ __forceinline__ unsigned fkey(float f) { const unsigned u = __builtin_bit_cast(unsigned, f); return u ^ ((unsigned)((int)u >> 31) | 0x80000000u); }
__device__ __forceinline__ unsigned mbcnt64(unsigned long long m) { return __builtin_amdgcn_mbcnt_hi((unsigned)(m >> 32), __builtin_amdgcn_mbcnt_lo((unsigned)m, 0u)); }
template <int N>
__device__ __forceinline__ void select16(const unsigned (&key)[N], unsigned (&pos)[N]) {
    unsigned prefix = 0u;
    for (int bit = 31; bit >= 0; --bit) {
        const unsigned cand = prefix | (1u << bit); int cnt = 0;
#pragma unroll
        for (int i = 0; i < N; ++i) cnt += __builtin_popcountll(__ballot(key[i] >= cand));
        if (cnt >= 16) prefix = cand;
        if (cnt == 16) break;
    }
    unsigned long long mg[N], me[N]; int cgt = 0;
#pragma unroll
    for (int i = 0; i < N; ++i) { mg[i] = __ballot(key[i] > prefix); me[i] = __ballot(key[i] == prefix); cgt += __builtin_popcountll(mg[i]); }
    int bg = 0, be = cgt;
#pragma unroll
    for (int i = 0; i < N; ++i) { const unsigned rg = mbcnt64(mg[i]), re = mbcnt64(me[i]);
        pos[i] = (key[i] > prefix) ? (unsigned)bg + rg : ((key[i] == prefix) ? (unsigned)be + re : 64u);
        bg += __builtin_popcountll(mg[i]); be += __builtin_popcountll(me[i]); }
}
__device__ __forceinline__ float gelu_tanh(float a) {
    const float u = 0.7978845608028654f * (a + 0.044715f * a * a * a);
    const float e = __builtin_amdgcn_exp2f(2.885390081777927f * u);
    const float th = 1.f - 2.f * __builtin_amdgcn_rcpf(1.f + e);
    return 0.5f * a * (1.f + th);
}
typedef short s16x2_t __attribute__((ext_vector_type(2)));
__device__ __forceinline__ unsigned hkey2(unsigned w) { const s16x2_t sg = __builtin_bit_cast(s16x2_t, w) >> 15; return w ^ (__builtin_bit_cast(unsigned, sg) | 0x80008000u); }
__device__ __forceinline__ float fkey_inv(unsigned k) { const unsigned u = (k & 0x80000000u) ? (k ^ 0x80000000u) : ~k; return __builtin_bit_cast(float, u); }
__device__ __forceinline__ void bit_transpose32(unsigned (&A)[32]) {
#define BT_STAGE(J, M) _Pragma("unroll") for (int k = 0; k < 32; ++k) if ((k & (J)) == 0) { const unsigned t = (A[k] ^ (A[k + (J)] >> (J))) & (M); A[k] ^= t; A[k + (J)] ^= t << (J); }
    BT_STAGE(16, 0x0000FFFFu) BT_STAGE(8, 0x00FF00FFu) BT_STAGE(4, 0x0F0F0F0Fu) BT_STAGE(2, 0x33333333u) BT_STAGE(1, 0x55555555u)
#undef BT_STAGE
}
template <int GL>
__device__ __forceinline__ void topk_select(unsigned (&key)[32], unsigned& Gm, unsigned& Em, int& ng) {
    bit_transpose32(key);
    unsigned A = 0xFFFFFFFFu, G = 0u; int n = 0;
#pragma unroll
    for (int i = 0; i < 32; ++i) {
        const unsigned x = A & key[i]; int c = __builtin_popcount(x);
        c += dppi<0xB1>(c); c += dppi<0x4E>(c);
        if (GL == 8) c += dppi<0x141>(c);
        const bool take = (n + c >= 16);
        A = take ? x : (A ^ x); G = take ? G : (G | x); n = take ? n : n + c;
    }
    Gm = G; Em = A; ng = n;
}
__device__ __forceinline__ void bit_transpose16x2(unsigned (&A)[16]) {
#define BT_STAGE(J, M) _Pragma("unroll") for (int k = 0; k < 16; ++k) if ((k & (J)) == 0) { const unsigned t = (A[k] ^ (A[k + (J)] >> (J))) & (M); A[k] ^= t; A[k + (J)] ^= t << (J); }
    _Pragma("unroll") for (int k = 0; k < 8; ++k) { const unsigned a = A[k], b = A[k + 8]; A[k] = __builtin_amdgcn_perm(b, a, 0x03070105u); A[k + 8] = __builtin_amdgcn_perm(b, a, 0x02060004u); }
    BT_STAGE(4, 0x0F0F0F0Fu) BT_STAGE(2, 0x33333333u) BT_STAGE(1, 0x55555555u)
#undef BT_STAGE
}
template <int GL>
__device__ __forceinline__ void topk_select16(unsigned (&key)[16], unsigned& Gm, unsigned& Em, int& ng) {
    bit_transpose16x2(key);
    unsigned A = 0xFFFFFFFFu, G = 0u; int n = 0;
#pragma unroll
    for (int i = 0; i < 16; ++i) {
        const unsigned x = A & key[i]; int c = __builtin_popcount(x);
        c += dppi<0xB1>(c); c += dppi<0x4E>(c);
        if (GL == 8) c += dppi<0x141>(c);
        const bool take = (n + c >= 16);
        A = take ? x : (A ^ x); G = take ? G : (G | x); n = take ? n : n + c;
    }
    Gm = G; Em = A; ng = n;
}
__device__ __forceinline__ float rs32(float p, float q) { asm volatile("s_nop 1\n\tv_permlane32_swap_b32 %0, %1" : "+v"(p), "+v"(q)); return p + q; }
__device__ __forceinline__ float rs16(float p, float q) { asm volatile("s_nop 1\n\tv_permlane16_swap_b32 %0, %1" : "+v"(p), "+v"(q)); return p + q; }
__device__ __forceinline__ float wave_sum_dpp(float v) {
    v += dppf<0xB1>(v); v += dppf<0x4E>(v); v += dppf<0x141>(v); v += dppf<0x140>(v); v = rs16(v, v); v = rs32(v, v); return v;
}
struct ConvNext { const float* u; const float* v; const float* gain; const float* p; unsigned char* U8; unsigned char* V8; float* SU; float* SV; bf16* PB; int on; };
template <int GL>
__device__ __forceinline__ void topk_select16x2(unsigned (&kA)[16], unsigned (&kB)[16], unsigned& GmA, unsigned& EmA, int& ngA, unsigned& GmB, unsigned& EmB, int& ngB) {
    bit_transpose16x2(kA); bit_transpose16x2(kB);
    unsigned AA = 0xFFFFFFFFu, GA = 0u, AB = 0xFFFFFFFFu, GB = 0u; int nA = 0, nB = 0;
#pragma unroll
    for (int i = 0; i < 16; ++i) {
        const unsigned xA = AA & kA[i], xB = AB & kB[i]; int cA = __builtin_popcount(xA), cB = __builtin_popcount(xB);
        cA += dppi<0xB1>(cA); cB += dppi<0xB1>(cB); cA += dppi<0x4E>(cA); cB += dppi<0x4E>(cB);
        if (GL == 8) { cA += dppi<0x141>(cA); cB += dppi<0x141>(cB); }
        const bool tA = (nA + cA >= 16), tB = (nB + cB >= 16);
        AA = tA ? xA : (AA ^ xA); GA = tA ? GA : (GA | xA); nA = tA ? nA : nA + cA;
        AB = tB ? xB : (AB ^ xB); GB = tB ? GB : (GB | xB); nB = tB ? nB : nB + cB;
    }
    GmA = GA; EmA = AA; ngA = nA; GmB = GB; EmB = AB; ngB = nB;
}
struct KTok { LAS unsigned char* s1i; LAS unsigned char* s2c; LAS unsigned char* scratch; LAS unsigned short* rowc; };
__device__ __forceinline__ KTok ktok(LAS unsigned char* lw, int lane) { KTok k; k.s1i = lw; k.s2c = lw + 256; k.scratch = lw + 512 + lane; k.rowc = (LAS unsigned short*)(lw + 2048); return k; }
__device__ __forceinline__ void k_compact(unsigned M, LAS unsigned char* wp, LAS unsigned char* scratch, int base) {
    while (__builtin_amdgcn_ballot_w64(M != 0u) != 0ull) {
#pragma unroll
        for (int u4 = 0; u4 < 4; ++u4) { const bool act = M != 0u; const int bp = __builtin_ctz(M | 0x80000000u); M &= M - 1u;
            LAS unsigned char* const p = act ? wp : scratch; *p = (unsigned char)(base + 30 - 2 * (bp & 15) + (bp >> 4)); wp += act ? 1 : 0; }
    }
}
__device__ __forceinline__ unsigned k_trim(unsigned Em, int ke) {
    unsigned Et = Em;
    while (__builtin_amdgcn_ballot_w64(__builtin_popcount(Et) > ke) != 0ull) { if (__builtin_popcount(Et) > ke) Et &= Et - 1u; asm volatile("" : "+v"(Et)); }
    return Et;
}
__device__ __forceinline__ void k_compact2(unsigned MA, LAS unsigned char* wpA, LAS unsigned char* scrA, unsigned MB, LAS unsigned char* wpB, LAS unsigned char* scrB, int base) {
    while (__builtin_amdgcn_ballot_w64((MA | MB) != 0u) != 0ull) {
#pragma unroll
        for (int u4 = 0; u4 < 4; ++u4) {
            { const bool act = MA != 0u; const int bp = __builtin_ctz(MA | 0x80000000u); MA &= MA - 1u;
              LAS unsigned char* const p = act ? wpA : scrA; *p = (unsigned char)(base + 30 - 2 * (bp & 15) + (bp >> 4)); wpA += act ? 1 : 0; }
            { const bool act = MB != 0u; const int bp = __builtin_ctz(MB | 0x80000000u); MB &= MB - 1u;
              LAS unsigned char* const p = act ? wpB : scrB; *p = (unsigned char)(base + 30 - 2 * (bp & 15) + (bp >> 4)); wpB += act ? 1 : 0; } }
    }
}
__device__ __forceinline__ void k_trim2(unsigned& EA, int keA, unsigned& EB, int keB) {
    while (__builtin_amdgcn_ballot_w64(__builtin_popcount(EA) > keA || __builtin_popcount(EB) > keB) != 0ull) {
        if (__builtin_popcount(EA) > keA) EA &= EA - 1u; if (__builtin_popcount(EB) > keB) EB &= EB - 1u; asm volatile("" : "+v"(EA), "+v"(EB)); }
}
__device__ __forceinline__ void k_l1_keys(const v4u (&cw)[4], const KTok& k, int lane, unsigned (&key)[16]) {
#pragma unroll
    for (int q = 0; q < 4; ++q) { const v4u w = cw[q]; *(LAS v4u*)(k.rowc + lane * 32 + q * 8) = w;
#pragma unroll
        for (int c = 0; c < 4; ++c) key[4 * q + c] = hkey2(w[c]); }
}
__device__ __forceinline__ void k_l1_post(unsigned Gm, unsigned Em, int ntot, const KTok& k, int lane) {
    const int g1 = lane >> 2, sub = lane & 3;
    const int neq = __builtin_popcount(Em);
    const int e0 = dppi<0x00>(neq), e1 = dppi<0x55>(neq), e2 = dppi<0xAA>(neq);
    const int pe = ntot + (sub > 0 ? e0 : 0) + (sub > 1 ? e1 : 0) + (sub > 2 ? e2 : 0);
    const unsigned M = Gm | k_trim(Em, min(max(16 - pe, 0), neq));
    const int cnt = __builtin_popcount(M);
    const int c0 = dppi<0x00>(cnt), c1 = dppi<0x55>(cnt), c2 = dppi<0xAA>(cnt);
    k_compact(M, k.s1i + g1 * 16 + (sub > 0 ? c0 : 0) + (sub > 1 ? c1 : 0) + (sub > 2 ? c2 : 0), k.scratch, sub * 32);
}
__device__ __forceinline__ void k_l1_post2(unsigned GmA, unsigned EmA, int ntA, const KTok& kA, unsigned GmB, unsigned EmB, int ntB, const KTok& kB, int lane) {
    const int g1 = lane >> 2, sub = lane & 3;
    const int neqA = __builtin_popcount(EmA), neqB = __builtin_popcount(EmB);
    const int eA0 = dppi<0x00>(neqA), eA1 = dppi<0x55>(neqA), eA2 = dppi<0xAA>(neqA), eB0 = dppi<0x00>(neqB), eB1 = dppi<0x55>(neqB), eB2 = dppi<0xAA>(neqB);
    const int peA = ntA + (sub > 0 ? eA0 : 0) + (sub > 1 ? eA1 : 0) + (sub > 2 ? eA2 : 0), peB = ntB + (sub > 0 ? eB0 : 0) + (sub > 1 ? eB1 : 0) + (sub > 2 ? eB2 : 0);
    unsigned EA = EmA, EB = EmB; k_trim2(EA, min(max(16 - peA, 0), neqA), EB, min(max(16 - peB, 0), neqB));
    const unsigned MA = GmA | EA, MB = GmB | EB;
    const int cntA = __builtin_popcount(MA), cntB = __builtin_popcount(MB);
    const int cA0 = dppi<0x00>(cntA), cA1 = dppi<0x55>(cntA), cA2 = dppi<0xAA>(cntA), cB0 = dppi<0x00>(cntB), cB1 = dppi<0x55>(cntB), cB2 = dppi<0xAA>(cntB);
    k_compact2(MA, kA.s1i + g1 * 16 + (sub > 0 ? cA0 : 0) + (sub > 1 ? cA1 : 0) + (sub > 2 ? cA2 : 0), kA.scratch,
               MB, kB.s1i + g1 * 16 + (sub > 0 ? cB0 : 0) + (sub > 1 ? cB1 : 0) + (sub > 2 ? cB2 : 0), kB.scratch, sub * 32);
}
__device__ __forceinline__ int k_scan8(int v, int sub8) {
    { const int t2 = dppi<0x111>(v); if (sub8 >= 1) v += t2; }
    { const int t2 = dppi<0x112>(v); if (sub8 >= 2) v += t2; }
    { const int t2 = dppi<0x114>(v); if (sub8 >= 4) v += t2; }
    return v;
}
__device__ __forceinline__ void k_l2_post2(unsigned GmA, unsigned EmA, int ntA, const KTok& kA, unsigned GmB, unsigned EmB, int ntB, const KTok& kB, int lane) {
    const int h = lane >> 3, sub8 = lane & 7;
    const int neqA = __builtin_popcount(EmA), neqB = __builtin_popcount(EmB);
    const int peA = ntA + (k_scan8(neqA, sub8) - neqA), peB = ntB + (k_scan8(neqB, sub8) - neqB);
    unsigned EA = EmA, EB = EmB; k_trim2(EA, min(max(16 - peA, 0), neqA), EB, min(max(16 - peB, 0), neqB));
    const unsigned MA = GmA | EA, MB = GmB | EB;
    const int cntA = __builtin_popcount(MA), cntB = __builtin_popcount(MB);
    k_compact2(MA, kA.s2c + h * 16 + (k_scan8(cntA, sub8) - cntA), kA.scratch, MB, kB.s2c + h * 16 + (k_scan8(cntB, sub8) - cntB), kB.scratch, sub8 * 32);
}
__device__ __forceinline__ void k_l2_keys(const KTok& k, int lane, unsigned (&key)[16]) {
    const int h = lane >> 3, sub8 = lane & 7;
    const unsigned aib = *(const LAS unsigned short*)(k.s1i + (2 * h) * 16 + 2 * sub8);
    const v4u bib = *(const LAS v4u*)(k.s1i + (2 * h + 1) * 16);
    LAS const unsigned short* ra = k.rowc + (2 * h) * 128; LAS const unsigned short* rb = ra + 128;
    const unsigned a0 = ra[aib & 0xffu], a1 = ra[aib >> 8];
    const half2_t a0x2 = __builtin_bit_cast(half2_t, a0 | (a0 << 16)), a1x2 = __builtin_bit_cast(half2_t, a1 | (a1 << 16));
    half2_t bp[8];
#pragma unroll
    for (int q = 0; q < 8; ++q) { const unsigned blo = rb[(bib[q >> 1] >> (16 * (q & 1))) & 0xffu], bhi = rb[(bib[q >> 1] >> (16 * (q & 1) + 8)) & 0xffu]; bp[q] = __builtin_bit_cast(half2_t, blo | (bhi << 16)); }
#pragma unroll
    for (int i = 0; i < 16; ++i) key[i] = hkey2(__builtin_bit_cast(unsigned, ((i < 8) ? a0x2 : a1x2) + bp[i & 7]));
}
__device__ __forceinline__ void k_l2_post(unsigned Gm, unsigned Em, int ntot, const KTok& k, int lane) {
    const int h = lane >> 3, sub8 = lane & 7;
    const int neq = __builtin_popcount(Em);
    int se = neq;
    { const int t2 = dppi<0x111>(se); if (sub8 >= 1) se += t2; }
    { const int t2 = dppi<0x112>(se); if (sub8 >= 2) se += t2; }
    { const int t2 = dppi<0x114>(se); if (sub8 >= 4) se += t2; }
    const int pe = ntot + (se - neq);
    const unsigned M = Gm | k_trim(Em, min(max(16 - pe, 0), neq));
    const int cnt = __builtin_popcount(M); int sc = cnt;
    { const int t1 = dppi<0x111>(sc); if (sub8 >= 1) sc += t1; }
    { const int t1 = dppi<0x112>(sc); if (sub8 >= 2) sc += t1; }
    { const int t1 = dppi<0x114>(sc); if (sub8 >= 4) sc += t1; }
    k_compact(M, k.s2c + h * 16 + (sc - cnt), k.scratch, sub8 * 32);
}
__device__ __forceinline__ void k_gates(int t, f32x4 rq, const KTok& k, int lane, const float* SU, const float* SV, unsigned short* IDX, float* GW, float* MU) {
    float rinv; { float sv_ = (rq[0] + rq[1]) + (rq[2] + rq[3]); sv_ += dppf<0xB1>(sv_); sv_ += dppf<0x4E>(sv_); rinv = __builtin_amdgcn_rsqf(sv_ * (1.f / D) + 1e-6f); }
#pragma unroll
    for (int kk = 0; kk < 2; ++kk) { const int kx = lane + 64 * kk, hh = kx >> 4; const unsigned cand = k.s2c[kx];
        const unsigned ia = k.s1i[(2 * hh) * 16 + (cand >> 4)], ib = k.s1i[(2 * hh + 1) * 16 + (cand & 15u)];
        const float sv = hlo((unsigned)k.rowc[(2 * hh) * 128 + ia]) + hlo((unsigned)k.rowc[(2 * hh + 1) * 128 + ib]); float mx = sv;
        mx = fmaxf(mx, dppf<0xB1>(mx)); mx = fmaxf(mx, dppf<0x4E>(mx)); mx = fmaxf(mx, dppf<0x141>(mx)); mx = fmaxf(mx, dppf<0x140>(mx));
        const float ex = __builtin_amdgcn_exp2f((sv - mx) * 1.4426950408889634f); float sum = ex;
        sum += dppf<0xB1>(sum); sum += dppf<0x4E>(sum); sum += dppf<0x141>(sum); sum += dppf<0x140>(sum);
        const unsigned ee = ia * 128u + ib; const size_t o = (size_t)t * 128 + (kx & 7) * 16 + (kx >> 3);
        IDX[o] = (unsigned short)ee; GW[o] = ex * __builtin_amdgcn_rcpf(sum) * SV[ee]; MU[o] = rinv * SU[ee]; }
}
struct KConv { f32x4 cr[4], cg[4], cp0; };
__device__ __forceinline__ void k_conv_load(const ConvNext& cv, int t, int lane, KConv& c) {
    const bool cu = t < NEXP; const float* rp = cu ? cv.u + (size_t)t * D : cv.v + (size_t)(t - NEXP) * D;
#pragma unroll
    for (int j = 0; j < 4; ++j) { c.cr[j] = *(const f32x4*)(rp + 16 * lane + 4 * j); c.cg[j] = *(const f32x4*)(cv.gain + 16 * lane + 4 * j); }
    c.cp0 = *(const f32x4*)(cv.p + ((size_t)t * 64 + lane) * 4);
}
__device__ __forceinline__ void k_conv_store(const ConvNext& cv, int t, int lane, KConv& c) {
    if (t < NEXP) {
#pragma unroll
        for (int j = 0; j < 4; ++j) c.cr[j] = c.cr[j] * c.cg[j];
        quant_store_i8(c.cr, cv.U8, t, cv.SU + t, lane); }
    else quant_store_i8(c.cr, cv.V8, t - NEXP, cv.SV + (t - NEXP), lane);
    { v2u w; w.x = pk2(c.cp0[0], c.cp0[1]); w.y = pk2(c.cp0[2], c.cp0[3]); *(v2u*)(cv.PB + ((size_t)t * 64 + lane) * 4) = w; }
}
__device__ __forceinline__ void peer_topk_phase(const unsigned short* S, const float* ssq_in, const float* SU, const float* SV, unsigned short* IDX, float* GW, float* MU,
                                                const ConvNext cv, LAS unsigned char* lds, int vcu, int G, int wave) {
    const int lane = lane_id_fresh();
    const KTok kA = ktok(lds + wave * 12288, lane), kB = ktok(lds + wave * 12288 + 6144, lane);
    const int gw = vcu * NWAVES + wave, NW = G * NWAVES;
    v4u nxA[4], nxB[4];
#define K_SROW(dst, tt) do { const v4u* sp_ = (const v4u*)(S + (size_t)min((tt), T - 1) * 2048 + lane * 32); _Pragma("unroll") for (int q = 0; q < 4; ++q) dst[q] = sp_[q]; } while (0)
    K_SROW(nxA, gw); K_SROW(nxB, gw + NW);
    for (int t = gw; t < T; t += 2 * NW) {
        const int tB = (t + NW < T) ? t + NW : t;
        v4u cwA[4], cwB[4];
#pragma unroll
        for (int q = 0; q < 4; ++q) { cwA[q] = nxA[q]; cwB[q] = nxB[q]; }
        const f32x4 rqA = *(const f32x4*)(ssq_in + (size_t)t * 16 + 4 * (lane & 3)), rqB = *(const f32x4*)(ssq_in + (size_t)tB * 16 + 4 * (lane & 3));
        K_SROW(nxA, t + 2 * NW); K_SROW(nxB, t + 3 * NW);
        KConv cA, cB; if (cv.on) { k_conv_load(cv, t, lane, cA); k_conv_load(cv, tB, lane, cB); }
        { unsigned keyA[16], keyB[16]; k_l1_keys(cwA, kA, lane, keyA); k_l1_keys(cwB, kB, lane, keyB);
          unsigned GmA, EmA, GmB, EmB; int nA, nB; topk_select16x2<4>(keyA, keyB, GmA, EmA, nA, GmB, EmB, nB);
          k_l1_post2(GmA, EmA, nA, kA, GmB, EmB, nB, kB, lane); }
        LDS_WAIT();
        { unsigned keyA[16], keyB[16]; k_l2_keys(kA, lane, keyA); k_l2_keys(kB, lane, keyB);
          unsigned GmA, EmA, GmB, EmB; int nA, nB; topk_select16x2<8>(keyA, keyB, GmA, EmA, nA, GmB, EmB, nB);
          k_l2_post2(GmA, EmA, nA, kA, GmB, EmB, nB, kB, lane); }
        LDS_WAIT();
        k_gates(t, rqA, kA, lane, SU, SV, IDX, GW, MU); k_gates(tB, rqB, kB, lane, SU, SV, IDX, GW, MU);
        if (cv.on) {
            if ((t < NEXP) == (tB < NEXP)) {
                if (t < NEXP) {
#pragma unroll
                    for (int j = 0; j < 4; ++j) { cA.cr[j] = cA.cr[j] * cA.cg[j]; cB.cr[j] = cB.cr[j] * cB.cg[j]; }
                    quant_store_i8(cA.cr, cv.U8, t, cv.SU + t, lane); quant_store_i8(cB.cr, cv.U8, tB, cv.SU + tB, lane); }
                else { quant_store_i8(cA.cr, cv.V8, t - NEXP, cv.SV + (t - NEXP), lane); quant_store_i8(cB.cr, cv.V8, tB - NEXP, cv.SV + (tB - NEXP), lane); }
                { v2u w; w.x = pk2(cA.cp0[0], cA.cp0[1]); w.y = pk2(cA.cp0[2], cA.cp0[3]); *(v2u*)(cv.PB + ((size_t)t * 64 + lane) * 4) = w; }
                { v2u w; w.x = pk2(cB.cp0[0], cB.cp0[1]); w.y = pk2(cB.cp0[2], cB.cp0[3]); *(v2u*)(cv.PB + ((size_t)tB * 64 + lane) * 4) = w; }
            } else { k_conv_store(cv, t, lane, cA); k_conv_store(cv, tB, lane, cB); } }
        LDS_WAIT();
    }
#undef K_SROW
}
__device__ __forceinline__ int dot4_first(int a, int b) { int r; asm("v_dot4_i32_i8 %0, %1, %2, 0" : "=v"(r) : "v"(a), "v"(b)); return r; }
__device__ __forceinline__ unsigned peer_off_lo(unsigned w, unsigned m, unsigned a) { unsigned r; asm("v_mad_u32_u16 %0, %1, %2, %3" : "=v"(r) : "v"(w), "s"(m), "v"(a)); return r; }
__device__ __forceinline__ unsigned peer_off_hi(unsigned w, unsigned m, unsigned a) { unsigned r; asm("v_mad_u32_u16 %0, %1, %2, %3 op_sel:[1,0,0,0]" : "=v"(r) : "v"(w), "s"(m), "v"(a)); return r; }
#define PEER_ISSUE8(buf, o, idw, TAB) do { _Pragma("unroll") for (int b = 0; b < 8; ++b) { \
        const unsigned off = (b & 1) ? peer_off_hi((idw)[b >> 1], 128u, taboff) : peer_off_lo((idw)[b >> 1], 128u, taboff); \
        buf[(o) + b] = *(const v4u*)((TAB) + (size_t)off); } } while (0)
#define PEER_ISSUE16(buf, i0, i1, TAB) do { PEER_ISSUE8(buf, 0, i0, TAB); PEER_ISSUE8(buf, 8, i1, TAB); } while (0)
template <int M> __device__ __forceinline__ unsigned swz8(unsigned v) { return (unsigned)__builtin_amdgcn_ds_swizzle((int)v, 0x18 | (M << 5)); }
#define SWZ8(v, m) swz8<m>(v)
#define PEER_ISSUE_U1(buf, iw, TAB, p) do { const unsigned w_ = swz8<p>(iw); \
        buf[2 * (p)] = *(const v4u*)((TAB) + (size_t)peer_off_lo(w_, 128u, taboff)); buf[2 * (p) + 1] = *(const v4u*)((TAB) + (size_t)peer_off_hi(w_, 128u, taboff)); } while (0)
#define PEER_ISSUE_U(buf, iw, TAB) do { PEER_ISSUE_U1(buf, iw, TAB, 0); PEER_ISSUE_U1(buf, iw, TAB, 1); PEER_ISSUE_U1(buf, iw, TAB, 2); PEER_ISSUE_U1(buf, iw, TAB, 3); \
        PEER_ISSUE_U1(buf, iw, TAB, 4); PEER_ISSUE_U1(buf, iw, TAB, 5); PEER_ISSUE_U1(buf, iw, TAB, 6); PEER_ISSUE_U1(buf, iw, TAB, 7); } while (0)
#define PEER_ISSUE_V1(buf, r, TAB, m) do { const unsigned w0_ = swz8<m>((r).x), w1_ = swz8<m>((r).y); \
        buf[4 * (m)] = *(const v4u*)((TAB) + (size_t)peer_off_lo(w0_, 128u, taboff)); buf[4 * (m) + 1] = *(const v4u*)((TAB) + (size_t)peer_off_hi(w0_, 128u, taboff)); \
        buf[4 * (m) + 2] = *(const v4u*)((TAB) + (size_t)peer_off_lo(w1_, 128u, taboff)); buf[4 * (m) + 3] = *(const v4u*)((TAB) + (size_t)peer_off_hi(w1_, 128u, taboff)); } while (0)
#define PEER_ISSUE_V(buf, r, TAB) do { PEER_ISSUE_V1(buf, r, TAB, 0); PEER_ISSUE_V1(buf, r, TAB, 1); PEER_ISSUE_V1(buf, r, TAB, 2); PEER_ISSUE_V1(buf, r, TAB, 3); } while (0)
#define PEER_PIN4(v) asm volatile("" : "+v"((v).x), "+v"((v).y), "+v"((v).z), "+v"((v).w))
#define VPTR(base, rowbytes, tt, off) ((const char*)(base) + (size_t)(tt) * (rowbytes) + (off))
template <int LIGHT>
__device__ __forceinline__ void peer_u_phase(const unsigned short* IDX, const bf16* XB, const unsigned char* U8, unsigned short* PART, int bid, int G, int wave) {
    const int lane = lane_id_fresh(), j = lane >> 3, c = lane & 7;
    const int NS = G < 8 ? G : 8, rank = bid / NS, nrank = (G - (bid % NS) + NS - 1) / NS;
    for (int s = bid % NS; s < 8; s += NS) {
        const unsigned coloff = (unsigned)(s * 128 + c * 16), taboff = (unsigned)(s * (NEXP * 128) + c * 16);
        const int stride = nrank * NWAVES;
        unsigned short* part = PART + (size_t)s * T * 128;
        unsigned o_idx = (unsigned)(j * 32 + c * 4), o_x = coloff * 2u + (unsigned)((j & 1) * 16), o_p = (unsigned)(j * 32 + c * 4); const bool xhalf = (j & 1) != 0;
#define PEER_U_TOKEN(buf, xh, tt) do { \
              \
            v4u xa, xb; { v4u ph; _Pragma("unroll") for (int k = 0; k < 4; ++k) ph[k] = (unsigned)dppi<0x128>((int)(xh)[k]); \
                _Pragma("unroll") for (int k = 0; k < 4; ++k) { xa[k] = xhalf ? ph[k] : (xh)[k]; xb[k] = xhalf ? (xh)[k] : ph[k]; } } \
            const float xv[16] = {bflo(xa.x), bfhi(xa.x), bflo(xa.y), bfhi(xa.y), bflo(xa.z), bfhi(xa.z), bflo(xa.w), bfhi(xa.w), bflo(xb.x), bfhi(xb.x), bflo(xb.y), bfhi(xb.y), bflo(xb.z), bfhi(xb.z), bflo(xb.w), bfhi(xb.w)}; \
              \
            float am = 0.f; _Pragma("unroll") for (int i = 0; i < 16; ++i) am = fmaxf(am, fabsf(xv[i])); \
            { unsigned ab = __builtin_bit_cast(unsigned, am); ab = max(ab, (unsigned)dppi<0xB1>((int)ab)); ab = max(ab, (unsigned)dppi<0x4E>((int)ab)); ab = max(ab, (unsigned)dppi<0x141>((int)ab)); am = __builtin_bit_cast(float, ab); }   \
            const float xinv = am > 0.f ? 127.f / am : 0.f, xsc = am * (0.015625f / 127.f)  ; \
            int xq[4]; _Pragma("unroll") for (int q = 0; q < 4; ++q) xq[q] = (int)pack_i8x4((f32x4){xv[4 * q], xv[4 * q + 1], xv[4 * q + 2], xv[4 * q + 3]}, xinv); \
            int dd[16]; \
            _Pragma("unroll") for (int b = 0; b < 16; ++b) { PEER_PIN4(buf[b]); \
                if (LIGHT) { dd[b] = (int)((buf[b].x ^ buf[b].y) ^ (buf[b].z ^ buf[b].w)) + xq[b & 3]; continue; } \
                int d = dot4_first((int)buf[b].x, xq[0]); d = __builtin_amdgcn_sdot4((int)buf[b].y, xq[1], d, false); \
                d = __builtin_amdgcn_sdot4((int)buf[b].z, xq[2], d, false); dd[b] = __builtin_amdgcn_sdot4((int)buf[b].w, xq[3], d, false); } \
              \
            const bool cb2 = (c & 4) != 0, cb1 = (c & 2) != 0, cb0 = (c & 1) != 0; \
            int e8[8], e4[4], e2[2]; \
            _Pragma("unroll") for (int k = 0; k < 8; ++k) { const int keep = cb2 ? dd[8 + k] : dd[k], send = cb2 ? dd[k] : dd[8 + k]; e8[k] = keep + dppi<0x141>(send); } \
            _Pragma("unroll") for (int k = 0; k < 4; ++k) { const int keep = cb1 ? e8[4 + k] : e8[k], send = cb1 ? e8[k] : e8[4 + k]; e4[k] = keep + dppi<0x1B>(send); } \
            _Pragma("unroll") for (int k = 0; k < 2; ++k) { const int keep = cb0 ? e4[2 + k] : e4[k], send = cb0 ? e4[k] : e4[2 + k]; e2[k] = keep + dppi<0xB1>(send); } \
            *(unsigned*)VPTR(part, 256, tt, o_p) = pkh2((float)e2[0] * xsc, (float)e2[1] * xsc); } while (0)
        v4u bufA[16], bufB[16], xA, xB; unsigned iA = 0u, iB = 0u;
        xA = xB = (v4u){0u, 0u, 0u, 0u};
        int t = rank * NWAVES + wave;
        if (t + 3 * stride < T) {
            { iA = *(const unsigned*)VPTR(IDX, 256, t, o_idx); xA = *(const v4u*)VPTR(XB, 2048, t, o_x); }
            { iB = *(const unsigned*)VPTR(IDX, 256, t + stride, o_idx); }
            PEER_ISSUE_U(bufA, iA, U8);
        do {
            asm volatile("" : "+v"(o_idx), "+v"(o_x), "+v"(o_p));
            const int t1 = t + stride, t2 = t1 + stride, t3 = t2 + stride;
            { iA = *(const unsigned*)VPTR(IDX, 256, t2, o_idx); }
            PEER_ISSUE_U(bufB, iB, U8);
            { xB = *(const v4u*)VPTR(XB, 2048, t1, o_x); }
            PEER_U_TOKEN(bufA, xA, t);
            { iB = *(const unsigned*)VPTR(IDX, 256, t3, o_idx); }
            PEER_ISSUE_U(bufA, iA, U8);
            { xA = *(const v4u*)VPTR(XB, 2048, t2, o_x); }
            PEER_U_TOKEN(bufB, xB, t1);
            t = t2;
        } while (t + 3 * stride < T);
        } else {
        if (t < T) { iA = *(const unsigned*)VPTR(IDX, 256, t, o_idx); xA = *(const v4u*)VPTR(XB, 2048, t, o_x); }
        if (t + stride < T) { iB = *(const unsigned*)VPTR(IDX, 256, t + stride, o_idx); }
        if (t < T) PEER_ISSUE_U(bufA, iA, U8);
        }
        while (t < T) {
            asm volatile("" : "+v"(o_idx), "+v"(o_x), "+v"(o_p));
            const int t1 = t + stride, t2 = t1 + stride, t3 = t2 + stride;
            if (t1 < T) { PEER_ISSUE_U(bufB, iB, U8); xB = *(const v4u*)VPTR(XB, 2048, t1, o_x); }
            if (t2 < T) { iA = *(const unsigned*)VPTR(IDX, 256, t2, o_idx); }
            PEER_U_TOKEN(bufA, xA, t);
            if (t1 < T) {
                if (t2 < T) { PEER_ISSUE_U(bufA, iA, U8); xA = *(const v4u*)VPTR(XB, 2048, t2, o_x); }
                if (t3 < T) { iB = *(const unsigned*)VPTR(IDX, 256, t3, o_idx); }
                PEER_U_TOKEN(bufB, xB, t1);
            }
            t = t2;
        }
#undef PEER_U_TOKEN
    }
}
__device__ __forceinline__ void peer_w_phase(const unsigned short* PART, const float* GW, const float* MU, const unsigned short* IDX, unsigned* VREC, int bid, int G, int wave) {
    const int tid = wave * 64 + lane_id_fresh(), gtid = bid * NTHR + tid, NT = G * NTHR;
#define PEER_W_LOAD(i_, p_, mu0_, mu1_, gw0_, gw1_, ids_) do { const size_t o_ = (size_t)min((i_), T * 16 - 1) * 8; _Pragma("unroll") for (int s = 0; s < 8; ++s) p_[s] = *(const v4u*)(PART + (size_t)s * T * 128 + o_); \
        mu0_ = *(const f32x4*)(MU + o_); mu1_ = *(const f32x4*)(MU + o_ + 4); gw0_ = *(const f32x4*)(GW + o_); gw1_ = *(const f32x4*)(GW + o_ + 4); ids_ = *(const v4u*)(IDX + o_); } while (0)
    v4u np[8]; f32x4 nmu0, nmu1, ngw0, ngw1; v4u nids;
    PEER_W_LOAD(gtid, np, nmu0, nmu1, ngw0, ngw1, nids);
    for (int i = gtid; i < T * 16; i += NT) {
        v4u p[8]; f32x4 mu0 = nmu0, mu1 = nmu1, gw0 = ngw0, gw1 = ngw1; const v4u ids = nids;
#pragma unroll
        for (int s = 0; s < 8; ++s) p[s] = np[s];
        PEER_W_LOAD(i + NT, np, nmu0, nmu1, ngw0, ngw1, nids);
        f32x4 a0 = {0.f, 0.f, 0.f, 0.f}, a1 = {0.f, 0.f, 0.f, 0.f}, w0, w1;
#pragma unroll
        for (int s = 0; s < 8; ++s) { a0 += (f32x4){hlo(p[s].x), hhi(p[s].x), hlo(p[s].y), hhi(p[s].y)}; a1 += (f32x4){hlo(p[s].z), hhi(p[s].z), hlo(p[s].w), hhi(p[s].w)}; }
#pragma unroll
        for (int q = 0; q < 4; ++q) { w0[q] = gw0[q] * gelu_tanh(a0[q] * 64.f * mu0[q]); w1[q] = gw1[q] * gelu_tanh(a1[q] * 64.f * mu1[q]); }
        float am = fmaxf(fmaxf(fmaxf(fabsf(w0[0]), fabsf(w0[1])), fmaxf(fabsf(w0[2]), fabsf(w0[3]))), fmaxf(fmaxf(fabsf(w1[0]), fabsf(w1[1])), fmaxf(fabsf(w1[2]), fabsf(w1[3]))));
        { unsigned ab = __builtin_bit_cast(unsigned, am); ab = max(ab, (unsigned)dppi<0xB1>((int)ab)); ab = max(ab, (unsigned)dppi<0x4E>((int)ab)); ab = max(ab, (unsigned)dppi<0x141>((int)ab)); ab = max(ab, (unsigned)dppi<0x140>((int)ab));
          am = __builtin_bit_cast(float, ab); }
        const float winv = am > 0.f ? 127.f / am : 0.f; const unsigned sc = __builtin_bit_cast(unsigned, am * (1.f / 127.f));
        unsigned* rec = VREC + (size_t)(i >> 1) * 16; const int h8 = i & 1;
        *(v4u*)(rec + 4 * h8) = ids; *(v2u*)(rec + 8 + 2 * h8) = (v2u){pack_i8x4(w0, winv), pack_i8x4(w1, winv)}; *(v2u*)(rec + 12 + 2 * h8) = (v2u){sc, sc}; }
#undef PEER_W_LOAD
}
__device__ __forceinline__ void peer_v_phase(const unsigned* VREC, const unsigned char* V8, const bf16* XB, bf16* XBo, float* ssq_out, int bid, int G, int wave) {
    const int lane = lane_id_fresh(), j = lane >> 3, c = lane & 7;
    const int NS = G < 8 ? G : 8, rank = bid / NS, nrank = (G - (bid % NS) + NS - 1) / NS;
    for (int s = bid % NS; s < 8; s += NS) {
        const unsigned coloff = (unsigned)(s * 128 + c * 16), taboff = (unsigned)(s * (NEXP * 128) + c * 16);
        const int stride = nrank * NWAVES;
        unsigned o_rec = (unsigned)(j * 64 + c * 8), o_xb = (coloff + 2u * j) * 2u;
#define PEER_V_TOKEN(buf, w, xr, tt) do { \
              \
            const float wsc = __builtin_bit_cast(float, SWZ8((w).x, 6)); const int wq[4] = {(int)SWZ8((w).x, 4), (int)SWZ8((w).y, 4), (int)SWZ8((w).x, 5), (int)SWZ8((w).y, 5)}; \
            int ia[16]; \
            _Pragma("unroll") for (int B = 0; B < 4; ++B) { PEER_PIN4(buf[4 * B]); PEER_PIN4(buf[4 * B + 1]); PEER_PIN4(buf[4 * B + 2]); PEER_PIN4(buf[4 * B + 3]); \
                _Pragma("unroll") for (int q = 0; q < 4; ++q) { const unsigned D0 = buf[4 * B][q], D1 = buf[4 * B + 1][q], D2 = buf[4 * B + 2][q], D3 = buf[4 * B + 3][q]; \
                    const unsigned P0 = __builtin_amdgcn_perm(D1, D0, 0x05010400u), P1 = __builtin_amdgcn_perm(D1, D0, 0x07030602u), Q0 = __builtin_amdgcn_perm(D3, D2, 0x05010400u), Q1 = __builtin_amdgcn_perm(D3, D2, 0x07030602u); \
                    ia[4 * q + 0] = (B == 0) ? dot4_first((int)__builtin_amdgcn_perm(Q0, P0, 0x05040100u), wq[0]) : __builtin_amdgcn_sdot4((int)__builtin_amdgcn_perm(Q0, P0, 0x05040100u), wq[B], ia[4 * q + 0], false); \
                    ia[4 * q + 1] = (B == 0) ? dot4_first((int)__builtin_amdgcn_perm(Q0, P0, 0x07060302u), wq[0]) : __builtin_amdgcn_sdot4((int)__builtin_amdgcn_perm(Q0, P0, 0x07060302u), wq[B], ia[4 * q + 1], false); \
                    ia[4 * q + 2] = (B == 0) ? dot4_first((int)__builtin_amdgcn_perm(Q1, P1, 0x05040100u), wq[0]) : __builtin_amdgcn_sdot4((int)__builtin_amdgcn_perm(Q1, P1, 0x05040100u), wq[B], ia[4 * q + 2], false); \
                    ia[4 * q + 3] = (B == 0) ? dot4_first((int)__builtin_amdgcn_perm(Q1, P1, 0x07060302u), wq[0]) : __builtin_amdgcn_sdot4((int)__builtin_amdgcn_perm(Q1, P1, 0x07060302u), wq[B], ia[4 * q + 3], false); } } \
              \
            int e2a, e2b, e2c, e2d; const bool b3 = (lane & 8) != 0; \
            { int p0 = ia[0], q0 = ia[8], p1 = ia[1], q1 = ia[9], p2 = ia[2], q2 = ia[10], p3 = ia[3], q3 = ia[11], p4 = ia[4], q4 = ia[12], p5 = ia[5], q5 = ia[13], p6 = ia[6], q6 = ia[14], p7 = ia[7], q7 = ia[15]; \
              asm volatile("s_nop 1\n\tv_permlane32_swap_b32 %0, %1\n\tv_permlane32_swap_b32 %2, %3\n\tv_permlane32_swap_b32 %4, %5\n\tv_permlane32_swap_b32 %6, %7\n\t" \
                           "v_permlane32_swap_b32 %8, %9\n\tv_permlane32_swap_b32 %10, %11\n\tv_permlane32_swap_b32 %12, %13\n\tv_permlane32_swap_b32 %14, %15" \
                           : "+v"(p0), "+v"(q0), "+v"(p1), "+v"(q1), "+v"(p2), "+v"(q2), "+v"(p3), "+v"(q3), "+v"(p4), "+v"(q4), "+v"(p5), "+v"(q5), "+v"(p6), "+v"(q6), "+v"(p7), "+v"(q7)); \
              int s0 = p0 + q0, s1 = p1 + q1, s2 = p2 + q2, s3 = p3 + q3, s4_ = p4 + q4, s5 = p5 + q5, s6 = p6 + q6, s7 = p7 + q7; \
              asm volatile("s_nop 1\n\tv_permlane16_swap_b32 %0, %1\n\tv_permlane16_swap_b32 %2, %3\n\tv_permlane16_swap_b32 %4, %5\n\tv_permlane16_swap_b32 %6, %7" \
                           : "+v"(s0), "+v"(s4_), "+v"(s1), "+v"(s5), "+v"(s2), "+v"(s6), "+v"(s3), "+v"(s7)); \
              e2a = s0 + s4_; e2b = s1 + s5; e2c = s2 + s6; e2d = s3 + s7; } \
            int r1x, r1y; { const int kx = b3 ? e2c : e2a, ky = b3 ? e2d : e2b, sx = b3 ? e2a : e2c, sy = b3 ? e2b : e2d; r1x = kx + dppi<0x128>(sx); r1y = ky + dppi<0x128>(sy); } \
            struct { float x, y; } r1 = {(float)r1x * wsc, (float)r1y * wsc}; \
            f32x2 xn = {bflo(xr) + r1.x, bfhi(xr) + r1.y}; \
            *(unsigned*)VPTR(XBo, 2048, tt, o_xb) = pk2(xn[0], xn[1]); \
            const float sq = wave_sum_dpp(xn[0] * xn[0] + xn[1] * xn[1]); SQOUT(sq, tt); } while (0)
        v4u bufA[16], bufB[16]; v2u rA = {0u, 0u}, rB = {0u, 0u}, rC = {0u, 0u};
        unsigned xrA = 0u, xrB = 0u;
#define PEER_V_REC(tt) (*(const v2u*)VPTR(VREC, 512, tt, o_rec))
#define PEER_V_XR(tt) (*(const unsigned*)VPTR(XB, 2048, tt, o_xb))
        int t = rank * NWAVES + wave;
        if (t + 3 * stride < T) {
            rA = PEER_V_REC(t); xrA = PEER_V_XR(t); rB = PEER_V_REC(t + stride);
            PEER_ISSUE_V(bufA, rA, V8);
        float sqA = 0.f;
#define SQOUT(v, tt) do { if ((tt) == t) sqA = (v); else if (lane < 2) ssq_out[(size_t)(lane ? (tt) : t) * 16 + s] = lane ? (v) : sqA; } while (0)
        do {
            asm volatile("" : "+v"(o_rec), "+v"(o_xb));
            const int t1 = t + stride, t2 = t1 + stride, t3 = t2 + stride;
            rC = PEER_V_REC(t2);
            PEER_ISSUE_V(bufB, rB, V8); xrB = PEER_V_XR(t1);
            PEER_V_TOKEN(bufA, rA, xrA, t);
            rA = rC; rC = PEER_V_REC(t3);
            PEER_ISSUE_V(bufA, rA, V8); xrA = PEER_V_XR(t2);
            PEER_V_TOKEN(bufB, rB, xrB, t1);
            rB = rC;
            t = t2;
        } while (t + 3 * stride < T);
#undef SQOUT
        } else {
        if (t < T) { rA = PEER_V_REC(t); xrA = PEER_V_XR(t); }
        if (t + stride < T) rB = PEER_V_REC(t + stride);
        if (t < T) PEER_ISSUE_V(bufA, rA, V8);
        }
#define SQOUT(v, tt) do { if (lane == 0) ssq_out[(size_t)(tt) * 16 + s] = (v); } while (0)
        while (t < T) {
            asm volatile("" : "+v"(o_rec), "+v"(o_xb));
            const int t1 = t + stride, t2 = t1 + stride, t3 = t2 + stride;
            if (t2 < T) rC = PEER_V_REC(t2);
            if (t1 < T) { PEER_ISSUE_V(bufB, rB, V8); xrB = PEER_V_XR(t1); }
            PEER_V_TOKEN(bufA, rA, xrA, t);
            if (t1 < T) {
                rA = rC; if (t3 < T) rC = PEER_V_REC(t3);
                if (t2 < T) { PEER_ISSUE_V(bufA, rA, V8); xrA = PEER_V_XR(t2); }
                PEER_V_TOKEN(bufB, rB, xrB, t1);
                rB = rC;
            }
            t = t2;
        }
#undef SQOUT
#undef PEER_V_REC
#undef PEER_V_XR
#undef PEER_V_TOKEN
    }
}
#undef PEER_ISSUE8
#undef PEER_ISSUE16
#undef PEER_PIN4
#undef VPTR

constexpr int AT_KST = 24576, AT_KPE = 16384, AT_VBASE = 3 * AT_KST, AT_VST = 16384;
constexpr int ATTN_LDS = AT_VBASE + 4 * AT_VST;
__device__ __forceinline__ void attn_phase(const bf16* Q, const bf16* KN, const bf16* KPE, const bf16* VT, bf16* AO, LAS unsigned char* lds, int vcu, int G, int wave) {
    const int lane = lane_id_fresh(), tid = wave * 64 + lane;
    const int rho = lane & 31, hh = lane >> 5;
    const int krow = (rho & 0x13) | ((rho & 4) << 1) | ((rho & 8) >> 1);
    const bool lag = wave >= 4;
    for (int it = vcu; it < 1024; it += G) {
        const int c = it & 255, kq = it >> 8, bh = c >> 2, q4 = c & 3;
        const int qb = (kq == 0) ? 15 - q4 : (kq == 1) ? q4 : (kq == 2) ? 8 + q4 : 7 - q4;
        const int b = bh >> 3, h = bh & 7;
        const int q0 = qb * 256, qlo = q0 + wave * 32, trow0 = b * SEQ + qlo;
        f32x16 o[4];
#pragma unroll
        for (int d = 0; d < 4; ++d)
#pragma unroll
            for (int r = 0; r < 16; ++r) o[d][r] = 0.f;
        float m_run = -1e30f, l_run = 0.f;
        const int nkt = 4 * (qb + 1);
        unsigned vk[2], vp, vv[2];
#pragma unroll
        for (int i = 0; i < 2; ++i) { const int id = tid + 512 * i; { const int row = id >> 4, cc = (id & 15) ^ (row & 15); vk[i] = (unsigned)(row * (D * 2) + cc * 16); }
            { const int row = id >> 3, cc = (id & 7) ^ ((row >> 1) & 7); vv[i] = (unsigned)row * (unsigned)(T * 2) + (unsigned)(cc * 16); } }
        { const int row = tid >> 3, cc = (tid & 7) ^ ((row >> 1) & 7); vp = (unsigned)(row * (QKR * 2) + cc * 16); }
        const unsigned ldsb = (unsigned)(size_t)lds + (unsigned)wave * 1024u;
#define AT_DMA(sbase, voff, ldsdst) do { unsigned _keep; asm volatile("s_mov_b32 %0, m0\n\ts_mov_b32 m0, %3\n\ts_nop 4\n\tglobal_load_lds_dwordx4 %1, %2\n\ts_mov_b32 m0, %0" \
            : "=&s"(_keep) : "v"(voff), "s"(sbase), "s"(ldsdst) : "memory"); } while (0)
#define AT_STAGE_TILE(kt, ks, vs) do { const int tk0 = b * SEQ + (kt) * 64; const unsigned kb2 = ldsb + (unsigned)(ks) * AT_KST, vb2 = ldsb + AT_VBASE + (unsigned)(vs) * AT_VST; \
            const bf16* kb_ = KN + (size_t)tk0 * D + h * QKN; const bf16* pb_ = KPE + (size_t)tk0 * QKR; const bf16* vb_ = VT + (size_t)(h * VH) * T + tk0; \
            AT_DMA(kb_, vk[0], kb2); AT_DMA(kb_, vk[1], kb2 + 8192u); AT_DMA(pb_, vp, kb2 + AT_KPE); AT_DMA(vb_, vv[0], vb2); AT_DMA(vb_, vv[1], vb2 + 8192u); } while (0)
#define AT_SYNC() asm volatile("s_waitcnt vmcnt(0) lgkmcnt(0)\n\ts_barrier" ::: "memory")
#define AT_SYNC5() asm volatile("s_waitcnt vmcnt(5) lgkmcnt(0)\n\ts_barrier" ::: "memory")
#define AT_KADDR(kb, s) ((s) < 8 ? st + ((kb) * 32 + krow) * 256 + (((2 * (s) + hh) ^ (krow & 15)) << 4) : st + AT_KPE + ((kb) * 32 + krow) * 128 + (((2 * ((s) - 8) + hh) ^ ((((kb) * 32 + krow) >> 1) & 7)) << 4))
#define AT_KREAD(dst, kb, s0) do { _Pragma("unroll") for (int i = 0; i < 6; ++i) dst[i] = *(const LAS bf16x8*)AT_KADDR(kb, (s0) + i); } while (0)
#define AT_KMMA(src_, kb, s0) do { _Pragma("unroll") for (int i = 0; i < 6; ++i) sacc[kb] = __builtin_amdgcn_mfma_f32_32x32x16_bf16(src_[i], qf[(s0) + i], sacc[kb], 0, 0, 0); } while (0)
#define AT_QK(ks) do { const LAS unsigned char* st = lds + (ks) * AT_KST; bf16x8 fx[6], fy[6]; \
            _Pragma("unroll") for (int kb = 0; kb < 2; ++kb) _Pragma("unroll") for (int r = 0; r < 16; ++r) sacc[kb][r] = 0.f; \
            AT_KREAD(fx, 0, 0); AT_KREAD(fy, 0, 6); \
            AT_KMMA(fx, 0, 0); __builtin_amdgcn_sched_barrier(0); AT_KREAD(fx, 1, 0); \
            AT_KMMA(fy, 0, 6); __builtin_amdgcn_sched_barrier(0); AT_KREAD(fy, 1, 6); \
            AT_KMMA(fx, 1, 0); AT_KMMA(fy, 1, 6); } while (0)
#define AT_SM(key0v) do { \
            if ((key0v) + 63 > qlo) { const int qpos = qlo + rho; \
                _Pragma("unroll") for (int kb = 0; kb < 2; ++kb) \
                    _Pragma("unroll") for (int r = 0; r < 16; ++r) { const int kpos = (key0v) + 32 * kb + (r & 3) + 4 * ((r >> 2) & 1) + 8 * hh + 16 * (r >> 3); if (kpos > qpos) sacc[kb][r] = -1e30f; } } \
            AT_SM_NM(); } while (0)
#define AT_SM_NM() do { \
            float mx = sacc[0][0]; \
            _Pragma("unroll") for (int kb = 0; kb < 2; ++kb) \
                _Pragma("unroll") for (int r = 0; r < 16; ++r) mx = fmaxf(mx, sacc[kb][r]); \
            mx = fmaxf(mx, shx<32>(mx, lane)); \
            const float m_new = fmaxf(m_run, mx), alpha = __builtin_amdgcn_exp2f(m_run - m_new); m_run = m_new; \
            float lsum = 0.f; \
            _Pragma("unroll") for (int kb = 0; kb < 2; ++kb) \
                _Pragma("unroll") for (int r = 0; r < 16; ++r) { const float p = __builtin_amdgcn_exp2f(sacc[kb][r] - m_new); sacc[kb][r] = p; lsum += p; } \
            l_run = l_run * alpha + lsum; \
            _Pragma("unroll") for (int d = 0; d < 4; ++d) \
                _Pragma("unroll") for (int r = 0; r < 16; ++r) o[d][r] *= alpha; \
            _Pragma("unroll") for (int s2 = 0; s2 < 4; ++s2) { const int kb = s2 >> 1, r0 = 8 * (s2 & 1); v4u w; \
                w.x = pk2(sacc[kb][r0 + 0], sacc[kb][r0 + 1]); w.y = pk2(sacc[kb][r0 + 2], sacc[kb][r0 + 3]); w.z = pk2(sacc[kb][r0 + 4], sacc[kb][r0 + 5]); w.w = pk2(sacc[kb][r0 + 6], sacc[kb][r0 + 7]); \
                pf[s2] = __builtin_bit_cast(bf16x8, w); } } while (0)
#define AT_VREAD(dst, d) do { const int row = (d) * 32 + rho; _Pragma("unroll") for (int s2 = 0; s2 < 4; ++s2) dst[s2] = *(const LAS bf16x8*)(sv + row * 128 + (((2 * s2 + hh) ^ ((row >> 1) & 7)) << 4)); } while (0)
#define AT_VMMA(src_, d) do { _Pragma("unroll") for (int s2 = 0; s2 < 4; ++s2) o[d] = __builtin_amdgcn_mfma_f32_32x32x16_bf16(src_[s2], pf[s2], o[d], 0, 0, 0); } while (0)
#define AT_PV(vs) do { const LAS unsigned char* sv = lds + AT_VBASE + (vs) * AT_VST; bf16x8 gx[4], gy[4]; \
            AT_VREAD(gx, 0); AT_VREAD(gy, 1); \
            AT_VMMA(gx, 0); __builtin_amdgcn_sched_barrier(0); AT_VREAD(gx, 2); \
            AT_VMMA(gy, 1); __builtin_amdgcn_sched_barrier(0); AT_VREAD(gy, 3); \
            AT_VMMA(gx, 2); AT_VMMA(gy, 3); } while (0)
        AT_SYNC();
        AT_STAGE_TILE(0, 0, 0); AT_STAGE_TILE(1, 1, 1);
        bf16x8 qf[12];
        { const bf16* qp = Q + (size_t)(trow0 + rho) * (NHEAD * DQK) + h * DQK + hh * 8;
#pragma unroll
          for (int s = 0; s < 12; ++s) qf[s] = *(const bf16x8*)(qp + 16 * s);
#pragma unroll
          for (int s = 0; s < 12; ++s) asm volatile("" : "+v"(qf[s])); }
        AT_SYNC5();
        bf16x8 pf[4];
#pragma unroll
        for (int s2 = 0; s2 < 4; ++s2) pf[s2] = (bf16x8){0, 0, 0, 0, 0, 0, 0, 0};
        int ks = 0, vs = 0;
        bool have = false; int pvs = 0;
        int kt = 0;
        const int nfull = 4 * qb;
        if (!lag) {
            for (; kt < nfull; ++kt) {
                AT_STAGE_TILE(kt + 2, (ks == 0 ? 2 : ks - 1), ((vs + 2) & 3));
                { f32x16 sacc[2]; AT_QK(ks); AT_SM_NM(); }
                AT_PV(vs);
                AT_SYNC5();
                ks = (ks == 2) ? 0 : ks + 1; vs = (vs + 1) & 3;
            }
        } else if (nfull > 0) {
            { AT_STAGE_TILE(2, 2, 2); { f32x16 sacc[2]; AT_QK(0); AT_SM_NM(); } have = true; pvs = 0; AT_SYNC5(); ks = 1; vs = 1; kt = 1; }
            for (; kt < nfull; ++kt) {
                AT_STAGE_TILE(kt + 2, (ks == 0 ? 2 : ks - 1), ((vs + 2) & 3));
                AT_PV(pvs);
                { f32x16 sacc[2]; AT_QK(ks); AT_SM_NM(); }
                pvs = vs;
                AT_SYNC5();
                ks = (ks == 2) ? 0 : ks + 1; vs = (vs + 1) & 3;
            }
        }
        for (; kt < nkt; ++kt) {
            if (kt + 2 < nkt) AT_STAGE_TILE(kt + 2, (ks == 0 ? 2 : ks - 1), ((vs + 2) & 3));
            const int key0 = kt * 64;
            const bool vis = key0 <= qlo + 31;
            if (have) AT_PV(pvs);
            if (vis) { f32x16 sacc[2]; AT_QK(ks); AT_SM(key0); }
            if (lag) { have = vis; pvs = vs; } else if (vis) AT_PV(vs);
            if (kt + 2 < nkt) AT_SYNC5(); else AT_SYNC();
            ks = (ks == 2) ? 0 : ks + 1; vs = (vs + 1) & 3;
        }
        if (lag && have) AT_PV(pvs);
#undef AT_DMA
#undef AT_STAGE_TILE
#undef AT_SYNC
#undef AT_SYNC5
#undef AT_QK
#undef AT_SM
#undef AT_SM_NM
#undef AT_PV
#undef AT_KADDR
#undef AT_KREAD
#undef AT_KMMA
#undef AT_VREAD
#undef AT_VMMA
        const float ltot = l_run + shx<32>(l_run, lane), inv = 1.f / ltot;
        bf16* orow = AO + (size_t)(trow0 + rho) * D + h * VH + 8 * hh;
#pragma unroll
        for (int d = 0; d < 4; ++d)
#pragma unroll
            for (int k = 0; k < 2; ++k) {
                unsigned ax = pk2(o[d][8 * k + 0] * inv, o[d][8 * k + 1] * inv), ay = pk2(o[d][8 * k + 2] * inv, o[d][8 * k + 3] * inv);
                unsigned bx = pk2(o[d][8 * k + 4] * inv, o[d][8 * k + 5] * inv), by = pk2(o[d][8 * k + 6] * inv, o[d][8 * k + 7] * inv);
                asm volatile("s_nop 1\n\tv_permlane32_swap_b32 %0, %1" : "+v"(ax), "+v"(bx)); asm volatile("s_nop 1\n\tv_permlane32_swap_b32 %0, %1" : "+v"(ay), "+v"(by));
                *(v4u*)(orow + 32 * d + 16 * k) = (v4u){ax, ay, bx, by}; }
    }
}

constexpr int N_PHASES = 42;
struct Args { In in; float* out; unsigned char* ws; int ph_lo, ph_hi; };
__global__ void __launch_bounds__(NTHR, 2) mk_fwd(Args a) {
    extern __shared__ __attribute__((aligned(16))) unsigned char lds_raw[];
    LAS unsigned char* lds = (LAS unsigned char*)lds_raw;
    const int wave = __builtin_amdgcn_readfirstlane(threadIdx.x >> 6);
    const int G = gridDim.x, bid = blockIdx.x, vcu = (G % 8 == 0) ? (bid % 8) * (G / 8) + bid / 8 : bid;
    typedef const __attribute__((address_space(4))) Args* KArgs;
#define KARGS(q) KArgs q = (KArgs)__builtin_amdgcn_kernarg_segment_ptr(); asm volatile("" : "+s"(q))
    const int lo = a.ph_lo, hi = a.ph_hi;
    { volatile LAS unsigned* MISC0 = (volatile LAS unsigned*)(lds + MISC_OFF); if (threadIdx.x < 32) MISC0[threadIdx.x] = 0u; }
    __syncthreads();
    XcdBarrier bar; bar.bar = (unsigned*)(a.ws + WS_CTL); bar.x = 0; bar.st = nullptr;
    if (hi - lo > 1) bar = xcd_barrier_post((unsigned*)(a.ws + WS_CTL), (volatile LAS unsigned*)(lds + MISC_OFF) + 8, threadIdx.x == 0);
#ifndef MK_MASK
#define MK_MASK 0xFFFF
#endif
#define IN_PH(k) (lo <= (k) && (k) < hi)
#define EN(b) ((MK_MASK >> (b)) & 1)
#if MK_PROBE & 256
#define PHASE_END(k) do { if ((k) + 1 < hi) { xcd_barrier(bar, wave == 0 && lane_id_fresh() == 0); xcd_barrier(bar, wave == 0 && lane_id_fresh() == 0); } } while (0)
#else
#define PHASE_END(k) do { if ((k) + 1 < hi) xcd_barrier(bar, wave == 0 && lane_id_fresh() == 0); } while (0)
#endif
#define PH_VARS KARGS(q); unsigned char* ws = q->ws; CIn& in = q->in; float* ssq = (float*)(ws + WS_SSQ); \
    const float* COS = (const float*)(ws + WS_COS); const float* SIN = (const float*)(ws + WS_SIN); (void)in; (void)ssq; (void)COS; (void)SIN

    if (EN(0) && IN_PH(0)) { PH_VARS;
#if MK_PROBE & 8
        p0_prologue(in, ws, lds, bid, G, wave); __syncthreads();
#endif
        p0_prologue(in, ws, lds, bid, G, wave); PHASE_END(0); }

#pragma unroll 1
    for (int layer = 0; layer < DEPTH; ++layer) {
        const int base = 1 + 10 * layer, v0 = 3 * layer;
#define XB_VARS bf16* XBc = (bf16*)(ws + ((layer & 1) ? WS_XBB : WS_XBA)); bf16* XBn = (bf16*)(ws + ((layer & 1) ? WS_XBA : WS_XBB)); pg8::StaticOrder SO; (void)XBc; (void)XBn; (void)SO
        if (EN(1) && IN_PH(base + 0)) { PH_VARS; XB_VARS;
#if MK_PROBE & 4096
#pragma unroll 1
            for (int rep = 0; rep < 2; ++rep)
#endif
            {
            if (layer == 0) convert_layer(in, ws, layer, bid, G, wave);
            if (layer < 2) pooled_phase(XBc, ssq + (size_t)v0 * SSQ_ARR, in.mix_norm + layer * D, (bf16*)(ws + WS_POOLED), lds, vcu, G, wave);
            else {
                const int N = (layer == 2) ? 1280 : 768;
                pg8::Gemm g{XBc, (const bf16*)(ws + ((layer == 2) ? W_DOWN2 : W_DOWN3)), T, N, D, D, D, 0}; SO.init(T, N, G, bid);
                epi::Down E{(bf16*)(ws + WS_CQ), (bf16*)(ws + WS_CKV), (bf16*)(ws + WS_KPE), ssq + (size_t)v0 * SSQ_ARR, ssq + (size_t)(13 + layer - 2) * SSQ_ARR, ssq + (size_t)15 * SSQ_ARR, COS, SIN};
                pg8::gemm_phase<epi::Down>(lds, g, SO, E, wave);
                if (G % 2 == 0 && ((T / 256) * (N / 256)) % G == G / 2) {
                    pg8::Gemm gp{(const bf16*)(ws + WS_PB), (const bf16*)(ws + W_WP) + (size_t)layer * D * PLE, T, D, PLE, PLE, PLE, 0}; SO.init(T, D, G, bid, 1);
                    epi::Bf16Row EP{(bf16*)(ws + WS_PP), D, nullptr, 0.f};
                    pg8::gemm_phase<epi::Bf16Row>(lds, gp, SO, EP, wave);
                }
            }
            }
            PHASE_END(base + 0);
        }
        if (EN(2) && IN_PH(base + 1)) { PH_VARS; XB_VARS;
#if MK_PROBE & 16
            if (layer < 2) {
                pg8::Gemm g{(const bf16*)(ws + WS_POOLED), (const bf16*)(ws + W_POOL) + (size_t)layer * 1024 * 256, T, D, 256, D, 256, 256}; SO.init(T, D, G, bid);
                epi::Resid E{(bf16*)(ws + WS_END), (float*)(ws + WS_END + 64 * MiB)};
                pg8::gemm_phase<epi::Resid>(lds, g, SO, E, wave);
            } else {
                pg8::Gemm g{(const bf16*)(ws + WS_CQ), (const bf16*)(ws + W_UQ) + (size_t)(layer - 2) * 1536 * QRANK, T, 1536, QRANK, QRANK, QRANK, 0}; SO.init(T, 1536, G, bid);
                epi::QUp E{(bf16*)(ws + WS_Q), ssq + (size_t)(13 + layer - 2) * SSQ_ARR, COS, SIN};
                pg8::gemm_phase<epi::QUp>(lds, g, SO, E, wave);
            }
#endif
            if (layer < 2) {
                pg8::Gemm g{(const bf16*)(ws + WS_POOLED), (const bf16*)(ws + W_POOL) + (size_t)layer * 1024 * 256, T, D, 256, D, 256, 256}; SO.init(T, D, G, bid);
                epi::Resid E{XBc, ssq + (size_t)(v0 + 1) * SSQ_ARR};
                pg8::gemm_phase<epi::Resid>(lds, g, SO, E, wave);
            } else {
                if (layer == 2) {
                    { pg8::Gemm g{(const bf16*)(ws + WS_CKV), (const bf16*)(ws + W_KNW), T, 1024, KVRANK, KVRANK, KVRANK, 0}; SO.init(T, 1024, G, bid);
                      epi::Bf16Row E{(bf16*)(ws + WS_KN), 1024, ssq + (size_t)15 * SSQ_ARR, 1.f / KVRANK};
                      pg8::gemm_phase<epi::Bf16Row>(lds, g, SO, E, wave); }
                    { pg8::Gemm g{(const bf16*)(ws + W_VW), (const bf16*)(ws + WS_CKV), 1024, T, KVRANK, KVRANK, KVRANK, 0}; SO.init(1024, T, G, bid);
                      epi::VTCol E{(bf16*)(ws + WS_VT), ssq + (size_t)15 * SSQ_ARR, 1.f / KVRANK};
                      pg8::gemm_phase<epi::VTCol>(lds, g, SO, E, wave); }
                }
                pg8::Gemm g{(const bf16*)(ws + WS_CQ), (const bf16*)(ws + W_UQ) + (size_t)(layer - 2) * 1536 * QRANK, T, 1536, QRANK, QRANK, QRANK, 0}; SO.init(T, 1536, G, bid);
                epi::QUp E{(bf16*)(ws + WS_Q), ssq + (size_t)(13 + layer - 2) * SSQ_ARR, COS, SIN};
                pg8::gemm_phase<epi::QUp>(lds, g, SO, E, wave);
            }
            PHASE_END(base + 1);
        }
        if (EN(3) && layer >= 2 && IN_PH(base + 2)) { PH_VARS; XB_VARS;
#if MK_PROBE & 2
            attn_phase((const bf16*)(ws + WS_Q), (const bf16*)(ws + WS_KN), (const bf16*)(ws + WS_KPE), (const bf16*)(ws + WS_VT), (bf16*)(ws + WS_AO), lds, vcu, G, wave);
#endif
            attn_phase((const bf16*)(ws + WS_Q), (const bf16*)(ws + WS_KN), (const bf16*)(ws + WS_KPE), (const bf16*)(ws + WS_VT), (bf16*)(ws + WS_AO), lds, vcu, G, wave);
            PHASE_END(base + 2);
        }
        if (EN(4) && layer >= 2 && IN_PH(base + 3)) { PH_VARS; XB_VARS;
            pg8::Gemm g{(const bf16*)(ws + WS_AO), (const bf16*)(ws + W_WO) + (size_t)(layer - 2) * D * D, T, D, D, D, D, 0}; SO.init(T, D, G, bid);
#if MK_PROBE & 16384
            { epi::Resid E2{(bf16*)(ws + WS_END), (float*)(ws + WS_END + 64 * MiB)}; pg8::gemm_phase<epi::Resid>(lds, g, SO, E2, wave); SO.init(T, D, G, bid); }
#endif
            epi::Resid E{XBc, ssq + (size_t)(v0 + 1) * SSQ_ARR};
            pg8::gemm_phase<epi::Resid>(lds, g, SO, E, wave);
            PHASE_END(base + 3);
        }
        if (EN(5) && IN_PH(base + 4)) { PH_VARS; XB_VARS;
#if MK_PROBE & 4
            { pg8::Gemm g{XBc, (const bf16*)(ws + W_WEFF) + (size_t)layer * 2048 * D, T, 2048, D, D, D, 0}; SO.init(T, 2048, G, bid);
              epi::Score E{(unsigned short*)(ws + WS_S), 2048, ssq + (size_t)(v0 + 1) * SSQ_ARR};
              pg8::gemm_phase<epi::Score>(lds, g, SO, E, wave); }
#endif
#if MK_PROBE & 65536
            { pg8::Gemm g{(const bf16*)(ws + WS_PB), (const bf16*)(ws + W_WP) + (size_t)layer * D * PLE, T, D, PLE, PLE, PLE, 0}; SO.init(T, D, G, bid);
              epi::Bf16Row E{(bf16*)(ws + WS_PP), D, nullptr, 0.f};
              pg8::gemm_phase<epi::Bf16Row>(lds, g, SO, E, wave); }
#endif
            {
            { pg8::Gemm g{XBc, (const bf16*)(ws + W_WEFF) + (size_t)layer * 2048 * D, T, 2048, D, D, D, 0}; SO.init(T, 2048, G, bid);
              epi::Score E{(unsigned short*)(ws + WS_S), 2048, ssq + (size_t)(v0 + 1) * SSQ_ARR};
              pg8::gemm_phase<epi::Score>(lds, g, SO, E, wave); }
            if (!(layer >= 2 && G % 2 == 0 && ((T / 256) * (((layer == 2) ? 1280 : 768) / 256)) % G == G / 2))
            { pg8::Gemm g{(const bf16*)(ws + WS_PB), (const bf16*)(ws + W_WP) + (size_t)layer * D * PLE, T, D, PLE, PLE, PLE, 0}; SO.init(T, D, G, bid);
              epi::Bf16Row E{(bf16*)(ws + WS_PP), D, nullptr, 0.f};
              pg8::gemm_phase<epi::Bf16Row>(lds, g, SO, E, wave); }
            }
            PHASE_END(base + 4);
        }
        if (EN(6) && EN(9) && IN_PH(base + 5)) { PH_VARS; XB_VARS;
            const int nl = layer + 1 < DEPTH ? layer + 1 : layer, ns = nl & 1;
            const ConvNext cvn{in.peer_u + (size_t)nl * NEXP * D, in.peer_v + (size_t)nl * NEXP * D, in.ffn_norm + nl * D, in.p + (size_t)nl * T * PLE,
                               ws + tab_off(ns), ws + tab_off(ns) + (size_t)NEXP * D, (float*)(ws + tabs_off(ns)), (float*)(ws + tabs_off(ns)) + NEXP, (bf16*)(ws + WS_PB), layer + 1 < DEPTH ? 1 : 0};
#if MK_PROBE & 64
            peer_topk_phase((const unsigned short*)(ws + WS_S), ssq + (size_t)(v0 + 1) * SSQ_ARR, (const float*)(ws + tabs_off(layer & 1)), (const float*)(ws + tabs_off(layer & 1)) + NEXP,
                            (unsigned short*)(ws + WS_IDX), (float*)(ws + WS_GW), (float*)(ws + WS_MU), cvn, lds, vcu, G, wave);
#endif
            peer_topk_phase((const unsigned short*)(ws + WS_S), ssq + (size_t)(v0 + 1) * SSQ_ARR, (const float*)(ws + tabs_off(layer & 1)), (const float*)(ws + tabs_off(layer & 1)) + NEXP,
                            (unsigned short*)(ws + WS_IDX), (float*)(ws + WS_GW), (float*)(ws + WS_MU), cvn, lds, vcu, G, wave);
            PHASE_END(base + 5);
        }
        if (EN(6) && EN(10) && IN_PH(base + 6)) { PH_VARS; XB_VARS;
#if MK_PROBE & 32
            peer_u_phase<0>((const unsigned short*)(ws + WS_IDX), XBc, ws + tab_off(layer & 1), (unsigned short*)(ws + WS_PART), bid, G, wave);
#endif
#if MK_PROBE & 128
            peer_u_phase<1>((const unsigned short*)(ws + WS_IDX), XBc, ws + tab_off(layer & 1), (unsigned short*)(ws + WS_WW), bid, G, wave);
#endif
            peer_u_phase<0>((const unsigned short*)(ws + WS_IDX), XBc, ws + tab_off(layer & 1), (unsigned short*)(ws + WS_PART), bid, G, wave);
            PHASE_END(base + 6);
        }
        if (EN(6) && EN(11) && IN_PH(base + 7)) { PH_VARS; XB_VARS;
#if MK_PROBE & 2048
            peer_w_phase((const unsigned short*)(ws + WS_PART), (const float*)(ws + WS_GW), (const float*)(ws + WS_MU), (const unsigned short*)(ws + WS_IDX), (unsigned*)(ws + WS_WW), bid, G, wave);
#endif
            peer_w_phase((const unsigned short*)(ws + WS_PART), (const float*)(ws + WS_GW), (const float*)(ws + WS_MU), (const unsigned short*)(ws + WS_IDX), (unsigned*)(ws + WS_WW), bid, G, wave);
            PHASE_END(base + 7);
        }
        if (EN(6) && EN(12) && IN_PH(base + 8)) { PH_VARS; XB_VARS;
#if MK_PROBE & 1024
            peer_v_phase((const unsigned*)(ws + WS_WW), ws + tab_off(layer & 1) + (size_t)NEXP * D, XBc, (bf16*)(ws + WS_END), (float*)(ws + WS_END + 64 * MiB), bid, G, wave);
#endif
            peer_v_phase((const unsigned*)(ws + WS_WW), ws + tab_off(layer & 1) + (size_t)NEXP * D, XBc, XBc, ssq + (size_t)(v0 + 2) * SSQ_ARR, bid, G, wave);
            PHASE_END(base + 8);
        }
        if (EN(7) && IN_PH(base + 9)) { PH_VARS; XB_VARS;
            pg8::Gemm g{XBc, (const bf16*)(ws + W_WG) + (size_t)layer * D * D, T, D, D, D, D, 0}; SO.init(T, D, G, bid);
#if MK_PROBE & 512
            { epi::Null EN_{(float*)(ws + WS_END)}; pg8::gemm_phase<epi::Null>(lds, g, SO, EN_, wave); }
#endif
#if MK_PROBE & 8192
            { epi::Gate E2{XBc, XBn, (const bf16*)(ws + WS_PP), ssq + (size_t)(v0 + 2) * SSQ_ARR, ssq + (size_t)(v0 + 3) * SSQ_ARR}; pg8::gemm_phase<epi::Gate>(lds, g, SO, E2, wave); SO.init(T, D, G, bid); }
#endif
            epi::Gate E{XBc, XBn, (const bf16*)(ws + WS_PP), ssq + (size_t)(v0 + 2) * SSQ_ARR, ssq + (size_t)(v0 + 3) * SSQ_ARR};
            pg8::gemm_phase<epi::Gate>(lds, g, SO, E, wave);
            PHASE_END(base + 9);
        }
    }
#if MK_PROBE & 32768
    if (EN(8) && IN_PH(41)) { PH_VARS; final_phase((const bf16*)(ws + WS_XBA), ssq + (size_t)12 * SSQ_ARR, in.final_norm, q->out, bid, G, wave); }
#endif
    if (EN(8) && IN_PH(41)) { PH_VARS; final_phase((const bf16*)(ws + WS_XBA), ssq + (size_t)12 * SSQ_ARR, in.final_norm, q->out, bid, G, wave); }
#undef IN_PH
#undef PHASE_END
}

extern "C" void kernel_launch(void* const* d_in, const int* in_sizes, int n_in, void* d_out, int out_size, void* d_ws, size_t ws_size, hipStream_t stream) {
    static int grid = 0;
    if (grid == 0) {
        if (n_in != 23 || out_size != T * D || ws_size < WS_END) { fprintf(stderr, "kernel_launch: unexpected problem (n_in %d, out %d, ws %zu < %zu)\n", n_in, out_size, ws_size, (size_t)WS_END); grid = -1; return; }
        int dev = 0, cus = 0, per_cu = 0;
        if (hipGetDevice(&dev) != hipSuccess || hipDeviceGetAttribute(&cus, hipDeviceAttributeMultiprocessorCount, dev) != hipSuccess) { grid = -1; return; }
        if (hipFuncSetAttribute((const void*)mk_fwd, hipFuncAttributeMaxDynamicSharedMemorySize, LDS_BYTES) != hipSuccess) { fprintf(stderr, "kernel_launch: hipFuncSetAttribute failed\n"); grid = -1; return; }
        if (hipOccupancyMaxActiveBlocksPerMultiprocessor(&per_cu, (const void*)mk_fwd, NTHR, LDS_BYTES) != hipSuccess || per_cu < 1) { fprintf(stderr, "kernel_launch: occupancy query says %d\n", per_cu); }
        (void)hipGetLastError();
        grid = cus;
    }
    if (grid < 0) return;
    (void)hipMemsetAsync((char*)d_ws + WS_CTL, 0, CTL_ZERO_BYTES, stream);
    Args a{};
    const void** ip = (const void**)&a.in;
    for (int i = 0; i < 23; ++i) ip[i] = d_in[i];
    a.out = (float*)d_out; a.ws = (unsigned char*)d_ws;
#if MK_ONE_LAUNCH
    a.ph_lo = 0; a.ph_hi = N_PHASES;
    hipLaunchKernelGGL(mk_fwd, dim3(grid), dim3(NTHR), LDS_BYTES, stream, a);
#else
    for (int k = 0; k < N_PHASES; ++k) {
        if (k >= 1 && k <= 40) { const int layer = (k - 1) / 10, slot = (k - 1) % 10; if (layer < 2 && (slot == 2 || slot == 3)) continue; }
        a.ph_lo = k; a.ph_hi = k + 1;
        hipLaunchKernelGGL(mk_fwd, dim3(grid), dim3(NTHR), LDS_BYTES, stream, a);
    }
#endif
}
```

```cpp
#include <hip/hip_runtime.h>
#include <cstdio>
#include <cstdint>

#ifndef MK_PROBE
#define MK_PROBE 0
#endif
#ifndef MK_ONE_LAUNCH
#define MK_ONE_LAUNCH 1
#endif


__device__ __forceinline__ int lane_id_fresh() { int l; asm volatile("v_mbcnt_lo_u32_b32 %0, -1, 0\n\tv_mbcnt_hi_u32_b32 %0, -1, %0" : "=v"(l)); return l; }
template <int M> __device__ __forceinline__ float shx(float v, int lane) {
    if constexpr (M < 32) return __builtin_bit_cast(float, __builtin_amdgcn_ds_swizzle(__builtin_bit_cast(int, v), (M << 10) | 0x1f));
    else return __builtin_bit_cast(float, __builtin_amdgcn_ds_bpermute((lane ^ 32) << 2, __builtin_bit_cast(int, v)));
}

namespace pg8 {
#define PG8_LAS __attribute__((address_space(3)))
typedef unsigned short bf16_t;
typedef short bf16x8 __attribute__((ext_vector_type(8)));
typedef float f32x4 __attribute__((ext_vector_type(4)));
typedef unsigned u32x4 __attribute__((ext_vector_type(4)));
typedef unsigned u32x2 __attribute__((ext_vector_type(2)));
constexpr int BM = 256, BK = 64, HALF = 128, HTB = HALF * BK * 2, STAGE_BYTES = 8 * HTB, NXCD = 8, WGM = 8;

__host__ __device__ __forceinline__ int lds_byte(int r, int c) { const int st = (r >> 4) * 2 + (c >> 5), rr = r & 15, cc = c & 31, ob = rr * 64 + cc * 2; return st * 1024 + (ob ^ (((ob >> 9) & 1) << 5)); }
__host__ __device__ __forceinline__ void stage_rc(int b, int& R, int& C) { const int st = b / 1024, sb = b % 1024, swz = sb ^ (((sb >> 9) & 1) << 5); R = (st >> 1) * 16 + swz / 64; C = (st & 1) * 32 + (swz % 64) / 2; }
__host__ __device__ __forceinline__ int perm32(int rho) { const int n = rho >> 4, i = rho & 15; return 8 * (i >> 2) + 4 * n + (i & 3); }

struct Unit { int pm, pn; };
struct Gemm { const bf16_t* A; const bf16_t* Bt; int M, N, K, lda, ldb, acs; };

struct StaticOrder {
    int nM, nN, nwg, G, c, skew;
    __host__ __device__ void init(int M, int N, int G_, int c_, int skew_ = 0) { nM = M / BM; nN = N / BM; nwg = nM * nN; G = G_; c = c_; skew = skew_; }
    __host__ __device__ bool next(int i, Unit& u) const {
        long L = (long)i * G + c;
        if (skew && i > 0) { if (2 * c < G) return false; L = (long)G + (long)(i - 1) * (G - G / 2) + (c - G / 2); }
        if (L >= nwg) return false;
        int wgid = (int)L; { const int q = nwg / NXCD, r = nwg % NXCD, xcd = wgid % NXCD, off = wgid / NXCD; wgid = (xcd < r ? xcd * (q + 1) : r * (q + 1) + (xcd - r) * q) + off; }
        const int nig = WGM * nN, gid = wgid / nig, fm = gid * WGM, gsz = (nM - fm) < WGM ? (nM - fm) : WGM;
        u.pm = fm + ((wgid % nig) % gsz); u.pn = (wgid % nig) / gsz; return true;
    }
};

__device__ __forceinline__ unsigned cvt_pk_bf16(float lo, float hi) { unsigned r; asm volatile("v_cvt_pk_bf16_f32 %0, %1, %2" : "=v"(r) : "v"(lo), "v"(hi)); return r; }

template <class Epi>
__device__ __forceinline__ void gemm_phase(PG8_LAS unsigned char* lds, const Gemm g, const StaticOrder& S, const Epi& E, const int wid) {
    const int lane = lane_id_fresh(), tid = wid * 64 + lane;
    const int wr = wid >> 2, wc = wid & 3, fr = lane & 15, fq = lane >> 4;
    const int K = g.K, nt = K / BK;
    unsigned voffA, voffB;
    { int R, C; stage_rc(tid * 16, R, C); const int Rb = Epi::PERM ? ((R & ~31) + perm32(R & 31)) : R;
      voffA = (unsigned)(R * g.lda + C) * 2u; voffB = (unsigned)(Rb * g.ldb + C) * 2u; }
    const unsigned d64A = 64u * g.lda * 2u, d64B = 64u * g.ldb * 2u;
    constexpr unsigned kstep = BK * 2;
    const unsigned hstepA = (unsigned)HALF * g.lda * 2u, hstepB = (unsigned)HALF * g.ldb * 2u;
    const unsigned tstepA = 2u * hstepA, tstepB = 2u * hstepB;
    const unsigned acsb = (unsigned)g.acs * 2u;
    const unsigned ldsw = (unsigned)wid * 1024u, ldsbase = (unsigned)(size_t)lds;
    const int aoff = lds_byte(wr * 64 + fr, fq * 8), boff = lds_byte(wc * 32 + fr, fq * 8);
#define PG8_SA(b, h) (((b) * 2 + (h)) * HTB)
#define PG8_SB(b, h) ((4 + (b) * 2 + (h)) * HTB)
#define PG8_DMA(sbase, voff, ldsdst) do { unsigned _keep; asm volatile("s_mov_b32 %0, m0\n\ts_mov_b32 m0, %3\n\ts_nop 4\n\tglobal_load_lds_dwordx4 %1, %2\n\ts_mov_b32 m0, %0" \
        : "=&s"(_keep) : "v"(voff), "s"(sbase), "s"(ldsdst) : "memory"); } while (0)
#define PG8_STAGE(bufoff, gbase, voff) do { const char* _b0 = (const char*)(gbase); const char* _b1 = _b0 + (&(voff) == &voffA ? d64A : d64B); \
        PG8_DMA(_b0, voff, ldsbase + (unsigned)(bufoff) + ldsw); PG8_DMA(_b1, voff, ldsbase + (unsigned)(bufoff) + ldsw + 8192u); } while (0)
#define PG8_LDA(dst, b, h) do { _Pragma("unroll") for (int m = 0; m < 4; ++m) _Pragma("unroll") for (int k = 0; k < 2; ++k) dst[m][k] = *(const PG8_LAS bf16x8*)(lds + PG8_SA(b, h) + aoff + m * 2048 + k * 1024); } while (0)
#define PG8_LDB(dst, b, h) do { _Pragma("unroll") for (int n = 0; n < 2; ++n) _Pragma("unroll") for (int k = 0; k < 2; ++k) dst[n][k] = *(const PG8_LAS bf16x8*)(lds + PG8_SB(b, h) + boff + n * 2048 + k * 1024); } while (0)
#define PG8_MMA(ai, bj, At, Bt) do { __builtin_amdgcn_s_setprio(1); _Pragma("unroll") for (int m = 0; m < 4; ++m) _Pragma("unroll") for (int n = 0; n < 2; ++n) _Pragma("unroll") for (int k = 0; k < 2; ++k) \
        acc[ai][bj][m][n] = __builtin_amdgcn_mfma_f32_16x16x32_bf16(Bt[n][k], At[m][k], acc[ai][bj][m][n], 0, 0, 0); __builtin_amdgcn_s_setprio(0); } while (0)
#define PG8_WAIT_V(n) asm volatile("s_waitcnt vmcnt(" #n ")" ::: "memory")
#define PG8_WAIT_L(n) asm volatile("s_waitcnt lgkmcnt(" #n ")" ::: "memory")
#define PG8_BAR __builtin_amdgcn_s_barrier()
#define PG8_SCHED __builtin_amdgcn_sched_barrier(0)
    Unit cur, nxt; int ui = 0;
    if (!S.next(0, cur)) return;
    f32x4 acc[2][2][4][2];
#pragma unroll
    for (int a = 0; a < 2; ++a)
#pragma unroll
        for (int b = 0; b < 2; ++b)
#pragma unroll
            for (int m = 0; m < 4; ++m)
#pragma unroll
                for (int n = 0; n < 2; ++n) acc[a][b][m][n] = (f32x4){0.f, 0.f, 0.f, 0.f};
    bf16x8 At[4][2], B0[2][2], B1[2][2];
    const char* cA = (const char*)g.A + ((unsigned)cur.pm * tstepA + (unsigned)cur.pn * acsb); const char* cB = (const char*)g.Bt + (unsigned)cur.pn * tstepB;
    PG8_STAGE(PG8_SB(0, 0), cB, voffB); PG8_STAGE(PG8_SB(0, 1), cB + hstepB, voffB); PG8_STAGE(PG8_SA(0, 0), cA, voffA); PG8_STAGE(PG8_SA(0, 1), cA + hstepA, voffA);
    if (wr == 1) PG8_BAR;
    PG8_WAIT_V(2); PG8_BAR;
    PG8_STAGE(PG8_SB(1, 0), cB + kstep, voffB); PG8_STAGE(PG8_SA(1, 0), cA + kstep, voffA); PG8_STAGE(PG8_SB(1, 1), cB + hstepB + kstep, voffB);
    PG8_WAIT_V(6); PG8_BAR;
    for (;;) {
        const bool has_next = S.next(ui + 1, nxt);
        const char* nA = has_next ? (const char*)g.A + ((unsigned)nxt.pm * tstepA + (unsigned)nxt.pn * acsb) : cA; const char* nB = has_next ? (const char*)g.Bt + (unsigned)nxt.pn * tstepB : cB;
        for (int t = 0; t < nt; t += 2) {
            const bool last = (t == nt - 2);
            const char* a1 = cA + (unsigned)(t + 1) * kstep;
            const char* a2 = last ? nA : cA + (unsigned)(t + 2) * kstep; const char* b2 = last ? nB : cB + (unsigned)(t + 2) * kstep;
            const char* a3 = a2 + kstep; const char* b3 = b2 + kstep;
            PG8_LDB(B0, 0, 0); PG8_LDB(B1, 0, 1); PG8_SCHED; PG8_LDA(At, 0, 0); PG8_STAGE(PG8_SA(1, 1), a1 + hstepA, voffA);
            PG8_WAIT_V(8); PG8_WAIT_L(0); PG8_BAR; PG8_MMA(0, 0, At, B0); PG8_MMA(0, 1, At, B1); PG8_BAR; PG8_SCHED;
            PG8_LDA(At, 0, 1); PG8_STAGE(PG8_SB(0, 0), b2, voffB); PG8_STAGE(PG8_SB(0, 1), b2 + hstepB, voffB); PG8_STAGE(PG8_SA(0, 0), a2, voffA);
            PG8_WAIT_V(8); PG8_WAIT_L(0); PG8_BAR; PG8_MMA(1, 0, At, B0); PG8_MMA(1, 1, At, B1); PG8_BAR; PG8_SCHED;
            PG8_LDB(B0, 1, 0); PG8_LDB(B1, 1, 1); PG8_SCHED; PG8_LDA(At, 1, 0); PG8_STAGE(PG8_SA(0, 1), a2 + hstepA, voffA);
            PG8_WAIT_V(8); PG8_WAIT_L(0); PG8_BAR; PG8_MMA(0, 0, At, B0); PG8_MMA(0, 1, At, B1); PG8_BAR; PG8_SCHED;
            PG8_LDA(At, 1, 1); PG8_STAGE(PG8_SB(1, 0), b3, voffB); PG8_STAGE(PG8_SB(1, 1), b3 + hstepB, voffB); PG8_STAGE(PG8_SA(1, 0), a3, voffA);
            PG8_WAIT_V(8); PG8_WAIT_L(0); PG8_BAR; PG8_MMA(1, 0, At, B0); PG8_MMA(1, 1, At, B1); PG8_BAR; PG8_SCHED;
        }
        if (wr == 0) PG8_BAR;
        { const int l2 = lane_id_fresh(); E(acc, cur, wr, wc, l2 & 15, l2 >> 4); }
        if (!has_next) break;
#pragma unroll
        for (int a = 0; a < 2; ++a)
#pragma unroll
            for (int b = 0; b < 2; ++b)
#pragma unroll
                for (int m = 0; m < 4; ++m)
#pragma unroll
                    for (int n = 0; n < 2; ++n) acc[a][b][m][n] = (f32x4){0.f, 0.f, 0.f, 0.f};
        cur = nxt; cA = nA; cB = nB; ++ui;
        if (wr == 1) PG8_BAR;
    }
    PG8_WAIT_V(0);
    PG8_BAR;
#undef PG8_SA
#undef PG8_SB
#undef PG8_STAGE
#undef PG8_LDA
#undef PG8_LDB
#undef PG8_MMA
#undef PG8_WAIT_V
#undef PG8_WAIT_L
#undef PG8_BAR
#undef PG8_SCHED
}
}

#define GAS __attribute__((address_space(1)))
#define LAS __attribute__((address_space(3)))
typedef unsigned short bf16;
typedef unsigned v4u __attribute__((ext_vector_type(4)));
typedef unsigned v2u __attribute__((ext_vector_type(2)));
typedef float f32x4 __attribute__((ext_vector_type(4)));
typedef float f32x2 __attribute__((ext_vector_type(2)));
typedef float f32x16 __attribute__((ext_vector_type(16)));
typedef short bf16x8 __attribute__((ext_vector_type(8)));
typedef __bf16 bf16x2_t __attribute__((ext_vector_type(2)));
typedef _Float16 half2_t __attribute__((ext_vector_type(2)));
__device__ __forceinline__ unsigned pkh2(float lo, float hi) { f32x2 v = {lo, hi}; half2_t h = __builtin_convertvector(v, half2_t); return __builtin_bit_cast(unsigned, h); }
__device__ __forceinline__ float hlo(unsigned u) { return (float)__builtin_bit_cast(half2_t, u)[0]; }
__device__ __forceinline__ float hhi(unsigned u) { return (float)__builtin_bit_cast(half2_t, u)[1]; }
typedef GAS unsigned gu32;
#define RLX_AGENT __ATOMIC_RELAXED, __HIP_MEMORY_SCOPE_AGENT
#define SWZ(o) (((o) << 10) | 0x1f)
#define LDS_WAIT() asm volatile("s_waitcnt lgkmcnt(0)" ::: "memory")
#define VM_WAIT() asm volatile("s_waitcnt vmcnt(0)" ::: "memory")
__device__ __forceinline__ unsigned pk2(float lo, float hi) { f32x2 v = {lo, hi}; bf16x2_t b = __builtin_convertvector(v, bf16x2_t); return __builtin_bit_cast(unsigned, b); }
__device__ __forceinline__ float bflo(unsigned u) { return __builtin_bit_cast(float, u << 16); }
__device__ __forceinline__ float bfhi(unsigned u) { return __builtin_bit_cast(float, u & 0xffff0000u); }
__device__ __forceinline__ float dot2bf(unsigned a, unsigned b, float acc) { return __builtin_amdgcn_fdot2_f32_bf16(__builtin_bit_cast(bf16x2_t, a), __builtin_bit_cast(bf16x2_t, b), acc, false); }
template <int CTRL> __device__ __forceinline__ float dppf(float v) { return __builtin_bit_cast(float, __builtin_amdgcn_update_dpp(0, __builtin_bit_cast(int, v), CTRL, 0xf, 0xf, true)); }
__device__ __forceinline__ float wave_sum(float v, int lane) {
    v += shx<1>(v, lane); v += shx<2>(v, lane); v += shx<4>(v, lane); v += shx<8>(v, lane); v += shx<16>(v, lane); v += shx<32>(v, lane);
    return v;
}


__device__ __forceinline__ float row_rinv(const float* ssq16, int r, float invdim) {
    const f32x4* p = (const f32x4*)(ssq16 + (size_t)r * 16); const f32x4 a = p[0], b = p[1], c = p[2], d = p[3];
    const float s = ((a[0] + a[1]) + (a[2] + a[3])) + ((b[0] + b[1]) + (b[2] + b[3])) + (((c[0] + c[1]) + (c[2] + c[3])) + ((d[0] + d[1]) + (d[2] + d[3])));
    return __builtin_amdgcn_rsqf(s * invdim + 1e-6f);
}

#define XB_TMO      128
#define XB_XCNT(j)  (256  + 64 * (j))
#define XB_XSUB(j)  (1280 + 64 * (j))
#define XB_XGEN(j)  (2304 + 64 * (j))
#define XB_TOP      3328
#define XB_TOPGEN   3392
#define XCD_BAR_WORDS 3456
#define XB_SPIN_CAP (1u << 18)

__device__ __forceinline__ unsigned xb_ld(unsigned* p)              { return __hip_atomic_load(p, __ATOMIC_RELAXED, __HIP_MEMORY_SCOPE_AGENT); }
__device__ __forceinline__ unsigned xb_add(unsigned* p, unsigned v) { return __hip_atomic_fetch_add(p, v, __ATOMIC_RELAXED, __HIP_MEMORY_SCOPE_AGENT); }
__device__ __forceinline__ unsigned xb_xcc_id() { return (unsigned)__builtin_amdgcn_s_getreg((3 << 11) | 20) & 0xFu; }
#define XB_SPIN(cond, bar) do { unsigned _sp = 0; while (cond) { __builtin_amdgcn_s_sleep(1); \
    if ((++_sp & 255u) == 0u) { if (xb_ld(&(bar)[XB_TMO])) break; if (_sp > XB_SPIN_CAP) { atomicAdd(&(bar)[XB_TMO], 1u); break; } } } } while (0)

struct XcdBarrier {
    unsigned* bar; unsigned x;
    volatile LAS unsigned* st;
};
__device__ __forceinline__ XcdBarrier xcd_barrier_post(unsigned* bar, volatile LAS unsigned* st, bool t0) {
    XcdBarrier b; b.bar = bar; b.x = xb_xcc_id(); b.st = st;
    if (t0) (void)xb_add(&bar[XB_XCNT(b.x)], 1u);
    return b;
}
__device__ __forceinline__ void xcd_barrier_complete(unsigned* bar, unsigned x, unsigned& nloc, unsigned& nx) {
    const unsigned G = gridDim.x * gridDim.y * gridDim.z;
    unsigned sum, cnt, mine, sp = 0u;
    for (;;) {
        sum = 0u; cnt = 0u; mine = 0u;
#pragma unroll
        for (unsigned j = 0; j < 16; ++j) { const unsigned c = xb_ld(&bar[XB_XCNT(j)]); sum += c; cnt += (c > 0u) ? 1u : 0u; mine = (j == x) ? c : mine; }
        if (sum == G) break;
        __builtin_amdgcn_s_sleep(1);
        if ((++sp & 255u) == 0u) { if (xb_ld(&bar[XB_TMO])) break; if (sp > XB_SPIN_CAP) { atomicAdd(&bar[XB_TMO], 1u); break; } }
    }
    nloc = mine > 0u ? mine : 1u; nx = cnt > 0u ? cnt : 1u;
}
__device__ __forceinline__ void xcd_barrier(const XcdBarrier& b, bool t0) {
    asm volatile("s_waitcnt vmcnt(0)" ::: "memory");
    __syncthreads();
    if (t0) {
        unsigned* bar = b.bar;
        __builtin_amdgcn_s_waitcnt(0);
        unsigned nloc = b.st[0], nx = b.st[1];
        if (nloc == 0u) { xcd_barrier_complete(bar, b.x, nloc, nx); b.st[0] = nloc; b.st[1] = nx; }
        const unsigned old = xb_add(&bar[XB_XSUB(b.x)], 1u);
        const unsigned gen = old / nloc;
        if (old + 1u == (gen + 1u) * nloc) {
            __builtin_amdgcn_fence(__ATOMIC_RELEASE, "agent");
            asm volatile("s_waitcnt vmcnt(0)" ::: "memory");
            const unsigned og = xb_add(&bar[XB_TOP], 1u);
            const unsigned tg = og / nx;
            if (og + 1u == (tg + 1u) * nx) xb_add(&bar[XB_TOPGEN], 1u);
            else XB_SPIN(xb_ld(&bar[XB_TOPGEN]) == tg, bar);
            __builtin_amdgcn_fence(__ATOMIC_ACQUIRE, "agent");
            xb_add(&bar[XB_XGEN(b.x)], 1u);
            asm volatile("s_waitcnt vmcnt(0)" ::: "memory");
        } else {
            XB_SPIN(xb_ld(&bar[XB_XGEN(b.x)]) == gen, bar);
            __builtin_amdgcn_fence(__ATOMIC_ACQUIRE, "agent");
            asm volatile("s_waitcnt vmcnt(0)" ::: "memory");
        }
    }
    __syncthreads();
}

constexpr int NWAVES = 8, NTHR = 512;
constexpr int T = 32768, D = 1024, NBATCH = 8, SEQ = 4096, DEPTH = 4;
constexpr int NHEAD = 8, QKN = 128, QKR = 64, DQK = 192, VH = 128, QRANK = 768, KVRANK = 256;
constexpr int NKEYS = 128, NEXP = 16384, PTOPK = 16, PLE = 256;
constexpr float EPS = 1e-6f;
constexpr float C2 = 0.07216878364870322f * 1.4426950408889634f;

constexpr size_t MiB = 1u << 20;
constexpr size_t WS_CTL = 0, CTL_ZERO_BYTES = 64 * 1024;
constexpr size_t WS_SSQ = 840 * MiB;
constexpr size_t WS_COS = 3 * MiB, WS_SIN = 7 * MiB;
constexpr size_t WS_W = 11 * MiB;
constexpr size_t W_WEFF = WS_W;
constexpr size_t W_WG = W_WEFF + 16 * MiB;
constexpr size_t W_WP = W_WG + 8 * MiB;
constexpr size_t W_POOL = W_WP + 2 * MiB;
constexpr size_t W_DOWN2 = W_POOL + 1 * MiB;
constexpr size_t W_DOWN3 = W_DOWN2 + 2560 * 1024;
constexpr size_t W_KNW = W_DOWN3 + 1536 * 1024;
constexpr size_t W_VW = W_KNW + 512 * 1024;
constexpr size_t W_UQ = W_VW + 512 * 1024;
constexpr size_t W_WO = W_UQ + 4608 * 1024;
constexpr size_t WS_WEND = W_WO + 4 * MiB;
constexpr size_t WS_X = 52 * MiB;
constexpr size_t WS_XBA = 180 * MiB, WS_XBB = 244 * MiB;
constexpr size_t WS_UV = 308 * MiB;
constexpr size_t WS_UVS = 340 * MiB;
constexpr size_t WS_UV2 = 52 * MiB, WS_UVS2 = 84 * MiB;
__host__ __device__ constexpr size_t tab_off(int set) { return set ? WS_UV2 : WS_UV; }
__host__ __device__ constexpr size_t tabs_off(int set) { return set ? WS_UVS2 : WS_UVS; }
constexpr size_t WS_PB = 372 * MiB;
constexpr size_t WS_PP = 388 * MiB;
constexpr size_t WS_KN = 452 * MiB;
constexpr size_t WS_VT = 516 * MiB;
constexpr size_t WS_KPE = 580 * MiB;
constexpr size_t WS_R1 = 584 * MiB;
constexpr size_t WS_S = WS_R1;
constexpr size_t WS_POOLED = WS_R1;
constexpr size_t WS_Q = WS_R1;
constexpr size_t WS_AO = WS_R1 + 96 * MiB;
constexpr size_t WS_CQ = WS_R1 + 160 * MiB;
constexpr size_t WS_CKV = WS_R1 + 208 * MiB;
constexpr size_t WS_IDX = 872 * MiB;
constexpr size_t WS_GW = 880 * MiB, WS_MU = 896 * MiB;
constexpr size_t WS_PART = WS_R1;
constexpr size_t WS_WW = WS_R1 + 128 * MiB;
constexpr size_t WS_END = 912 * MiB;
constexpr size_t SSQ_ARR = (size_t)32768 * 16;
static_assert(WS_WEND <= WS_X, "weights");

constexpr int RING_BYTES = 139264;
constexpr int MISC_OFF = RING_BYTES + 320;
constexpr int LDS_BYTES = 147456;

namespace epi {
using pg8::Unit; using pg8::cvt_pk_bf16;
typedef float f32x4 __attribute__((ext_vector_type(4)));
typedef unsigned u32x4 __attribute__((ext_vector_type(4)));
typedef unsigned u32x2 __attribute__((ext_vector_type(2)));
__device__ __forceinline__ float dot4(f32x4 v) { return (v[0] * v[0] + v[1] * v[1]) + (v[2] * v[2] + v[3] * v[3]); }
__device__ __forceinline__ void rinv8(const float* ssq, int rbase, int fr, int fq, float invdim, float (&ri)[8]) {
    f32x4 q[8];
#pragma unroll
    for (int k = 0; k < 8; ++k) q[k] = *(const f32x4*)(ssq + (size_t)(rbase + (k >> 2) * 128 + (k & 3) * 16) * 16 + 4 * fq);
#pragma unroll
    for (int k = 0; k < 8; ++k) { float s = (q[k][0] + q[k][1]) + (q[k][2] + q[k][3]); s += shx<16>(s, fq * 16 + fr); s += shx<32>(s, fq * 16 + fr); ri[k] = __builtin_amdgcn_rsqf(s * invdim + 1e-6f); }
}

struct Resid {
    static constexpr bool PERM = true;
    bf16* XB; float* ssq_out;
    __device__ __forceinline__ void operator()(const f32x4 (&acc)[2][2][4][2], const Unit& u, int wr, int wc, int fr, int fq) const {
        const int col0 = u.pn * 256 + wc * 32 + 8 * fq;
        float sv[8]; u32x4 xo[8][2];
        bf16* const b0 = XB + (size_t)(u.pm * 256 + wr * 64 + fr) * D + col0;
#define EPI_ROW(k) (b0 + (size_t)(((k) >> 2) * 128 + ((k) & 3) * 16) * D)
#define EPI_LOAD(k) do { xo[k][0] = *(const u32x4*)EPI_ROW(k); xo[k][1] = *(const u32x4*)(EPI_ROW(k) + 128); } while (0)
        EPI_LOAD(0); EPI_LOAD(1); EPI_LOAD(2);
#pragma unroll
        for (int k = 0; k < 8; ++k) { const int ai = k >> 2, m = k & 3; float s = 0.f;
            if (k + 3 < 8) EPI_LOAD(k + 3);
#pragma unroll
            for (int bj = 0; bj < 2; ++bj) { const u32x4 x = xo[k][bj];
                const f32x4 v0 = (f32x4){bflo(x.x), bfhi(x.x), bflo(x.y), bfhi(x.y)} + acc[ai][bj][m][0], v1 = (f32x4){bflo(x.z), bfhi(x.z), bflo(x.w), bfhi(x.w)} + acc[ai][bj][m][1];
                u32x4 w; w.x = cvt_pk_bf16(v0[0], v0[1]); w.y = cvt_pk_bf16(v0[2], v0[3]); w.z = cvt_pk_bf16(v1[0], v1[1]); w.w = cvt_pk_bf16(v1[2], v1[3]); *(u32x4*)(EPI_ROW(k) + bj * 128) = w;
                s += dot4(v0) + dot4(v1); }
            s += shx<16>(s, fq * 16 + fr); s += shx<32>(s, fq * 16 + fr); sv[k] = s;
        }
#undef EPI_LOAD
#undef EPI_ROW
        if (fq == 0) {
#pragma unroll
            for (int k = 0; k < 8; ++k) ssq_out[(size_t)(u.pm * 256 + (k >> 2) * 128 + wr * 64 + (k & 3) * 16 + fr) * 16 + u.pn * 4 + wc] = sv[k]; }
    }
};
struct Score {
    static constexpr bool PERM = true;
    unsigned short* S; int ldc; const float* ssq;
    __device__ __forceinline__ void operator()(const f32x4 (&acc)[2][2][4][2], const Unit& u, int wr, int wc, int fr, int fq) const {
        const int col0 = u.pn * 256 + wc * 32 + 8 * fq;
        float ri8[8]; rinv8(ssq, u.pm * 256 + wr * 64 + fr, fr, fq, 1.f / D, ri8);
#pragma unroll
        for (int ai = 0; ai < 2; ++ai)
#pragma unroll
            for (int m = 0; m < 4; ++m) {
                const int r = u.pm * 256 + ai * 128 + wr * 64 + m * 16 + fr; const float ri = ri8[ai * 4 + m];
                unsigned short* sr = S + (size_t)r * ldc + col0;
#pragma unroll
                for (int bj = 0; bj < 2; ++bj) { const f32x4 v0 = acc[ai][bj][m][0] * ri, v1 = acc[ai][bj][m][1] * ri; u32x4 w;
                    w.x = pkh2(v0[0], v0[1]); w.y = pkh2(v0[2], v0[3]); w.z = pkh2(v1[0], v1[1]); w.w = pkh2(v1[2], v1[3]); *(u32x4*)(sr + bj * 128) = w; }
            }
    }
};
struct Bf16Row {
    static constexpr bool PERM = true;
    bf16* O; int ldc; const float* ssq; float invdim;
    __device__ __forceinline__ void operator()(const f32x4 (&acc)[2][2][4][2], const Unit& u, int wr, int wc, int fr, int fq) const {
        const int col0 = u.pn * 256 + wc * 32 + 8 * fq;
        float ri8[8];
        if (ssq) rinv8(ssq, u.pm * 256 + wr * 64 + fr, fr, fq, invdim, ri8);
        else {
#pragma unroll
            for (int k = 0; k < 8; ++k) ri8[k] = 1.f; }
#pragma unroll
        for (int ai = 0; ai < 2; ++ai)
#pragma unroll
            for (int m = 0; m < 4; ++m) {
                const int r = u.pm * 256 + ai * 128 + wr * 64 + m * 16 + fr; const float ri = ri8[ai * 4 + m];
                bf16* orow = O + (size_t)r * ldc + col0;
#pragma unroll
                for (int bj = 0; bj < 2; ++bj) { const f32x4 v0 = acc[ai][bj][m][0] * ri, v1 = acc[ai][bj][m][1] * ri; u32x4 w;
                    w.x = cvt_pk_bf16(v0[0], v0[1]); w.y = cvt_pk_bf16(v0[2], v0[3]); w.z = cvt_pk_bf16(v1[0], v1[1]); w.w = cvt_pk_bf16(v1[2], v1[3]); *(u32x4*)(orow + bj * 128) = w; }
            }
    }
};
struct VTCol {
    static constexpr bool PERM = true;
    bf16* O; const float* ssq; float invdim;
    __device__ __forceinline__ void operator()(const f32x4 (&acc)[2][2][4][2], const Unit& u, int wr, int wc, int fr, int fq) const {
        const int col0 = u.pn * 256 + wc * 32 + 8 * fq;
#pragma unroll
        for (int bj = 0; bj < 2; ++bj) {
            f32x4 sc0, sc1;
#pragma unroll
            for (int j = 0; j < 4; ++j) { sc0[j] = row_rinv(ssq, col0 + bj * 128 + j, invdim); sc1[j] = row_rinv(ssq, col0 + bj * 128 + 4 + j, invdim); }
#pragma unroll
            for (int ai = 0; ai < 2; ++ai)
#pragma unroll
                for (int m = 0; m < 4; ++m) {
                    const int r = u.pm * 256 + ai * 128 + wr * 64 + m * 16 + fr;
                    const f32x4 v0 = acc[ai][bj][m][0] * sc0, v1 = acc[ai][bj][m][1] * sc1; u32x4 w;
                    w.x = cvt_pk_bf16(v0[0], v0[1]); w.y = cvt_pk_bf16(v0[2], v0[3]); w.z = cvt_pk_bf16(v1[0], v1[1]); w.w = cvt_pk_bf16(v1[2], v1[3]);
                    *(u32x4*)(O + (size_t)r * T + col0 + bj * 128) = w;
                }
        }
    }
};
struct Gate {
    static constexpr bool PERM = true;
    const bf16* XBc; bf16* XBn; const bf16* PP; const float* ssq; float* ssq_out;
    __device__ __forceinline__ void operator()(const f32x4 (&acc)[2][2][4][2], const Unit& u, int wr, int wc, int fr, int fq) const {
        const int col0 = u.pn * 256 + wc * 32 + 8 * fq;
        float ri8[8], sv[8]; rinv8(ssq, u.pm * 256 + wr * 64 + fr, fr, fq, 1.f / D, ri8);
        u32x4 xo[8][2], pw[8][2];
        const size_t o0 = (size_t)(u.pm * 256 + wr * 64 + fr) * D + col0;
#define EPI_OFF(k) (o0 + (size_t)(((k) >> 2) * 128 + ((k) & 3) * 16) * D)
#define EPI_LOAD(k) do { xo[k][0] = *(const u32x4*)(XBc + EPI_OFF(k)); pw[k][0] = *(const u32x4*)(PP + EPI_OFF(k)); xo[k][1] = *(const u32x4*)(XBc + EPI_OFF(k) + 128); pw[k][1] = *(const u32x4*)(PP + EPI_OFF(k) + 128); } while (0)
        EPI_LOAD(0); EPI_LOAD(1); EPI_LOAD(2);
#pragma unroll
        for (int k = 0; k < 8; ++k) { const int ai = k >> 2, m = k & 3; const float ri = ri8[k]; float s = 0.f;
            if (k + 3 < 8) EPI_LOAD(k + 3);
#pragma unroll
            for (int bj = 0; bj < 2; ++bj) { const u32x4 x = xo[k][bj], p = pw[k][bj];
                const f32x4 z0 = acc[ai][bj][m][0] * ri, z1 = acc[ai][bj][m][1] * ri; f32x4 g0, g1;
#pragma unroll
                for (int j = 0; j < 4; ++j) { g0[j] = __builtin_amdgcn_rcpf(1.f + __builtin_amdgcn_exp2f(-1.4426950408889634f * z0[j])); g1[j] = __builtin_amdgcn_rcpf(1.f + __builtin_amdgcn_exp2f(-1.4426950408889634f * z1[j])); }
                const f32x4 v0 = (f32x4){bflo(x.x), bfhi(x.x), bflo(x.y), bfhi(x.y)} + g0 * (f32x4){bflo(p.x), bfhi(p.x), bflo(p.y), bfhi(p.y)};
                const f32x4 v1 = (f32x4){bflo(x.z), bfhi(x.z), bflo(x.w), bfhi(x.w)} + g1 * (f32x4){bflo(p.z), bfhi(p.z), bflo(p.w), bfhi(p.w)};
                u32x4 w; w.x = cvt_pk_bf16(v0[0], v0[1]); w.y = cvt_pk_bf16(v0[2], v0[3]); w.z = cvt_pk_bf16(v1[0], v1[1]); w.w = cvt_pk_bf16(v1[2], v1[3]); *(u32x4*)(XBn + EPI_OFF(k) + bj * 128) = w;
                s += dot4(v0) + dot4(v1); }
            s += shx<16>(s, fq * 16 + fr); s += shx<32>(s, fq * 16 + fr); sv[k] = s;
        }
#undef EPI_LOAD
#undef EPI_OFF
        if (fq == 0) {
#pragma unroll
            for (int k = 0; k < 8; ++k) ssq_out[(size_t)(u.pm * 256 + (k >> 2) * 128 + wr * 64 + (k & 3) * 16 + fr) * 16 + u.pn * 4 + wc] = sv[k]; }
    }
};
struct Down {
    static constexpr bool PERM = true;
    bf16* CQ; bf16* CKV; bf16* KPE; const float* ssq; float* ssq_q; float* ssq_kv; const float* COS; const float* SIN;
    __device__ __forceinline__ void operator()(const f32x4 (&acc)[2][2][4][2], const Unit& u, int wr, int wc, int fr, int fq) const {
        const int tc0 = wc * 32 + 8 * fq;
        float ri8[8], sv[8]; rinv8(ssq, u.pm * 256 + wr * 64 + fr, fr, fq, 1.f / D, ri8);
#pragma unroll
        for (int k = 0; k < 8; ++k) sv[k] = 0.f;
#pragma unroll
        for (int ai = 0; ai < 2; ++ai)
#pragma unroll
            for (int m = 0; m < 4; ++m) {
                const int r = u.pm * 256 + ai * 128 + wr * 64 + m * 16 + fr; const float ri = ri8[ai * 4 + m];
                if (u.pn < 4) {
                    bf16* orow = (u.pn < 3) ? CQ + (size_t)r * QRANK + u.pn * 256 + tc0 : CKV + (size_t)r * KVRANK + tc0; float s = 0.f;
#pragma unroll
                    for (int bj = 0; bj < 2; ++bj) { const f32x4 v0 = acc[ai][bj][m][0] * ri, v1 = acc[ai][bj][m][1] * ri; u32x4 w;
                        w.x = cvt_pk_bf16(v0[0], v0[1]); w.y = cvt_pk_bf16(v0[2], v0[3]); w.z = cvt_pk_bf16(v1[0], v1[1]); w.w = cvt_pk_bf16(v1[2], v1[3]); *(u32x4*)(orow + bj * 128) = w;
                        s += dot4(v0) + dot4(v1); }
                    s += shx<16>(s, fq * 16 + fr); s += shx<32>(s, fq * 16 + fr); sv[ai * 4 + m] = s;
                } else if (wc < 2) {
                    const f32x4 cs = *(const f32x4*)(COS + (size_t)r * 32 + wc * 16 + 4 * fq), sn = *(const f32x4*)(SIN + (size_t)r * 32 + wc * 16 + 4 * fq);
                    const f32x4 v0 = acc[ai][0][m][0] * ri, v1 = acc[ai][0][m][1] * ri; u32x4 w;
                    w.x = cvt_pk_bf16(v0[0] * cs[0] - v0[1] * sn[0], v0[1] * cs[0] + v0[0] * sn[0]);
                    w.y = cvt_pk_bf16(v0[2] * cs[1] - v0[3] * sn[1], v0[3] * cs[1] + v0[2] * sn[1]);
                    w.z = cvt_pk_bf16(v1[0] * cs[2] - v1[1] * sn[2], v1[1] * cs[2] + v1[0] * sn[2]);
                    w.w = cvt_pk_bf16(v1[2] * cs[3] - v1[3] * sn[3], v1[3] * cs[3] + v1[2] * sn[3]);
                    *(u32x4*)(KPE + (size_t)r * QKR + tc0) = w;
                }
            }
        if (u.pn < 4 && fq == 0) {
            float* const so = (u.pn < 3) ? ssq_q + u.pn * 4 + wc : ssq_kv + wc;
#pragma unroll
            for (int k = 0; k < 8; ++k) so[(size_t)(u.pm * 256 + (k >> 2) * 128 + wr * 64 + (k & 3) * 16 + fr) * 16] = sv[k]; }
    }
};
struct QUp {
    static constexpr bool PERM = true;
    bf16* Q; const float* ssq_q; const float* COS; const float* SIN;
    __device__ __forceinline__ void operator()(const f32x4 (&acc)[2][2][4][2], const Unit& u, int wr, int wc, int fr, int fq) const {
        float ri8[8]; rinv8(ssq_q, u.pm * 256 + wr * 64 + fr, fr, fq, 1.f / QRANK, ri8);
        const int r0 = u.pm * 256 + wr * 64 + fr;
#pragma unroll
        for (int bj = 0; bj < 2; ++bj) {
            const int c0w = u.pn * 256 + bj * 128 + wc * 32, c8 = c0w + 8 * fq;
            if ((c0w % DQK) >= QKN) {
                const int pb = ((c8 % DQK) - QKN) >> 1;
                f32x4 cs[8], sn[8];
#pragma unroll
                for (int k = 0; k < 8; ++k) { const size_t ro = (size_t)(r0 + (k >> 2) * 128 + (k & 3) * 16) * 32 + pb; cs[k] = *(const f32x4*)(COS + ro); sn[k] = *(const f32x4*)(SIN + ro); }
#pragma unroll
                for (int k = 0; k < 8; ++k) { const int ai = k >> 2, m = k & 3; const float ri = ri8[k];
                    const f32x4 v0 = acc[ai][bj][m][0] * ri, v1 = acc[ai][bj][m][1] * ri; u32x4 w;
                    w.x = cvt_pk_bf16(v0[0] * cs[k][0] - v0[1] * sn[k][0], v0[1] * cs[k][0] + v0[0] * sn[k][0]);
                    w.y = cvt_pk_bf16(v0[2] * cs[k][1] - v0[3] * sn[k][1], v0[3] * cs[k][1] + v0[2] * sn[k][1]);
                    w.z = cvt_pk_bf16(v1[0] * cs[k][2] - v1[1] * sn[k][2], v1[1] * cs[k][2] + v1[0] * sn[k][2]);
                    w.w = cvt_pk_bf16(v1[2] * cs[k][3] - v1[3] * sn[k][3], v1[3] * cs[k][3] + v1[2] * sn[k][3]);
                    *(u32x4*)(Q + (size_t)(r0 + ai * 128 + m * 16) * (NHEAD * DQK) + c8) = w; }
            } else {
#pragma unroll
                for (int k = 0; k < 8; ++k) { const int ai = k >> 2, m = k & 3; const float ri = ri8[k];
                    const f32x4 v0 = acc[ai][bj][m][0] * ri, v1 = acc[ai][bj][m][1] * ri; u32x4 w;
                    w.x = cvt_pk_bf16(v0[0], v0[1]); w.y = cvt_pk_bf16(v0[2], v0[3]); w.z = cvt_pk_bf16(v1[0], v1[1]); w.w = cvt_pk_bf16(v1[2], v1[3]);
                    *(u32x4*)(Q + (size_t)(r0 + ai * 128 + m * 16) * (NHEAD * DQK) + c8) = w; }
            }
        }
    }
};
struct Null {
    static constexpr bool PERM = true;
    float* O;
    __device__ __forceinline__ void operator()(const f32x4 (&acc)[2][2][4][2], const Unit& u, int wr, int wc, int fr, int fq) const {
        f32x4 s = {0.f, 0.f, 0.f, 0.f};
#pragma unroll
        for (int ai = 0; ai < 2; ++ai)
#pragma unroll
            for (int bj = 0; bj < 2; ++bj)
#pragma unroll
                for (int m = 0; m < 4; ++m) s += acc[ai][bj][m][0] + acc[ai][bj][m][1];
        O[(size_t)(u.pm * 8 + u.pn) * 512 + (wr * 4 + wc) * 64 + fq * 16 + fr] = (s[0] + s[1]) + (s[2] + s[3]);
    }
};
}

struct TJob { const float* W; int ldw; int K; int Nout; bf16* out; int mode; const float* rs; const float* cs; float cmul; };
__device__ __forceinline__ int tj_src(int mode, int n) {
    if (mode == 1) { if (n < KVRANK) return n; const int rr = n - KVRANK; return KVRANK + (rr >> 1) + 32 * (rr & 1); }
    if (mode == 2) { const int hd = n / DQK, r = n % DQK; if (r < QKN) return n; const int rr = r - QKN; return hd * DQK + QKN + (rr >> 1) + 32 * (rr & 1); }
    if (mode == 3) return (n >> 7) * 256 + (n & 127);
    if (mode == 4) return (n >> 7) * 256 + 128 + (n & 127);
    return n;
}
__device__ __forceinline__ void transpose_tile(const TJob& j, LAS float* scr, int tile, int tid) {
    const int nkt = j.K >> 6, n0 = (tile / nkt) * 64, k0 = (tile % nkt) * 64;
    { const int nn = tid & 63; const int src = (j.mode == 5) ? -1 : tj_src(j.mode, n0 + nn);
      const float csv = (j.cs ? j.cs[n0 + nn] : 1.f) * j.cmul;
#pragma unroll
      for (int i = 0; i < 8; ++i) { const int kk = (tid >> 6) + 8 * i; float v = 0.f;
          if (src >= 0) v = j.W[(size_t)(k0 + kk) * j.ldw + src] * (j.rs ? j.rs[k0 + kk] : 1.f) * csv;
          scr[kk * 65 + nn] = v; } }
    __syncthreads();
    { const int kk2 = (tid & 31) * 2;
#pragma unroll
      for (int i = 0; i < 4; ++i) { const int nn2 = (tid >> 5) + 16 * i;
          *(unsigned*)(j.out + (size_t)(n0 + nn2) * j.K + k0 + kk2) = pk2(scr[kk2 * 65 + nn2], scr[(kk2 + 1) * 65 + nn2]); } }
    __syncthreads();
}
__device__ __forceinline__ void transpose_tile2(const TJob& ja, int tileA, const TJob& jb, int tileB, LAS float* scr, int tid) {
    LAS float* scr2 = scr + 64 * 65 + 32;
    const int nkA = ja.K >> 6, nkB = jb.K >> 6;
    const int nA = (tileA / nkA) * 64, kA = (tileA % nkA) * 64, nB = (tileB / nkB) * 64, kB = (tileB % nkB) * 64;
    { const int nn = tid & 63; const bool zA = ja.mode == 5, zB = jb.mode == 5; const int sA = zA ? 0 : tj_src(ja.mode, nA + nn), sB = zB ? 0 : tj_src(jb.mode, nB + nn);
      const float cA = zA ? 0.f : (ja.cs ? ja.cs[nA + nn] : 1.f) * ja.cmul, cB = zB ? 0.f : (jb.cs ? jb.cs[nB + nn] : 1.f) * jb.cmul;
      float va[8], vb[8], ra[8], rb[8];
#pragma unroll
      for (int i = 0; i < 8; ++i) { const int kk = (tid >> 6) + 8 * i; va[i] = ja.W[(size_t)(kA + kk) * ja.ldw + sA]; vb[i] = jb.W[(size_t)(kB + kk) * jb.ldw + sB];
          ra[i] = ja.rs ? ja.rs[kA + kk] : 1.f; rb[i] = jb.rs ? jb.rs[kB + kk] : 1.f; }
#pragma unroll
      for (int i = 0; i < 8; ++i) { const int kk = (tid >> 6) + 8 * i; scr[kk * 65 + nn] = va[i] * ra[i] * cA; scr2[kk * 65 + nn] = vb[i] * rb[i] * cB; } }
    __syncthreads();
    { const int kk2 = (tid & 31) * 2;
#pragma unroll
      for (int i = 0; i < 4; ++i) { const int nn2 = (tid >> 5) + 16 * i;
          *(unsigned*)(ja.out + (size_t)(nA + nn2) * ja.K + kA + kk2) = pk2(scr[kk2 * 65 + nn2], scr[(kk2 + 1) * 65 + nn2]);
          *(unsigned*)(jb.out + (size_t)(nB + nn2) * jb.K + kB + kk2) = pk2(scr2[kk2 * 65 + nn2], scr2[(kk2 + 1) * 65 + nn2]); } }
    __syncthreads();
}
struct In {
    const float *x, *p; const int* pos; const float *mix_norm, *ffn_norm, *pool_w, *pool_scale, *kv_in_norm, *w_dkv, *kv_norm, *w_ukv, *w_dq, *q_norm, *w_uq, *w_o,
                *peer_wq, *peer_keys, *peer_u, *peer_v, *ple_norm, *ple_wg, *ple_wp, *final_norm;
};
typedef const __attribute__((address_space(4))) In CIn;
__device__ __forceinline__ TJob get_job(int id, CIn& in, unsigned char* ws) {
    TJob j; j.mode = 0; j.rs = nullptr; j.cs = nullptr; j.cmul = 1.f;
    if (id < 4) { j.W = in.ple_wg + (size_t)id * D * D; j.ldw = D; j.K = D; j.Nout = D; j.out = (bf16*)(ws + W_WG) + (size_t)id * D * D; j.rs = in.ple_norm + id * D; }
    else if (id < 8) { const int i = id - 4; j.W = in.ple_wp + (size_t)i * PLE * D; j.ldw = D; j.K = PLE; j.Nout = D; j.out = (bf16*)(ws + W_WP) + (size_t)i * D * PLE; }
    else if (id < 16) { const int i = (id - 8) >> 2, g = (id - 8) & 3; j.W = in.pool_w + (size_t)(i * 4 + g) * 65536; j.ldw = 256; j.K = 256; j.Nout = 256;
        j.out = (bf16*)(ws + W_POOL) + (size_t)(i * 1024 + g * 256) * 256; j.cs = in.pool_scale + i * D + g * 256; }
    else if (id == 16) { j.W = in.w_dq; j.ldw = QRANK; j.K = D; j.Nout = QRANK; j.out = (bf16*)(ws + W_DOWN2); j.rs = in.mix_norm + 2 * D; }
    else if (id == 17) { j.W = in.w_dkv; j.ldw = KVRANK + QKR; j.K = D; j.Nout = KVRANK + QKR; j.out = (bf16*)(ws + W_DOWN2) + (size_t)QRANK * D; j.mode = 1; j.rs = in.kv_in_norm; }
    else if (id == 18) { j.W = in.w_dkv; j.ldw = KVRANK + QKR; j.K = D; j.Nout = 192; j.out = (bf16*)(ws + W_DOWN2) + (size_t)(QRANK + KVRANK + QKR) * D; j.mode = 5; }
    else if (id == 19) { j.W = in.w_dq + (size_t)D * QRANK; j.ldw = QRANK; j.K = D; j.Nout = QRANK; j.out = (bf16*)(ws + W_DOWN3); j.rs = in.mix_norm + 3 * D; }
    else if (id == 20) { j.W = in.w_ukv; j.ldw = 2048; j.K = KVRANK; j.Nout = 1024; j.out = (bf16*)(ws + W_KNW); j.mode = 3; j.rs = in.kv_norm; }
    else if (id == 21) { j.W = in.w_ukv; j.ldw = 2048; j.K = KVRANK; j.Nout = 1024; j.out = (bf16*)(ws + W_VW); j.mode = 4; j.rs = in.kv_norm; }
    else if (id < 24) { const int jj = id - 22; j.W = in.w_uq + (size_t)jj * QRANK * 1536; j.ldw = 1536; j.K = QRANK; j.Nout = 1536; j.out = (bf16*)(ws + W_UQ) + (size_t)jj * 1536 * QRANK;
        j.mode = 2; j.rs = in.q_norm + jj * QRANK; j.cmul = C2; }
    else { const int jj = id - 24; j.W = in.w_o + (size_t)jj * D * D; j.ldw = D; j.K = D; j.Nout = D; j.out = (bf16*)(ws + W_WO) + (size_t)jj * D * D; }
    return j;
}
constexpr int N_TJOBS = 26;
__host__ __device__ constexpr int tj_tiles(int id) {
    return id < 4 ? (D >> 6) * (D >> 6) : id < 8 ? (PLE >> 6) * (D >> 6) : id < 16 ? 16 : id == 16 ? (D >> 6) * (QRANK >> 6) : id == 17 ? (D >> 6) * ((KVRANK + QKR) >> 6)
         : id == 18 ? (D >> 6) * 3 : id == 19 ? (D >> 6) * (QRANK >> 6) : id < 22 ? (KVRANK >> 6) * 16 : id < 24 ? (QRANK >> 6) * 24 : (D >> 6) * (D >> 6);
}

__device__ __forceinline__ void weff_item(const float* wq, const float* keys, const float* gain, bf16* out, int hp, int kt, LAS float* lds, int tid) {
    constexpr int RS = 136;
    LAS unsigned short* Wh = (LAS unsigned short*)lds; LAS unsigned short* Wl = Wh + 64 * RS; LAS unsigned short* Kh = Wl + 64 * RS; LAS unsigned short* Kl = Kh + 128 * RS;
    const int k0 = kt * 64;
#define WEFF_SPLIT(v, ph, pl) do { v2u h_, l_; h_.x = pk2((v)[0], (v)[1]); h_.y = pk2((v)[2], (v)[3]); \
        l_.x = pk2((v)[0] - bflo(h_.x), (v)[1] - bfhi(h_.x)); l_.y = pk2((v)[2] - bflo(h_.y), (v)[3] - bfhi(h_.y)); *(LAS v2u*)(ph) = h_; *(LAS v2u*)(pl) = l_; } while (0)
#pragma unroll
    for (int i = 0; i < 4; ++i) { const int idx = tid + 512 * i, row = idx >> 5, c4 = idx & 31;
        const f32x4 v = *(const f32x4*)(wq + (size_t)(k0 + row) * 2048 + hp * 128 + c4 * 4) * gain[k0 + row]; WEFF_SPLIT(v, Wh + row * RS + c4 * 4, Wl + row * RS + c4 * 4); }
#pragma unroll
    for (int i = 0; i < 8; ++i) { const int idx = tid + 512 * i, row = idx >> 5, c4 = idx & 31;
        const f32x4 v = *(const f32x4*)(keys + (size_t)(hp * 128 + row) * 128 + c4 * 4); WEFF_SPLIT(v, Kh + row * RS + c4 * 4, Kl + row * RS + c4 * 4); }
#undef WEFF_SPLIT
    __syncthreads();
    const int w = tid >> 6, l = tid & 63, tk = w & 1, tn = w >> 1, r32 = l & 31, g = l >> 5;
    f32x16 acc;
#pragma unroll
    for (int r = 0; r < 16; ++r) acc[r] = 0.f;
    const int ao = (32 * tk + r32) * RS + 8 * g, bo = (32 * tn + r32) * RS + 8 * g;
#pragma unroll
    for (int s8 = 0; s8 < 8; ++s8) {
        const bf16x8 ah = *(const LAS bf16x8*)(Wh + ao + 16 * s8), al = *(const LAS bf16x8*)(Wl + ao + 16 * s8);
        const bf16x8 bh = *(const LAS bf16x8*)(Kh + bo + 16 * s8), bl = *(const LAS bf16x8*)(Kl + bo + 16 * s8);
        acc = __builtin_amdgcn_mfma_f32_32x32x16_bf16(ah, bh, acc, 0, 0, 0);
        acc = __builtin_amdgcn_mfma_f32_32x32x16_bf16(ah, bl, acc, 0, 0, 0);
        acc = __builtin_amdgcn_mfma_f32_32x32x16_bf16(al, bh, acc, 0, 0, 0);
    }
#pragma unroll
    for (int gq = 0; gq < 4; ++gq) { v2u o_; o_.x = pk2(acc[4 * gq + 0], acc[4 * gq + 1]); o_.y = pk2(acc[4 * gq + 2], acc[4 * gq + 3]);
        *(v2u*)(out + (size_t)(hp * 128 + 32 * tn + r32) * D + k0 + 32 * tk + 8 * gq + 4 * g) = o_; }
    __syncthreads();
}

__device__ __forceinline__ void p0_prologue(CIn& in, unsigned char* ws, LAS unsigned char* lds, int bid, int G, int wave) {
    const int tid = wave * 64 + lane_id_fresh();
    const int gtid = bid * NTHR + tid, NT = G * NTHR;
    for (int i = gtid + (int)(SSQ_ARR / 4); i < (int)(16 * SSQ_ARR / 4); i += NT) ((f32x4*)(ws + WS_SSQ))[i] = (f32x4){0.f, 0.f, 0.f, 0.f};
    {
      int total = 0;
#pragma unroll
      for (int id = 0; id < N_TJOBS; ++id) total += tj_tiles(id);
      for (int g = bid; g < total; g += 2 * G) {
          int idA = 0, tA = g; while (tA >= tj_tiles(idA)) { tA -= tj_tiles(idA); ++idA; }
          const TJob ja = get_job(idA, in, ws);
          if (g + G < total) { int idB = idA, tB = tA + G; while (tB >= tj_tiles(idB)) { tB -= tj_tiles(idB); ++idB; }
              const TJob jb = get_job(idB, in, ws); transpose_tile2(ja, tA, jb, tB, (LAS float*)lds, tid); }
          else transpose_tile(ja, (LAS float*)lds, tA, tid); } }
    for (int it = bid; it < 4 * 16 * 16; it += G) { const int l = it >> 8, hp = (it >> 4) & 15, kt = it & 15;
        weff_item(in.peer_wq + (size_t)l * D * 2048, in.peer_keys + (size_t)l * 2048 * 128, in.ffn_norm + l * D, (bf16*)(ws + W_WEFF) + (size_t)l * 2048 * D, hp, kt, (LAS float*)lds, tid); }
    for (int i = gtid; i < T * 32; i += NT) { const int t = i >> 5, c = i & 31;
        double inv = 0.15915494309189535; for (int k = 0; k < c; ++k) inv *= 0.7498942093324559;
        double rd = (double)in.pos[t] * inv; rd -= __builtin_floor(rd); const float rr = (float)rd;
        ((float*)(ws + WS_COS))[i] = __builtin_amdgcn_cosf(rr); ((float*)(ws + WS_SIN))[i] = __builtin_amdgcn_sinf(rr); }
    { const int lane = tid & 63, gw = gtid >> 6, NW = NT >> 6; bf16* XB = (bf16*)(ws + WS_XBA); float* ssq = (float*)(ws + WS_SSQ);
      for (int r = gw; r < T; r += 2 * NW) { const int r2 = (r + NW < T) ? r + NW : r; f32x4 va[4], vb[4];
#pragma unroll
          for (int j = 0; j < 4; ++j) { va[j] = *(const f32x4*)(in.x + (size_t)r * D + j * 256 + 4 * lane); vb[j] = *(const f32x4*)(in.x + (size_t)r2 * D + j * 256 + 4 * lane); }
          float s = 0.f, s2 = 0.f;
#pragma unroll
          for (int j = 0; j < 4; ++j) { const size_t o = (size_t)r * D + j * 256 + 4 * lane, o2 = (size_t)r2 * D + j * 256 + 4 * lane;
              v2u w; w.x = pk2(va[j][0], va[j][1]); w.y = pk2(va[j][2], va[j][3]); *(v2u*)(XB + o) = w; s += (va[j][0] * va[j][0] + va[j][1] * va[j][1]) + (va[j][2] * va[j][2] + va[j][3] * va[j][3]);
              v2u y; y.x = pk2(vb[j][0], vb[j][1]); y.y = pk2(vb[j][2], vb[j][3]); *(v2u*)(XB + o2) = y; s2 += (vb[j][0] * vb[j][0] + vb[j][1] * vb[j][1]) + (vb[j][2] * vb[j][2] + vb[j][3] * vb[j][3]); }
          s = wave_sum(s, lane); s2 = wave_sum(s2, lane);
          if (lane < 16) { ssq[(size_t)r * 16 + lane] = (lane == 0) ? s : 0.f; ssq[(size_t)r2 * 16 + lane] = (lane == 0) ? s2 : 0.f; } } }
}
typedef float f2_t __attribute__((ext_vector_type(2)));
template <int CTRL> __device__ __forceinline__ int dppi(int v) { return __builtin_amdgcn_update_dpp(0, v, CTRL, 0xf, 0xf, true); }
__device__ __forceinline__ unsigned wave_max_dpp(unsigned v) {
    v = max(v, (unsigned)dppi<0xB1>((int)v)); v = max(v, (unsigned)dppi<0x4E>((int)v)); v = max(v, (unsigned)dppi<0x141>((int)v)); v = max(v, (unsigned)dppi<0x140>((int)v));
    { unsigned p = v, q = v; asm volatile("s_nop 1\n\tv_permlane16_swap_b32 %0, %1" : "+v"(p), "+v"(q)); v = max(p, q); }
    { unsigned p = v, q = v; asm volatile("s_nop 1\n\tv_permlane32_swap_b32 %0, %1" : "+v"(p), "+v"(q)); v = max(p, q); }
    return v;
}
__device__ __forceinline__ unsigned pack_i8x4(f32x4 v, float inv) {
    const unsigned y0 = __builtin_bit_cast(unsigned, __builtin_fmaf(v[0], inv, 12582912.f)), y1 = __builtin_bit_cast(unsigned, __builtin_fmaf(v[1], inv, 12582912.f));
    const unsigned y2 = __builtin_bit_cast(unsigned, __builtin_fmaf(v[2], inv, 12582912.f)), y3 = __builtin_bit_cast(unsigned, __builtin_fmaf(v[3], inv, 12582912.f));
    return __builtin_amdgcn_perm(y1, y0, 0x0c0c0400u) | (__builtin_amdgcn_perm(y3, y2, 0x0c0c0400u) << 16);
}
__device__ __forceinline__ void quant_store_i8(const f32x4 (&v)[4], unsigned char* tab, int row, float* scale_out, int lane) {
    unsigned amb = 0u;
#pragma unroll
    for (int j = 0; j < 4; ++j)
#pragma unroll
        for (int i = 0; i < 4; ++i) { const float f_ = v[j][i]; amb = max(amb, __builtin_bit_cast(unsigned, f_) & 0x7fffffffu); }
    const float am = __builtin_bit_cast(float, wave_max_dpp(amb));
    const float inv = am > 0.f ? 126.99f * __builtin_amdgcn_rcpf(am) : 0.f;
    v4u w;
#pragma unroll
    for (int j = 0; j < 4; ++j) w[j] = pack_i8x4(v[j], inv);
    *(v4u*)(tab + (size_t)((unsigned)(lane >> 3) * (unsigned)(NEXP * 128) + (unsigned)row * 128u + (unsigned)(lane & 7) * 16u)) = w;
    *scale_out = am * (1.f / 126.99f);
}
__device__ __forceinline__ void convert_layer(CIn& in, unsigned char* ws, int layer, int bid, int G, int wave) {
    const int set = layer & 1;
    const int lane = lane_id_fresh(), tid = wave * 64 + lane;
    const int gtid = bid * NTHR + tid, NT = G * NTHR, gw = gtid >> 6, NW = NT >> 6;
    const float* u = in.peer_u + (size_t)layer * NEXP * D; const float* v = in.peer_v + (size_t)layer * NEXP * D; const float* gn = in.ffn_norm + layer * D;
    unsigned char* U8 = ws + tab_off(set); unsigned char* V8 = U8 + (size_t)NEXP * D; float* SU = (float*)(ws + tabs_off(set)); float* SV = SU + NEXP;
    f32x4 gv[4];
#pragma unroll
    for (int j = 0; j < 4; ++j) gv[j] = *(const f32x4*)(gn + 16 * lane + 4 * j);
    for (int r = gw; r < NEXP; r += 2 * NW) {
        const int r2 = r + NW; const bool ok2 = r2 < NEXP; const int rb = ok2 ? r2 : r;
        f32x4 ua[4], va[4], ub[4], vb[4];
#pragma unroll
        for (int j = 0; j < 4; ++j) { ua[j] = *(const f32x4*)(u + (size_t)r * D + 16 * lane + 4 * j); va[j] = *(const f32x4*)(v + (size_t)r * D + 16 * lane + 4 * j);
            ub[j] = *(const f32x4*)(u + (size_t)rb * D + 16 * lane + 4 * j); vb[j] = *(const f32x4*)(v + (size_t)rb * D + 16 * lane + 4 * j); }
#pragma unroll
        for (int j = 0; j < 4; ++j) { ua[j] = ua[j] * gv[j]; ub[j] = ub[j] * gv[j]; }
        quant_store_i8(ua, U8, r, SU + r, lane); quant_store_i8(va, V8, r, SV + r, lane);
        if (ok2) { quant_store_i8(ub, U8, r2, SU + r2, lane); quant_store_i8(vb, V8, r2, SV + r2, lane); }
    }
    const float* p = in.p + (size_t)layer * T * PLE; bf16* PB = (bf16*)(ws + WS_PB);
    for (int i = gtid; i < T * PLE / 8; i += NT) { const size_t o = (size_t)i * 8; const f32x4 a0 = *(const f32x4*)(p + o), a1 = *(const f32x4*)(p + o + 4);
        v4u w; w.x = pk2(a0[0], a0[1]); w.y = pk2(a0[2], a0[3]); w.z = pk2(a1[0], a1[1]); w.w = pk2(a1[2], a1[3]); *(v4u*)(PB + o) = w; }
}
template <int W>
__device__ __forceinline__ void pooled_strip(const bf16* XB, const LAS float* rinv, const float* gain, bf16* P, int t0, int s0, int tid) {
    const int c0 = 2 * tid; const f32x2 gv = *(const f32x2*)(gain + c0);
    f32x2 ring[W]; f32x2 sum = {0.f, 0.f};
    { unsigned xw[W];
#pragma unroll
      for (int j = 0; j < W; ++j) xw[j] = (s0 - W + j >= 0) ? *(const unsigned*)(XB + (size_t)(t0 - W + j) * D + c0) : 0u;
#pragma unroll
      for (int j = 0; j < W; ++j) { const float ri = (s0 - W + j >= 0) ? rinv[16 - W + j] : 0.f; const f32x2 hv = (f32x2){bflo(xw[j]), bfhi(xw[j])} * ri * gv; ring[j] = hv; sum += hv; } }
    for (int sb = 0; sb < 64; sb += 16) {
        unsigned xw[16];
#pragma unroll
        for (int j = 0; j < 16; ++j) xw[j] = *(const unsigned*)(XB + (size_t)(t0 + sb + j) * D + c0);
#pragma unroll
        for (int j = 0; j < 16; ++j) { const int t = t0 + sb + j, s = s0 + sb + j; const float ri = rinv[16 + sb + j];
            const f32x2 hv = (f32x2){bflo(xw[j]), bfhi(xw[j])} * ri * gv; sum += hv - ring[j % W]; ring[j % W] = hv;
            const float ic = 1.f / (float)((s + 1 < W) ? s + 1 : W); const f32x2 pv = sum * ic - hv;
            *(unsigned*)(P + (size_t)t * D + c0) = pk2(pv[0], pv[1]); }
    }
}
__device__ __forceinline__ void pooled_phase(const bf16* XB, const float* ssq, const float* gain, bf16* P, LAS unsigned char* lds, int vcu, int G, int wave) {
    const int tid = wave * 64 + lane_id_fresh();
    const int g = wave >> 1;
    LAS float* rinv = (LAS float*)lds;
    for (int strip = vcu; strip < T / 64; strip += G) { const int t0 = strip * 64, s0 = t0 & (SEQ - 1);
        __syncthreads();
        if (tid < 80) { const int t = t0 - 16 + tid; rinv[tid] = (s0 - 16 + tid >= 0) ? row_rinv(ssq, t, 1.f / D) : 0.f; }
        __syncthreads();
        if (g == 0) pooled_strip<2>(XB, rinv, gain, P, t0, s0, tid); else if (g == 1) pooled_strip<4>(XB, rinv, gain, P, t0, s0, tid);
        else if (g == 2) pooled_strip<8>(XB, rinv, gain, P, t0, s0, tid); else pooled_strip<16>(XB, rinv, gain, P, t0, s0, tid); }
}
__device__ __forceinline__ void final_phase(const bf16* XB, const float* ssq, const float* gain, float* out, int bid, int G, int wave) {
    const int tid = wave * 64 + lane_id_fresh();
    const int lane = tid & 63, gw = (bid * NTHR + tid) >> 6, NW = (G * NTHR) >> 6;
    f32x4 gv[4];
#pragma unroll
    for (int j = 0; j < 4; ++j) gv[j] = *(const f32x4*)(gain + j * 256 + 4 * lane);
    int r = gw;
    for (; r + 3 * NW < T; r += 4 * NW) {
        f32x4 sq[4]; v2u xw[4][4];
#pragma unroll
        for (int k = 0; k < 4; ++k) { const int rr = r + k * NW; sq[k] = *(const f32x4*)(ssq + (size_t)rr * 16 + 4 * (lane & 3));
#pragma unroll
            for (int j = 0; j < 4; ++j) xw[k][j] = *(const v2u*)(XB + (size_t)rr * D + j * 256 + 4 * lane); }
#pragma unroll
        for (int k = 0; k < 4; ++k) { const int rr = r + k * NW;
            float sv = (sq[k][0] + sq[k][1]) + (sq[k][2] + sq[k][3]); sv += dppf<0xB1>(sv); sv += dppf<0x4E>(sv);
            const float ri = __builtin_amdgcn_rsqf(sv * (1.f / D) + 1e-6f);
#pragma unroll
            for (int j = 0; j < 4; ++j) *(f32x4*)(out + (size_t)rr * D + j * 256 + 4 * lane) = (f32x4){bflo(xw[k][j].x), bfhi(xw[k][j].x), bflo(xw[k][j].y), bfhi(xw[k][j].y)} * ri * gv[j]; }
    }
    for (; r < T; r += NW) { const float ri = row_rinv(ssq, r, 1.f / D);
#pragma unroll
        for (int j = 0; j < 4; ++j) { const size_t o = (size_t)r * D + j * 256 + 4 * lane; const v2u x1 = *(const v2u*)(XB + o); *(f32x4*)(out + o) = (f32x4){bflo(x1.x), bfhi(x1.x), bflo(x1.y), bfhi(x1.y)} * ri * gv[j]; } }
}

__device__ __forceinline__ unsigned fkey(float f) { const unsigned u = __builtin_bit_cast(unsigned, f); return u ^ ((unsigned)((int)u >> 31) | 0x80000000u); }
__device__ __forceinline__ unsigned mbcnt64(unsigned long long m) { return __builtin_amdgcn_mbcnt_hi((unsigned)(m >> 32), __builtin_amdgcn_mbcnt_lo((unsigned)m, 0u)); }
template <int N>
__device__ __forceinline__ void select16(const unsigned (&key)[N], unsigned (&pos)[N]) {
    unsigned prefix = 0u;
    for (int bit = 31; bit >= 0; --bit) {
        const unsigned cand = prefix | (1u << bit); int cnt = 0;
#pragma unroll
        for (int i = 0; i < N; ++i) cnt += __builtin_popcountll(__ballot(key[i] >= cand));
        if (cnt >= 16) prefix = cand;
        if (cnt == 16) break;
    }
    unsigned long long mg[N], me[N]; int cgt = 0;
#pragma unroll
    for (int i = 0; i < N; ++i) { mg[i] = __ballot(key[i] > prefix); me[i] = __ballot(key[i] == prefix); cgt += __builtin_popcountll(mg[i]); }
    int bg = 0, be = cgt;
#pragma unroll
    for (int i = 0; i < N; ++i) { const unsigned rg = mbcnt64(mg[i]), re = mbcnt64(me[i]);
        pos[i] = (key[i] > prefix) ? (unsigned)bg + rg : ((key[i] == prefix) ? (unsigned)be + re : 64u);
        bg += __builtin_popcountll(mg[i]); be += __builtin_popcountll(me[i]); }
}
__device__ __forceinline__ float gelu_tanh(float a) {
    const float u = 0.7978845608028654f * (a + 0.044715f * a * a * a);
    const float e = __builtin_amdgcn_exp2f(2.885390081777927f * u);
    const float th = 1.f - 2.f * __builtin_amdgcn_rcpf(1.f + e);
    return 0.5f * a * (1.f + th);
}
typedef short s16x2_t __attribute__((ext_vector_type(2)));
__device__ __forceinline__ unsigned hkey2(unsigned w) { const s16x2_t sg = __builtin_bit_cast(s16x2_t, w) >> 15; return w ^ (__builtin_bit_cast(unsigned, sg) | 0x80008000u); }
__device__ __forceinline__ float fkey_inv(unsigned k) { const unsigned u = (k & 0x80000000u) ? (k ^ 0x80000000u) : ~k; return __builtin_bit_cast(float, u); }
__device__ __forceinline__ void bit_transpose32(unsigned (&A)[32]) {
#define BT_STAGE(J, M) _Pragma("unroll") for (int k = 0; k < 32; ++k) if ((k & (J)) == 0) { const unsigned t = (A[k] ^ (A[k + (J)] >> (J))) & (M); A[k] ^= t; A[k + (J)] ^= t << (J); }
    BT_STAGE(16, 0x0000FFFFu) BT_STAGE(8, 0x00FF00FFu) BT_STAGE(4, 0x0F0F0F0Fu) BT_STAGE(2, 0x33333333u) BT_STAGE(1, 0x55555555u)
#undef BT_STAGE
}
template <int GL>
__device__ __forceinline__ void topk_select(unsigned (&key)[32], unsigned& Gm, unsigned& Em, int& ng) {
    bit_transpose32(key);
    unsigned A = 0xFFFFFFFFu, G = 0u; int n = 0;
#pragma unroll
    for (int i = 0; i < 32; ++i) {
        const unsigned x = A & key[i]; int c = __builtin_popcount(x);
        c += dppi<0xB1>(c); c += dppi<0x4E>(c);
        if (GL == 8) c += dppi<0x141>(c);
        const bool take = (n + c >= 16);
        A = take ? x : (A ^ x); G = take ? G : (G | x); n = take ? n : n + c;
    }
    Gm = G; Em = A; ng = n;
}
__device__ __forceinline__ void bit_transpose16x2(unsigned (&A)[16]) {
#define BT_STAGE(J, M) _Pragma("unroll") for (int k = 0; k < 16; ++k) if ((k & (J)) == 0) { const unsigned t = (A[k] ^ (A[k + (J)] >> (J))) & (M); A[k] ^= t; A[k + (J)] ^= t << (J); }
    _Pragma("unroll") for (int k = 0; k < 8; ++k) { const unsigned a = A[k], b = A[k + 8]; A[k] = __builtin_amdgcn_perm(b, a, 0x03070105u); A[k + 8] = __builtin_amdgcn_perm(b, a, 0x02060004u); }
    BT_STAGE(4, 0x0F0F0F0Fu) BT_STAGE(2, 0x33333333u) BT_STAGE(1, 0x55555555u)
#undef BT_STAGE
}
template <int GL>
__device__ __forceinline__ void topk_select16(unsigned (&key)[16], unsigned& Gm, unsigned& Em, int& ng) {
    bit_transpose16x2(key);
    unsigned A = 0xFFFFFFFFu, G = 0u; int n = 0;
#pragma unroll
    for (int i = 0; i < 16; ++i) {
        const unsigned x = A & key[i]; int c = __builtin_popcount(x);
        c += dppi<0xB1>(c); c += dppi<0x4E>(c);
        if (GL == 8) c += dppi<0x141>(c);
        const bool take = (n + c >= 16);
        A = take ? x : (A ^ x); G = take ? G : (G | x); n = take ? n : n + c;
    }
    Gm = G; Em = A; ng = n;
}
__device__ __forceinline__ float rs32(float p, float q) { asm volatile("s_nop 1\n\tv_permlane32_swap_b32 %0, %1" : "+v"(p), "+v"(q)); return p + q; }
__device__ __forceinline__ float rs16(float p, float q) { asm volatile("s_nop 1\n\tv_permlane16_swap_b32 %0, %1" : "+v"(p), "+v"(q)); return p + q; }
__device__ __forceinline__ float wave_sum_dpp(float v) {
    v += dppf<0xB1>(v); v += dppf<0x4E>(v); v += dppf<0x141>(v); v += dppf<0x140>(v); v = rs16(v, v); v = rs32(v, v); return v;
}
struct ConvNext { const float* u; const float* v; const float* gain; const float* p; unsigned char* U8; unsigned char* V8; float* SU; float* SV; bf16* PB; int on; };
template <int GL>
__device__ __forceinline__ void topk_select16x2(unsigned (&kA)[16], unsigned (&kB)[16], unsigned& GmA, unsigned& EmA, int& ngA, unsigned& GmB, unsigned& EmB, int& ngB) {
    bit_transpose16x2(kA); bit_transpose16x2(kB);
    unsigned AA = 0xFFFFFFFFu, GA = 0u, AB = 0xFFFFFFFFu, GB = 0u; int nA = 0, nB = 0;
#pragma unroll
    for (int i = 0; i < 16; ++i) {
        const unsigned xA = AA & kA[i], xB = AB & kB[i]; int cA = __builtin_popcount(xA), cB = __builtin_popcount(xB);
        cA += dppi<0xB1>(cA); cB += dppi<0xB1>(cB); cA += dppi<0x4E>(cA); cB += dppi<0x4E>(cB);
        if (GL == 8) { cA += dppi<0x141>(cA); cB += dppi<0x141>(cB); }
        const bool tA = (nA + cA >= 16), tB = (nB + cB >= 16);
        AA = tA ? xA : (AA ^ xA); GA = tA ? GA : (GA | xA); nA = tA ? nA : nA + cA;
        AB = tB ? xB : (AB ^ xB); GB = tB ? GB : (GB | xB); nB = tB ? nB : nB + cB;
    }
    GmA = GA; EmA = AA; ngA = nA; GmB = GB; EmB = AB; ngB = nB;
}
struct KTok { LAS unsigned char* s1i; LAS unsigned char* s2c; LAS unsigned char* scratch; LAS unsigned short* rowc; };
__device__ __forceinline__ KTok ktok(LAS unsigned char* lw, int lane) { KTok k; k.s1i = lw; k.s2c = lw + 256; k.scratch = lw + 512 + lane; k.rowc = (LAS unsigned short*)(lw + 2048); return k; }
__device__ __forceinline__ void k_compact(unsigned M, LAS unsigned char* wp, LAS unsigned char* scratch, int base) {
    while (__builtin_amdgcn_ballot_w64(M != 0u) != 0ull) {
#pragma unroll
        for (int u4 = 0; u4 < 4; ++u4) { const bool act = M != 0u; const int bp = __builtin_ctz(M | 0x80000000u); M &= M - 1u;
            LAS unsigned char* const p = act ? wp : scratch; *p = (unsigned char)(base + 30 - 2 * (bp & 15) + (bp >> 4)); wp += act ? 1 : 0; }
    }
}
__device__ __forceinline__ unsigned k_trim(unsigned Em, int ke) {
    unsigned Et = Em;
    while (__builtin_amdgcn_ballot_w64(__builtin_popcount(Et) > ke) != 0ull) { if (__builtin_popcount(Et) > ke) Et &= Et - 1u; asm volatile("" : "+v"(Et)); }
    return Et;
}
__device__ __forceinline__ void k_compact2(unsigned MA, LAS unsigned char* wpA, LAS unsigned char* scrA, unsigned MB, LAS unsigned char* wpB, LAS unsigned char* scrB, int base) {
    while (__builtin_amdgcn_ballot_w64((MA | MB) != 0u) != 0ull) {
#pragma unroll
        for (int u4 = 0; u4 < 4; ++u4) {
            { const bool act = MA != 0u; const int bp = __builtin_ctz(MA | 0x80000000u); MA &= MA - 1u;
              LAS unsigned char* const p = act ? wpA : scrA; *p = (unsigned char)(base + 30 - 2 * (bp & 15) + (bp >> 4)); wpA += act ? 1 : 0; }
            { const bool act = MB != 0u; const int bp = __builtin_ctz(MB | 0x80000000u); MB &= MB - 1u;
              LAS unsigned char* const p = act ? wpB : scrB; *p = (unsigned char)(base + 30 - 2 * (bp & 15) + (bp >> 4)); wpB += act ? 1 : 0; } }
    }
}
__device__ __forceinline__ void k_trim2(unsigned& EA, int keA, unsigned& EB, int keB) {
    while (__builtin_amdgcn_ballot_w64(__builtin_popcount(EA) > keA || __builtin_popcount(EB) > keB) != 0ull) {
        if (__builtin_popcount(EA) > keA) EA &= EA - 1u; if (__builtin_popcount(EB) > keB) EB &= EB - 1u; asm volatile("" : "+v"(EA), "+v"(EB)); }
}
__device__ __forceinline__ void k_l1_keys(const v4u (&cw)[4], const KTok& k, int lane, unsigned (&key)[16]) {
#pragma unroll
    for (int q = 0; q < 4; ++q) { const v4u w = cw[q]; *(LAS v4u*)(k.rowc + lane * 32 + q * 8) = w;
#pragma unroll
        for (int c = 0; c < 4; ++c) key[4 * q + c] = hkey2(w[c]); }
}
__device__ __forceinline__ void k_l1_post(unsigned Gm, unsigned Em, int ntot, const KTok& k, int lane) {
    const int g1 = lane >> 2, sub = lane & 3;
    const int neq = __builtin_popcount(Em);
    const int e0 = dppi<0x00>(neq), e1 = dppi<0x55>(neq), e2 = dppi<0xAA>(neq);
    const int pe = ntot + (sub > 0 ? e0 : 0) + (sub > 1 ? e1 : 0) + (sub > 2 ? e2 : 0);
    const unsigned M = Gm | k_trim(Em, min(max(16 - pe, 0), neq));
    const int cnt = __builtin_popcount(M);
    const int c0 = dppi<0x00>(cnt), c1 = dppi<0x55>(cnt), c2 = dppi<0xAA>(cnt);
    k_compact(M, k.s1i + g1 * 16 + (sub > 0 ? c0 : 0) + (sub > 1 ? c1 : 0) + (sub > 2 ? c2 : 0), k.scratch, sub * 32);
}
__device__ __forceinline__ void k_l1_post2(unsigned GmA, unsigned EmA, int ntA, const KTok& kA, unsigned GmB, unsigned EmB, int ntB, const KTok& kB, int lane) {
    const int g1 = lane >> 2, sub = lane & 3;
    const int neqA = __builtin_popcount(EmA), neqB = __builtin_popcount(EmB);
    const int eA0 = dppi<0x00>(neqA), eA1 = dppi<0x55>(neqA), eA2 = dppi<0xAA>(neqA), eB0 = dppi<0x00>(neqB), eB1 = dppi<0x55>(neqB), eB2 = dppi<0xAA>(neqB);
    const int peA = ntA + (sub > 0 ? eA0 : 0) + (sub > 1 ? eA1 : 0) + (sub > 2 ? eA2 : 0), peB = ntB + (sub > 0 ? eB0 : 0) + (sub > 1 ? eB1 : 0) + (sub > 2 ? eB2 : 0);
    unsigned EA = EmA, EB = EmB; k_trim2(EA, min(max(16 - peA, 0), neqA), EB, min(max(16 - peB, 0), neqB));
    const unsigned MA = GmA | EA, MB = GmB | EB;
    const int cntA = __builtin_popcount(MA), cntB = __builtin_popcount(MB);
    const int cA0 = dppi<0x00>(cntA), cA1 = dppi<0x55>(cntA), cA2 = dppi<0xAA>(cntA), cB0 = dppi<0x00>(cntB), cB1 = dppi<0x55>(cntB), cB2 = dppi<0xAA>(cntB);
    k_compact2(MA, kA.s1i + g1 * 16 + (sub > 0 ? cA0 : 0) + (sub > 1 ? cA1 : 0) + (sub > 2 ? cA2 : 0), kA.scratch,
               MB, kB.s1i + g1 * 16 + (sub > 0 ? cB0 : 0) + (sub > 1 ? cB1 : 0) + (sub > 2 ? cB2 : 0), kB.scratch, sub * 32);
}
__device__ __forceinline__ int k_scan8(int v, int sub8) {
    { const int t2 = dppi<0x111>(v); if (sub8 >= 1) v += t2; }
    { const int t2 = dppi<0x112>(v); if (sub8 >= 2) v += t2; }
    { const int t2 = dppi<0x114>(v); if (sub8 >= 4) v += t2; }
    return v;
}
__device__ __forceinline__ void k_l2_post2(unsigned GmA, unsigned EmA, int ntA, const KTok& kA, unsigned GmB, unsigned EmB, int ntB, const KTok& kB, int lane) {
    const int h = lane >> 3, sub8 = lane & 7;
    const int neqA = __builtin_popcount(EmA), neqB = __builtin_popcount(EmB);
    const int peA = ntA + (k_scan8(neqA, sub8) - neqA), peB = ntB + (k_scan8(neqB, sub8) - neqB);
    unsigned EA = EmA, EB = EmB; k_trim2(EA, min(max(16 - peA, 0), neqA), EB, min(max(16 - peB, 0), neqB));
    const unsigned MA = GmA | EA, MB = GmB | EB;
    const int cntA = __builtin_popcount(MA), cntB = __builtin_popcount(MB);
    k_compact2(MA, kA.s2c + h * 16 + (k_scan8(cntA, sub8) - cntA), kA.scratch, MB, kB.s2c + h * 16 + (k_scan8(cntB, sub8) - cntB), kB.scratch, sub8 * 32);
}
__device__ __forceinline__ void k_l2_keys(const KTok& k, int lane, unsigned (&key)[16]) {
    const int h = lane >> 3, sub8 = lane & 7;
    const unsigned aib = *(const LAS unsigned short*)(k.s1i + (2 * h) * 16 + 2 * sub8);
    const v4u bib = *(const LAS v4u*)(k.s1i + (2 * h + 1) * 16);
    LAS const unsigned short* ra = k.rowc + (2 * h) * 128; LAS const unsigned short* rb = ra + 128;
    const unsigned a0 = ra[aib & 0xffu], a1 = ra[aib >> 8];
    const half2_t a0x2 = __builtin_bit_cast(half2_t, a0 | (a0 << 16)), a1x2 = __builtin_bit_cast(half2_t, a1 | (a1 << 16));
    half2_t bp[8];
#pragma unroll
    for (int q = 0; q < 8; ++q) { const unsigned blo = rb[(bib[q >> 1] >> (16 * (q & 1))) & 0xffu], bhi = rb[(bib[q >> 1] >> (16 * (q & 1) + 8)) & 0xffu]; bp[q] = __builtin_bit_cast(half2_t, blo | (bhi << 16)); }
#pragma unroll
    for (int i = 0; i < 16; ++i) key[i] = hkey2(__builtin_bit_cast(unsigned, ((i < 8) ? a0x2 : a1x2) + bp[i & 7]));
}
__device__ __forceinline__ void k_l2_post(unsigned Gm, unsigned Em, int ntot, const KTok& k, int lane) {
    const int h = lane >> 3, sub8 = lane & 7;
    const int neq = __builtin_popcount(Em);
    int se = neq;
    { const int t2 = dppi<0x111>(se); if (sub8 >= 1) se += t2; }
    { const int t2 = dppi<0x112>(se); if (sub8 >= 2) se += t2; }
    { const int t2 = dppi<0x114>(se); if (sub8 >= 4) se += t2; }
    const int pe = ntot + (se - neq);
    const unsigned M = Gm | k_trim(Em, min(max(16 - pe, 0), neq));
    const int cnt = __builtin_popcount(M); int sc = cnt;
    { const int t1 = dppi<0x111>(sc); if (sub8 >= 1) sc += t1; }
    { const int t1 = dppi<0x112>(sc); if (sub8 >= 2) sc += t1; }
    { const int t1 = dppi<0x114>(sc); if (sub8 >= 4) sc += t1; }
    k_compact(M, k.s2c + h * 16 + (sc - cnt), k.scratch, sub8 * 32);
}
__device__ __forceinline__ void k_gates(int t, f32x4 rq, const KTok& k, int lane, const float* SU, const float* SV, unsigned short* IDX, float* GW, float* MU) {
    float rinv; { float sv_ = (rq[0] + rq[1]) + (rq[2] + rq[3]); sv_ += dppf<0xB1>(sv_); sv_ += dppf<0x4E>(sv_); rinv = __builtin_amdgcn_rsqf(sv_ * (1.f / D) + 1e-6f); }
#pragma unroll
    for (int kk = 0; kk < 2; ++kk) { const int kx = lane + 64 * kk, hh = kx >> 4; const unsigned cand = k.s2c[kx];
        const unsigned ia = k.s1i[(2 * hh) * 16 + (cand >> 4)], ib = k.s1i[(2 * hh + 1) * 16 + (cand & 15u)];
        const float sv = hlo((unsigned)k.rowc[(2 * hh) * 128 + ia]) + hlo((unsigned)k.rowc[(2 * hh + 1) * 128 + ib]); float mx = sv;
        mx = fmaxf(mx, dppf<0xB1>(mx)); mx = fmaxf(mx, dppf<0x4E>(mx)); mx = fmaxf(mx, dppf<0x141>(mx)); mx = fmaxf(mx, dppf<0x140>(mx));
        const float ex = __builtin_amdgcn_exp2f((sv - mx) * 1.4426950408889634f); float sum = ex;
        sum += dppf<0xB1>(sum); sum += dppf<0x4E>(sum); sum += dppf<0x141>(sum); sum += dppf<0x140>(sum);
        const unsigned ee = ia * 128u + ib; const size_t o = (size_t)t * 128 + (kx & 7) * 16 + (kx >> 3);
        IDX[o] = (unsigned short)ee; GW[o] = ex * __builtin_amdgcn_rcpf(sum) * SV[ee]; MU[o] = rinv * SU[ee]; }
}
struct KConv { f32x4 cr[4], cg[4], cp0; };
__device__ __forceinline__ void k_conv_load(const ConvNext& cv, int t, int lane, KConv& c) {
    const bool cu = t < NEXP; const float* rp = cu ? cv.u + (size_t)t * D : cv.v + (size_t)(t - NEXP) * D;
#pragma unroll
    for (int j = 0; j < 4; ++j) { c.cr[j] = *(const f32x4*)(rp + 16 * lane + 4 * j); c.cg[j] = *(const f32x4*)(cv.gain + 16 * lane + 4 * j); }
    c.cp0 = *(const f32x4*)(cv.p + ((size_t)t * 64 + lane) * 4);
}
__device__ __forceinline__ void k_conv_store(const ConvNext& cv, int t, int lane, KConv& c) {
    if (t < NEXP) {
#pragma unroll
        for (int j = 0; j < 4; ++j) c.cr[j] = c.cr[j] * c.cg[j];
        quant_store_i8(c.cr, cv.U8, t, cv.SU + t, lane); }
    else quant_store_i8(c.cr, cv.V8, t - NEXP, cv.SV + (t - NEXP), lane);
    { v2u w; w.x = pk2(c.cp0[0], c.cp0[1]); w.y = pk2(c.cp0[2], c.cp0[3]); *(v2u*)(cv.PB + ((size_t)t * 64 + lane) * 4) = w; }
}
__device__ __forceinline__ void peer_topk_phase(const unsigned short* S, const float* ssq_in, const float* SU, const float* SV, unsigned short* IDX, float* GW, float* MU,
                                                const ConvNext cv, LAS unsigned char* lds, int vcu, int G, int wave) {
    const int lane = lane_id_fresh();
    const KTok kA = ktok(lds + wave * 12288, lane), kB = ktok(lds + wave * 12288 + 6144, lane);
    const int gw = vcu * NWAVES + wave, NW = G * NWAVES;
    v4u nxA[4], nxB[4];
#define K_SROW(dst, tt) do { const v4u* sp_ = (const v4u*)(S + (size_t)min((tt), T - 1) * 2048 + lane * 32); _Pragma("unroll") for (int q = 0; q < 4; ++q) dst[q] = sp_[q]; } while (0)
    K_SROW(nxA, gw); K_SROW(nxB, gw + NW);
    for (int t = gw; t < T; t += 2 * NW) {
        const int tB = (t + NW < T) ? t + NW : t;
        v4u cwA[4], cwB[4];
#pragma unroll
        for (int q = 0; q < 4; ++q) { cwA[q] = nxA[q]; cwB[q] = nxB[q]; }
        const f32x4 rqA = *(const f32x4*)(ssq_in + (size_t)t * 16 + 4 * (lane & 3)), rqB = *(const f32x4*)(ssq_in + (size_t)tB * 16 + 4 * (lane & 3));
        K_SROW(nxA, t + 2 * NW); K_SROW(nxB, t + 3 * NW);
        KConv cA, cB; if (cv.on) { k_conv_load(cv, t, lane, cA); k_conv_load(cv, tB, lane, cB); }
        { unsigned keyA[16], keyB[16]; k_l1_keys(cwA, kA, lane, keyA); k_l1_keys(cwB, kB, lane, keyB);
          unsigned GmA, EmA, GmB, EmB; int nA, nB; topk_select16x2<4>(keyA, keyB, GmA, EmA, nA, GmB, EmB, nB);
          k_l1_post2(GmA, EmA, nA, kA, GmB, EmB, nB, kB, lane); }
        LDS_WAIT();
        { unsigned keyA[16], keyB[16]; k_l2_keys(kA, lane, keyA); k_l2_keys(kB, lane, keyB);
          unsigned GmA, EmA, GmB, EmB; int nA, nB; topk_select16x2<8>(keyA, keyB, GmA, EmA, nA, GmB, EmB, nB);
          k_l2_post2(GmA, EmA, nA, kA, GmB, EmB, nB, kB, lane); }
        LDS_WAIT();
        k_gates(t, rqA, kA, lane, SU, SV, IDX, GW, MU); k_gates(tB, rqB, kB, lane, SU, SV, IDX, GW, MU);
        if (cv.on) {
            if ((t < NEXP) == (tB < NEXP)) {
                if (t < NEXP) {
#pragma unroll
                    for (int j = 0; j < 4; ++j) { cA.cr[j] = cA.cr[j] * cA.cg[j]; cB.cr[j] = cB.cr[j] * cB.cg[j]; }
                    quant_store_i8(cA.cr, cv.U8, t, cv.SU + t, lane); quant_store_i8(cB.cr, cv.U8, tB, cv.SU + tB, lane); }
                else { quant_store_i8(cA.cr, cv.V8, t - NEXP, cv.SV + (t - NEXP), lane); quant_store_i8(cB.cr, cv.V8, tB - NEXP, cv.SV + (tB - NEXP), lane); }
                { v2u w; w.x = pk2(cA.cp0[0], cA.cp0[1]); w.y = pk2(cA.cp0[2], cA.cp0[3]); *(v2u*)(cv.PB + ((size_t)t * 64 + lane) * 4) = w; }
                { v2u w; w.x = pk2(cB.cp0[0], cB.cp0[1]); w.y = pk2(cB.cp0[2], cB.cp0[3]); *(v2u*)(cv.PB + ((size_t)tB * 64 + lane) * 4) = w; }
            } else { k_conv_store(cv, t, lane, cA); k_conv_store(cv, tB, lane, cB); } }
        LDS_WAIT();
    }
#undef K_SROW
}
__device__ __forceinline__ int dot4_first(int a, int b) { int r; asm("v_dot4_i32_i8 %0, %1, %2, 0" : "=v"(r) : "v"(a), "v"(b)); return r; }
__device__ __forceinline__ unsigned peer_off_lo(unsigned w, unsigned m, unsigned a) { unsigned r; asm("v_mad_u32_u16 %0, %1, %2, %3" : "=v"(r) : "v"(w), "s"(m), "v"(a)); return r; }
__device__ __forceinline__ unsigned peer_off_hi(unsigned w, unsigned m, unsigned a) { unsigned r; asm("v_mad_u32_u16 %0, %1, %2, %3 op_sel:[1,0,0,0]" : "=v"(r) : "v"(w), "s"(m), "v"(a)); return r; }
#define PEER_ISSUE8(buf, o, idw, TAB) do { _Pragma("unroll") for (int b = 0; b < 8; ++b) { \
        const unsigned off = (b & 1) ? peer_off_hi((idw)[b >> 1], 128u, taboff) : peer_off_lo((idw)[b >> 1], 128u, taboff); \
        buf[(o) + b] = *(const v4u*)((TAB) + (size_t)off); } } while (0)
#define PEER_ISSUE16(buf, i0, i1, TAB) do { PEER_ISSUE8(buf, 0, i0, TAB); PEER_ISSUE8(buf, 8, i1, TAB); } while (0)
template <int M> __device__ __forceinline__ unsigned swz8(unsigned v) { return (unsigned)__builtin_amdgcn_ds_swizzle((int)v, 0x18 | (M << 5)); }
#define SWZ8(v, m) swz8<m>(v)
#define PEER_ISSUE_U1(buf, iw, TAB, p) do { const unsigned w_ = swz8<p>(iw); \
        buf[2 * (p)] = *(const v4u*)((TAB) + (size_t)peer_off_lo(w_, 128u, taboff)); buf[2 * (p) + 1] = *(const v4u*)((TAB) + (size_t)peer_off_hi(w_, 128u, taboff)); } while (0)
#define PEER_ISSUE_U(buf, iw, TAB) do { PEER_ISSUE_U1(buf, iw, TAB, 0); PEER_ISSUE_U1(buf, iw, TAB, 1); PEER_ISSUE_U1(buf, iw, TAB, 2); PEER_ISSUE_U1(buf, iw, TAB, 3); \
        PEER_ISSUE_U1(buf, iw, TAB, 4); PEER_ISSUE_U1(buf, iw, TAB, 5); PEER_ISSUE_U1(buf, iw, TAB, 6); PEER_ISSUE_U1(buf, iw, TAB, 7); } while (0)
#define PEER_ISSUE_V1(buf, r, TAB, m) do { const unsigned w0_ = swz8<m>((r).x), w1_ = swz8<m>((r).y); \
        buf[4 * (m)] = *(const v4u*)((TAB) + (size_t)peer_off_lo(w0_, 128u, taboff)); buf[4 * (m) + 1] = *(const v4u*)((TAB) + (size_t)peer_off_hi(w0_, 128u, taboff)); \
        buf[4 * (m) + 2] = *(const v4u*)((TAB) + (size_t)peer_off_lo(w1_, 128u, taboff)); buf[4 * (m) + 3] = *(const v4u*)((TAB) + (size_t)peer_off_hi(w1_, 128u, taboff)); } while (0)
#define PEER_ISSUE_V(buf, r, TAB) do { PEER_ISSUE_V1(buf, r, TAB, 0); PEER_ISSUE_V1(buf, r, TAB, 1); PEER_ISSUE_V1(buf, r, TAB, 2); PEER_ISSUE_V1(buf, r, TAB, 3); } while (0)
#define PEER_PIN4(v) asm volatile("" : "+v"((v).x), "+v"((v).y), "+v"((v).z), "+v"((v).w))
#define VPTR(base, rowbytes, tt, off) ((const char*)(base) + (size_t)(tt) * (rowbytes) + (off))
template <int LIGHT>
__device__ __forceinline__ void peer_u_phase(const unsigned short* IDX, const bf16* XB, const unsigned char* U8, unsigned short* PART, int bid, int G, int wave) {
    const int lane = lane_id_fresh(), j = lane >> 3, c = lane & 7;
    const int NS = G < 8 ? G : 8, rank = bid / NS, nrank = (G - (bid % NS) + NS - 1) / NS;
    for (int s = bid % NS; s < 8; s += NS) {
        const unsigned coloff = (unsigned)(s * 128 + c * 16), taboff = (unsigned)(s * (NEXP * 128) + c * 16);
        const int stride = nrank * NWAVES;
        unsigned short* part = PART + (size_t)s * T * 128;
        unsigned o_idx = (unsigned)(j * 32 + c * 4), o_x = coloff * 2u + (unsigned)((j & 1) * 16), o_p = (unsigned)(j * 32 + c * 4); const bool xhalf = (j & 1) != 0;
#define PEER_U_TOKEN(buf, xh, tt) do { \
              \
            v4u xa, xb; { v4u ph; _Pragma("unroll") for (int k = 0; k < 4; ++k) ph[k] = (unsigned)dppi<0x128>((int)(xh)[k]); \
                _Pragma("unroll") for (int k = 0; k < 4; ++k) { xa[k] = xhalf ? ph[k] : (xh)[k]; xb[k] = xhalf ? (xh)[k] : ph[k]; } } \
            const float xv[16] = {bflo(xa.x), bfhi(xa.x), bflo(xa.y), bfhi(xa.y), bflo(xa.z), bfhi(xa.z), bflo(xa.w), bfhi(xa.w), bflo(xb.x), bfhi(xb.x), bflo(xb.y), bfhi(xb.y), bflo(xb.z), bfhi(xb.z), bflo(xb.w), bfhi(xb.w)}; \
              \
            float am = 0.f; _Pragma("unroll") for (int i = 0; i < 16; ++i) am = fmaxf(am, fabsf(xv[i])); \
            { unsigned ab = __builtin_bit_cast(unsigned, am); ab = max(ab, (unsigned)dppi<0xB1>((int)ab)); ab = max(ab, (unsigned)dppi<0x4E>((int)ab)); ab = max(ab, (unsigned)dppi<0x141>((int)ab)); am = __builtin_bit_cast(float, ab); }   \
            const float xinv = am > 0.f ? 127.f / am : 0.f, xsc = am * (0.015625f / 127.f)  ; \
            int xq[4]; _Pragma("unroll") for (int q = 0; q < 4; ++q) xq[q] = (int)pack_i8x4((f32x4){xv[4 * q], xv[4 * q + 1], xv[4 * q + 2], xv[4 * q + 3]}, xinv); \
            int dd[16]; \
            _Pragma("unroll") for (int b = 0; b < 16; ++b) { PEER_PIN4(buf[b]); \
                if (LIGHT) { dd[b] = (int)((buf[b].x ^ buf[b].y) ^ (buf[b].z ^ buf[b].w)) + xq[b & 3]; continue; } \
                int d = dot4_first((int)buf[b].x, xq[0]); d = __builtin_amdgcn_sdot4((int)buf[b].y, xq[1], d, false); \
                d = __builtin_amdgcn_sdot4((int)buf[b].z, xq[2], d, false); dd[b] = __builtin_amdgcn_sdot4((int)buf[b].w, xq[3], d, false); } \
              \
            const bool cb2 = (c & 4) != 0, cb1 = (c & 2) != 0, cb0 = (c & 1) != 0; \
            int e8[8], e4[4], e2[2]; \
            _Pragma("unroll") for (int k = 0; k < 8; ++k) { const int keep = cb2 ? dd[8 + k] : dd[k], send = cb2 ? dd[k] : dd[8 + k]; e8[k] = keep + dppi<0x141>(send); } \
            _Pragma("unroll") for (int k = 0; k < 4; ++k) { const int keep = cb1 ? e8[4 + k] : e8[k], send = cb1 ? e8[k] : e8[4 + k]; e4[k] = keep + dppi<0x1B>(send); } \
            _Pragma("unroll") for (int k = 0; k < 2; ++k) { const int keep = cb0 ? e4[2 + k] : e4[k], send = cb0 ? e4[k] : e4[2 + k]; e2[k] = keep + dppi<0xB1>(send); } \
            *(unsigned*)VPTR(part, 256, tt, o_p) = pkh2((float)e2[0] * xsc, (float)e2[1] * xsc); } while (0)
        v4u bufA[16], bufB[16], xA, xB; unsigned iA = 0u, iB = 0u;
        xA = xB = (v4u){0u, 0u, 0u, 0u};
        int t = rank * NWAVES + wave;
        if (t + 3 * stride < T) {
            { iA = *(const unsigned*)VPTR(IDX, 256, t, o_idx); xA = *(const v4u*)VPTR(XB, 2048, t, o_x); }
            { iB = *(const unsigned*)VPTR(IDX, 256, t + stride, o_idx); }
            PEER_ISSUE_U(bufA, iA, U8);
        do {
            asm volatile("" : "+v"(o_idx), "+v"(o_x), "+v"(o_p));
            const int t1 = t + stride, t2 = t1 + stride, t3 = t2 + stride;
            { iA = *(const unsigned*)VPTR(IDX, 256, t2, o_idx); }
            PEER_ISSUE_U(bufB, iB, U8);
            { xB = *(const v4u*)VPTR(XB, 2048, t1, o_x); }
            PEER_U_TOKEN(bufA, xA, t);
            { iB = *(const unsigned*)VPTR(IDX, 256, t3, o_idx); }
            PEER_ISSUE_U(bufA, iA, U8);
            { xA = *(const v4u*)VPTR(XB, 2048, t2, o_x); }
            PEER_U_TOKEN(bufB, xB, t1);
            t = t2;
        } while (t + 3 * stride < T);
        } else {
        if (t < T) { iA = *(const unsigned*)VPTR(IDX, 256, t, o_idx); xA = *(const v4u*)VPTR(XB, 2048, t, o_x); }
        if (t + stride < T) { iB = *(const unsigned*)VPTR(IDX, 256, t + stride, o_idx); }
        if (t < T) PEER_ISSUE_U(bufA, iA, U8);
        }
        while (t < T) {
            asm volatile("" : "+v"(o_idx), "+v"(o_x), "+v"(o_p));
            const int t1 = t + stride, t2 = t1 + stride, t3 = t2 + stride;
            if (t1 < T) { PEER_ISSUE_U(bufB, iB, U8); xB = *(const v4u*)VPTR(XB, 2048, t1, o_x); }
            if (t2 < T) { iA = *(const unsigned*)VPTR(IDX, 256, t2, o_idx); }
            PEER_U_TOKEN(bufA, xA, t);
            if (t1 < T) {
                if (t2 < T) { PEER_ISSUE_U(bufA, iA, U8); xA = *(const v4u*)VPTR(XB, 2048, t2, o_x); }
                if (t3 < T) { iB = *(const unsigned*)VPTR(IDX, 256, t3, o_idx); }
                PEER_U_TOKEN(bufB, xB, t1);
            }
            t = t2;
        }
#undef PEER_U_TOKEN
    }
}
__device__ __forceinline__ void peer_w_phase(const unsigned short* PART, const float* GW, const float* MU, const unsigned short* IDX, unsigned* VREC, int bid, int G, int wave) {
    const int tid = wave * 64 + lane_id_fresh(), gtid = bid * NTHR + tid, NT = G * NTHR;
#define PEER_W_LOAD(i_, p_, mu0_, mu1_, gw0_, gw1_, ids_) do { const size_t o_ = (size_t)min((i_), T * 16 - 1) * 8; _Pragma("unroll") for (int s = 0; s < 8; ++s) p_[s] = *(const v4u*)(PART + (size_t)s * T * 128 + o_); \
        mu0_ = *(const f32x4*)(MU + o_); mu1_ = *(const f32x4*)(MU + o_ + 4); gw0_ = *(const f32x4*)(GW + o_); gw1_ = *(const f32x4*)(GW + o_ + 4); ids_ = *(const v4u*)(IDX + o_); } while (0)
    v4u np[8]; f32x4 nmu0, nmu1, ngw0, ngw1; v4u nids;
    PEER_W_LOAD(gtid, np, nmu0, nmu1, ngw0, ngw1, nids);
    for (int i = gtid; i < T * 16; i += NT) {
        v4u p[8]; f32x4 mu0 = nmu0, mu1 = nmu1, gw0 = ngw0, gw1 = ngw1; const v4u ids = nids;
#pragma unroll
        for (int s = 0; s < 8; ++s) p[s] = np[s];
        PEER_W_LOAD(i + NT, np, nmu0, nmu1, ngw0, ngw1, nids);
        f32x4 a0 = {0.f, 0.f, 0.f, 0.f}, a1 = {0.f, 0.f, 0.f, 0.f}, w0, w1;
#pragma unroll
        for (int s = 0; s < 8; ++s) { a0 += (f32x4){hlo(p[s].x), hhi(p[s].x), hlo(p[s].y), hhi(p[s].y)}; a1 += (f32x4){hlo(p[s].z), hhi(p[s].z), hlo(p[s].w), hhi(p[s].w)}; }
#pragma unroll
        for (int q = 0; q < 4; ++q) { w0[q] = gw0[q] * gelu_tanh(a0[q] * 64.f * mu0[q]); w1[q] = gw1[q] * gelu_tanh(a1[q] * 64.f * mu1[q]); }
        float am = fmaxf(fmaxf(fmaxf(fabsf(w0[0]), fabsf(w0[1])), fmaxf(fabsf(w0[2]), fabsf(w0[3]))), fmaxf(fmaxf(fabsf(w1[0]), fabsf(w1[1])), fmaxf(fabsf(w1[2]), fabsf(w1[3]))));
        { unsigned ab = __builtin_bit_cast(unsigned, am); ab = max(ab, (unsigned)dppi<0xB1>((int)ab)); ab = max(ab, (unsigned)dppi<0x4E>((int)ab)); ab = max(ab, (unsigned)dppi<0x141>((int)ab)); ab = max(ab, (unsigned)dppi<0x140>((int)ab));
          am = __builtin_bit_cast(float, ab); }
        const float winv = am > 0.f ? 127.f / am : 0.f; const unsigned sc = __builtin_bit_cast(unsigned, am * (1.f / 127.f));
        unsigned* rec = VREC + (size_t)(i >> 1) * 16; const int h8 = i & 1;
        *(v4u*)(rec + 4 * h8) = ids; *(v2u*)(rec + 8 + 2 * h8) = (v2u){pack_i8x4(w0, winv), pack_i8x4(w1, winv)}; *(v2u*)(rec + 12 + 2 * h8) = (v2u){sc, sc}; }
#undef PEER_W_LOAD
}
__device__ __forceinline__ void peer_v_phase(const unsigned* VREC, const unsigned char* V8, const bf16* XB, bf16* XBo, float* ssq_out, int bid, int G, int wave) {
    const int lane = lane_id_fresh(), j = lane >> 3, c = lane & 7;
    const int NS = G < 8 ? G : 8, rank = bid / NS, nrank = (G - (bid % NS) + NS - 1) / NS;
    for (int s = bid % NS; s < 8; s += NS) {
        const unsigned coloff = (unsigned)(s * 128 + c * 16), taboff = (unsigned)(s * (NEXP * 128) + c * 16);
        const int stride = nrank * NWAVES;
        unsigned o_rec = (unsigned)(j * 64 + c * 8), o_xb = (coloff + 2u * j) * 2u;
#define PEER_V_TOKEN(buf, w, xr, tt) do { \
              \
            const float wsc = __builtin_bit_cast(float, SWZ8((w).x, 6)); const int wq[4] = {(int)SWZ8((w).x, 4), (int)SWZ8((w).y, 4), (int)SWZ8((w).x, 5), (int)SWZ8((w).y, 5)}; \
            int ia[16]; \
            _Pragma("unroll") for (int B = 0; B < 4; ++B) { PEER_PIN4(buf[4 * B]); PEER_PIN4(buf[4 * B + 1]); PEER_PIN4(buf[4 * B + 2]); PEER_PIN4(buf[4 * B + 3]); \
                _Pragma("unroll") for (int q = 0; q < 4; ++q) { const unsigned D0 = buf[4 * B][q], D1 = buf[4 * B + 1][q], D2 = buf[4 * B + 2][q], D3 = buf[4 * B + 3][q]; \
                    const unsigned P0 = __builtin_amdgcn_perm(D1, D0, 0x05010400u), P1 = __builtin_amdgcn_perm(D1, D0, 0x07030602u), Q0 = __builtin_amdgcn_perm(D3, D2, 0x05010400u), Q1 = __builtin_amdgcn_perm(D3, D2, 0x07030602u); \
                    ia[4 * q + 0] = (B == 0) ? dot4_first((int)__builtin_amdgcn_perm(Q0, P0, 0x05040100u), wq[0]) : __builtin_amdgcn_sdot4((int)__builtin_amdgcn_perm(Q0, P0, 0x05040100u), wq[B], ia[4 * q + 0], false); \
                    ia[4 * q + 1] = (B == 0) ? dot4_first((int)__builtin_amdgcn_perm(Q0, P0, 0x07060302u), wq[0]) : __builtin_amdgcn_sdot4((int)__builtin_amdgcn_perm(Q0, P0, 0x07060302u), wq[B], ia[4 * q + 1], false); \
                    ia[4 * q + 2] = (B == 0) ? dot4_first((int)__builtin_amdgcn_perm(Q1, P1, 0x05040100u), wq[0]) : __builtin_amdgcn_sdot4((int)__builtin_amdgcn_perm(Q1, P1, 0x05040100u), wq[B], ia[4 * q + 2], false); \
                    ia[4 * q + 3] = (B == 0) ? dot4_first((int)__builtin_amdgcn_perm(Q1, P1, 0x07060302u), wq[0]) : __builtin_amdgcn_sdot4((int)__builtin_amdgcn_perm(Q1, P1, 0x07060302u), wq[B], ia[4 * q + 3], false); } } \
              \
            int e2a, e2b, e2c, e2d; const bool b3 = (lane & 8) != 0; \
            { int p0 = ia[0], q0 = ia[8], p1 = ia[1], q1 = ia[9], p2 = ia[2], q2 = ia[10], p3 = ia[3], q3 = ia[11], p4 = ia[4], q4 = ia[12], p5 = ia[5], q5 = ia[13], p6 = ia[6], q6 = ia[14], p7 = ia[7], q7 = ia[15]; \
              asm volatile("s_nop 1\n\tv_permlane32_swap_b32 %0, %1\n\tv_permlane32_swap_b32 %2, %3\n\tv_permlane32_swap_b32 %4, %5\n\tv_permlane32_swap_b32 %6, %7\n\t" \
                           "v_permlane32_swap_b32 %8, %9\n\tv_permlane32_swap_b32 %10, %11\n\tv_permlane32_swap_b32 %12, %13\n\tv_permlane32_swap_b32 %14, %15" \
                           : "+v"(p0), "+v"(q0), "+v"(p1), "+v"(q1), "+v"(p2), "+v"(q2), "+v"(p3), "+v"(q3), "+v"(p4), "+v"(q4), "+v"(p5), "+v"(q5), "+v"(p6), "+v"(q6), "+v"(p7), "+v"(q7)); \
              int s0 = p0 + q0, s1 = p1 + q1, s2 = p2 + q2, s3 = p3 + q3, s4_ = p4 + q4, s5 = p5 + q5, s6 = p6 + q6, s7 = p7 + q7; \
              asm volatile("s_nop 1\n\tv_permlane16_swap_b32 %0, %1\n\tv_permlane16_swap_b32 %2, %3\n\tv_permlane16_swap_b32 %4, %5\n\tv_permlane16_swap_b32 %6, %7" \
                           : "+v"(s0), "+v"(s4_), "+v"(s1), "+v"(s5), "+v"(s2), "+v"(s6), "+v"(s3), "+v"(s7)); \
              e2a = s0 + s4_; e2b = s1 + s5; e2c = s2 + s6; e2d = s3 + s7; } \
            int r1x, r1y; { const int kx = b3 ? e2c : e2a, ky = b3 ? e2d : e2b, sx = b3 ? e2a : e2c, sy = b3 ? e2b : e2d; r1x = kx + dppi<0x128>(sx); r1y = ky + dppi<0x128>(sy); } \
            struct { float x, y; } r1 = {(float)r1x * wsc, (float)r1y * wsc}; \
            f32x2 xn = {bflo(xr) + r1.x, bfhi(xr) + r1.y}; \
            *(unsigned*)VPTR(XBo, 2048, tt, o_xb) = pk2(xn[0], xn[1]); \
            const float sq = wave_sum_dpp(xn[0] * xn[0] + xn[1] * xn[1]); SQOUT(sq, tt); } while (0)
        v4u bufA[16], bufB[16]; v2u rA = {0u, 0u}, rB = {0u, 0u}, rC = {0u, 0u};
        unsigned xrA = 0u, xrB = 0u;
#define PEER_V_REC(tt) (*(const v2u*)VPTR(VREC, 512, tt, o_rec))
#define PEER_V_XR(tt) (*(const unsigned*)VPTR(XB, 2048, tt, o_xb))
        int t = rank * NWAVES + wave;
        if (t + 3 * stride < T) {
            rA = PEER_V_REC(t); xrA = PEER_V_XR(t); rB = PEER_V_REC(t + stride);
            PEER_ISSUE_V(bufA, rA, V8);
        float sqA = 0.f;
#define SQOUT(v, tt) do { if ((tt) == t) sqA = (v); else if (lane < 2) ssq_out[(size_t)(lane ? (tt) : t) * 16 + s] = lane ? (v) : sqA; } while (0)
        do {
            asm volatile("" : "+v"(o_rec), "+v"(o_xb));
            const int t1 = t + stride, t2 = t1 + stride, t3 = t2 + stride;
            rC = PEER_V_REC(t2);
            PEER_ISSUE_V(bufB, rB, V8); xrB = PEER_V_XR(t1);
            PEER_V_TOKEN(bufA, rA, xrA, t);
            rA = rC; rC = PEER_V_REC(t3);
            PEER_ISSUE_V(bufA, rA, V8); xrA = PEER_V_XR(t2);
            PEER_V_TOKEN(bufB, rB, xrB, t1);
            rB = rC;
            t = t2;
        } while (t + 3 * stride < T);
#undef SQOUT
        } else {
        if (t < T) { rA = PEER_V_REC(t); xrA = PEER_V_XR(t); }
        if (t + stride < T) rB = PEER_V_REC(t + stride);
        if (t < T) PEER_ISSUE_V(bufA, rA, V8);
        }
#define SQOUT(v, tt) do { if (lane == 0) ssq_out[(size_t)(tt) * 16 + s] = (v); } while (0)
        while (t < T) {
            asm volatile("" : "+v"(o_rec), "+v"(o_xb));
            const int t1 = t + stride, t2 = t1 + stride, t3 = t2 + stride;
            if (t2 < T) rC = PEER_V_REC(t2);
            if (t1 < T) { PEER_ISSUE_V(bufB, rB, V8); xrB = PEER_V_XR(t1); }
            PEER_V_TOKEN(bufA, rA, xrA, t);
            if (t1 < T) {
                rA = rC; if (t3 < T) rC = PEER_V_REC(t3);
                if (t2 < T) { PEER_ISSUE_V(bufA, rA, V8); xrA = PEER_V_XR(t2); }
                PEER_V_TOKEN(bufB, rB, xrB, t1);
                rB = rC;
            }
            t = t2;
        }
#undef SQOUT
#undef PEER_V_REC
#undef PEER_V_XR
#undef PEER_V_TOKEN
    }
}
#undef PEER_ISSUE8
#undef PEER_ISSUE16
#undef PEER_PIN4
#undef VPTR

constexpr int AT_KST = 24576, AT_KPE = 16384, AT_VBASE = 3 * AT_KST, AT_VST = 16384;
constexpr int ATTN_LDS = AT_VBASE + 4 * AT_VST;
__device__ __forceinline__ void attn_phase(const bf16* Q, const bf16* KN, const bf16* KPE, const bf16* VT, bf16* AO, LAS unsigned char* lds, int vcu, int G, int wave) {
    const int lane = lane_id_fresh(), tid = wave * 64 + lane;
    const int rho = lane & 31, hh = lane >> 5;
    const int krow = (rho & 0x13) | ((rho & 4) << 1) | ((rho & 8) >> 1);
    const bool lag = wave >= 4;
    for (int it = vcu; it < 1024; it += G) {
        const int c = it & 255, kq = it >> 8, bh = c >> 2, q4 = c & 3;
        const int qb = (kq == 0) ? 15 - q4 : (kq == 1) ? q4 : (kq == 2) ? 8 + q4 : 7 - q4;
        const int b = bh >> 3, h = bh & 7;
        const int q0 = qb * 256, qlo = q0 + wave * 32, trow0 = b * SEQ + qlo;
        f32x16 o[4];
#pragma unroll
        for (int d = 0; d < 4; ++d)
#pragma unroll
            for (int r = 0; r < 16; ++r) o[d][r] = 0.f;
        float m_run = -1e30f, l_run = 0.f;
        const int nkt = 4 * (qb + 1);
        unsigned vk[2], vp, vv[2];
#pragma unroll
        for (int i = 0; i < 2; ++i) { const int id = tid + 512 * i; { const int row = id >> 4, cc = (id & 15) ^ (row & 15); vk[i] = (unsigned)(row * (D * 2) + cc * 16); }
            { const int row = id >> 3, cc = (id & 7) ^ ((row >> 1) & 7); vv[i] = (unsigned)row * (unsigned)(T * 2) + (unsigned)(cc * 16); } }
        { const int row = tid >> 3, cc = (tid & 7) ^ ((row >> 1) & 7); vp = (unsigned)(row * (QKR * 2) + cc * 16); }
        const unsigned ldsb = (unsigned)(size_t)lds + (unsigned)wave * 1024u;
#define AT_DMA(sbase, voff, ldsdst) do { unsigned _keep; asm volatile("s_mov_b32 %0, m0\n\ts_mov_b32 m0, %3\n\ts_nop 4\n\tglobal_load_lds_dwordx4 %1, %2\n\ts_mov_b32 m0, %0" \
            : "=&s"(_keep) : "v"(voff), "s"(sbase), "s"(ldsdst) : "memory"); } while (0)
#define AT_STAGE_TILE(kt, ks, vs) do { const int tk0 = b * SEQ + (kt) * 64; const unsigned kb2 = ldsb + (unsigned)(ks) * AT_KST, vb2 = ldsb + AT_VBASE + (unsigned)(vs) * AT_VST; \
            const bf16* kb_ = KN + (size_t)tk0 * D + h * QKN; const bf16* pb_ = KPE + (size_t)tk0 * QKR; const bf16* vb_ = VT + (size_t)(h * VH) * T + tk0; \
            AT_DMA(kb_, vk[0], kb2); AT_DMA(kb_, vk[1], kb2 + 8192u); AT_DMA(pb_, vp, kb2 + AT_KPE); AT_DMA(vb_, vv[0], vb2); AT_DMA(vb_, vv[1], vb2 + 8192u); } while (0)
#define AT_SYNC() asm volatile("s_waitcnt vmcnt(0) lgkmcnt(0)\n\ts_barrier" ::: "memory")
#define AT_SYNC5() asm volatile("s_waitcnt vmcnt(5) lgkmcnt(0)\n\ts_barrier" ::: "memory")
#define AT_KADDR(kb, s) ((s) < 8 ? st + ((kb) * 32 + krow) * 256 + (((2 * (s) + hh) ^ (krow & 15)) << 4) : st + AT_KPE + ((kb) * 32 + krow) * 128 + (((2 * ((s) - 8) + hh) ^ ((((kb) * 32 + krow) >> 1) & 7)) << 4))
#define AT_KREAD(dst, kb, s0) do { _Pragma("unroll") for (int i = 0; i < 6; ++i) dst[i] = *(const LAS bf16x8*)AT_KADDR(kb, (s0) + i); } while (0)
#define AT_KMMA(src_, kb, s0) do { _Pragma("unroll") for (int i = 0; i < 6; ++i) sacc[kb] = __builtin_amdgcn_mfma_f32_32x32x16_bf16(src_[i], qf[(s0) + i], sacc[kb], 0, 0, 0); } while (0)
#define AT_QK(ks) do { const LAS unsigned char* st = lds + (ks) * AT_KST; bf16x8 fx[6], fy[6]; __builtin_amdgcn_s_setprio(1); \
            _Pragma("unroll") for (int kb = 0; kb < 2; ++kb) _Pragma("unroll") for (int r = 0; r < 16; ++r) sacc[kb][r] = 0.f; \
            AT_KREAD(fx, 0, 0); AT_KREAD(fy, 0, 6); \
            AT_KMMA(fx, 0, 0); __builtin_amdgcn_sched_barrier(0); AT_KREAD(fx, 1, 0); \
            AT_KMMA(fy, 0, 6); __builtin_amdgcn_sched_barrier(0); AT_KREAD(fy, 1, 6); \
            AT_KMMA(fx, 1, 0); AT_KMMA(fy, 1, 6); __builtin_amdgcn_s_setprio(0); } while (0)
#define AT_SM(key0v) do { \
            if ((key0v) + 63 > qlo) { const int qpos = qlo + rho; \
                _Pragma("unroll") for (int kb = 0; kb < 2; ++kb) \
                    _Pragma("unroll") for (int r = 0; r < 16; ++r) { const int kpos = (key0v) + 32 * kb + (r & 3) + 4 * ((r >> 2) & 1) + 8 * hh + 16 * (r >> 3); if (kpos > qpos) sacc[kb][r] = -1e30f; } } \
            AT_SM_NM(); } while (0)
#define AT_SM_NM() do { \
            float mx = sacc[0][0]; \
            _Pragma("unroll") for (int kb = 0; kb < 2; ++kb) \
                _Pragma("unroll") for (int r = 0; r < 16; ++r) mx = fmaxf(mx, sacc[kb][r]); \
            mx = fmaxf(mx, shx<32>(mx, lane)); \
            const float m_new = fmaxf(m_run, mx), alpha = __builtin_amdgcn_exp2f(m_run - m_new); m_run = m_new; \
            float lsum = 0.f; \
            _Pragma("unroll") for (int kb = 0; kb < 2; ++kb) \
                _Pragma("unroll") for (int r = 0; r < 16; ++r) { const float p = __builtin_amdgcn_exp2f(sacc[kb][r] - m_new); sacc[kb][r] = p; lsum += p; } \
            l_run = l_run * alpha + lsum; \
            _Pragma("unroll") for (int d = 0; d < 4; ++d) \
                _Pragma("unroll") for (int r = 0; r < 16; ++r) o[d][r] *= alpha; \
            _Pragma("unroll") for (int s2 = 0; s2 < 4; ++s2) { const int kb = s2 >> 1, r0 = 8 * (s2 & 1); v4u w; \
                w.x = pk2(sacc[kb][r0 + 0], sacc[kb][r0 + 1]); w.y = pk2(sacc[kb][r0 + 2], sacc[kb][r0 + 3]); w.z = pk2(sacc[kb][r0 + 4], sacc[kb][r0 + 5]); w.w = pk2(sacc[kb][r0 + 6], sacc[kb][r0 + 7]); \
                pf[s2] = __builtin_bit_cast(bf16x8, w); } } while (0)
#define AT_VREAD(dst, d) do { const int row = (d) * 32 + rho; _Pragma("unroll") for (int s2 = 0; s2 < 4; ++s2) dst[s2] = *(const LAS bf16x8*)(sv + row * 128 + (((2 * s2 + hh) ^ ((row >> 1) & 7)) << 4)); } while (0)
#define AT_VMMA(src_, d) do { _Pragma("unroll") for (int s2 = 0; s2 < 4; ++s2) o[d] = __builtin_amdgcn_mfma_f32_32x32x16_bf16(src_[s2], pf[s2], o[d], 0, 0, 0); } while (0)
#define AT_PV(vs) do { const LAS unsigned char* sv = lds + AT_VBASE + (vs) * AT_VST; bf16x8 gx[4], gy[4]; __builtin_amdgcn_s_setprio(1); \
            AT_VREAD(gx, 0); AT_VREAD(gy, 1); \
            AT_VMMA(gx, 0); __builtin_amdgcn_sched_barrier(0); AT_VREAD(gx, 2); \
            AT_VMMA(gy, 1); __builtin_amdgcn_sched_barrier(0); AT_VREAD(gy, 3); \
            AT_VMMA(gx, 2); AT_VMMA(gy, 3); __builtin_amdgcn_s_setprio(0); } while (0)
        AT_SYNC();
        AT_STAGE_TILE(0, 0, 0); AT_STAGE_TILE(1, 1, 1);
        bf16x8 qf[12];
        { const bf16* qp = Q + (size_t)(trow0 + rho) * (NHEAD * DQK) + h * DQK + hh * 8;
#pragma unroll
          for (int s = 0; s < 12; ++s) qf[s] = *(const bf16x8*)(qp + 16 * s);
#pragma unroll
          for (int s = 0; s < 12; ++s) asm volatile("" : "+v"(qf[s])); }
        AT_SYNC5();
        bf16x8 pf[4];
#pragma unroll
        for (int s2 = 0; s2 < 4; ++s2) pf[s2] = (bf16x8){0, 0, 0, 0, 0, 0, 0, 0};
        int ks = 0, vs = 0;
        bool have = false; int pvs = 0;
        int kt = 0;
        const int nfull = 4 * qb;
        if (!lag) {
            for (; kt < nfull; ++kt) {
                AT_STAGE_TILE(kt + 2, (ks == 0 ? 2 : ks - 1), ((vs + 2) & 3));
                { f32x16 sacc[2]; AT_QK(ks); AT_SM_NM(); }
                AT_PV(vs);
                AT_SYNC5();
                ks = (ks == 2) ? 0 : ks + 1; vs = (vs + 1) & 3;
            }
        } else if (nfull > 0) {
            { AT_STAGE_TILE(2, 2, 2); { f32x16 sacc[2]; AT_QK(0); AT_SM_NM(); } have = true; pvs = 0; AT_SYNC5(); ks = 1; vs = 1; kt = 1; }
            for (; kt < nfull; ++kt) {
                AT_STAGE_TILE(kt + 2, (ks == 0 ? 2 : ks - 1), ((vs + 2) & 3));
                AT_PV(pvs);
                { f32x16 sacc[2]; AT_QK(ks); AT_SM_NM(); }
                pvs = vs;
                AT_SYNC5();
                ks = (ks == 2) ? 0 : ks + 1; vs = (vs + 1) & 3;
            }
        }
        for (; kt < nkt; ++kt) {
            if (kt + 2 < nkt) AT_STAGE_TILE(kt + 2, (ks == 0 ? 2 : ks - 1), ((vs + 2) & 3));
            const int key0 = kt * 64;
            const bool vis = key0 <= qlo + 31;
            if (have) AT_PV(pvs);
            if (vis) { f32x16 sacc[2]; AT_QK(ks); AT_SM(key0); }
            if (lag) { have = vis; pvs = vs; } else if (vis) AT_PV(vs);
            if (kt + 2 < nkt) AT_SYNC5(); else AT_SYNC();
            ks = (ks == 2) ? 0 : ks + 1; vs = (vs + 1) & 3;
        }
        if (lag && have) AT_PV(pvs);
#undef AT_DMA
#undef AT_STAGE_TILE
#undef AT_SYNC
#undef AT_SYNC5
#undef AT_QK
#undef AT_SM
#undef AT_SM_NM
#undef AT_PV
#undef AT_KADDR
#undef AT_KREAD
#undef AT_KMMA
#undef AT_VREAD
#undef AT_VMMA
        const float ltot = l_run + shx<32>(l_run, lane), inv = 1.f / ltot;
        bf16* orow = AO + (size_t)(trow0 + rho) * D + h * VH + 8 * hh;
#pragma unroll
        for (int d = 0; d < 4; ++d)
#pragma unroll
            for (int k = 0; k < 2; ++k) {
                unsigned ax = pk2(o[d][8 * k + 0] * inv, o[d][8 * k + 1] * inv), ay = pk2(o[d][8 * k + 2] * inv, o[d][8 * k + 3] * inv);
                unsigned bx = pk2(o[d][8 * k + 4] * inv, o[d][8 * k + 5] * inv), by = pk2(o[d][8 * k + 6] * inv, o[d][8 * k + 7] * inv);
                asm volatile("s_nop 1\n\tv_permlane32_swap_b32 %0, %1" : "+v"(ax), "+v"(bx)); asm volatile("s_nop 1\n\tv_permlane32_swap_b32 %0, %1" : "+v"(ay), "+v"(by));
                *(v4u*)(orow + 32 * d + 16 * k) = (v4u){ax, ay, bx, by}; }
    }
}

constexpr int N_PHASES = 42;
struct Args { In in; float* out; unsigned char* ws; int ph_lo, ph_hi; };
__global__ void __launch_bounds__(NTHR, 2) mk_fwd(Args a) {
    extern __shared__ __attribute__((aligned(16))) unsigned char lds_raw[];
    LAS unsigned char* lds = (LAS unsigned char*)lds_raw;
    const int wave = __builtin_amdgcn_readfirstlane(threadIdx.x >> 6);
    const int G = gridDim.x, bid = blockIdx.x, vcu = (G % 8 == 0) ? (bid % 8) * (G / 8) + bid / 8 : bid;
    typedef const __attribute__((address_space(4))) Args* KArgs;
#define KARGS(q) KArgs q = (KArgs)__builtin_amdgcn_kernarg_segment_ptr(); asm volatile("" : "+s"(q))
    const int lo = a.ph_lo, hi = a.ph_hi;
    { volatile LAS unsigned* MISC0 = (volatile LAS unsigned*)(lds + MISC_OFF); if (threadIdx.x < 32) MISC0[threadIdx.x] = 0u; }
    __syncthreads();
    XcdBarrier bar; bar.bar = (unsigned*)(a.ws + WS_CTL); bar.x = 0; bar.st = nullptr;
    if (hi - lo > 1) bar = xcd_barrier_post((unsigned*)(a.ws + WS_CTL), (volatile LAS unsigned*)(lds + MISC_OFF) + 8, threadIdx.x == 0);
#ifndef MK_MASK
#define MK_MASK 0xFFFF
#endif
#define IN_PH(k) (lo <= (k) && (k) < hi)
#define EN(b) ((MK_MASK >> (b)) & 1)
#if MK_PROBE & 256
#define PHASE_END(k) do { if ((k) + 1 < hi) { xcd_barrier(bar, wave == 0 && lane_id_fresh() == 0); xcd_barrier(bar, wave == 0 && lane_id_fresh() == 0); } } while (0)
#else
#define PHASE_END(k) do { if ((k) + 1 < hi) xcd_barrier(bar, wave == 0 && lane_id_fresh() == 0); } while (0)
#endif
#define PH_VARS KARGS(q); unsigned char* ws = q->ws; CIn& in = q->in; float* ssq = (float*)(ws + WS_SSQ); \
    const float* COS = (const float*)(ws + WS_COS); const float* SIN = (const float*)(ws + WS_SIN); (void)in; (void)ssq; (void)COS; (void)SIN

    if (EN(0) && IN_PH(0)) { PH_VARS;
#if MK_PROBE & 8
        p0_prologue(in, ws, lds, bid, G, wave); __syncthreads();
#endif
        p0_prologue(in, ws, lds, bid, G, wave); PHASE_END(0); }

#pragma unroll 1
    for (int layer = 0; layer < DEPTH; ++layer) {
        const int base = 1 + 10 * layer, v0 = 3 * layer;
#define XB_VARS bf16* XBc = (bf16*)(ws + ((layer & 1) ? WS_XBB : WS_XBA)); bf16* XBn = (bf16*)(ws + ((layer & 1) ? WS_XBA : WS_XBB)); pg8::StaticOrder SO; (void)XBc; (void)XBn; (void)SO
        if (EN(1) && IN_PH(base + 0)) { PH_VARS; XB_VARS;
#if MK_PROBE & 4096
#pragma unroll 1
            for (int rep = 0; rep < 2; ++rep)
#endif
            {
            if (layer == 0) convert_layer(in, ws, layer, bid, G, wave);
            if (layer < 2) pooled_phase(XBc, ssq + (size_t)v0 * SSQ_ARR, in.mix_norm + layer * D, (bf16*)(ws + WS_POOLED), lds, vcu, G, wave);
            else {
                const int N = (layer == 2) ? 1280 : 768;
                pg8::Gemm g{XBc, (const bf16*)(ws + ((layer == 2) ? W_DOWN2 : W_DOWN3)), T, N, D, D, D, 0}; SO.init(T, N, G, bid);
                epi::Down E{(bf16*)(ws + WS_CQ), (bf16*)(ws + WS_CKV), (bf16*)(ws + WS_KPE), ssq + (size_t)v0 * SSQ_ARR, ssq + (size_t)(13 + layer - 2) * SSQ_ARR, ssq + (size_t)15 * SSQ_ARR, COS, SIN};
                pg8::gemm_phase<epi::Down>(lds, g, SO, E, wave);
                if (G % 2 == 0 && ((T / 256) * (N / 256)) % G == G / 2) {
                    pg8::Gemm gp{(const bf16*)(ws + WS_PB), (const bf16*)(ws + W_WP) + (size_t)layer * D * PLE, T, D, PLE, PLE, PLE, 0}; SO.init(T, D, G, bid, 1);
                    epi::Bf16Row EP{(bf16*)(ws + WS_PP), D, nullptr, 0.f};
                    pg8::gemm_phase<epi::Bf16Row>(lds, gp, SO, EP, wave);
                }
            }
            }
            PHASE_END(base + 0);
        }
        if (EN(2) && IN_PH(base + 1)) { PH_VARS; XB_VARS;
#if MK_PROBE & 16
            if (layer < 2) {
                pg8::Gemm g{(const bf16*)(ws + WS_POOLED), (const bf16*)(ws + W_POOL) + (size_t)layer * 1024 * 256, T, D, 256, D, 256, 256}; SO.init(T, D, G, bid);
                epi::Resid E{(bf16*)(ws + WS_END), (float*)(ws + WS_END + 64 * MiB)};
                pg8::gemm_phase<epi::Resid>(lds, g, SO, E, wave);
            } else {
                pg8::Gemm g{(const bf16*)(ws + WS_CQ), (const bf16*)(ws + W_UQ) + (size_t)(layer - 2) * 1536 * QRANK, T, 1536, QRANK, QRANK, QRANK, 0}; SO.init(T, 1536, G, bid);
                epi::QUp E{(bf16*)(ws + WS_Q), ssq + (size_t)(13 + layer - 2) * SSQ_ARR, COS, SIN};
                pg8::gemm_phase<epi::QUp>(lds, g, SO, E, wave);
            }
#endif
            if (layer < 2) {
                pg8::Gemm g{(const bf16*)(ws + WS_POOLED), (const bf16*)(ws + W_POOL) + (size_t)layer * 1024 * 256, T, D, 256, D, 256, 256}; SO.init(T, D, G, bid);
                epi::Resid E{XBc, ssq + (size_t)(v0 + 1) * SSQ_ARR};
                pg8::gemm_phase<epi::Resid>(lds, g, SO, E, wave);
            } else {
                if (layer == 2) {
                    { pg8::Gemm g{(const bf16*)(ws + WS_CKV), (const bf16*)(ws + W_KNW), T, 1024, KVRANK, KVRANK, KVRANK, 0}; SO.init(T, 1024, G, bid);
                      epi::Bf16Row E{(bf16*)(ws + WS_KN), 1024, ssq + (size_t)15 * SSQ_ARR, 1.f / KVRANK};
                      pg8::gemm_phase<epi::Bf16Row>(lds, g, SO, E, wave); }
                    { pg8::Gemm g{(const bf16*)(ws + W_VW), (const bf16*)(ws + WS_CKV), 1024, T, KVRANK, KVRANK, KVRANK, 0}; SO.init(1024, T, G, bid);
                      epi::VTCol E{(bf16*)(ws + WS_VT), ssq + (size_t)15 * SSQ_ARR, 1.f / KVRANK};
                      pg8::gemm_phase<epi::VTCol>(lds, g, SO, E, wave); }
                }
                pg8::Gemm g{(const bf16*)(ws + WS_CQ), (const bf16*)(ws + W_UQ) + (size_t)(layer - 2) * 1536 * QRANK, T, 1536, QRANK, QRANK, QRANK, 0}; SO.init(T, 1536, G, bid);
                epi::QUp E{(bf16*)(ws + WS_Q), ssq + (size_t)(13 + layer - 2) * SSQ_ARR, COS, SIN};
                pg8::gemm_phase<epi::QUp>(lds, g, SO, E, wave);
            }
            PHASE_END(base + 1);
        }
        if (EN(3) && layer >= 2 && IN_PH(base + 2)) { PH_VARS; XB_VARS;
#if MK_PROBE & 2
            attn_phase((const bf16*)(ws + WS_Q), (const bf16*)(ws + WS_KN), (const bf16*)(ws + WS_KPE), (const bf16*)(ws + WS_VT), (bf16*)(ws + WS_AO), lds, vcu, G, wave);
#endif
            attn_phase((const bf16*)(ws + WS_Q), (const bf16*)(ws + WS_KN), (const bf16*)(ws + WS_KPE), (const bf16*)(ws + WS_VT), (bf16*)(ws + WS_AO), lds, vcu, G, wave);
            PHASE_END(base + 2);
        }
        if (EN(4) && layer >= 2 && IN_PH(base + 3)) { PH_VARS; XB_VARS;
            pg8::Gemm g{(const bf16*)(ws + WS_AO), (const bf16*)(ws + W_WO) + (size_t)(layer - 2) * D * D, T, D, D, D, D, 0}; SO.init(T, D, G, bid);
#if MK_PROBE & 16384
            { epi::Resid E2{(bf16*)(ws + WS_END), (float*)(ws + WS_END + 64 * MiB)}; pg8::gemm_phase<epi::Resid>(lds, g, SO, E2, wave); SO.init(T, D, G, bid); }
#endif
            epi::Resid E{XBc, ssq + (size_t)(v0 + 1) * SSQ_ARR};
            pg8::gemm_phase<epi::Resid>(lds, g, SO, E, wave);
            PHASE_END(base + 3);
        }
        if (EN(5) && IN_PH(base + 4)) { PH_VARS; XB_VARS;
#if MK_PROBE & 4
            { pg8::Gemm g{XBc, (const bf16*)(ws + W_WEFF) + (size_t)layer * 2048 * D, T, 2048, D, D, D, 0}; SO.init(T, 2048, G, bid);
              epi::Score E{(unsigned short*)(ws + WS_S), 2048, ssq + (size_t)(v0 + 1) * SSQ_ARR};
              pg8::gemm_phase<epi::Score>(lds, g, SO, E, wave); }
#endif
#if MK_PROBE & 65536
            { pg8::Gemm g{(const bf16*)(ws + WS_PB), (const bf16*)(ws + W_WP) + (size_t)layer * D * PLE, T, D, PLE, PLE, PLE, 0}; SO.init(T, D, G, bid);
              epi::Bf16Row E{(bf16*)(ws + WS_PP), D, nullptr, 0.f};
              pg8::gemm_phase<epi::Bf16Row>(lds, g, SO, E, wave); }
#endif
            {
            { pg8::Gemm g{XBc, (const bf16*)(ws + W_WEFF) + (size_t)layer * 2048 * D, T, 2048, D, D, D, 0}; SO.init(T, 2048, G, bid);
              epi::Score E{(unsigned short*)(ws + WS_S), 2048, ssq + (size_t)(v0 + 1) * SSQ_ARR};
              pg8::gemm_phase<epi::Score>(lds, g, SO, E, wave); }
            if (!(layer >= 2 && G % 2 == 0 && ((T / 256) * (((layer == 2) ? 1280 : 768) / 256)) % G == G / 2))
            { pg8::Gemm g{(const bf16*)(ws + WS_PB), (const bf16*)(ws + W_WP) + (size_t)layer * D * PLE, T, D, PLE, PLE, PLE, 0}; SO.init(T, D, G, bid);
              epi::Bf16Row E{(bf16*)(ws + WS_PP), D, nullptr, 0.f};
              pg8::gemm_phase<epi::Bf16Row>(lds, g, SO, E, wave); }
            }
            PHASE_END(base + 4);
        }
        if (EN(6) && EN(9) && IN_PH(base + 5)) { PH_VARS; XB_VARS;
            const int nl = layer + 1 < DEPTH ? layer + 1 : layer, ns = nl & 1;
            const ConvNext cvn{in.peer_u + (size_t)nl * NEXP * D, in.peer_v + (size_t)nl * NEXP * D, in.ffn_norm + nl * D, in.p + (size_t)nl * T * PLE,
                               ws + tab_off(ns), ws + tab_off(ns) + (size_t)NEXP * D, (float*)(ws + tabs_off(ns)), (float*)(ws + tabs_off(ns)) + NEXP, (bf16*)(ws + WS_PB), layer + 1 < DEPTH ? 1 : 0};
#if MK_PROBE & 64
            peer_topk_phase((const unsigned short*)(ws + WS_S), ssq + (size_t)(v0 + 1) * SSQ_ARR, (const float*)(ws + tabs_off(layer & 1)), (const float*)(ws + tabs_off(layer & 1)) + NEXP,
                            (unsigned short*)(ws + WS_IDX), (float*)(ws + WS_GW), (float*)(ws + WS_MU), cvn, lds, vcu, G, wave);
#endif
            peer_topk_phase((const unsigned short*)(ws + WS_S), ssq + (size_t)(v0 + 1) * SSQ_ARR, (const float*)(ws + tabs_off(layer & 1)), (const float*)(ws + tabs_off(layer & 1)) + NEXP,
                            (unsigned short*)(ws + WS_IDX), (float*)(ws + WS_GW), (float*)(ws + WS_MU), cvn, lds, vcu, G, wave);
            PHASE_END(base + 5);
        }
        if (EN(6) && EN(10) && IN_PH(base + 6)) { PH_VARS; XB_VARS;
#if MK_PROBE & 32
            peer_u_phase<0>((const unsigned short*)(ws + WS_IDX), XBc, ws + tab_off(layer & 1), (unsigned short*)(ws + WS_PART), bid, G, wave);
#endif
#if MK_PROBE & 128
            peer_u_phase<1>((const unsigned short*)(ws + WS_IDX), XBc, ws + tab_off(layer & 1), (unsigned short*)(ws + WS_WW), bid, G, wave);
#endif
            peer_u_phase<0>((const unsigned short*)(ws + WS_IDX), XBc, ws + tab_off(layer & 1), (unsigned short*)(ws + WS_PART), bid, G, wave);
            PHASE_END(base + 6);
        }
        if (EN(6) && EN(11) && IN_PH(base + 7)) { PH_VARS; XB_VARS;
#if MK_PROBE & 2048
            peer_w_phase((const unsigned short*)(ws + WS_PART), (const float*)(ws + WS_GW), (const float*)(ws + WS_MU), (const unsigned short*)(ws + WS_IDX), (unsigned*)(ws + WS_WW), bid, G, wave);
#endif
            peer_w_phase((const unsigned short*)(ws + WS_PART), (const float*)(ws + WS_GW), (const float*)(ws + WS_MU), (const unsigned short*)(ws + WS_IDX), (unsigned*)(ws + WS_WW), bid, G, wave);
            PHASE_END(base + 7);
        }
        if (EN(6) && EN(12) && IN_PH(base + 8)) { PH_VARS; XB_VARS;
#if MK_PROBE & 1024
            peer_v_phase((const unsigned*)(ws + WS_WW), ws + tab_off(layer & 1) + (size_t)NEXP * D, XBc, (bf16*)(ws + WS_END), (float*)(ws + WS_END + 64 * MiB), bid, G, wave);
#endif
            peer_v_phase((const unsigned*)(ws + WS_WW), ws + tab_off(layer & 1) + (size_t)NEXP * D, XBc, XBc, ssq + (size_t)(v0 + 2) * SSQ_ARR, bid, G, wave);
            PHASE_END(base + 8);
        }
        if (EN(7) && IN_PH(base + 9)) { PH_VARS; XB_VARS;
            pg8::Gemm g{XBc, (const bf16*)(ws + W_WG) + (size_t)layer * D * D, T, D, D, D, D, 0}; SO.init(T, D, G, bid);
#if MK_PROBE & 512
            { epi::Null EN_{(float*)(ws + WS_END)}; pg8::gemm_phase<epi::Null>(lds, g, SO, EN_, wave); }
#endif
#if MK_PROBE & 8192
            { epi::Gate E2{XBc, XBn, (const bf16*)(ws + WS_PP), ssq + (size_t)(v0 + 2) * SSQ_ARR, ssq + (size_t)(v0 + 3) * SSQ_ARR}; pg8::gemm_phase<epi::Gate>(lds, g, SO, E2, wave); SO.init(T, D, G, bid); }
#endif
            epi::Gate E{XBc, XBn, (const bf16*)(ws + WS_PP), ssq + (size_t)(v0 + 2) * SSQ_ARR, ssq + (size_t)(v0 + 3) * SSQ_ARR};
            pg8::gemm_phase<epi::Gate>(lds, g, SO, E, wave);
            PHASE_END(base + 9);
        }
    }
#if MK_PROBE & 32768
    if (EN(8) && IN_PH(41)) { PH_VARS; final_phase((const bf16*)(ws + WS_XBA), ssq + (size_t)12 * SSQ_ARR, in.final_norm, q->out, bid, G, wave); }
#endif
    if (EN(8) && IN_PH(41)) { PH_VARS; final_phase((const bf16*)(ws + WS_XBA), ssq + (size_t)12 * SSQ_ARR, in.final_norm, q->out, bid, G, wave); }
#undef IN_PH
#undef PHASE_END
}

extern "C" void kernel_launch(void* const* d_in, const int* in_sizes, int n_in, void* d_out, int out_size, void* d_ws, size_t ws_size, hipStream_t stream) {
    static int grid = 0;
    if (grid == 0) {
        if (n_in != 23 || out_size != T * D || ws_size < WS_END) { fprintf(stderr, "kernel_launch: unexpected problem (n_in %d, out %d, ws %zu < %zu)\n", n_in, out_size, ws_size, (size_t)WS_END); grid = -1; return; }
        int dev = 0, cus = 0, per_cu = 0;
        if (hipGetDevice(&dev) != hipSuccess || hipDeviceGetAttribute(&cus, hipDeviceAttributeMultiprocessorCount, dev) != hipSuccess) { grid = -1; return; }
        if (hipFuncSetAttribute((const void*)mk_fwd, hipFuncAttributeMaxDynamicSharedMemorySize, LDS_BYTES) != hipSuccess) { fprintf(stderr, "kernel_launch: hipFuncSetAttribute failed\n"); grid = -1; return; }
        if (hipOccupancyMaxActiveBlocksPerMultiprocessor(&per_cu, (const void*)mk_fwd, NTHR, LDS_BYTES) != hipSuccess || per_cu < 1) { fprintf(stderr, "kernel_launch: occupancy query says %d\n", per_cu); }
        (void)hipGetLastError();
        grid = cus;
    }
    if (grid < 0) return;
    (void)hipMemsetAsync((char*)d_ws + WS_CTL, 0, CTL_ZERO_BYTES, stream);
    Args a{};
    const void** ip = (const void**)&a.in;
    for (int i = 0; i < 23; ++i) ip[i] = d_in[i];
    a.out = (float*)d_out; a.ws = (unsigned char*)d_ws;
#if MK_ONE_LAUNCH
    a.ph_lo = 0; a.ph_hi = N_PHASES;
    hipLaunchKernelGGL(mk_fwd, dim3(grid), dim3(NTHR), LDS_BYTES, stream, a);
#else
    for (int k = 0; k < N_PHASES; ++k) {
        if (k >= 1 && k <= 40) { const int layer = (k - 1) / 10, slot = (k - 1) % 10; if (layer < 2 && (slot == 2 || slot == 3)) continue; }
        a.ph_lo = k; a.ph_hi = k + 1;
        hipLaunchKernelGGL(mk_fwd, dim3(grid), dim3(NTHR), LDS_BYTES, stream, a);
    }
#endif
}
```

```cpp
#include <hip/hip_runtime.h>
#include <cstdio>
#include <cstdint>

#ifndef MK_PROBE
#define MK_PROBE 0
#endif
#ifndef MK_ONE_LAUNCH
#define MK_ONE_LAUNCH 1
#endif


__device__ __forceinline__ int lane_id_fresh() { int l; asm volatile("v_mbcnt_lo_u32_b32 %0, -1, 0\n\tv_mbcnt_hi_u32_b32 %0, -1, %0" : "=v"(l)); return l; }
template <int M> __device__ __forceinline__ float shx(float v, int lane) {
    if constexpr (M < 32) return __builtin_bit_cast(float, __builtin_amdgcn_ds_swizzle(__builtin_bit_cast(int, v), (M << 10) | 0x1f));
    else return __builtin_bit_cast(float, __builtin_amdgcn_ds_bpermute((lane ^ 32) << 2, __builtin_bit_cast(int, v)));
}

namespace pg8 {
#define PG8_LAS __attribute__((address_space(3)))
typedef unsigned short bf16_t;
typedef short bf16x8 __attribute__((ext_vector_type(8)));
typedef float f32x4 __attribute__((ext_vector_type(4)));
typedef unsigned u32x4 __attribute__((ext_vector_type(4)));
typedef unsigned u32x2 __attribute__((ext_vector_type(2)));
constexpr int BM = 256, BK = 64, HALF = 128, HTB = HALF * BK * 2, STAGE_BYTES = 8 * HTB, NXCD = 8, WGM = 8;

__host__ __device__ __forceinline__ int lds_byte(int r, int c) { const int st = (r >> 4) * 2 + (c >> 5), rr = r & 15, cc = c & 31, ob = rr * 64 + cc * 2; return st * 1024 + (ob ^ (((ob >> 9) & 1) << 5)); }
__host__ __device__ __forceinline__ void stage_rc(int b, int& R, int& C) { const int st = b / 1024, sb = b % 1024, swz = sb ^ (((sb >> 9) & 1) << 5); R = (st >> 1) * 16 + swz / 64; C = (st & 1) * 32 + (swz % 64) / 2; }
__host__ __device__ __forceinline__ int perm32(int rho) { const int n = rho >> 4, i = rho & 15; return 8 * (i >> 2) + 4 * n + (i & 3); }

struct Unit { int pm, pn; };
struct Gemm { const bf16_t* A; const bf16_t* Bt; int M, N, K, lda, ldb, acs; };

struct StaticOrder {
    int nM, nN, nwg, G, c, skew;
    __host__ __device__ void init(int M, int N, int G_, int c_, int skew_ = 0) { nM = M / BM; nN = N / BM; nwg = nM * nN; G = G_; c = c_; skew = skew_; }
    __host__ __device__ bool next(int i, Unit& u) const {
        long L = (long)i * G + c;
        if (skew && i > 0) { if (2 * c < G) return false; L = (long)G + (long)(i - 1) * (G - G / 2) + (c - G / 2); }
        if (L >= nwg) return false;
        int wgid = (int)L; { const int q = nwg / NXCD, r = nwg % NXCD, xcd = wgid % NXCD, off = wgid / NXCD; wgid = (xcd < r ? xcd * (q + 1) : r * (q + 1) + (xcd - r) * q) + off; }
        const int nig = WGM * nN, gid = wgid / nig, fm = gid * WGM, gsz = (nM - fm) < WGM ? (nM - fm) : WGM;
        u.pm = fm + ((wgid % nig) % gsz); u.pn = (wgid % nig) / gsz; return true;
    }
};

__device__ __forceinline__ unsigned cvt_pk_bf16(float lo, float hi) { unsigned r; asm volatile("v_cvt_pk_bf16_f32 %0, %1, %2" : "=v"(r) : "v"(lo), "v"(hi)); return r; }

template <class Epi>
__device__ __forceinline__ void gemm_phase(PG8_LAS unsigned char* lds, const Gemm g, const StaticOrder& S, const Epi& E, const int wid) {
    const int lane = lane_id_fresh(), tid = wid * 64 + lane;
    const int wr = wid >> 2, wc = wid & 3, fr = lane & 15, fq = lane >> 4;
    const int K = g.K, nt = K / BK;
    unsigned voffA, voffB;
    { int R, C; stage_rc(tid * 16, R, C); const int Rb = Epi::PERM ? ((R & ~31) + perm32(R & 31)) : R;
      voffA = (unsigned)(R * g.lda + C) * 2u; voffB = (unsigned)(Rb * g.ldb + C) * 2u; }
    const unsigned d64A = 64u * g.lda * 2u, d64B = 64u * g.ldb * 2u;
    constexpr unsigned kstep = BK * 2;
    const unsigned hstepA = (unsigned)HALF * g.lda * 2u, hstepB = (unsigned)HALF * g.ldb * 2u;
    const unsigned tstepA = 2u * hstepA, tstepB = 2u * hstepB;
    const unsigned acsb = (unsigned)g.acs * 2u;
    const unsigned ldsw = (unsigned)wid * 1024u, ldsbase = (unsigned)(size_t)lds;
    const int aoff = lds_byte(wr * 64 + fr, fq * 8), boff = lds_byte(wc * 32 + fr, fq * 8);
#define PG8_SA(b, h) (((b) * 2 + (h)) * HTB)
#define PG8_SB(b, h) ((4 + (b) * 2 + (h)) * HTB)
#define PG8_DMA(sbase, voff, ldsdst) do { unsigned _keep; asm volatile("s_mov_b32 %0, m0\n\ts_mov_b32 m0, %3\n\ts_nop 4\n\tglobal_load_lds_dwordx4 %1, %2\n\ts_mov_b32 m0, %0" \
        : "=&s"(_keep) : "v"(voff), "s"(sbase), "s"(ldsdst) : "memory"); } while (0)
#define PG8_STAGE(bufoff, gbase, voff) do { const char* _b0 = (const char*)(gbase); const char* _b1 = _b0 + (&(voff) == &voffA ? d64A : d64B); \
        PG8_DMA(_b0, voff, ldsbase + (unsigned)(bufoff) + ldsw); PG8_DMA(_b1, voff, ldsbase + (unsigned)(bufoff) + ldsw + 8192u); } while (0)
#define PG8_LDA(dst, b, h) do { _Pragma("unroll") for (int m = 0; m < 4; ++m) _Pragma("unroll") for (int k = 0; k < 2; ++k) dst[m][k] = *(const PG8_LAS bf16x8*)(lds + PG8_SA(b, h) + aoff + m * 2048 + k * 1024); } while (0)
#define PG8_LDB(dst, b, h) do { _Pragma("unroll") for (int n = 0; n < 2; ++n) _Pragma("unroll") for (int k = 0; k < 2; ++k) dst[n][k] = *(const PG8_LAS bf16x8*)(lds + PG8_SB(b, h) + boff + n * 2048 + k * 1024); } while (0)
#define PG8_MMA(ai, bj, At, Bt) do { __builtin_amdgcn_s_setprio(1); _Pragma("unroll") for (int m = 0; m < 4; ++m) _Pragma("unroll") for (int n = 0; n < 2; ++n) _Pragma("unroll") for (int k = 0; k < 2; ++k) \
        acc[ai][bj][m][n] = __builtin_amdgcn_mfma_f32_16x16x32_bf16(Bt[n][k], At[m][k], acc[ai][bj][m][n], 0, 0, 0); __builtin_amdgcn_s_setprio(0); } while (0)
#define PG8_WAIT_V(n) asm volatile("s_waitcnt vmcnt(" #n ")" ::: "memory")
#define PG8_WAIT_L(n) asm volatile("s_waitcnt lgkmcnt(" #n ")" ::: "memory")
#define PG8_BAR __builtin_amdgcn_s_barrier()
#define PG8_SCHED __builtin_amdgcn_sched_barrier(0)
    Unit cur, nxt; int ui = 0;
    if (!S.next(0, cur)) return;
    f32x4 acc[2][2][4][2];
#pragma unroll
    for (int a = 0; a < 2; ++a)
#pragma unroll
        for (int b = 0; b < 2; ++b)
#pragma unroll
            for (int m = 0; m < 4; ++m)
#pragma unroll
                for (int n = 0; n < 2; ++n) acc[a][b][m][n] = (f32x4){0.f, 0.f, 0.f, 0.f};
    bf16x8 At[4][2], B0[2][2], B1[2][2];
    const char* cA = (const char*)g.A + ((unsigned)cur.pm * tstepA + (unsigned)cur.pn * acsb); const char* cB = (const char*)g.Bt + (unsigned)cur.pn * tstepB;
    PG8_STAGE(PG8_SB(0, 0), cB, voffB); PG8_STAGE(PG8_SB(0, 1), cB + hstepB, voffB); PG8_STAGE(PG8_SA(0, 0), cA, voffA); PG8_STAGE(PG8_SA(0, 1), cA + hstepA, voffA);
    if (wr == 1) PG8_BAR;
    PG8_WAIT_V(2); PG8_BAR;
    PG8_STAGE(PG8_SB(1, 0), cB + kstep, voffB); PG8_STAGE(PG8_SA(1, 0), cA + kstep, voffA); PG8_STAGE(PG8_SB(1, 1), cB + hstepB + kstep, voffB);
    PG8_WAIT_V(6); PG8_BAR;
    for (;;) {
        const bool has_next = S.next(ui + 1, nxt);
        const char* nA = has_next ? (const char*)g.A + ((unsigned)nxt.pm * tstepA + (unsigned)nxt.pn * acsb) : cA; const char* nB = has_next ? (const char*)g.Bt + (unsigned)nxt.pn * tstepB : cB;
        for (int t = 0; t < nt; t += 2) {
            const bool last = (t == nt - 2);
            const char* a1 = cA + (unsigned)(t + 1) * kstep;
            const char* a2 = last ? nA : cA + (unsigned)(t + 2) * kstep; const char* b2 = last ? nB : cB + (unsigned)(t + 2) * kstep;
            const char* a3 = a2 + kstep; const char* b3 = b2 + kstep;
            PG8_LDB(B0, 0, 0); PG8_LDB(B1, 0, 1); PG8_SCHED; PG8_LDA(At, 0, 0); PG8_STAGE(PG8_SA(1, 1), a1 + hstepA, voffA);
            PG8_WAIT_V(8); PG8_WAIT_L(0); PG8_BAR; PG8_MMA(0, 0, At, B0); PG8_MMA(0, 1, At, B1); PG8_BAR; PG8_SCHED;
            PG8_LDA(At, 0, 1); PG8_STAGE(PG8_SB(0, 0), b2, voffB); PG8_STAGE(PG8_SB(0, 1), b2 + hstepB, voffB); PG8_STAGE(PG8_SA(0, 0), a2, voffA);
            PG8_WAIT_V(8); PG8_WAIT_L(0); PG8_BAR; PG8_MMA(1, 0, At, B0); PG8_MMA(1, 1, At, B1); PG8_BAR; PG8_SCHED;
            PG8_LDB(B0, 1, 0); PG8_LDB(B1, 1, 1); PG8_SCHED; PG8_LDA(At, 1, 0); PG8_STAGE(PG8_SA(0, 1), a2 + hstepA, voffA);
            PG8_WAIT_V(8); PG8_WAIT_L(0); PG8_BAR; PG8_MMA(0, 0, At, B0); PG8_MMA(0, 1, At, B1); PG8_BAR; PG8_SCHED;
            PG8_LDA(At, 1, 1); PG8_STAGE(PG8_SB(1, 0), b3, voffB); PG8_STAGE(PG8_SB(1, 1), b3 + hstepB, voffB); PG8_STAGE(PG8_SA(1, 0), a3, voffA);
            PG8_WAIT_V(8); PG8_WAIT_L(0); PG8_BAR; PG8_MMA(1, 0, At, B0); PG8_MMA(1, 1, At, B1); PG8_BAR; PG8_SCHED;
        }
        if (wr == 0) PG8_BAR;
        { const int l2 = lane_id_fresh(); E(acc, cur, wr, wc, l2 & 15, l2 >> 4); }
        if (!has_next) break;
#pragma unroll
        for (int a = 0; a < 2; ++a)
#pragma unroll
            for (int b = 0; b < 2; ++b)
#pragma unroll
                for (int m = 0; m < 4; ++m)
#pragma unroll
                    for (int n = 0; n < 2; ++n) acc[a][b][m][n] = (f32x4){0.f, 0.f, 0.f, 0.f};
        cur = nxt; cA = nA; cB = nB; ++ui;
        if (wr == 1) PG8_BAR;
    }
    PG8_WAIT_V(0);
    PG8_BAR;
#undef PG8_SA
#undef PG8_SB
#undef PG8_STAGE
#undef PG8_LDA
#undef PG8_LDB
#undef PG8_MMA
#undef PG8_WAIT_V
#undef PG8_WAIT_L
#undef PG8_BAR
#undef PG8_SCHED
}
}

#define GAS __attribute__((address_space(1)))
#define LAS __attribute__((address_space(3)))
typedef unsigned short bf16;
typedef unsigned v4u __attribute__((ext_vector_type(4)));
typedef unsigned v2u __attribute__((ext_vector_type(2)));
typedef float f32x4 __attribute__((ext_vector_type(4)));
typedef float f32x2 __attribute__((ext_vector_type(2)));
typedef float f32x16 __attribute__((ext_vector_type(16)));
typedef short bf16x8 __attribute__((ext_vector_type(8)));
typedef __bf16 bf16x2_t __attribute__((ext_vector_type(2)));
typedef _Float16 half2_t __attribute__((ext_vector_type(2)));
__device__ __forceinline__ unsigned pkh2(float lo, float hi) { f32x2 v = {lo, hi}; half2_t h = __builtin_convertvector(v, half2_t); return __builtin_bit_cast(unsigned, h); }
__device__ __forceinline__ float hlo(unsigned u) { return (float)__builtin_bit_cast(half2_t, u)[0]; }
__device__ __forceinline__ float hhi(unsigned u) { return (float)__builtin_bit_cast(half2_t, u)[1]; }
typedef GAS unsigned gu32;
#define RLX_AGENT __ATOMIC_RELAXED, __HIP_MEMORY_SCOPE_AGENT
#define SWZ(o) (((o) << 10) | 0x1f)
#define LDS_WAIT() asm volatile("s_waitcnt lgkmcnt(0)" ::: "memory")
#define VM_WAIT() asm volatile("s_waitcnt vmcnt(0)" ::: "memory")
__device__ __forceinline__ unsigned pk2(float lo, float hi) { f32x2 v = {lo, hi}; bf16x2_t b = __builtin_convertvector(v, bf16x2_t); return __builtin_bit_cast(unsigned, b); }
__device__ __forceinline__ float bflo(unsigned u) { return __builtin_bit_cast(float, u << 16); }
__device__ __forceinline__ float bfhi(unsigned u) { return __builtin_bit_cast(float, u & 0xffff0000u); }
__device__ __forceinline__ float dot2bf(unsigned a, unsigned b, float acc) { return __builtin_amdgcn_fdot2_f32_bf16(__builtin_bit_cast(bf16x2_t, a), __builtin_bit_cast(bf16x2_t, b), acc, false); }
template <int CTRL> __device__ __forceinline__ float dppf(float v) { return __builtin_bit_cast(float, __builtin_amdgcn_update_dpp(0, __builtin_bit_cast(int, v), CTRL, 0xf, 0xf, true)); }
__device__ __forceinline__ float wave_sum(float v, int lane) {
    v += shx<1>(v, lane); v += shx<2>(v, lane); v += shx<4>(v, lane); v += shx<8>(v, lane); v += shx<16>(v, lane); v += shx<32>(v, lane);
    return v;
}


__device__ __forceinline__ float row_rinv(const float* ssq16, int r, float invdim) {
    const f32x4* p = (const f32x4*)(ssq16 + (size_t)r * 16); const f32x4 a = p[0], b = p[1], c = p[2], d = p[3];
    const float s = ((a[0] + a[1]) + (a[2] + a[3])) + ((b[0] + b[1]) + (b[2] + b[3])) + (((c[0] + c[1]) + (c[2] + c[3])) + ((d[0] + d[1]) + (d[2] + d[3])));
    return __builtin_amdgcn_rsqf(s * invdim + 1e-6f);
}

#define XB_TMO      128
#define XB_XCNT(j)  (256  + 64 * (j))
#define XB_XSUB(j)  (1280 + 64 * (j))
#define XB_XGEN(j)  (2304 + 64 * (j))
#define XB_TOP      3328
#define XB_TOPGEN   3392
#define XCD_BAR_WORDS 3456
#define XB_SPIN_CAP (1u << 18)

__device__ __forceinline__ unsigned xb_ld(unsigned* p)              { return __hip_atomic_load(p, __ATOMIC_RELAXED, __HIP_MEMORY_SCOPE_AGENT); }
__device__ __forceinline__ unsigned xb_add(unsigned* p, unsigned v) { return __hip_atomic_fetch_add(p, v, __ATOMIC_RELAXED, __HIP_MEMORY_SCOPE_AGENT); }
__device__ __forceinline__ unsigned xb_xcc_id() { return (unsigned)__builtin_amdgcn_s_getreg((3 << 11) | 20) & 0xFu; }
#define XB_SPIN(cond, bar) do { unsigned _sp = 0; while (cond) { __builtin_amdgcn_s_sleep(1); \
    if ((++_sp & 255u) == 0u) { if (xb_ld(&(bar)[XB_TMO])) break; if (_sp > XB_SPIN_CAP) { atomicAdd(&(bar)[XB_TMO], 1u); break; } } } } while (0)

struct XcdBarrier {
    unsigned* bar; unsigned x;
    volatile LAS unsigned* st;
};
__device__ __forceinline__ XcdBarrier xcd_barrier_post(unsigned* bar, volatile LAS unsigned* st, bool t0) {
    XcdBarrier b; b.bar = bar; b.x = xb_xcc_id(); b.st = st;
    if (t0) (void)xb_add(&bar[XB_XCNT(b.x)], 1u);
    return b;
}
__device__ __forceinline__ void xcd_barrier_complete(unsigned* bar, unsigned x, unsigned& nloc, unsigned& nx) {
    const unsigned G = gridDim.x * gridDim.y * gridDim.z;
    unsigned sum, cnt, mine, sp = 0u;
    for (;;) {
        sum = 0u; cnt = 0u; mine = 0u;
#pragma unroll
        for (unsigned j = 0; j < 16; ++j) { const unsigned c = xb_ld(&bar[XB_XCNT(j)]); sum += c; cnt += (c > 0u) ? 1u : 0u; mine = (j == x) ? c : mine; }
        if (sum == G) break;
        __builtin_amdgcn_s_sleep(1);
        if ((++sp & 255u) == 0u) { if (xb_ld(&bar[XB_TMO])) break; if (sp > XB_SPIN_CAP) { atomicAdd(&bar[XB_TMO], 1u); break; } }
    }
    nloc = mine > 0u ? mine : 1u; nx = cnt > 0u ? cnt : 1u;
}
__device__ __forceinline__ void xcd_barrier(const XcdBarrier& b, bool t0) {
    asm volatile("s_waitcnt vmcnt(0)" ::: "memory");
    __syncthreads();
    if (t0) {
        unsigned* bar = b.bar;
        __builtin_amdgcn_s_waitcnt(0);
        unsigned nloc = b.st[0], nx = b.st[1];
        if (nloc == 0u) { xcd_barrier_complete(bar, b.x, nloc, nx); b.st[0] = nloc; b.st[1] = nx; }
        const unsigned old = xb_add(&bar[XB_XSUB(b.x)], 1u);
        const unsigned gen = old / nloc;
        if (old + 1u == (gen + 1u) * nloc) {
            __builtin_amdgcn_fence(__ATOMIC_RELEASE, "agent");
            asm volatile("s_waitcnt vmcnt(0)" ::: "memory");
            const unsigned og = xb_add(&bar[XB_TOP], 1u);
            const unsigned tg = og / nx;
            if (og + 1u == (tg + 1u) * nx) xb_add(&bar[XB_TOPGEN], 1u);
            else XB_SPIN(xb_ld(&bar[XB_TOPGEN]) == tg, bar);
            __builtin_amdgcn_fence(__ATOMIC_ACQUIRE, "agent");
            xb_add(&bar[XB_XGEN(b.x)], 1u);
            asm volatile("s_waitcnt vmcnt(0)" ::: "memory");
        } else {
            XB_SPIN(xb_ld(&bar[XB_XGEN(b.x)]) == gen, bar);
            __builtin_amdgcn_fence(__ATOMIC_ACQUIRE, "agent");
            asm volatile("s_waitcnt vmcnt(0)" ::: "memory");
        }
    }
    __syncthreads();
}

constexpr int NWAVES = 8, NTHR = 512;
constexpr int T = 32768, D = 1024, NBATCH = 8, SEQ = 4096, DEPTH = 4;
constexpr int NHEAD = 8, QKN = 128, QKR = 64, DQK = 192, VH = 128, QRANK = 768, KVRANK = 256;
constexpr int NKEYS = 128, NEXP = 16384, PTOPK = 16, PLE = 256;
constexpr float EPS = 1e-6f;
constexpr float C2 = 0.07216878364870322f * 1.4426950408889634f;

constexpr size_t MiB = 1u << 20;
constexpr size_t WS_CTL = 0, CTL_ZERO_BYTES = 64 * 1024;
constexpr size_t WS_SSQ = 840 * MiB;
constexpr size_t WS_COS = 3 * MiB, WS_SIN = 7 * MiB;
constexpr size_t WS_W = 11 * MiB;
constexpr size_t W_WEFF = WS_W;
constexpr size_t W_WG = W_WEFF + 16 * MiB;
constexpr size_t W_WP = W_WG + 8 * MiB;
constexpr size_t W_POOL = W_WP + 2 * MiB;
constexpr size_t W_DOWN2 = W_POOL + 1 * MiB;
constexpr size_t W_DOWN3 = W_DOWN2 + 2560 * 1024;
constexpr size_t W_KNW = W_DOWN3 + 1536 * 1024;
constexpr size_t W_VW = W_KNW + 512 * 1024;
constexpr size_t W_UQ = W_VW + 512 * 1024;
constexpr size_t W_WO = W_UQ + 4608 * 1024;
constexpr size_t WS_WEND = W_WO + 4 * MiB;
constexpr size_t WS_X = 52 * MiB;
constexpr size_t WS_XBA = 180 * MiB, WS_XBB = 244 * MiB;
constexpr size_t WS_UV = 308 * MiB;
constexpr size_t WS_UVS = 340 * MiB;
constexpr size_t WS_UV2 = 52 * MiB, WS_UVS2 = 84 * MiB;
__host__ __device__ constexpr size_t tab_off(int set) { return set ? WS_UV2 : WS_UV; }
__host__ __device__ constexpr size_t tabs_off(int set) { return set ? WS_UVS2 : WS_UVS; }
constexpr size_t WS_PB = 372 * MiB;
constexpr size_t WS_PP = 388 * MiB;
constexpr size_t WS_KN = 452 * MiB;
constexpr size_t WS_VT = 516 * MiB;
constexpr size_t WS_KPE = 580 * MiB;
constexpr size_t WS_R1 = 584 * MiB;
constexpr size_t WS_S = WS_R1;
constexpr size_t WS_POOLED = WS_R1;
constexpr size_t WS_Q = WS_R1;
constexpr size_t WS_AO = WS_R1 + 96 * MiB;
constexpr size_t WS_CQ = WS_R1 + 160 * MiB;
constexpr size_t WS_CKV = WS_R1 + 208 * MiB;
constexpr size_t WS_IDX = 872 * MiB;
constexpr size_t WS_GW = 880 * MiB, WS_MU = 896 * MiB;
constexpr size_t WS_PART = WS_R1;
constexpr size_t WS_WW = WS_R1 + 128 * MiB;
constexpr size_t WS_END = 912 * MiB;
constexpr size_t SSQ_ARR = (size_t)32768 * 16;
static_assert(WS_WEND <= WS_X, "weights");

constexpr int RING_BYTES = 139264;
constexpr int MISC_OFF = RING_BYTES + 320;
constexpr int LDS_BYTES = 147456;

namespace epi {
using pg8::Unit; using pg8::cvt_pk_bf16;
typedef float f32x4 __attribute__((ext_vector_type(4)));
typedef unsigned u32x4 __attribute__((ext_vector_type(4)));
typedef unsigned u32x2 __attribute__((ext_vector_type(2)));
__device__ __forceinline__ float dot4(f32x4 v) { return (v[0] * v[0] + v[1] * v[1]) + (v[2] * v[2] + v[3] * v[3]); }
__device__ __forceinline__ void rinv8(const float* ssq, int rbase, int fr, int fq, float invdim, float (&ri)[8]) {
    f32x4 q[8];
#pragma unroll
    for (int k = 0; k < 8; ++k) q[k] = *(const f32x4*)(ssq + (size_t)(rbase + (k >> 2) * 128 + (k & 3) * 16) * 16 + 4 * fq);
#pragma unroll
    for (int k = 0; k < 8; ++k) { float s = (q[k][0] + q[k][1]) + (q[k][2] + q[k][3]); s += shx<16>(s, fq * 16 + fr); s += shx<32>(s, fq * 16 + fr); ri[k] = __builtin_amdgcn_rsqf(s * invdim + 1e-6f); }
}

struct Resid {
    static constexpr bool PERM = true;
    bf16* XB; float* ssq_out;
    __device__ __forceinline__ void operator()(const f32x4 (&acc)[2][2][4][2], const Unit& u, int wr, int wc, int fr, int fq) const {
        const int col0 = u.pn * 256 + wc * 32 + 8 * fq;
        float sv[8]; u32x4 xo[8][2];
        bf16* const b0 = XB + (size_t)(u.pm * 256 + wr * 64 + fr) * D + col0;
#define EPI_ROW(k) (b0 + (size_t)(((k) >> 2) * 128 + ((k) & 3) * 16) * D)
#define EPI_LOAD(k) do { xo[k][0] = *(const u32x4*)EPI_ROW(k); xo[k][1] = *(const u32x4*)(EPI_ROW(k) + 128); } while (0)
        EPI_LOAD(0); EPI_LOAD(1); EPI_LOAD(2);
#pragma unroll
        for (int k = 0; k < 8; ++k) { const int ai = k >> 2, m = k & 3; float s = 0.f;
            if (k + 3 < 8) EPI_LOAD(k + 3);
#pragma unroll
            for (int bj = 0; bj < 2; ++bj) { const u32x4 x = xo[k][bj];
                const f32x4 v0 = (f32x4){bflo(x.x), bfhi(x.x), bflo(x.y), bfhi(x.y)} + acc[ai][bj][m][0], v1 = (f32x4){bflo(x.z), bfhi(x.z), bflo(x.w), bfhi(x.w)} + acc[ai][bj][m][1];
                u32x4 w; w.x = cvt_pk_bf16(v0[0], v0[1]); w.y = cvt_pk_bf16(v0[2], v0[3]); w.z = cvt_pk_bf16(v1[0], v1[1]); w.w = cvt_pk_bf16(v1[2], v1[3]); *(u32x4*)(EPI_ROW(k) + bj * 128) = w;
                s += dot4(v0) + dot4(v1); }
            s += shx<16>(s, fq * 16 + fr); s += shx<32>(s, fq * 16 + fr); sv[k] = s;
        }
#undef EPI_LOAD
#undef EPI_ROW
        if (fq == 0) {
#pragma unroll
            for (int k = 0; k < 8; ++k) ssq_out[(size_t)(u.pm * 256 + (k >> 2) * 128 + wr * 64 + (k & 3) * 16 + fr) * 16 + u.pn * 4 + wc] = sv[k]; }
    }
};
struct Score {
    static constexpr bool PERM = true;
    unsigned short* S; int ldc; const float* ssq;
    __device__ __forceinline__ void operator()(const f32x4 (&acc)[2][2][4][2], const Unit& u, int wr, int wc, int fr, int fq) const {
        const int col0 = u.pn * 256 + wc * 32 + 8 * fq;
        float ri8[8]; rinv8(ssq, u.pm * 256 + wr * 64 + fr, fr, fq, 1.f / D, ri8);
#pragma unroll
        for (int ai = 0; ai < 2; ++ai)
#pragma unroll
            for (int m = 0; m < 4; ++m) {
                const int r = u.pm * 256 + ai * 128 + wr * 64 + m * 16 + fr; const float ri = ri8[ai * 4 + m];
                unsigned short* sr = S + (size_t)r * ldc + col0;
#pragma unroll
                for (int bj = 0; bj < 2; ++bj) { const f32x4 v0 = acc[ai][bj][m][0] * ri, v1 = acc[ai][bj][m][1] * ri; u32x4 w;
                    w.x = pkh2(v0[0], v0[1]); w.y = pkh2(v0[2], v0[3]); w.z = pkh2(v1[0], v1[1]); w.w = pkh2(v1[2], v1[3]); *(u32x4*)(sr + bj * 128) = w; }
            }
    }
};
struct Bf16Row {
    static constexpr bool PERM = true;
    bf16* O; int ldc; const float* ssq; float invdim;
    __device__ __forceinline__ void operator()(const f32x4 (&acc)[2][2][4][2], const Unit& u, int wr, int wc, int fr, int fq) const {
        const int col0 = u.pn * 256 + wc * 32 + 8 * fq;
        float ri8[8];
        if (ssq) rinv8(ssq, u.pm * 256 + wr * 64 + fr, fr, fq, invdim, ri8);
        else {
#pragma unroll
            for (int k = 0; k < 8; ++k) ri8[k] = 1.f; }
#pragma unroll
        for (int ai = 0; ai < 2; ++ai)
#pragma unroll
            for (int m = 0; m < 4; ++m) {
                const int r = u.pm * 256 + ai * 128 + wr * 64 + m * 16 + fr; const float ri = ri8[ai * 4 + m];
                bf16* orow = O + (size_t)r * ldc + col0;
#pragma unroll
                for (int bj = 0; bj < 2; ++bj) { const f32x4 v0 = acc[ai][bj][m][0] * ri, v1 = acc[ai][bj][m][1] * ri; u32x4 w;
                    w.x = cvt_pk_bf16(v0[0], v0[1]); w.y = cvt_pk_bf16(v0[2], v0[3]); w.z = cvt_pk_bf16(v1[0], v1[1]); w.w = cvt_pk_bf16(v1[2], v1[3]); *(u32x4*)(orow + bj * 128) = w; }
            }
    }
};
struct VTCol {
    static constexpr bool PERM = true;
    bf16* O; const float* ssq; float invdim;
    __device__ __forceinline__ void operator()(const f32x4 (&acc)[2][2][4][2], const Unit& u, int wr, int wc, int fr, int fq) const {
        const int col0 = u.pn * 256 + wc * 32 + 8 * fq;
#pragma unroll
        for (int bj = 0; bj < 2; ++bj) {
            f32x4 sc0, sc1;
#pragma unroll
            for (int j = 0; j < 4; ++j) { sc0[j] = row_rinv(ssq, col0 + bj * 128 + j, invdim); sc1[j] = row_rinv(ssq, col0 + bj * 128 + 4 + j, invdim); }
#pragma unroll
            for (int ai = 0; ai < 2; ++ai)
#pragma unroll
                for (int m = 0; m < 4; ++m) {
                    const int r = u.pm * 256 + ai * 128 + wr * 64 + m * 16 + fr;
                    const f32x4 v0 = acc[ai][bj][m][0] * sc0, v1 = acc[ai][bj][m][1] * sc1; u32x4 w;
                    w.x = cvt_pk_bf16(v0[0], v0[1]); w.y = cvt_pk_bf16(v0[2], v0[3]); w.z = cvt_pk_bf16(v1[0], v1[1]); w.w = cvt_pk_bf16(v1[2], v1[3]);
                    *(u32x4*)(O + (size_t)r * T + col0 + bj * 128) = w;
                }
        }
    }
};
struct Gate {
    static constexpr bool PERM = true;
    const bf16* XBc; bf16* XBn; const bf16* PP; const float* ssq; float* ssq_out;
    __device__ __forceinline__ void operator()(const f32x4 (&acc)[2][2][4][2], const Unit& u, int wr, int wc, int fr, int fq) const {
        const int col0 = u.pn * 256 + wc * 32 + 8 * fq;
        float ri8[8], sv[8]; rinv8(ssq, u.pm * 256 + wr * 64 + fr, fr, fq, 1.f / D, ri8);
        u32x4 xo[8][2], pw[8][2];
        const size_t o0 = (size_t)(u.pm * 256 + wr * 64 + fr) * D + col0;
#define EPI_OFF(k) (o0 + (size_t)(((k) >> 2) * 128 + ((k) & 3) * 16) * D)
#define EPI_LOAD(k) do { xo[k][0] = *(const u32x4*)(XBc + EPI_OFF(k)); pw[k][0] = *(const u32x4*)(PP + EPI_OFF(k)); xo[k][1] = *(const u32x4*)(XBc + EPI_OFF(k) + 128); pw[k][1] = *(const u32x4*)(PP + EPI_OFF(k) + 128); } while (0)
        EPI_LOAD(0); EPI_LOAD(1); EPI_LOAD(2);
#pragma unroll
        for (int k = 0; k < 8; ++k) { const int ai = k >> 2, m = k & 3; const float ri = ri8[k]; float s = 0.f;
            if (k + 3 < 8) EPI_LOAD(k + 3);
#pragma unroll
            for (int bj = 0; bj < 2; ++bj) { const u32x4 x = xo[k][bj], p = pw[k][bj];
                const f32x4 z0 = acc[ai][bj][m][0] * ri, z1 = acc[ai][bj][m][1] * ri; f32x4 g0, g1;
#pragma unroll
                for (int j = 0; j < 4; ++j) { g0[j] = __builtin_amdgcn_rcpf(1.f + __builtin_amdgcn_exp2f(-1.4426950408889634f * z0[j])); g1[j] = __builtin_amdgcn_rcpf(1.f + __builtin_amdgcn_exp2f(-1.4426950408889634f * z1[j])); }
                const f32x4 v0 = (f32x4){bflo(x.x), bfhi(x.x), bflo(x.y), bfhi(x.y)} + g0 * (f32x4){bflo(p.x), bfhi(p.x), bflo(p.y), bfhi(p.y)};
                const f32x4 v1 = (f32x4){bflo(x.z), bfhi(x.z), bflo(x.w), bfhi(x.w)} + g1 * (f32x4){bflo(p.z), bfhi(p.z), bflo(p.w), bfhi(p.w)};
                u32x4 w; w.x = cvt_pk_bf16(v0[0], v0[1]); w.y = cvt_pk_bf16(v0[2], v0[3]); w.z = cvt_pk_bf16(v1[0], v1[1]); w.w = cvt_pk_bf16(v1[2], v1[3]); *(u32x4*)(XBn + EPI_OFF(k) + bj * 128) = w;
                s += dot4(v0) + dot4(v1); }
            s += shx<16>(s, fq * 16 + fr); s += shx<32>(s, fq * 16 + fr); sv[k] = s;
        }
#undef EPI_LOAD
#undef EPI_OFF
        if (fq == 0) {
#pragma unroll
            for (int k = 0; k < 8; ++k) ssq_out[(size_t)(u.pm * 256 + (k >> 2) * 128 + wr * 64 + (k & 3) * 16 + fr) * 16 + u.pn * 4 + wc] = sv[k]; }
    }
};
struct Down {
    static constexpr bool PERM = true;
    bf16* CQ; bf16* CKV; bf16* KPE; const float* ssq; float* ssq_q; float* ssq_kv; const float* COS; const float* SIN;
    __device__ __forceinline__ void operator()(const f32x4 (&acc)[2][2][4][2], const Unit& u, int wr, int wc, int fr, int fq) const {
        const int tc0 = wc * 32 + 8 * fq;
        float ri8[8], sv[8]; rinv8(ssq, u.pm * 256 + wr * 64 + fr, fr, fq, 1.f / D, ri8);
#pragma unroll
        for (int k = 0; k < 8; ++k) sv[k] = 0.f;
#pragma unroll
        for (int ai = 0; ai < 2; ++ai)
#pragma unroll
            for (int m = 0; m < 4; ++m) {
                const int r = u.pm * 256 + ai * 128 + wr * 64 + m * 16 + fr; const float ri = ri8[ai * 4 + m];
                if (u.pn < 4) {
                    bf16* orow = (u.pn < 3) ? CQ + (size_t)r * QRANK + u.pn * 256 + tc0 : CKV + (size_t)r * KVRANK + tc0; float s = 0.f;
#pragma unroll
                    for (int bj = 0; bj < 2; ++bj) { const f32x4 v0 = acc[ai][bj][m][0] * ri, v1 = acc[ai][bj][m][1] * ri; u32x4 w;
                        w.x = cvt_pk_bf16(v0[0], v0[1]); w.y = cvt_pk_bf16(v0[2], v0[3]); w.z = cvt_pk_bf16(v1[0], v1[1]); w.w = cvt_pk_bf16(v1[2], v1[3]); *(u32x4*)(orow + bj * 128) = w;
                        s += dot4(v0) + dot4(v1); }
                    s += shx<16>(s, fq * 16 + fr); s += shx<32>(s, fq * 16 + fr); sv[ai * 4 + m] = s;
                } else if (wc < 2) {
                    const f32x4 cs = *(const f32x4*)(COS + (size_t)r * 32 + wc * 16 + 4 * fq), sn = *(const f32x4*)(SIN + (size_t)r * 32 + wc * 16 + 4 * fq);
                    const f32x4 v0 = acc[ai][0][m][0] * ri, v1 = acc[ai][0][m][1] * ri; u32x4 w;
                    w.x = cvt_pk_bf16(v0[0] * cs[0] - v0[1] * sn[0], v0[1] * cs[0] + v0[0] * sn[0]);
                    w.y = cvt_pk_bf16(v0[2] * cs[1] - v0[3] * sn[1], v0[3] * cs[1] + v0[2] * sn[1]);
                    w.z = cvt_pk_bf16(v1[0] * cs[2] - v1[1] * sn[2], v1[1] * cs[2] + v1[0] * sn[2]);
                    w.w = cvt_pk_bf16(v1[2] * cs[3] - v1[3] * sn[3], v1[3] * cs[3] + v1[2] * sn[3]);
                    *(u32x4*)(KPE + (size_t)r * QKR + tc0) = w;
                }
            }
        if (u.pn < 4 && fq == 0) {
            float* const so = (u.pn < 3) ? ssq_q + u.pn * 4 + wc : ssq_kv + wc;
#pragma unroll
            for (int k = 0; k < 8; ++k) so[(size_t)(u.pm * 256 + (k >> 2) * 128 + wr * 64 + (k & 3) * 16 + fr) * 16] = sv[k]; }
    }
};
struct QUp {
    static constexpr bool PERM = true;
    bf16* Q; const float* ssq_q; const float* COS; const float* SIN;
    __device__ __forceinline__ void operator()(const f32x4 (&acc)[2][2][4][2], const Unit& u, int wr, int wc, int fr, int fq) const {
        float ri8[8]; rinv8(ssq_q, u.pm * 256 + wr * 64 + fr, fr, fq, 1.f / QRANK, ri8);
        const int r0 = u.pm * 256 + wr * 64 + fr;
#pragma unroll
        for (int bj = 0; bj < 2; ++bj) {
            const int c0w = u.pn * 256 + bj * 128 + wc * 32, c8 = c0w + 8 * fq;
            if ((c0w % DQK) >= QKN) {
                const int pb = ((c8 % DQK) - QKN) >> 1;
                f32x4 cs[8], sn[8];
#pragma unroll
                for (int k = 0; k < 8; ++k) { const size_t ro = (size_t)(r0 + (k >> 2) * 128 + (k & 3) * 16) * 32 + pb; cs[k] = *(const f32x4*)(COS + ro); sn[k] = *(const f32x4*)(SIN + ro); }
#pragma unroll
                for (int k = 0; k < 8; ++k) { const int ai = k >> 2, m = k & 3; const float ri = ri8[k];
                    const f32x4 v0 = acc[ai][bj][m][0] * ri, v1 = acc[ai][bj][m][1] * ri; u32x4 w;
                    w.x = cvt_pk_bf16(v0[0] * cs[k][0] - v0[1] * sn[k][0], v0[1] * cs[k][0] + v0[0] * sn[k][0]);
                    w.y = cvt_pk_bf16(v0[2] * cs[k][1] - v0[3] * sn[k][1], v0[3] * cs[k][1] + v0[2] * sn[k][1]);
                    w.z = cvt_pk_bf16(v1[0] * cs[k][2] - v1[1] * sn[k][2], v1[1] * cs[k][2] + v1[0] * sn[k][2]);
                    w.w = cvt_pk_bf16(v1[2] * cs[k][3] - v1[3] * sn[k][3], v1[3] * cs[k][3] + v1[2] * sn[k][3]);
                    *(u32x4*)(Q + (size_t)(r0 + ai * 128 + m * 16) * (NHEAD * DQK) + c8) = w; }
            } else {
#pragma unroll
                for (int k = 0; k < 8; ++k) { const int ai = k >> 2, m = k & 3; const float ri = ri8[k];
                    const f32x4 v0 = acc[ai][bj][m][0] * ri, v1 = acc[ai][bj][m][1] * ri; u32x4 w;
                    w.x = cvt_pk_bf16(v0[0], v0[1]); w.y = cvt_pk_bf16(v0[2], v0[3]); w.z = cvt_pk_bf16(v1[0], v1[1]); w.w = cvt_pk_bf16(v1[2], v1[3]);
                    *(u32x4*)(Q + (size_t)(r0 + ai * 128 + m * 16) * (NHEAD * DQK) + c8) = w; }
            }
        }
    }
};
struct Null {
    static constexpr bool PERM = true;
    float* O;
    __device__ __forceinline__ void operator()(const f32x4 (&acc)[2][2][4][2], const Unit& u, int wr, int wc, int fr, int fq) const {
        f32x4 s = {0.f, 0.f, 0.f, 0.f};
#pragma unroll
        for (int ai = 0; ai < 2; ++ai)
#pragma unroll
            for (int bj = 0; bj < 2; ++bj)
#pragma unroll
                for (int m = 0; m < 4; ++m) s += acc[ai][bj][m][0] + acc[ai][bj][m][1];
        O[(size_t)(u.pm * 8 + u.pn) * 512 + (wr * 4 + wc) * 64 + fq * 16 + fr] = (s[0] + s[1]) + (s[2] + s[3]);
    }
};
}

struct TJob { const float* W; int ldw; int K; int Nout; bf16* out; int mode; const float* rs; const float* cs; float cmul; };
__device__ __forceinline__ int tj_src(int mode, int n) {
    if (mode == 1) { if (n < KVRANK) return n; const int rr = n - KVRANK; return KVRANK + (rr >> 1) + 32 * (rr & 1); }
    if (mode == 2) { const int hd = n / DQK, r = n % DQK; if (r < QKN) return n; const int rr = r - QKN; return hd * DQK + QKN + (rr >> 1) + 32 * (rr & 1); }
    if (mode == 3) return (n >> 7) * 256 + (n & 127);
    if (mode == 4) return (n >> 7) * 256 + 128 + (n & 127);
    return n;
}
__device__ __forceinline__ void transpose_tile(const TJob& j, LAS float* scr, int tile, int tid) {
    const int nkt = j.K >> 6, n0 = (tile / nkt) * 64, k0 = (tile % nkt) * 64;
    { const int nn = tid & 63; const int src = (j.mode == 5) ? -1 : tj_src(j.mode, n0 + nn);
      const float csv = (j.cs ? j.cs[n0 + nn] : 1.f) * j.cmul;
#pragma unroll
      for (int i = 0; i < 8; ++i) { const int kk = (tid >> 6) + 8 * i; float v = 0.f;
          if (src >= 0) v = j.W[(size_t)(k0 + kk) * j.ldw + src] * (j.rs ? j.rs[k0 + kk] : 1.f) * csv;
          scr[kk * 65 + nn] = v; } }
    __syncthreads();
    { const int kk2 = (tid & 31) * 2;
#pragma unroll
      for (int i = 0; i < 4; ++i) { const int nn2 = (tid >> 5) + 16 * i;
          *(unsigned*)(j.out + (size_t)(n0 + nn2) * j.K + k0 + kk2) = pk2(scr[kk2 * 65 + nn2], scr[(kk2 + 1) * 65 + nn2]); } }
    __syncthreads();
}
__device__ __forceinline__ void transpose_tile2(const TJob& ja, int tileA, const TJob& jb, int tileB, LAS float* scr, int tid) {
    LAS float* scr2 = scr + 64 * 65 + 32;
    const int nkA = ja.K >> 6, nkB = jb.K >> 6;
    const int nA = (tileA / nkA) * 64, kA = (tileA % nkA) * 64, nB = (tileB / nkB) * 64, kB = (tileB % nkB) * 64;
    { const int nn = tid & 63; const bool zA = ja.mode == 5, zB = jb.mode == 5; const int sA = zA ? 0 : tj_src(ja.mode, nA + nn), sB = zB ? 0 : tj_src(jb.mode, nB + nn);
      const float cA = zA ? 0.f : (ja.cs ? ja.cs[nA + nn] : 1.f) * ja.cmul, cB = zB ? 0.f : (jb.cs ? jb.cs[nB + nn] : 1.f) * jb.cmul;
      float va[8], vb[8], ra[8], rb[8];
#pragma unroll
      for (int i = 0; i < 8; ++i) { const int kk = (tid >> 6) + 8 * i; va[i] = ja.W[(size_t)(kA + kk) * ja.ldw + sA]; vb[i] = jb.W[(size_t)(kB + kk) * jb.ldw + sB];
          ra[i] = ja.rs ? ja.rs[kA + kk] : 1.f; rb[i] = jb.rs ? jb.rs[kB + kk] : 1.f; }
#pragma unroll
      for (int i = 0; i < 8; ++i) { const int kk = (tid >> 6) + 8 * i; scr[kk * 65 + nn] = va[i] * ra[i] * cA; scr2[kk * 65 + nn] = vb[i] * rb[i] * cB; } }
    __syncthreads();
    { const int kk2 = (tid & 31) * 2;
#pragma unroll
      for (int i = 0; i < 4; ++i) { const int nn2 = (tid >> 5) + 16 * i;
          *(unsigned*)(ja.out + (size_t)(nA + nn2) * ja.K + kA + kk2) = pk2(scr[kk2 * 65 + nn2], scr[(kk2 + 1) * 65 + nn2]);
          *(unsigned*)(jb.out + (size_t)(nB + nn2) * jb.K + kB + kk2) = pk2(scr2[kk2 * 65 + nn2], scr2[(kk2 + 1) * 65 + nn2]); } }
    __syncthreads();
}
struct In {
    const float *x, *p; const int* pos; const float *mix_norm, *ffn_norm, *pool_w, *pool_scale, *kv_in_norm, *w_dkv, *kv_norm, *w_ukv, *w_dq, *q_norm, *w_uq, *w_o,
                *peer_wq, *peer_keys, *peer_u, *peer_v, *ple_norm, *ple_wg, *ple_wp, *final_norm;
};
typedef const __attribute__((address_space(4))) In CIn;
__device__ __forceinline__ TJob get_job(int id, CIn& in, unsigned char* ws) {
    TJob j; j.mode = 0; j.rs = nullptr; j.cs = nullptr; j.cmul = 1.f;
    if (id < 4) { j.W = in.ple_wg + (size_t)id * D * D; j.ldw = D; j.K = D; j.Nout = D; j.out = (bf16*)(ws + W_WG) + (size_t)id * D * D; j.rs = in.ple_norm + id * D; }
    else if (id < 8) { const int i = id - 4; j.W = in.ple_wp + (size_t)i * PLE * D; j.ldw = D; j.K = PLE; j.Nout = D; j.out = (bf16*)(ws + W_WP) + (size_t)i * D * PLE; }
    else if (id < 16) { const int i = (id - 8) >> 2, g = (id - 8) & 3; j.W = in.pool_w + (size_t)(i * 4 + g) * 65536; j.ldw = 256; j.K = 256; j.Nout = 256;
        j.out = (bf16*)(ws + W_POOL) + (size_t)(i * 1024 + g * 256) * 256; j.cs = in.pool_scale + i * D + g * 256; }
    else if (id == 16) { j.W = in.w_dq; j.ldw = QRANK; j.K = D; j.Nout = QRANK; j.out = (bf16*)(ws + W_DOWN2); j.rs = in.mix_norm + 2 * D; }
    else if (id == 17) { j.W = in.w_dkv; j.ldw = KVRANK + QKR; j.K = D; j.Nout = KVRANK + QKR; j.out = (bf16*)(ws + W_DOWN2) + (size_t)QRANK * D; j.mode = 1; j.rs = in.kv_in_norm; }
    else if (id == 18) { j.W = in.w_dkv; j.ldw = KVRANK + QKR; j.K = D; j.Nout = 192; j.out = (bf16*)(ws + W_DOWN2) + (size_t)(QRANK + KVRANK + QKR) * D; j.mode = 5; }
    else if (id == 19) { j.W = in.w_dq + (size_t)D * QRANK; j.ldw = QRANK; j.K = D; j.Nout = QRANK; j.out = (bf16*)(ws + W_DOWN3); j.rs = in.mix_norm + 3 * D; }
    else if (id == 20) { j.W = in.w_ukv; j.ldw = 2048; j.K = KVRANK; j.Nout = 1024; j.out = (bf16*)(ws + W_KNW); j.mode = 3; j.rs = in.kv_norm; }
    else if (id == 21) { j.W = in.w_ukv; j.ldw = 2048; j.K = KVRANK; j.Nout = 1024; j.out = (bf16*)(ws + W_VW); j.mode = 4; j.rs = in.kv_norm; }
    else if (id < 24) { const int jj = id - 22; j.W = in.w_uq + (size_t)jj * QRANK * 1536; j.ldw = 1536; j.K = QRANK; j.Nout = 1536; j.out = (bf16*)(ws + W_UQ) + (size_t)jj * 1536 * QRANK;
        j.mode = 2; j.rs = in.q_norm + jj * QRANK; j.cmul = C2; }
    else { const int jj = id - 24; j.W = in.w_o + (size_t)jj * D * D; j.ldw = D; j.K = D; j.Nout = D; j.out = (bf16*)(ws + W_WO) + (size_t)jj * D * D; }
    return j;
}
constexpr int N_TJOBS = 26;
__host__ __device__ constexpr int tj_tiles(int id) {
    return id < 4 ? (D >> 6) * (D >> 6) : id < 8 ? (PLE >> 6) * (D >> 6) : id < 16 ? 16 : id == 16 ? (D >> 6) * (QRANK >> 6) : id == 17 ? (D >> 6) * ((KVRANK + QKR) >> 6)
         : id == 18 ? (D >> 6) * 3 : id == 19 ? (D >> 6) * (QRANK >> 6) : id < 22 ? (KVRANK >> 6) * 16 : id < 24 ? (QRANK >> 6) * 24 : (D >> 6) * (D >> 6);
}

__device__ __forceinline__ void weff_item(const float* wq, const float* keys, const float* gain, bf16* out, int hp, int kt, LAS float* lds, int tid) {
    constexpr int RS = 136;
    LAS unsigned short* Wh = (LAS unsigned short*)lds; LAS unsigned short* Wl = Wh + 64 * RS; LAS unsigned short* Kh = Wl + 64 * RS; LAS unsigned short* Kl = Kh + 128 * RS;
    const int k0 = kt * 64;
#define WEFF_SPLIT(v, ph, pl) do { v2u h_, l_; h_.x = pk2((v)[0], (v)[1]); h_.y = pk2((v)[2], (v)[3]); \
        l_.x = pk2((v)[0] - bflo(h_.x), (v)[1] - bfhi(h_.x)); l_.y = pk2((v)[2] - bflo(h_.y), (v)[3] - bfhi(h_.y)); *(LAS v2u*)(ph) = h_; *(LAS v2u*)(pl) = l_; } while (0)
#pragma unroll
    for (int i = 0; i < 4; ++i) { const int idx = tid + 512 * i, row = idx >> 5, c4 = idx & 31;
        const f32x4 v = *(const f32x4*)(wq + (size_t)(k0 + row) * 2048 + hp * 128 + c4 * 4) * gain[k0 + row]; WEFF_SPLIT(v, Wh + row * RS + c4 * 4, Wl + row * RS + c4 * 4); }
#pragma unroll
    for (int i = 0; i < 8; ++i) { const int idx = tid + 512 * i, row = idx >> 5, c4 = idx & 31;
        const f32x4 v = *(const f32x4*)(keys + (size_t)(hp * 128 + row) * 128 + c4 * 4); WEFF_SPLIT(v, Kh + row * RS + c4 * 4, Kl + row * RS + c4 * 4); }
#undef WEFF_SPLIT
    __syncthreads();
    const int w = tid >> 6, l = tid & 63, tk = w & 1, tn = w >> 1, r32 = l & 31, g = l >> 5;
    f32x16 acc;
#pragma unroll
    for (int r = 0; r < 16; ++r) acc[r] = 0.f;
    const int ao = (32 * tk + r32) * RS + 8 * g, bo = (32 * tn + r32) * RS + 8 * g;
#pragma unroll
    for (int s8 = 0; s8 < 8; ++s8) {
        const bf16x8 ah = *(const LAS bf16x8*)(Wh + ao + 16 * s8), al = *(const LAS bf16x8*)(Wl + ao + 16 * s8);
        const bf16x8 bh = *(const LAS bf16x8*)(Kh + bo + 16 * s8), bl = *(const LAS bf16x8*)(Kl + bo + 16 * s8);
        acc = __builtin_amdgcn_mfma_f32_32x32x16_bf16(ah, bh, acc, 0, 0, 0);
        acc = __builtin_amdgcn_mfma_f32_32x32x16_bf16(ah, bl, acc, 0, 0, 0);
        acc = __builtin_amdgcn_mfma_f32_32x32x16_bf16(al, bh, acc, 0, 0, 0);
    }
#pragma unroll
    for (int gq = 0; gq < 4; ++gq) { v2u o_; o_.x = pk2(acc[4 * gq + 0], acc[4 * gq + 1]); o_.y = pk2(acc[4 * gq + 2], acc[4 * gq + 3]);
        *(v2u*)(out + (size_t)(hp * 128 + 32 * tn + r32) * D + k0 + 32 * tk + 8 * gq + 4 * g) = o_; }
    __syncthreads();
}

__device__ __forceinline__ void p0_prologue(CIn& in, unsigned char* ws, LAS unsigned char* lds, int bid, int G, int wave) {
    const int tid = wave * 64 + lane_id_fresh();
    const int gtid = bid * NTHR + tid, NT = G * NTHR;
    for (int i = gtid + (int)(SSQ_ARR / 4); i < (int)(16 * SSQ_ARR / 4); i += NT) ((f32x4*)(ws + WS_SSQ))[i] = (f32x4){0.f, 0.f, 0.f, 0.f};
    {
      int total = 0;
#pragma unroll
      for (int id = 0; id < N_TJOBS; ++id) total += tj_tiles(id);
      for (int g = bid; g < total; g += 2 * G) {
          int idA = 0, tA = g; while (tA >= tj_tiles(idA)) { tA -= tj_tiles(idA); ++idA; }
          const TJob ja = get_job(idA, in, ws);
          if (g + G < total) { int idB = idA, tB = tA + G; while (tB >= tj_tiles(idB)) { tB -= tj_tiles(idB); ++idB; }
              const TJob jb = get_job(idB, in, ws); transpose_tile2(ja, tA, jb, tB, (LAS float*)lds, tid); }
          else transpose_tile(ja, (LAS float*)lds, tA, tid); } }
    for (int it = bid; it < 4 * 16 * 16; it += G) { const int l = it >> 8, hp = (it >> 4) & 15, kt = it & 15;
        weff_item(in.peer_wq + (size_t)l * D * 2048, in.peer_keys + (size_t)l * 2048 * 128, in.ffn_norm + l * D, (bf16*)(ws + W_WEFF) + (size_t)l * 2048 * D, hp, kt, (LAS float*)lds, tid); }
    for (int i = gtid; i < T * 32; i += NT) { const int t = i >> 5, c = i & 31;
        double inv = 0.15915494309189535; for (int k = 0; k < c; ++k) inv *= 0.7498942093324559;
        double rd = (double)in.pos[t] * inv; rd -= __builtin_floor(rd); const float rr = (float)rd;
        ((float*)(ws + WS_COS))[i] = __builtin_amdgcn_cosf(rr); ((float*)(ws + WS_SIN))[i] = __builtin_amdgcn_sinf(rr); }
    { const int lane = tid & 63, gw = gtid >> 6, NW = NT >> 6; bf16* XB = (bf16*)(ws + WS_XBA); float* ssq = (float*)(ws + WS_SSQ);
      for (int r = gw; r < T; r += 2 * NW) { const int r2 = (r + NW < T) ? r + NW : r; f32x4 va[4], vb[4];
#pragma unroll
          for (int j = 0; j < 4; ++j) { va[j] = *(const f32x4*)(in.x + (size_t)r * D + j * 256 + 4 * lane); vb[j] = *(const f32x4*)(in.x + (size_t)r2 * D + j * 256 + 4 * lane); }
          float s = 0.f, s2 = 0.f;
#pragma unroll
          for (int j = 0; j < 4; ++j) { const size_t o = (size_t)r * D + j * 256 + 4 * lane, o2 = (size_t)r2 * D + j * 256 + 4 * lane;
              v2u w; w.x = pk2(va[j][0], va[j][1]); w.y = pk2(va[j][2], va[j][3]); *(v2u*)(XB + o) = w; s += (va[j][0] * va[j][0] + va[j][1] * va[j][1]) + (va[j][2] * va[j][2] + va[j][3] * va[j][3]);
              v2u y; y.x = pk2(vb[j][0], vb[j][1]); y.y = pk2(vb[j][2], vb[j][3]); *(v2u*)(XB + o2) = y; s2 += (vb[j][0] * vb[j][0] + vb[j][1] * vb[j][1]) + (vb[j][2] * vb[j][2] + vb[j][3] * vb[j][3]); }
          s = wave_sum(s, lane); s2 = wave_sum(s2, lane);
          if (lane < 16) { ssq[(size_t)r * 16 + lane] = (lane == 0) ? s : 0.f; ssq[(size_t)r2 * 16 + lane] = (lane == 0) ? s2 : 0.f; } } }
}
typedef float f2_t __attribute__((ext_vector_type(2)));
template <int CTRL> __device__ __forceinline__ int dppi(int v) { return __builtin_amdgcn_update_dpp(0, v, CTRL, 0xf, 0xf, true); }
__device__ __forceinline__ unsigned wave_max_dpp(unsigned v) {
    v = max(v, (unsigned)dppi<0xB1>((int)v)); v = max(v, (unsigned)dppi<0x4E>((int)v)); v = max(v, (unsigned)dppi<0x141>((int)v)); v = max(v, (unsigned)dppi<0x140>((int)v));
    { unsigned p = v, q = v; asm volatile("s_nop 1\n\tv_permlane16_swap_b32 %0, %1" : "+v"(p), "+v"(q)); v = max(p, q); }
    { unsigned p = v, q = v; asm volatile("s_nop 1\n\tv_permlane32_swap_b32 %0, %1" : "+v"(p), "+v"(q)); v = max(p, q); }
    return v;
}
__device__ __forceinline__ unsigned pack_i8x4(f32x4 v, float inv) {
    const unsigned y0 = __builtin_bit_cast(unsigned, __builtin_fmaf(v[0], inv, 12582912.f)), y1 = __builtin_bit_cast(unsigned, __builtin_fmaf(v[1], inv, 12582912.f));
    const unsigned y2 = __builtin_bit_cast(unsigned, __builtin_fmaf(v[2], inv, 12582912.f)), y3 = __builtin_bit_cast(unsigned, __builtin_fmaf(v[3], inv, 12582912.f));
    return __builtin_amdgcn_perm(y1, y0, 0x0c0c0400u) | (__builtin_amdgcn_perm(y3, y2, 0x0c0c0400u) << 16);
}
__device__ __forceinline__ void quant_store_i8(const f32x4 (&v)[4], unsigned char* tab, int row, float* scale_out, int lane) {
    unsigned amb = 0u;
#pragma unroll
    for (int j = 0; j < 4; ++j)
#pragma unroll
        for (int i = 0; i < 4; ++i) { const float f_ = v[j][i]; amb = max(amb, __builtin_bit_cast(unsigned, f_) & 0x7fffffffu); }
    const float am = __builtin_bit_cast(float, wave_max_dpp(amb));
    const float inv = am > 0.f ? 126.99f * __builtin_amdgcn_rcpf(am) : 0.f;
    v4u w;
#pragma unroll
    for (int j = 0; j < 4; ++j) w[j] = pack_i8x4(v[j], inv);
    *(v4u*)(tab + (size_t)((unsigned)(lane >> 3) * (unsigned)(NEXP * 128) + (unsigned)row * 128u + (unsigned)(lane & 7) * 16u)) = w;
    *scale_out = am * (1.f / 126.99f);
}
__device__ __forceinline__ void convert_layer(CIn& in, unsigned char* ws, int layer, int bid, int G, int wave) {
    const int set = layer & 1;
    const int lane = lane_id_fresh(), tid = wave * 64 + lane;
    const int gtid = bid * NTHR + tid, NT = G * NTHR, gw = gtid >> 6, NW = NT >> 6;
    const float* u = in.peer_u + (size_t)layer * NEXP * D; const float* v = in.peer_v + (size_t)layer * NEXP * D; const float* gn = in.ffn_norm + layer * D;
    unsigned char* U8 = ws + tab_off(set); unsigned char* V8 = U8 + (size_t)NEXP * D; float* SU = (float*)(ws + tabs_off(set)); float* SV = SU + NEXP;
    f32x4 gv[4];
#pragma unroll
    for (int j = 0; j < 4; ++j) gv[j] = *(const f32x4*)(gn + 16 * lane + 4 * j);
    for (int r = gw; r < NEXP; r += 2 * NW) {
        const int r2 = r + NW; const bool ok2 = r2 < NEXP; const int rb = ok2 ? r2 : r;
        f32x4 ua[4], va[4], ub[4], vb[4];
#pragma unroll
        for (int j = 0; j < 4; ++j) { ua[j] = *(const f32x4*)(u + (size_t)r * D + 16 * lane + 4 * j); va[j] = *(const f32x4*)(v + (size_t)r * D + 16 * lane + 4 * j);
            ub[j] = *(const f32x4*)(u + (size_t)rb * D + 16 * lane + 4 * j); vb[j] = *(const f32x4*)(v + (size_t)rb * D + 16 * lane + 4 * j); }
#pragma unroll
        for (int j = 0; j < 4; ++j) { ua[j] = ua[j] * gv[j]; ub[j] = ub[j] * gv[j]; }
        quant_store_i8(ua, U8, r, SU + r, lane); quant_store_i8(va, V8, r, SV + r, lane);
        if (ok2) { quant_store_i8(ub, U8, r2, SU + r2, lane); quant_store_i8(vb, V8, r2, SV + r2, lane); }
    }
    const float* p = in.p + (size_t)layer * T * PLE; bf16* PB = (bf16*)(ws + WS_PB);
    for (int i = gtid; i < T * PLE / 8; i += NT) { const size_t o = (size_t)i * 8; const f32x4 a0 = *(const f32x4*)(p + o), a1 = *(const f32x4*)(p + o + 4);
        v4u w; w.x = pk2(a0[0], a0[1]); w.y = pk2(a0[2], a0[3]); w.z = pk2(a1[0], a1[1]); w.w = pk2(a1[2], a1[3]); *(v4u*)(PB + o) = w; }
}
template <int W>
__device__ __forceinline__ void pooled_strip(const bf16* XB, const LAS float* rinv, const float* gain, bf16* P, int t0, int s0, int tid) {
    const int c0 = 2 * tid; const f32x2 gv = *(const f32x2*)(gain + c0);
    f32x2 ring[W]; f32x2 sum = {0.f, 0.f};
    { unsigned xw[W];
#pragma unroll
      for (int j = 0; j < W; ++j) xw[j] = (s0 - W + j >= 0) ? *(const unsigned*)(XB + (size_t)(t0 - W + j) * D + c0) : 0u;
#pragma unroll
      for (int j = 0; j < W; ++j) { const float ri = (s0 - W + j >= 0) ? rinv[16 - W + j] : 0.f; const f32x2 hv = (f32x2){bflo(xw[j]), bfhi(xw[j])} * ri * gv; ring[j] = hv; sum += hv; } }
    for (int sb = 0; sb < 64; sb += 16) {
        unsigned xw[16];
#pragma unroll
        for (int j = 0; j < 16; ++j) xw[j] = *(const unsigned*)(XB + (size_t)(t0 + sb + j) * D + c0);
#pragma unroll
        for (int j = 0; j < 16; ++j) { const int t = t0 + sb + j, s = s0 + sb + j; const float ri = rinv[16 + sb + j];
            const f32x2 hv = (f32x2){bflo(xw[j]), bfhi(xw[j])} * ri * gv; sum += hv - ring[j % W]; ring[j % W] = hv;
            const float ic = 1.f / (float)((s + 1 < W) ? s + 1 : W); const f32x2 pv = sum * ic - hv;
            *(unsigned*)(P + (size_t)t * D + c0) = pk2(pv[0], pv[1]); }
    }
}
__device__ __forceinline__ void pooled_phase(const bf16* XB, const float* ssq, const float* gain, bf16* P, LAS unsigned char* lds, int vcu, int G, int wave) {
    const int tid = wave * 64 + lane_id_fresh();
    const int g = wave >> 1;
    LAS float* rinv = (LAS float*)lds;
    for (int strip = vcu; strip < T / 64; strip += G) { const int t0 = strip * 64, s0 = t0 & (SEQ - 1);
        __syncthreads();
        if (tid < 80) { const int t = t0 - 16 + tid; rinv[tid] = (s0 - 16 + tid >= 0) ? row_rinv(ssq, t, 1.f / D) : 0.f; }
        __syncthreads();
        if (g == 0) pooled_strip<2>(XB, rinv, gain, P, t0, s0, tid); else if (g == 1) pooled_strip<4>(XB, rinv, gain, P, t0, s0, tid);
        else if (g == 2) pooled_strip<8>(XB, rinv, gain, P, t0, s0, tid); else pooled_strip<16>(XB, rinv, gain, P, t0, s0, tid); }
}
__device__ __forceinline__ void final_phase(const bf16* XB, const float* ssq, const float* gain, float* out, int bid, int G, int wave) {
    const int tid = wave * 64 + lane_id_fresh();
    const int lane = tid & 63, gw = (bid * NTHR + tid) >> 6, NW = (G * NTHR) >> 6;
    f32x4 gv[4];
#pragma unroll
    for (int j = 0; j < 4; ++j) gv[j] = *(const f32x4*)(gain + j * 256 + 4 * lane);
    int r = gw;
    for (; r + 3 * NW < T; r += 4 * NW) {
        f32x4 sq[4]; v2u xw[4][4];
#pragma unroll
        for (int k = 0; k < 4; ++k) { const int rr = r + k * NW; sq[k] = *(const f32x4*)(ssq + (size_t)rr * 16 + 4 * (lane & 3));
#pragma unroll
            for (int j = 0; j < 4; ++j) xw[k][j] = *(const v2u*)(XB + (size_t)rr * D + j * 256 + 4 * lane); }
#pragma unroll
        for (int k = 0; k < 4; ++k) { const int rr = r + k * NW;
            float sv = (sq[k][0] + sq[k][1]) + (sq[k][2] + sq[k][3]); sv += dppf<0xB1>(sv); sv += dppf<0x4E>(sv);
            const float ri = __builtin_amdgcn_rsqf(sv * (1.f / D) + 1e-6f);
#pragma unroll
            for (int j = 0; j < 4; ++j) *(f32x4*)(out + (size_t)rr * D + j * 256 + 4 * lane) = (f32x4){bflo(xw[k][j].x), bfhi(xw[k][j].x), bflo(xw[k][j].y), bfhi(xw[k][j].y)} * ri * gv[j]; }
    }
    for (; r < T; r += NW) { const float ri = row_rinv(ssq, r, 1.f / D);
#pragma unroll
        for (int j = 0; j < 4; ++j) { const size_t o = (size_t)r * D + j * 256 + 4 * lane; const v2u x1 = *(const v2u*)(XB + o); *(f32x4*)(out + o) = (f32x4){bflo(x1.x), bfhi(x1.x), bflo(x1.y), bfhi(x1.y)} * ri * gv[j]; } }
}

__device__ __forceinline__ unsigned fkey(float f) { const unsigned u = __builtin_bit_cast(unsigned, f); return u ^ ((unsigned)((int)u >> 31) | 0x80000000u); }
__device__ __forceinline__ unsigned mbcnt64(unsigned long long m) { return __builtin_amdgcn_mbcnt_hi((unsigned)(m >> 32), __builtin_amdgcn_mbcnt_lo((unsigned)m, 0u)); }
template <int N>
__device__ __forceinline__ void select16(const unsigned (&key)[N], unsigned (&pos)[N]) {
    unsigned prefix = 0u;
    for (int bit = 31; bit >= 0; --bit) {
        const unsigned cand = prefix | (1u << bit); int cnt = 0;
#pragma unroll
        for (int i = 0; i < N; ++i) cnt += __builtin_popcountll(__ballot(key[i] >= cand));
        if (cnt >= 16) prefix = cand;
        if (cnt == 16) break;
    }
    unsigned long long mg[N], me[N]; int cgt = 0;
#pragma unroll
    for (int i = 0; i < N; ++i) { mg[i] = __ballot(key[i] > prefix); me[i] = __ballot(key[i] == prefix); cgt += __builtin_popcountll(mg[i]); }
    int bg = 0, be = cgt;
#pragma unroll
    for (int i = 0; i < N; ++i) { const unsigned rg = mbcnt64(mg[i]), re = mbcnt64(me[i]);
        pos[i] = (key[i] > prefix) ? (unsigned)bg + rg : ((key[i] == prefix) ? (unsigned)be + re : 64u);
        bg += __builtin_popcountll(mg[i]); be += __builtin_popcountll(me[i]); }
}
__device__ __forceinline__ float gelu_tanh(float a) {
    const float u = 0.7978845608028654f * (a + 0.044715f * a * a * a);
    const float e = __builtin_amdgcn_exp2f(2.885390081777927f * u);
    const float th = 1.f - 2.f * __builtin_amdgcn_rcpf(1.f + e);
    return 0.5f * a * (1.f + th);
}
typedef short s16x2_t __attribute__((ext_vector_type(2)));
__device__ __forceinline__ unsigned hkey2(unsigned w) { const s16x2_t sg = __builtin_bit_cast(s16x2_t, w) >> 15; return w ^ (__builtin_bit_cast(unsigned, sg) | 0x80008000u); }
__device__ __forceinline__ float fkey_inv(unsigned k) { const unsigned u = (k & 0x80000000u) ? (k ^ 0x80000000u) : ~k; return __builtin_bit_cast(float, u); }
__device__ __forceinline__ void bit_transpose32(unsigned (&A)[32]) {
#define BT_STAGE(J, M) _Pragma("unroll") for (int k = 0; k < 32; ++k) if ((k & (J)) == 0) { const unsigned t = (A[k] ^ (A[k + (J)] >> (J))) & (M); A[k] ^= t; A[k + (J)] ^= t << (J); }
    BT_STAGE(16, 0x0000FFFFu) BT_STAGE(8, 0x00FF00FFu) BT_STAGE(4, 0x0F0F0F0Fu) BT_STAGE(2, 0x33333333u) BT_STAGE(1, 0x55555555u)
#undef BT_STAGE
}
template <int GL>
__device__ __forceinline__ void topk_select(unsigned (&key)[32], unsigned& Gm, unsigned& Em, int& ng) {
    bit_transpose32(key);
    unsigned A = 0xFFFFFFFFu, G = 0u; int n = 0;
#pragma unroll
    for (int i = 0; i < 32; ++i) {
        const unsigned x = A & key[i]; int c = __builtin_popcount(x);
        c += dppi<0xB1>(c); c += dppi<0x4E>(c);
        if (GL == 8) c += dppi<0x141>(c);
        const bool take = (n + c >= 16);
        A = take ? x : (A ^ x); G = take ? G : (G | x); n = take ? n : n + c;
    }
    Gm = G; Em = A; ng = n;
}
__device__ __forceinline__ void bit_transpose16x2(unsigned (&A)[16]) {
#define BT_STAGE(J, M) _Pragma("unroll") for (int k = 0; k < 16; ++k) if ((k & (J)) == 0) { const unsigned t = (A[k] ^ (A[k + (J)] >> (J))) & (M); A[k] ^= t; A[k + (J)] ^= t << (J); }
    _Pragma("unroll") for (int k = 0; k < 8; ++k) { const unsigned a = A[k], b = A[k + 8]; A[k] = __builtin_amdgcn_perm(b, a, 0x03070105u); A[k + 8] = __builtin_amdgcn_perm(b, a, 0x02060004u); }
    BT_STAGE(4, 0x0F0F0F0Fu) BT_STAGE(2, 0x33333333u) BT_STAGE(1, 0x55555555u)
#undef BT_STAGE
}
template <int GL>
__device__ __forceinline__ void topk_select16(unsigned (&key)[16], unsigned& Gm, unsigned& Em, int& ng) {
    bit_transpose16x2(key);
    unsigned A = 0xFFFFFFFFu, G = 0u; int n = 0;
#pragma unroll
    for (int i = 0; i < 16; ++i) {
        const unsigned x = A & key[i]; int c = __builtin_popcount(x);
        c += dppi<0xB1>(c); c += dppi<0x4E>(c);
        if (GL == 8) c += dppi<0x141>(c);
        const bool take = (n + c >= 16);
        A = take ? x : (A ^ x); G = take ? G : (G | x); n = take ? n : n + c;
    }
    Gm = G; Em = A; ng = n;
}
__device__ __forceinline__ float rs32(float p, float q) { asm volatile("s_nop 1\n\tv_permlane32_swap_b32 %0, %1" : "+v"(p), "+v"(q)); return p + q; }
__device__ __forceinline__ float rs16(float p, float q) { asm volatile("s_nop 1\n\tv_permlane16_swap_b32 %0, %1" : "+v"(p), "+v"(q)); return p + q; }
__device__ __forceinline__ float wave_sum_dpp(float v) {
    v += dppf<0xB1>(v); v += dppf<0x4E>(v); v += dppf<0x141>(v); v += dppf<0x140>(v); v = rs16(v, v); v = rs32(v, v); return v;
}
struct ConvNext { const float* u; const float* v; const float* gain; const float* p; unsigned char* U8; unsigned char* V8; float* SU; float* SV; bf16* PB; int on; };
template <int GL>
__device__ __forceinline__ void topk_select16x2(unsigned (&kA)[16], unsigned (&kB)[16], unsigned& GmA, unsigned& EmA, int& ngA, unsigned& GmB, unsigned& EmB, int& ngB) {
    bit_transpose16x2(kA); bit_transpose16x2(kB);
    unsigned AA = 0xFFFFFFFFu, GA = 0u, AB = 0xFFFFFFFFu, GB = 0u; int nA = 0, nB = 0;
#pragma unroll
    for (int i = 0; i < 16; ++i) {
        const unsigned xA = AA & kA[i], xB = AB & kB[i]; int cA = __builtin_popcount(xA), cB = __builtin_popcount(xB);
        cA += dppi<0xB1>(cA); cB += dppi<0xB1>(cB); cA += dppi<0x4E>(cA); cB += dppi<0x4E>(cB);
        if (GL == 8) { cA += dppi<0x141>(cA); cB += dppi<0x141>(cB); }
        const bool tA = (nA + cA >= 16), tB = (nB + cB >= 16);
        AA = tA ? xA : (AA ^ xA); GA = tA ? GA : (GA | xA); nA = tA ? nA : nA + cA;
        AB = tB ? xB : (AB ^ xB); GB = tB ? GB : (GB | xB); nB = tB ? nB : nB + cB;
    }
    GmA = GA; EmA = AA; ngA = nA; GmB = GB; EmB = AB; ngB = nB;
}
struct KTok { LAS unsigned char* s1i; LAS unsigned char* s2c; LAS unsigned char* scratch; LAS unsigned short* rowc; };
__device__ __forceinline__ KTok ktok(LAS unsigned char* lw, int lane) { KTok k; k.s1i = lw; k.s2c = lw + 256; k.scratch = lw + 512 + lane; k.rowc = (LAS unsigned short*)(lw + 2048); return k; }
__device__ __forceinline__ void k_compact(unsigned M, LAS unsigned char* wp, LAS unsigned char* scratch, int base) {
    while (__builtin_amdgcn_ballot_w64(M != 0u) != 0ull) {
#pragma unroll
        for (int u4 = 0; u4 < 4; ++u4) { const bool act = M != 0u; const int bp = __builtin_ctz(M | 0x80000000u); M &= M - 1u;
            LAS unsigned char* const p = act ? wp : scratch; *p = (unsigned char)(base + 30 - 2 * (bp & 15) + (bp >> 4)); wp += act ? 1 : 0; }
    }
}
__device__ __forceinline__ unsigned k_trim(unsigned Em, int ke) {
    unsigned Et = Em;
    while (__builtin_amdgcn_ballot_w64(__builtin_popcount(Et) > ke) != 0ull) { if (__builtin_popcount(Et) > ke) Et &= Et - 1u; asm volatile("" : "+v"(Et)); }
    return Et;
}
__device__ __forceinline__ void k_compact2(unsigned MA, LAS unsigned char* wpA, LAS unsigned char* scrA, unsigned MB, LAS unsigned char* wpB, LAS unsigned char* scrB, int base) {
    while (__builtin_amdgcn_ballot_w64((MA | MB) != 0u) != 0ull) {
#pragma unroll
        for (int u4 = 0; u4 < 4; ++u4) {
            { const bool act = MA != 0u; const int bp = __builtin_ctz(MA | 0x80000000u); MA &= MA - 1u;
              LAS unsigned char* const p = act ? wpA : scrA; *p = (unsigned char)(base + 30 - 2 * (bp & 15) + (bp >> 4)); wpA += act ? 1 : 0; }
            { const bool act = MB != 0u; const int bp = __builtin_ctz(MB | 0x80000000u); MB &= MB - 1u;
              LAS unsigned char* const p = act ? wpB : scrB; *p = (unsigned char)(base + 30 - 2 * (bp & 15) + (bp >> 4)); wpB += act ? 1 : 0; } }
    }
}
__device__ __forceinline__ void k_trim2(unsigned& EA, int keA, unsigned& EB, int keB) {
    while (__builtin_amdgcn_ballot_w64(__builtin_popcount(EA) > keA || __builtin_popcount(EB) > keB) != 0ull) {
        if (__builtin_popcount(EA) > keA) EA &= EA - 1u; if (__builtin_popcount(EB) > keB) EB &= EB - 1u; asm volatile("" : "+v"(EA), "+v"(EB)); }
}
__device__ __forceinline__ void k_l1_keys(const v4u (&cw)[4], const KTok& k, int lane, unsigned (&key)[16]) {
#pragma unroll
    for (int q = 0; q < 4; ++q) { const v4u w = cw[q]; *(LAS v4u*)(k.rowc + lane * 32 + q * 8) = w;
#pragma unroll
        for (int c = 0; c < 4; ++c) key[4 * q + c] = hkey2(w[c]); }
}
__device__ __forceinline__ void k_l1_post(unsigned Gm, unsigned Em, int ntot, const KTok& k, int lane) {
    const int g1 = lane >> 2, sub = lane & 3;
    const int neq = __builtin_popcount(Em);
    const int e0 = dppi<0x00>(neq), e1 = dppi<0x55>(neq), e2 = dppi<0xAA>(neq);
    const int pe = ntot + (sub > 0 ? e0 : 0) + (sub > 1 ? e1 : 0) + (sub > 2 ? e2 : 0);
    const unsigned M = Gm | k_trim(Em, min(max(16 - pe, 0), neq));
    const int cnt = __builtin_popcount(M);
    const int c0 = dppi<0x00>(cnt), c1 = dppi<0x55>(cnt), c2 = dppi<0xAA>(cnt);
    k_compact(M, k.s1i + g1 * 16 + (sub > 0 ? c0 : 0) + (sub > 1 ? c1 : 0) + (sub > 2 ? c2 : 0), k.scratch, sub * 32);
}
__device__ __forceinline__ void k_l1_post2(unsigned GmA, unsigned EmA, int ntA, const KTok& kA, unsigned GmB, unsigned EmB, int ntB, const KTok& kB, int lane) {
    const int g1 = lane >> 2, sub = lane & 3;
    const int neqA = __builtin_popcount(EmA), neqB = __builtin_popcount(EmB);
    const int eA0 = dppi<0x00>(neqA), eA1 = dppi<0x55>(neqA), eA2 = dppi<0xAA>(neqA), eB0 = dppi<0x00>(neqB), eB1 = dppi<0x55>(neqB), eB2 = dppi<0xAA>(neqB);
    const int peA = ntA + (sub > 0 ? eA0 : 0) + (sub > 1 ? eA1 : 0) + (sub > 2 ? eA2 : 0), peB = ntB + (sub > 0 ? eB0 : 0) + (sub > 1 ? eB1 : 0) + (sub > 2 ? eB2 : 0);
    unsigned EA = EmA, EB = EmB; k_trim2(EA, min(max(16 - peA, 0), neqA), EB, min(max(16 - peB, 0), neqB));
    const unsigned MA = GmA | EA, MB = GmB | EB;
    const int cntA = __builtin_popcount(MA), cntB = __builtin_popcount(MB);
    const int cA0 = dppi<0x00>(cntA), cA1 = dppi<0x55>(cntA), cA2 = dppi<0xAA>(cntA), cB0 = dppi<0x00>(cntB), cB1 = dppi<0x55>(cntB), cB2 = dppi<0xAA>(cntB);
    k_compact2(MA, kA.s1i + g1 * 16 + (sub > 0 ? cA0 : 0) + (sub > 1 ? cA1 : 0) + (sub > 2 ? cA2 : 0), kA.scratch,
               MB, kB.s1i + g1 * 16 + (sub > 0 ? cB0 : 0) + (sub > 1 ? cB1 : 0) + (sub > 2 ? cB2 : 0), kB.scratch, sub * 32);
}
__device__ __forceinline__ int k_scan8(int v, int sub8) {
    { const int t2 = dppi<0x111>(v); if (sub8 >= 1) v += t2; }
    { const int t2 = dppi<0x112>(v); if (sub8 >= 2) v += t2; }
    { const int t2 = dppi<0x114>(v); if (sub8 >= 4) v += t2; }
    return v;
}
__device__ __forceinline__ void k_l2_post2(unsigned GmA, unsigned EmA, int ntA, const KTok& kA, unsigned GmB, unsigned EmB, int ntB, const KTok& kB, int lane) {
    const int h = lane >> 3, sub8 = lane & 7;
    const int neqA = __builtin_popcount(EmA), neqB = __builtin_popcount(EmB);
    const int peA = ntA + (k_scan8(neqA, sub8) - neqA), peB = ntB + (k_scan8(neqB, sub8) - neqB);
    unsigned EA = EmA, EB = EmB; k_trim2(EA, min(max(16 - peA, 0), neqA), EB, min(max(16 - peB, 0), neqB));
    const unsigned MA = GmA | EA, MB = GmB | EB;
    const int cntA = __builtin_popcount(MA), cntB = __builtin_popcount(MB);
    k_compact2(MA, kA.s2c + h * 16 + (k_scan8(cntA, sub8) - cntA), kA.scratch, MB, kB.s2c + h * 16 + (k_scan8(cntB, sub8) - cntB), kB.scratch, sub8 * 32);
}
__device__ __forceinline__ void k_l2_keys(const KTok& k, int lane, unsigned (&key)[16]) {
    const int h = lane >> 3, sub8 = lane & 7;
    const unsigned aib = *(const LAS unsigned short*)(k.s1i + (2 * h) * 16 + 2 * sub8);
    const v4u bib = *(const LAS v4u*)(k.s1i + (2 * h + 1) * 16);
    LAS const unsigned short* ra = k.rowc + (2 * h) * 128; LAS const unsigned short* rb = ra + 128;
    const unsigned a0 = ra[aib & 0xffu], a1 = ra[aib >> 8];
    const half2_t a0x2 = __builtin_bit_cast(half2_t, a0 | (a0 << 16)), a1x2 = __builtin_bit_cast(half2_t, a1 | (a1 << 16));
    half2_t bp[8];
#pragma unroll
    for (int q = 0; q < 8; ++q) { const unsigned blo = rb[(bib[q >> 1] >> (16 * (q & 1))) & 0xffu], bhi = rb[(bib[q >> 1] >> (16 * (q & 1) + 8)) & 0xffu]; bp[q] = __builtin_bit_cast(half2_t, blo | (bhi << 16)); }
#pragma unroll
    for (int i = 0; i < 16; ++i) key[i] = hkey2(__builtin_bit_cast(unsigned, ((i < 8) ? a0x2 : a1x2) + bp[i & 7]));
}
__device__ __forceinline__ void k_l2_post(unsigned Gm, unsigned Em, int ntot, const KTok& k, int lane) {
    const int h = lane >> 3, sub8 = lane & 7;
    const int neq = __builtin_popcount(Em);
    int se = neq;
    { const int t2 = dppi<0x111>(se); if (sub8 >= 1) se += t2; }
    { const int t2 = dppi<0x112>(se); if (sub8 >= 2) se += t2; }
    { const int t2 = dppi<0x114>(se); if (sub8 >= 4) se += t2; }
    const int pe = ntot + (se - neq);
    const unsigned M = Gm | k_trim(Em, min(max(16 - pe, 0), neq));
    const int cnt = __builtin_popcount(M); int sc = cnt;
    { const int t1 = dppi<0x111>(sc); if (sub8 >= 1) sc += t1; }
    { const int t1 = dppi<0x112>(sc); if (sub8 >= 2) sc += t1; }
    { const int t1 = dppi<0x114>(sc); if (sub8 >= 4) sc += t1; }
    k_compact(M, k.s2c + h * 16 + (sc - cnt), k.scratch, sub8 * 32);
}
__device__ __forceinline__ void k_gates(int t, f32x4 rq, const KTok& k, int lane, const float* SU, const float* SV, unsigned short* IDX, float* GW, float* MU) {
    float rinv; { float sv_ = (rq[0] + rq[1]) + (rq[2] + rq[3]); sv_ += dppf<0xB1>(sv_); sv_ += dppf<0x4E>(sv_); rinv = __builtin_amdgcn_rsqf(sv_ * (1.f / D) + 1e-6f); }
#pragma unroll
    for (int kk = 0; kk < 2; ++kk) { const int kx = lane + 64 * kk, hh = kx >> 4; const unsigned cand = k.s2c[kx];
        const unsigned ia = k.s1i[(2 * hh) * 16 + (cand >> 4)], ib = k.s1i[(2 * hh + 1) * 16 + (cand & 15u)];
        const float sv = hlo((unsigned)k.rowc[(2 * hh) * 128 + ia]) + hlo((unsigned)k.rowc[(2 * hh + 1) * 128 + ib]); float mx = sv;
        mx = fmaxf(mx, dppf<0xB1>(mx)); mx = fmaxf(mx, dppf<0x4E>(mx)); mx = fmaxf(mx, dppf<0x141>(mx)); mx = fmaxf(mx, dppf<0x140>(mx));
        const float ex = __builtin_amdgcn_exp2f((sv - mx) * 1.4426950408889634f); float sum = ex;
        sum += dppf<0xB1>(sum); sum += dppf<0x4E>(sum); sum += dppf<0x141>(sum); sum += dppf<0x140>(sum);
        const unsigned ee = ia * 128u + ib; const size_t o = (size_t)t * 128 + (kx & 7) * 16 + (kx >> 3);
        IDX[o] = (unsigned short)ee; GW[o] = ex * __builtin_amdgcn_rcpf(sum) * SV[ee]; MU[o] = rinv * SU[ee]; }
}
struct KConv { f32x4 cr[4], cg[4], cp0; };
__device__ __forceinline__ void k_conv_load(const ConvNext& cv, int t, int lane, KConv& c) {
    const bool cu = t < NEXP; const float* rp = cu ? cv.u + (size_t)t * D : cv.v + (size_t)(t - NEXP) * D;
#pragma unroll
    for (int j = 0; j < 4; ++j) { c.cr[j] = *(const f32x4*)(rp + 16 * lane + 4 * j); c.cg[j] = *(const f32x4*)(cv.gain + 16 * lane + 4 * j); }
    c.cp0 = *(const f32x4*)(cv.p + ((size_t)t * 64 + lane) * 4);
}
__device__ __forceinline__ void k_conv_store(const ConvNext& cv, int t, int lane, KConv& c) {
    if (t < NEXP) {
#pragma unroll
        for (int j = 0; j < 4; ++j) c.cr[j] = c.cr[j] * c.cg[j];
        quant_store_i8(c.cr, cv.U8, t, cv.SU + t, lane); }
    else quant_store_i8(c.cr, cv.V8, t - NEXP, cv.SV + (t - NEXP), lane);
    { v2u w; w.x = pk2(c.cp0[0], c.cp0[1]); w.y = pk2(c.cp0[2], c.cp0[3]); *(v2u*)(cv.PB + ((size_t)t * 64 + lane) * 4) = w; }
}
__device__ __forceinline__ void peer_topk_phase(const unsigned short* S, const float* ssq_in, const float* SU, const float* SV, unsigned short* IDX, float* GW, float* MU,
                                                const ConvNext cv, LAS unsigned char* lds, int vcu, int G, int wave) {
    const int lane = lane_id_fresh();
    const KTok kA = ktok(lds + wave * 12288, lane), kB = ktok(lds + wave * 12288 + 6144, lane);
    const int gw = vcu * NWAVES + wave, NW = G * NWAVES;
    v4u nxA[4], nxB[4];
#define K_SROW(dst, tt) do { const v4u* sp_ = (const v4u*)(S + (size_t)min((tt), T - 1) * 2048 + lane * 32); _Pragma("unroll") for (int q = 0; q < 4; ++q) dst[q] = sp_[q]; } while (0)
    K_SROW(nxA, gw); K_SROW(nxB, gw + NW);
    for (int t = gw; t < T; t += 2 * NW) {
        const int tB = (t + NW < T) ? t + NW : t;
        v4u cwA[4], cwB[4];
#pragma unroll
        for (int q = 0; q < 4; ++q) { cwA[q] = nxA[q]; cwB[q] = nxB[q]; }
        const f32x4 rqA = *(const f32x4*)(ssq_in + (size_t)t * 16 + 4 * (lane & 3)), rqB = *(const f32x4*)(ssq_in + (size_t)tB * 16 + 4 * (lane & 3));
        K_SROW(nxA, t + 2 * NW); K_SROW(nxB, t + 3 * NW);
        KConv cA, cB; if (cv.on) { k_conv_load(cv, t, lane, cA); k_conv_load(cv, tB, lane, cB); }
        { unsigned keyA[16], keyB[16]; k_l1_keys(cwA, kA, lane, keyA); k_l1_keys(cwB, kB, lane, keyB);
          unsigned GmA, EmA, GmB, EmB; int nA, nB; topk_select16x2<4>(keyA, keyB, GmA, EmA, nA, GmB, EmB, nB);
          k_l1_post2(GmA, EmA, nA, kA, GmB, EmB, nB, kB, lane); }
        LDS_WAIT();
        { unsigned keyA[16], keyB[16]; k_l2_keys(kA, lane, keyA); k_l2_keys(kB, lane, keyB);
          unsigned GmA, EmA, GmB, EmB; int nA, nB; topk_select16x2<8>(keyA, keyB, GmA, EmA, nA, GmB, EmB, nB);
          k_l2_post2(GmA, EmA, nA, kA, GmB, EmB, nB, kB, lane); }
        LDS_WAIT();
        k_gates(t, rqA, kA, lane, SU, SV, IDX, GW, MU); k_gates(tB, rqB, kB, lane, SU, SV, IDX, GW, MU);
        if (cv.on) {
            if ((t < NEXP) == (tB < NEXP)) {
                if (t < NEXP) {
#pragma unroll
                    for (int j = 0; j < 4; ++j) { cA.cr[j] = cA.cr[j] * cA.cg[j]; cB.cr[j] = cB.cr[j] * cB.cg[j]; }
                    quant_store_i8(cA.cr, cv.U8, t, cv.SU + t, lane); quant_store_i8(cB.cr, cv.U8, tB, cv.SU + tB, lane); }
                else { quant_store_i8(cA.cr, cv.V8, t - NEXP, cv.SV + (t - NEXP), lane); quant_store_i8(cB.cr, cv.V8, tB - NEXP, cv.SV + (tB - NEXP), lane); }
                { v2u w; w.x = pk2(cA.cp0[0], cA.cp0[1]); w.y = pk2(cA.cp0[2], cA.cp0[3]); *(v2u*)(cv.PB + ((size_t)t * 64 + lane) * 4) = w; }
                { v2u w; w.x = pk2(cB.cp0[0], cB.cp0[1]); w.y = pk2(cB.cp0[2], cB.cp0[3]); *(v2u*)(cv.PB + ((size_t)tB * 64 + lane) * 4) = w; }
            } else { k_conv_store(cv, t, lane, cA); k_conv_store(cv, tB, lane, cB); } }
        LDS_WAIT();
    }
#undef K_SROW
}
__device__ __forceinline__ int dot4_first(int a, int b) { int r; asm("v_dot4_i32_i8 %0, %1, %2, 0" : "=v"(r) : "v"(a), "v"(b)); return r; }
__device__ __forceinline__ unsigned peer_off_lo(unsigned w, unsigned m, unsigned a) { unsigned r; asm("v_mad_u32_u16 %0, %1, %2, %3" : "=v"(r) : "v"(w), "s"(m), "v"(a)); return r; }
__device__ __forceinline__ unsigned peer_off_hi(unsigned w, unsigned m, unsigned a) { unsigned r; asm("v_mad_u32_u16 %0, %1, %2, %3 op_sel:[1,0,0,0]" : "=v"(r) : "v"(w), "s"(m), "v"(a)); return r; }
#define PEER_ISSUE8(buf, o, idw, TAB) do { _Pragma("unroll") for (int b = 0; b < 8; ++b) { \
        const unsigned off = (b & 1) ? peer_off_hi((idw)[b >> 1], 128u, taboff) : peer_off_lo((idw)[b >> 1], 128u, taboff); \
        buf[(o) + b] = *(const v4u*)((TAB) + (size_t)off); } } while (0)
#define PEER_ISSUE16(buf, i0, i1, TAB) do { PEER_ISSUE8(buf, 0, i0, TAB); PEER_ISSUE8(buf, 8, i1, TAB); } while (0)
template <int M> __device__ __forceinline__ unsigned swz8(unsigned v) { return (unsigned)__builtin_amdgcn_ds_swizzle((int)v, 0x18 | (M << 5)); }
#define SWZ8(v, m) swz8<m>(v)
#define PEER_ISSUE_U1(buf, iw, TAB, p) do { const unsigned w_ = swz8<p>(iw); \
        buf[2 * (p)] = *(const v4u*)((TAB) + (size_t)peer_off_lo(w_, 128u, taboff)); buf[2 * (p) + 1] = *(const v4u*)((TAB) + (size_t)peer_off_hi(w_, 128u, taboff)); } while (0)
#define PEER_ISSUE_U(buf, iw, TAB) do { PEER_ISSUE_U1(buf, iw, TAB, 0); PEER_ISSUE_U1(buf, iw, TAB, 1); PEER_ISSUE_U1(buf, iw, TAB, 2); PEER_ISSUE_U1(buf, iw, TAB, 3); \
        PEER_ISSUE_U1(buf, iw, TAB, 4); PEER_ISSUE_U1(buf, iw, TAB, 5); PEER_ISSUE_U1(buf, iw, TAB, 6); PEER_ISSUE_U1(buf, iw, TAB, 7); } while (0)
#define PEER_ISSUE_V1(buf, r, TAB, m) do { const unsigned w0_ = swz8<m>((r).x), w1_ = swz8<m>((r).y); \
        buf[4 * (m)] = *(const v4u*)((TAB) + (size_t)peer_off_lo(w0_, 128u, taboff)); buf[4 * (m) + 1] = *(const v4u*)((TAB) + (size_t)peer_off_hi(w0_, 128u, taboff)); \
        buf[4 * (m) + 2] = *(const v4u*)((TAB) + (size_t)peer_off_lo(w1_, 128u, taboff)); buf[4 * (m) + 3] = *(const v4u*)((TAB) + (size_t)peer_off_hi(w1_, 128u, taboff)); } while (0)
#define PEER_ISSUE_V(buf, r, TAB) do { PEER_ISSUE_V1(buf, r, TAB, 0); PEER_ISSUE_V1(buf, r, TAB, 1); PEER_ISSUE_V1(buf, r, TAB, 2); PEER_ISSUE_V1(buf, r, TAB, 3); } while (0)
#define PEER_PIN4(v) asm volatile("" : "+v"((v).x), "+v"((v).y), "+v"((v).z), "+v"((v).w))
#define VPTR(base, rowbytes, tt, off) ((const char*)(base) + (size_t)(tt) * (rowbytes) + (off))
template <int LIGHT>
__device__ __forceinline__ void peer_u_phase(const unsigned short* IDX, const bf16* XB, const unsigned char* U8, unsigned short* PART, int bid, int G, int wave) {
    const int lane = lane_id_fresh(), j = lane >> 3, c = lane & 7;
    const int NS = G < 8 ? G : 8, rank = bid / NS, nrank = (G - (bid % NS) + NS - 1) / NS;
    for (int s = bid % NS; s < 8; s += NS) {
        const unsigned coloff = (unsigned)(s * 128 + c * 16), taboff = (unsigned)(s * (NEXP * 128) + c * 16);
        const int stride = nrank * NWAVES;
        unsigned short* part = PART + (size_t)s * T * 128;
        unsigned o_idx = (unsigned)(j * 32 + c * 4), o_x = coloff * 2u + (unsigned)((j & 1) * 16), o_p = (unsigned)(j * 32 + c * 4); const bool xhalf = (j & 1) != 0;
#define PEER_U_TOKEN(buf, xh, tt) do { \
              \
            v4u xa, xb; { v4u ph; _Pragma("unroll") for (int k = 0; k < 4; ++k) ph[k] = (unsigned)dppi<0x128>((int)(xh)[k]); \
                _Pragma("unroll") for (int k = 0; k < 4; ++k) { xa[k] = xhalf ? ph[k] : (xh)[k]; xb[k] = xhalf ? (xh)[k] : ph[k]; } } \
            const float xv[16] = {bflo(xa.x), bfhi(xa.x), bflo(xa.y), bfhi(xa.y), bflo(xa.z), bfhi(xa.z), bflo(xa.w), bfhi(xa.w), bflo(xb.x), bfhi(xb.x), bflo(xb.y), bfhi(xb.y), bflo(xb.z), bfhi(xb.z), bflo(xb.w), bfhi(xb.w)}; \
              \
            float am = 0.f; _Pragma("unroll") for (int i = 0; i < 16; ++i) am = fmaxf(am, fabsf(xv[i])); \
            { unsigned ab = __builtin_bit_cast(unsigned, am); ab = max(ab, (unsigned)dppi<0xB1>((int)ab)); ab = max(ab, (unsigned)dppi<0x4E>((int)ab)); ab = max(ab, (unsigned)dppi<0x141>((int)ab)); am = __builtin_bit_cast(float, ab); }   \
            const float xinv = am > 0.f ? 127.f / am : 0.f, xsc = am * (0.015625f / 127.f)  ; \
            int xq[4]; _Pragma("unroll") for (int q = 0; q < 4; ++q) xq[q] = (int)pack_i8x4((f32x4){xv[4 * q], xv[4 * q + 1], xv[4 * q + 2], xv[4 * q + 3]}, xinv); \
            int dd[16]; \
            _Pragma("unroll") for (int b = 0; b < 16; ++b) { PEER_PIN4(buf[b]); \
                if (LIGHT) { dd[b] = (int)((buf[b].x ^ buf[b].y) ^ (buf[b].z ^ buf[b].w)) + xq[b & 3]; continue; } \
                int d = dot4_first((int)buf[b].x, xq[0]); d = __builtin_amdgcn_sdot4((int)buf[b].y, xq[1], d, false); \
                d = __builtin_amdgcn_sdot4((int)buf[b].z, xq[2], d, false); dd[b] = __builtin_amdgcn_sdot4((int)buf[b].w, xq[3], d, false); } \
              \
            const bool cb2 = (c & 4) != 0, cb1 = (c & 2) != 0, cb0 = (c & 1) != 0; \
            int e8[8], e4[4], e2[2]; \
            _Pragma("unroll") for (int k = 0; k < 8; ++k) { const int keep = cb2 ? dd[8 + k] : dd[k], send = cb2 ? dd[k] : dd[8 + k]; e8[k] = keep + dppi<0x141>(send); } \
            _Pragma("unroll") for (int k = 0; k < 4; ++k) { const int keep = cb1 ? e8[4 + k] : e8[k], send = cb1 ? e8[k] : e8[4 + k]; e4[k] = keep + dppi<0x1B>(send); } \
            _Pragma("unroll") for (int k = 0; k < 2; ++k) { const int keep = cb0 ? e4[2 + k] : e4[k], send = cb0 ? e4[k] : e4[2 + k]; e2[k] = keep + dppi<0xB1>(send); } \
            *(unsigned*)VPTR(part, 256, tt, o_p) = pkh2((float)e2[0] * xsc, (float)e2[1] * xsc); } while (0)
        v4u bufA[16], bufB[16], xA, xB; unsigned iA = 0u, iB = 0u;
        xA = xB = (v4u){0u, 0u, 0u, 0u};
        int t = rank * NWAVES + wave;
        if (t + 3 * stride < T) {
            { iA = *(const unsigned*)VPTR(IDX, 256, t, o_idx); xA = *(const v4u*)VPTR(XB, 2048, t, o_x); }
            { iB = *(const unsigned*)VPTR(IDX, 256, t + stride, o_idx); }
            PEER_ISSUE_U(bufA, iA, U8);
        do {
            asm volatile("" : "+v"(o_idx), "+v"(o_x), "+v"(o_p));
            const int t1 = t + stride, t2 = t1 + stride, t3 = t2 + stride;
            { iA = *(const unsigned*)VPTR(IDX, 256, t2, o_idx); }
            PEER_ISSUE_U(bufB, iB, U8);
            { xB = *(const v4u*)VPTR(XB, 2048, t1, o_x); }
            PEER_U_TOKEN(bufA, xA, t);
            { iB = *(const unsigned*)VPTR(IDX, 256, t3, o_idx); }
            PEER_ISSUE_U(bufA, iA, U8);
            { xA = *(const v4u*)VPTR(XB, 2048, t2, o_x); }
            PEER_U_TOKEN(bufB, xB, t1);
            t = t2;
        } while (t + 3 * stride < T);
        } else {
        if (t < T) { iA = *(const unsigned*)VPTR(IDX, 256, t, o_idx); xA = *(const v4u*)VPTR(XB, 2048, t, o_x); }
        if (t + stride < T) { iB = *(const unsigned*)VPTR(IDX, 256, t + stride, o_idx); }
        if (t < T) PEER_ISSUE_U(bufA, iA, U8);
        }
        while (t < T) {
            asm volatile("" : "+v"(o_idx), "+v"(o_x), "+v"(o_p));
            const int t1 = t + stride, t2 = t1 + stride, t3 = t2 + stride;
            if (t1 < T) { PEER_ISSUE_U(bufB, iB, U8); xB = *(const v4u*)VPTR(XB, 2048, t1, o_x); }
            if (t2 < T) { iA = *(const unsigned*)VPTR(IDX, 256, t2, o_idx); }
            PEER_U_TOKEN(bufA, xA, t);
            if (t1 < T) {
                if (t2 < T) { PEER_ISSUE_U(bufA, iA, U8); xA = *(const v4u*)VPTR(XB, 2048, t2, o_x); }
                if (t3 < T) { iB = *(const unsigned*)VPTR(IDX, 256, t3, o_idx); }
                PEER_U_TOKEN(bufB, xB, t1);
            }
            t = t2;
        }
#undef PEER_U_TOKEN
    }
}
__device__ __forceinline__ void peer_w_phase(const unsigned short* PART, const float* GW, const float* MU, const unsigned short* IDX, unsigned* VREC, int bid, int G, int wave) {
    const int tid = wave * 64 + lane_id_fresh(), gtid = bid * NTHR + tid, NT = G * NTHR;
#define PEER_W_LOAD(i_, p_, mu0_, mu1_, gw0_, gw1_, ids_) do { const size_t o_ = (size_t)min((i_), T * 16 - 1) * 8; _Pragma("unroll") for (int s = 0; s < 8; ++s) p_[s] = *(const v4u*)(PART + (size_t)s * T * 128 + o_); \
        mu0_ = *(const f32x4*)(MU + o_); mu1_ = *(const f32x4*)(MU + o_ + 4); gw0_ = *(const f32x4*)(GW + o_); gw1_ = *(const f32x4*)(GW + o_ + 4); ids_ = *(const v4u*)(IDX + o_); } while (0)
    v4u np[8]; f32x4 nmu0, nmu1, ngw0, ngw1; v4u nids;
    PEER_W_LOAD(gtid, np, nmu0, nmu1, ngw0, ngw1, nids);
    for (int i = gtid; i < T * 16; i += NT) {
        v4u p[8]; f32x4 mu0 = nmu0, mu1 = nmu1, gw0 = ngw0, gw1 = ngw1; const v4u ids = nids;
#pragma unroll
        for (int s = 0; s < 8; ++s) p[s] = np[s];
        PEER_W_LOAD(i + NT, np, nmu0, nmu1, ngw0, ngw1, nids);
        f32x4 a0 = {0.f, 0.f, 0.f, 0.f}, a1 = {0.f, 0.f, 0.f, 0.f}, w0, w1;
#pragma unroll
        for (int s = 0; s < 8; ++s) { a0 += (f32x4){hlo(p[s].x), hhi(p[s].x), hlo(p[s].y), hhi(p[s].y)}; a1 += (f32x4){hlo(p[s].z), hhi(p[s].z), hlo(p[s].w), hhi(p[s].w)}; }
#pragma unroll
        for (int q = 0; q < 4; ++q) { w0[q] = gw0[q] * gelu_tanh(a0[q] * 64.f * mu0[q]); w1[q] = gw1[q] * gelu_tanh(a1[q] * 64.f * mu1[q]); }
        float am = fmaxf(fmaxf(fmaxf(fabsf(w0[0]), fabsf(w0[1])), fmaxf(fabsf(w0[2]), fabsf(w0[3]))), fmaxf(fmaxf(fabsf(w1[0]), fabsf(w1[1])), fmaxf(fabsf(w1[2]), fabsf(w1[3]))));
        { unsigned ab = __builtin_bit_cast(unsigned, am); ab = max(ab, (unsigned)dppi<0xB1>((int)ab)); ab = max(ab, (unsigned)dppi<0x4E>((int)ab)); ab = max(ab, (unsigned)dppi<0x141>((int)ab)); ab = max(ab, (unsigned)dppi<0x140>((int)ab));
          am = __builtin_bit_cast(float, ab); }
        const float winv = am > 0.f ? 127.f / am : 0.f; const unsigned sc = __builtin_bit_cast(unsigned, am * (1.f / 127.f));
        unsigned* rec = VREC + (size_t)(i >> 1) * 16; const int h8 = i & 1;
        *(v4u*)(rec + 4 * h8) = ids; *(v2u*)(rec + 8 + 2 * h8) = (v2u){pack_i8x4(w0, winv), pack_i8x4(w1, winv)}; *(v2u*)(rec + 12 + 2 * h8) = (v2u){sc, sc}; }
#undef PEER_W_LOAD
}
__device__ __forceinline__ void peer_v_phase(const unsigned* VREC, const unsigned char* V8, const bf16* XB, bf16* XBo, float* ssq_out, int bid, int G, int wave) {
    const int lane = lane_id_fresh(), j = lane >> 3, c = lane & 7;
    const int NS = G < 8 ? G : 8, rank = bid / NS, nrank = (G - (bid % NS) + NS - 1) / NS;
    for (int s = bid % NS; s < 8; s += NS) {
        const unsigned coloff = (unsigned)(s * 128 + c * 16), taboff = (unsigned)(s * (NEXP * 128) + c * 16);
        const int stride = nrank * NWAVES;
        unsigned o_rec = (unsigned)(j * 64 + c * 8), o_xb = (coloff + 2u * j) * 2u;
#define PEER_V_TOKEN(buf, w, xr, tt) do { \
              \
            const float wsc = __builtin_bit_cast(float, SWZ8((w).x, 6)); const int wq[4] = {(int)SWZ8((w).x, 4), (int)SWZ8((w).y, 4), (int)SWZ8((w).x, 5), (int)SWZ8((w).y, 5)}; \
            int ia[16]; \
            _Pragma("unroll") for (int B = 0; B < 4; ++B) { PEER_PIN4(buf[4 * B]); PEER_PIN4(buf[4 * B + 1]); PEER_PIN4(buf[4 * B + 2]); PEER_PIN4(buf[4 * B + 3]); \
                _Pragma("unroll") for (int q = 0; q < 4; ++q) { const unsigned D0 = buf[4 * B][q], D1 = buf[4 * B + 1][q], D2 = buf[4 * B + 2][q], D3 = buf[4 * B + 3][q]; \
                    const unsigned P0 = __builtin_amdgcn_perm(D1, D0, 0x05010400u), P1 = __builtin_amdgcn_perm(D1, D0, 0x07030602u), Q0 = __builtin_amdgcn_perm(D3, D2, 0x05010400u), Q1 = __builtin_amdgcn_perm(D3, D2, 0x07030602u); \
                    ia[4 * q + 0] = (B == 0) ? dot4_first((int)__builtin_amdgcn_perm(Q0, P0, 0x05040100u), wq[0]) : __builtin_amdgcn_sdot4((int)__builtin_amdgcn_perm(Q0, P0, 0x05040100u), wq[B], ia[4 * q + 0], false); \
                    ia[4 * q + 1] = (B == 0) ? dot4_first((int)__builtin_amdgcn_perm(Q0, P0, 0x07060302u), wq[0]) : __builtin_amdgcn_sdot4((int)__builtin_amdgcn_perm(Q0, P0, 0x07060302u), wq[B], ia[4 * q + 1], false); \
                    ia[4 * q + 2] = (B == 0) ? dot4_first((int)__builtin_amdgcn_perm(Q1, P1, 0x05040100u), wq[0]) : __builtin_amdgcn_sdot4((int)__builtin_amdgcn_perm(Q1, P1, 0x05040100u), wq[B], ia[4 * q + 2], false); \
                    ia[4 * q + 3] = (B == 0) ? dot4_first((int)__builtin_amdgcn_perm(Q1, P1, 0x07060302u), wq[0]) : __builtin_amdgcn_sdot4((int)__builtin_amdgcn_perm(Q1, P1, 0x07060302u), wq[B], ia[4 * q + 3], false); } } \
              \
            int e2a, e2b, e2c, e2d; const bool b3 = (lane & 8) != 0; \
            { int p0 = ia[0], q0 = ia[8], p1 = ia[1], q1 = ia[9], p2 = ia[2], q2 = ia[10], p3 = ia[3], q3 = ia[11], p4 = ia[4], q4 = ia[12], p5 = ia[5], q5 = ia[13], p6 = ia[6], q6 = ia[14], p7 = ia[7], q7 = ia[15]; \
              asm volatile("s_nop 1\n\tv_permlane32_swap_b32 %0, %1\n\tv_permlane32_swap_b32 %2, %3\n\tv_permlane32_swap_b32 %4, %5\n\tv_permlane32_swap_b32 %6, %7\n\t" \
                           "v_permlane32_swap_b32 %8, %9\n\tv_permlane32_swap_b32 %10, %11\n\tv_permlane32_swap_b32 %12, %13\n\tv_permlane32_swap_b32 %14, %15" \
                           : "+v"(p0), "+v"(q0), "+v"(p1), "+v"(q1), "+v"(p2), "+v"(q2), "+v"(p3), "+v"(q3), "+v"(p4), "+v"(q4), "+v"(p5), "+v"(q5), "+v"(p6), "+v"(q6), "+v"(p7), "+v"(q7)); \
              int s0 = p0 + q0, s1 = p1 + q1, s2 = p2 + q2, s3 = p3 + q3, s4_ = p4 + q4, s5 = p5 + q5, s6 = p6 + q6, s7 = p7 + q7; \
              asm volatile("s_nop 1\n\tv_permlane16_swap_b32 %0, %1\n\tv_permlane16_swap_b32 %2, %3\n\tv_permlane16_swap_b32 %4, %5\n\tv_permlane16_swap_b32 %6, %7" \
                           : "+v"(s0), "+v"(s4_), "+v"(s1), "+v"(s5), "+v"(s2), "+v"(s6), "+v"(s3), "+v"(s7)); \
              e2a = s0 + s4_; e2b = s1 + s5; e2c = s2 + s6; e2d = s3 + s7; } \
            int r1x, r1y; { const int kx = b3 ? e2c : e2a, ky = b3 ? e2d : e2b, sx = b3 ? e2a : e2c, sy = b3 ? e2b : e2d; r1x = kx + dppi<0x128>(sx); r1y = ky + dppi<0x128>(sy); } \
            struct { float x, y; } r1 = {(float)r1x * wsc, (float)r1y * wsc}; \
            f32x2 xn = {bflo(xr) + r1.x, bfhi(xr) + r1.y}; \
            *(unsigned*)VPTR(XBo, 2048, tt, o_xb) = pk2(xn[0], xn[1]); \
            const float sq = wave_sum_dpp(xn[0] * xn[0] + xn[1] * xn[1]); SQOUT(sq, tt); } while (0)
        v4u bufA[16], bufB[16]; v2u rA = {0u, 0u}, rB = {0u, 0u}, rC = {0u, 0u};
        unsigned xrA = 0u, xrB = 0u;
#define PEER_V_REC(tt) (*(const v2u*)VPTR(VREC, 512, tt, o_rec))
#define PEER_V_XR(tt) (*(const unsigned*)VPTR(XB, 2048, tt, o_xb))
        int t = rank * NWAVES + wave;
        if (t + 3 * stride < T) {
            rA = PEER_V_REC(t); xrA = PEER_V_XR(t); rB = PEER_V_REC(t + stride);
            PEER_ISSUE_V(bufA, rA, V8);
        float sqA = 0.f;
#define SQOUT(v, tt) do { if ((tt) == t) sqA = (v); else if (lane < 2) ssq_out[(size_t)(lane ? (tt) : t) * 16 + s] = lane ? (v) : sqA; } while (0)
        do {
            asm volatile("" : "+v"(o_rec), "+v"(o_xb));
            const int t1 = t + stride, t2 = t1 + stride, t3 = t2 + stride;
            rC = PEER_V_REC(t2);
            PEER_ISSUE_V(bufB, rB, V8); xrB = PEER_V_XR(t1);
            PEER_V_TOKEN(bufA, rA, xrA, t);
            rA = rC; rC = PEER_V_REC(t3);
            PEER_ISSUE_V(bufA, rA, V8); xrA = PEER_V_XR(t2);
            PEER_V_TOKEN(bufB, rB, xrB, t1);
            rB = rC;
            t = t2;
        } while (t + 3 * stride < T);
#undef SQOUT
        } else {
        if (t < T) { rA = PEER_V_REC(t); xrA = PEER_V_XR(t); }
        if (t + stride < T) rB = PEER_V_REC(t + stride);
        if (t < T) PEER_ISSUE_V(bufA, rA, V8);
        }
#define SQOUT(v, tt) do { if (lane == 0) ssq_out[(size_t)(tt) * 16 + s] = (v); } while (0)
        while (t < T) {
            asm volatile("" : "+v"(o_rec), "+v"(o_xb));
            const int t1 = t + stride, t2 = t1 + stride, t3 = t2 + stride;
            if (t2 < T) rC = PEER_V_REC(t2);
            if (t1 < T) { PEER_ISSUE_V(bufB, rB, V8); xrB = PEER_V_XR(t1); }
            PEER_V_TOKEN(bufA, rA, xrA, t);
            if (t1 < T) {
                rA = rC; if (t3 < T) rC = PEER_V_REC(t3);
                if (t2 < T) { PEER_ISSUE_V(bufA, rA, V8); xrA = PEER_V_XR(t2); }
                PEER_V_TOKEN(bufB, rB, xrB, t1);
                rB = rC;
            }
            t = t2;
        }
#undef SQOUT
#undef PEER_V_REC
#undef PEER_V_XR
#undef PEER_V_TOKEN
    }
}
#undef PEER_ISSUE8
#undef PEER_ISSUE16
#undef PEER_PIN4
#undef VPTR

constexpr int AT_KST = 24576, AT_KPE = 16384, AT_VBASE = 3 * AT_KST, AT_VST = 16384;
constexpr int ATTN_LDS = AT_VBASE + 4 * AT_VST;
__device__ __forceinline__ void attn_phase(const bf16* Q, const bf16* KN, const bf16* KPE, const bf16* VT, bf16* AO, LAS unsigned char* lds, int vcu, int G, int wave) {
    const int lane = lane_id_fresh(), tid = wave * 64 + lane;
    const int rho = lane & 31, hh = lane >> 5;
    const int krow = (rho & 0x13) | ((rho & 4) << 1) | ((rho & 8) >> 1);
    const bool lag = wave >= 4;
    for (int it = vcu; it < 1024; it += G) {
        const int c = it & 255, kq = it >> 8, bh = c >> 2, q4 = c & 3;
        const int qb = (kq == 0) ? 15 - q4 : (kq == 1) ? q4 : (kq == 2) ? 8 + q4 : 7 - q4;
        const int b = bh >> 3, h = bh & 7;
        const int q0 = qb * 256, qlo = q0 + wave * 32, trow0 = b * SEQ + qlo;
        f32x16 o[4];
#pragma unroll
        for (int d = 0; d < 4; ++d)
#pragma unroll
            for (int r = 0; r < 16; ++r) o[d][r] = 0.f;
        float m_run = -1e30f, l_run = 0.f;
        const int nkt = 4 * (qb + 1);
        unsigned vk[2], vp, vv[2];
#pragma unroll
        for (int i = 0; i < 2; ++i) { const int id = tid + 512 * i; { const int row = id >> 4, cc = (id & 15) ^ (row & 15); vk[i] = (unsigned)(row * (D * 2) + cc * 16); }
            { const int row = id >> 3, cc = (id & 7) ^ ((row >> 1) & 7); vv[i] = (unsigned)row * (unsigned)(T * 2) + (unsigned)(cc * 16); } }
        { const int row = tid >> 3, cc = (tid & 7) ^ ((row >> 1) & 7); vp = (unsigned)(row * (QKR * 2) + cc * 16); }
        const unsigned ldsb = (unsigned)(size_t)lds + (unsigned)wave * 1024u;
#define AT_DMA(sbase, voff, ldsdst) do { unsigned _keep; asm volatile("s_mov_b32 %0, m0\n\ts_mov_b32 m0, %3\n\ts_nop 4\n\tglobal_load_lds_dwordx4 %1, %2\n\ts_mov_b32 m0, %0" \
            : "=&s"(_keep) : "v"(voff), "s"(sbase), "s"(ldsdst) : "memory"); } while (0)
#define AT_STAGE_TILE(kt, ks, vs) do { const int tk0 = b * SEQ + (kt) * 64; const unsigned kb2 = ldsb + (unsigned)(ks) * AT_KST, vb2 = ldsb + AT_VBASE + (unsigned)(vs) * AT_VST; \
            const bf16* kb_ = KN + (size_t)tk0 * D + h * QKN; const bf16* pb_ = KPE + (size_t)tk0 * QKR; const bf16* vb_ = VT + (size_t)(h * VH) * T + tk0; \
            AT_DMA(kb_, vk[0], kb2); AT_DMA(kb_, vk[1], kb2 + 8192u); AT_DMA(pb_, vp, kb2 + AT_KPE); AT_DMA(vb_, vv[0], vb2); AT_DMA(vb_, vv[1], vb2 + 8192u); } while (0)
#define AT_SYNC() asm volatile("s_waitcnt vmcnt(0) lgkmcnt(0)\n\ts_barrier" ::: "memory")
#define AT_SYNC5() asm volatile("s_waitcnt vmcnt(5) lgkmcnt(0)\n\ts_barrier" ::: "memory")
#define AT_KADDR(kb, s) ((s) < 8 ? st + ((kb) * 32 + krow) * 256 + (((2 * (s) + hh) ^ (krow & 15)) << 4) : st + AT_KPE + ((kb) * 32 + krow) * 128 + (((2 * ((s) - 8) + hh) ^ ((((kb) * 32 + krow) >> 1) & 7)) << 4))
#define AT_KREAD(dst, kb, s0) do { _Pragma("unroll") for (int i = 0; i < 6; ++i) dst[i] = *(const LAS bf16x8*)AT_KADDR(kb, (s0) + i); } while (0)
#define AT_KMMA(src_, kb, s0) do { _Pragma("unroll") for (int i = 0; i < 6; ++i) sacc[kb] = __builtin_amdgcn_mfma_f32_32x32x16_bf16(src_[i], qf[(s0) + i], sacc[kb], 0, 0, 0); } while (0)
#define AT_QK(ks) do { const LAS unsigned char* st = lds + (ks) * AT_KST; bf16x8 fx[6], fy[6]; __builtin_amdgcn_s_setprio(1); \
            _Pragma("unroll") for (int kb = 0; kb < 2; ++kb) _Pragma("unroll") for (int r = 0; r < 16; ++r) sacc[kb][r] = 0.f; \
            AT_KREAD(fx, 0, 0); AT_KREAD(fy, 0, 6); \
            AT_KMMA(fx, 0, 0); __builtin_amdgcn_sched_barrier(0); AT_KREAD(fx, 1, 0); \
            AT_KMMA(fy, 0, 6); __builtin_amdgcn_sched_barrier(0); AT_KREAD(fy, 1, 6); \
            AT_KMMA(fx, 1, 0); AT_KMMA(fy, 1, 6); __builtin_amdgcn_s_setprio(0); } while (0)
#define AT_SM(key0v) do { \
            if ((key0v) + 63 > qlo) { const int qpos = qlo + rho; \
                _Pragma("unroll") for (int kb = 0; kb < 2; ++kb) \
                    _Pragma("unroll") for (int r = 0; r < 16; ++r) { const int kpos = (key0v) + 32 * kb + (r & 3) + 4 * ((r >> 2) & 1) + 8 * hh + 16 * (r >> 3); if (kpos > qpos) sacc[kb][r] = -1e30f; } } \
            AT_SM_NM(); } while (0)
#define AT_SM_NM() do { \
            float mx = sacc[0][0]; \
            _Pragma("unroll") for (int kb = 0; kb < 2; ++kb) \
                _Pragma("unroll") for (int r = 0; r < 16; ++r) mx = fmaxf(mx, sacc[kb][r]); \
            mx = fmaxf(mx, shx<32>(mx, lane)); \
            const float m_new = fmaxf(m_run, mx), alpha = __builtin_amdgcn_exp2f(m_run - m_new); m_run = m_new; \
            float lsum = 0.f; \
            _Pragma("unroll") for (int kb = 0; kb < 2; ++kb) \
                _Pragma("unroll") for (int r = 0; r < 16; ++r) { const float p = __builtin_amdgcn_exp2f(sacc[kb][r] - m_new); sacc[kb][r] = p; lsum += p; } \
            l_run = l_run * alpha + lsum; \
            _Pragma("unroll") for (int d = 0; d < 4; ++d) \
                _Pragma("unroll") for (int r = 0; r < 16; ++r) o[d][r] *= alpha; \
            _Pragma("unroll") for (int s2 = 0; s2 < 4; ++s2) { const int kb = s2 >> 1, r0 = 8 * (s2 & 1); v4u w; \
                w.x = pk2(sacc[kb][r0 + 0], sacc[kb][r0 + 1]); w.y = pk2(sacc[kb][r0 + 2], sacc[kb][r0 + 3]); w.z = pk2(sacc[kb][r0 + 4], sacc[kb][r0 + 5]); w.w = pk2(sacc[kb][r0 + 6], sacc[kb][r0 + 7]); \
                pf[s2] = __builtin_bit_cast(bf16x8, w); } } while (0)
#define AT_VREAD(dst, d) do { const int row = (d) * 32 + rho; _Pragma("unroll") for (int s2 = 0; s2 < 4; ++s2) dst[s2] = *(const LAS bf16x8*)(sv + row * 128 + (((2 * s2 + hh) ^ ((row >> 1) & 7)) << 4)); } while (0)
#define AT_VMMA(src_, d) do { __builtin_amdgcn_s_setprio(1); _Pragma("unroll") for (int s2 = 0; s2 < 4; ++s2) o[d] = __builtin_amdgcn_mfma_f32_32x32x16_bf16(src_[s2], pf[s2], o[d], 0, 0, 0); __builtin_amdgcn_s_setprio(0); } while (0)
#define AT_PV(vs) do { const LAS unsigned char* sv = lds + AT_VBASE + (vs) * AT_VST; bf16x8 gx[4], gy[4]; \
            AT_VREAD(gx, 0); AT_VREAD(gy, 1); \
            AT_VMMA(gx, 0); __builtin_amdgcn_sched_barrier(0); AT_VREAD(gx, 2); \
            AT_VMMA(gy, 1); __builtin_amdgcn_sched_barrier(0); AT_VREAD(gy, 3); \
            AT_VMMA(gx, 2); AT_VMMA(gy, 3); } while (0)
        AT_SYNC();
        AT_STAGE_TILE(0, 0, 0); AT_STAGE_TILE(1, 1, 1);
        bf16x8 qf[12];
        { const bf16* qp = Q + (size_t)(trow0 + rho) * (NHEAD * DQK) + h * DQK + hh * 8;
#pragma unroll
          for (int s = 0; s < 12; ++s) qf[s] = *(const bf16x8*)(qp + 16 * s);
#pragma unroll
          for (int s = 0; s < 12; ++s) asm volatile("" : "+v"(qf[s])); }
        AT_SYNC5();
        bf16x8 pf[4];
#pragma unroll
        for (int s2 = 0; s2 < 4; ++s2) pf[s2] = (bf16x8){0, 0, 0, 0, 0, 0, 0, 0};
        int ks = 0, vs = 0;
        bool have = false; int pvs = 0;
        int kt = 0;
        const int nfull = 4 * qb;
        if (!lag) {
            for (; kt < nfull; ++kt) {
                AT_STAGE_TILE(kt + 2, (ks == 0 ? 2 : ks - 1), ((vs + 2) & 3));
                { f32x16 sacc[2]; AT_QK(ks); AT_SM_NM(); }
                AT_PV(vs);
                AT_SYNC5();
                ks = (ks == 2) ? 0 : ks + 1; vs = (vs + 1) & 3;
            }
        } else if (nfull > 0) {
            { AT_STAGE_TILE(2, 2, 2); { f32x16 sacc[2]; AT_QK(0); AT_SM_NM(); } have = true; pvs = 0; AT_SYNC5(); ks = 1; vs = 1; kt = 1; }
            for (; kt < nfull; ++kt) {
                AT_STAGE_TILE(kt + 2, (ks == 0 ? 2 : ks - 1), ((vs + 2) & 3));
                AT_PV(pvs);
                { f32x16 sacc[2]; AT_QK(ks); AT_SM_NM(); }
                pvs = vs;
                AT_SYNC5();
                ks = (ks == 2) ? 0 : ks + 1; vs = (vs + 1) & 3;
            }
        }
        for (; kt < nkt; ++kt) {
            if (kt + 2 < nkt) AT_STAGE_TILE(kt + 2, (ks == 0 ? 2 : ks - 1), ((vs + 2) & 3));
            const int key0 = kt * 64;
            const bool vis = key0 <= qlo + 31;
            if (have) AT_PV(pvs);
            if (vis) { f32x16 sacc[2]; AT_QK(ks); AT_SM(key0); }
            if (lag) { have = vis; pvs = vs; } else if (vis) AT_PV(vs);
            if (kt + 2 < nkt) AT_SYNC5(); else AT_SYNC();
            ks = (ks == 2) ? 0 : ks + 1; vs = (vs + 1) & 3;
        }
        if (lag && have) AT_PV(pvs);
#undef AT_DMA
#undef AT_STAGE_TILE
#undef AT_SYNC
#undef AT_SYNC5
#undef AT_QK
#undef AT_SM
#undef AT_SM_NM
#undef AT_PV
#undef AT_KADDR
#undef AT_KREAD
#undef AT_KMMA
#undef AT_VREAD
#undef AT_VMMA
        const float ltot = l_run + shx<32>(l_run, lane), inv = 1.f / ltot;
        bf16* orow = AO + (size_t)(trow0 + rho) * D + h * VH + 8 * hh;
#pragma unroll
        for (int d = 0; d < 4; ++d)
#pragma unroll
            for (int k = 0; k < 2; ++k) {
                unsigned ax = pk2(o[d][8 * k + 0] * inv, o[d][8 * k + 1] * inv), ay = pk2(o[d][8 * k + 2] * inv, o[d][8 * k + 3] * inv);
                unsigned bx = pk2(o[d][8 * k + 4] * inv, o[d][8 * k + 5] * inv), by = pk2(o[d][8 * k + 6] * inv, o[d][8 * k + 7] * inv);
                asm volatile("s_nop 1\n\tv_permlane32_swap_b32 %0, %1" : "+v"(ax), "+v"(bx)); asm volatile("s_nop 1\n\tv_permlane32_swap_b32 %0, %1" : "+v"(ay), "+v"(by));
                *(v4u*)(orow + 32 * d + 16 * k) = (v4u){ax, ay, bx, by}; }
    }
}

constexpr int N_PHASES = 42;
struct Args { In in; float* out; unsigned char* ws; int ph_lo, ph_hi; };
__global__ void __launch_bounds__(NTHR, 2) mk_fwd(Args a) {
    extern __shared__ __attribute__((aligned(16))) unsigned char lds_raw[];
    LAS unsigned char* lds = (LAS unsigned char*)lds_raw;
    const int wave = __builtin_amdgcn_readfirstlane(threadIdx.x >> 6);
    const int G = gridDim.x, bid = blockIdx.x, vcu = (G % 8 == 0) ? (bid % 8) * (G / 8) + bid / 8 : bid;
    typedef const __attribute__((address_space(4))) Args* KArgs;
#define KARGS(q) KArgs q = (KArgs)__builtin_amdgcn_kernarg_segment_ptr(); asm volatile("" : "+s"(q))
    const int lo = a.ph_lo, hi = a.ph_hi;
    { volatile LAS unsigned* MISC0 = (volatile LAS unsigned*)(lds + MISC_OFF); if (threadIdx.x < 32) MISC0[threadIdx.x] = 0u; }
    __syncthreads();
    XcdBarrier bar; bar.bar = (unsigned*)(a.ws + WS_CTL); bar.x = 0; bar.st = nullptr;
    if (hi - lo > 1) bar = xcd_barrier_post((unsigned*)(a.ws + WS_CTL), (volatile LAS unsigned*)(lds + MISC_OFF) + 8, threadIdx.x == 0);
#ifndef MK_MASK
#define MK_MASK 0xFFFF
#endif
#define IN_PH(k) (lo <= (k) && (k) < hi)
#define EN(b) ((MK_MASK >> (b)) & 1)
#if MK_PROBE & 256
#define PHASE_END(k) do { if ((k) + 1 < hi) { xcd_barrier(bar, wave == 0 && lane_id_fresh() == 0); xcd_barrier(bar, wave == 0 && lane_id_fresh() == 0); } } while (0)
#else
#define PHASE_END(k) do { if ((k) + 1 < hi) xcd_barrier(bar, wave == 0 && lane_id_fresh() == 0); } while (0)
#endif
#define PH_VARS KARGS(q); unsigned char* ws = q->ws; CIn& in = q->in; float* ssq = (float*)(ws + WS_SSQ); \
    const float* COS = (const float*)(ws + WS_COS); const float* SIN = (const float*)(ws + WS_SIN); (void)in; (void)ssq; (void)COS; (void)SIN

    if (EN(0) && IN_PH(0)) { PH_VARS;
#if MK_PROBE & 8
        p0_prologue(in, ws, lds, bid, G, wave); __syncthreads();
#endif
        p0_prologue(in, ws, lds, bid, G, wave); PHASE_END(0); }

#pragma unroll 1
    for (int layer = 0; layer < DEPTH; ++layer) {
        const int base = 1 + 10 * layer, v0 = 3 * layer;
#define XB_VARS bf16* XBc = (bf16*)(ws + ((layer & 1) ? WS_XBB : WS_XBA)); bf16* XBn = (bf16*)(ws + ((layer & 1) ? WS_XBA : WS_XBB)); pg8::StaticOrder SO; (void)XBc; (void)XBn; (void)SO
        if (EN(1) && IN_PH(base + 0)) { PH_VARS; XB_VARS;
#if MK_PROBE & 4096
#pragma unroll 1
            for (int rep = 0; rep < 2; ++rep)
#endif
            {
            if (layer == 0) convert_layer(in, ws, layer, bid, G, wave);
            if (layer < 2) pooled_phase(XBc, ssq + (size_t)v0 * SSQ_ARR, in.mix_norm + layer * D, (bf16*)(ws + WS_POOLED), lds, vcu, G, wave);
            else {
                const int N = (layer == 2) ? 1280 : 768;
                pg8::Gemm g{XBc, (const bf16*)(ws + ((layer == 2) ? W_DOWN2 : W_DOWN3)), T, N, D, D, D, 0}; SO.init(T, N, G, bid);
                epi::Down E{(bf16*)(ws + WS_CQ), (bf16*)(ws + WS_CKV), (bf16*)(ws + WS_KPE), ssq + (size_t)v0 * SSQ_ARR, ssq + (size_t)(13 + layer - 2) * SSQ_ARR, ssq + (size_t)15 * SSQ_ARR, COS, SIN};
                pg8::gemm_phase<epi::Down>(lds, g, SO, E, wave);
                if (G % 2 == 0 && ((T / 256) * (N / 256)) % G == G / 2) {
                    pg8::Gemm gp{(const bf16*)(ws + WS_PB), (const bf16*)(ws + W_WP) + (size_t)layer * D * PLE, T, D, PLE, PLE, PLE, 0}; SO.init(T, D, G, bid, 1);
                    epi::Bf16Row EP{(bf16*)(ws + WS_PP), D, nullptr, 0.f};
                    pg8::gemm_phase<epi::Bf16Row>(lds, gp, SO, EP, wave);
                }
            }
            }
            PHASE_END(base + 0);
        }
        if (EN(2) && IN_PH(base + 1)) { PH_VARS; XB_VARS;
#if MK_PROBE & 16
            if (layer < 2) {
                pg8::Gemm g{(const bf16*)(ws + WS_POOLED), (const bf16*)(ws + W_POOL) + (size_t)layer * 1024 * 256, T, D, 256, D, 256, 256}; SO.init(T, D, G, bid);
                epi::Resid E{(bf16*)(ws + WS_END), (float*)(ws + WS_END + 64 * MiB)};
                pg8::gemm_phase<epi::Resid>(lds, g, SO, E, wave);
            } else {
                pg8::Gemm g{(const bf16*)(ws + WS_CQ), (const bf16*)(ws + W_UQ) + (size_t)(layer - 2) * 1536 * QRANK, T, 1536, QRANK, QRANK, QRANK, 0}; SO.init(T, 1536, G, bid);
                epi::QUp E{(bf16*)(ws + WS_Q), ssq + (size_t)(13 + layer - 2) * SSQ_ARR, COS, SIN};
                pg8::gemm_phase<epi::QUp>(lds, g, SO, E, wave);
            }
#endif
            if (layer < 2) {
                pg8::Gemm g{(const bf16*)(ws + WS_POOLED), (const bf16*)(ws + W_POOL) + (size_t)layer * 1024 * 256, T, D, 256, D, 256, 256}; SO.init(T, D, G, bid);
                epi::Resid E{XBc, ssq + (size_t)(v0 + 1) * SSQ_ARR};
                pg8::gemm_phase<epi::Resid>(lds, g, SO, E, wave);
            } else {
                if (layer == 2) {
                    { pg8::Gemm g{(const bf16*)(ws + WS_CKV), (const bf16*)(ws + W_KNW), T, 1024, KVRANK, KVRANK, KVRANK, 0}; SO.init(T, 1024, G, bid);
                      epi::Bf16Row E{(bf16*)(ws + WS_KN), 1024, ssq + (size_t)15 * SSQ_ARR, 1.f / KVRANK};
                      pg8::gemm_phase<epi::Bf16Row>(lds, g, SO, E, wave); }
                    { pg8::Gemm g{(const bf16*)(ws + W_VW), (const bf16*)(ws + WS_CKV), 1024, T, KVRANK, KVRANK, KVRANK, 0}; SO.init(1024, T, G, bid);
                      epi::VTCol E{(bf16*)(ws + WS_VT), ssq + (size_t)15 * SSQ_ARR, 1.f / KVRANK};
                      pg8::gemm_phase<epi::VTCol>(lds, g, SO, E, wave); }
                }
                pg8::Gemm g{(const bf16*)(ws + WS_CQ), (const bf16*)(ws + W_UQ) + (size_t)(layer - 2) * 1536 * QRANK, T, 1536, QRANK, QRANK, QRANK, 0}; SO.init(T, 1536, G, bid);
                epi::QUp E{(bf16*)(ws + WS_Q), ssq + (size_t)(13 + layer - 2) * SSQ_ARR, COS, SIN};
                pg8::gemm_phase<epi::QUp>(lds, g, SO, E, wave);
            }
            PHASE_END(base + 1);
        }
        if (EN(3) && layer >= 2 && IN_PH(base + 2)) { PH_VARS; XB_VARS;
#if MK_PROBE & 2
            attn_phase((const bf16*)(ws + WS_Q), (const bf16*)(ws + WS_KN), (const bf16*)(ws + WS_KPE), (const bf16*)(ws + WS_VT), (bf16*)(ws + WS_AO), lds, vcu, G, wave);
#endif
            attn_phase((const bf16*)(ws + WS_Q), (const bf16*)(ws + WS_KN), (const bf16*)(ws + WS_KPE), (const bf16*)(ws + WS_VT), (bf16*)(ws + WS_AO), lds, vcu, G, wave);
            PHASE_END(base + 2);
        }
        if (EN(4) && layer >= 2 && IN_PH(base + 3)) { PH_VARS; XB_VARS;
            pg8::Gemm g{(const bf16*)(ws + WS_AO), (const bf16*)(ws + W_WO) + (size_t)(layer - 2) * D * D, T, D, D, D, D, 0}; SO.init(T, D, G, bid);
#if MK_PROBE & 16384
            { epi::Resid E2{(bf16*)(ws + WS_END), (float*)(ws + WS_END + 64 * MiB)}; pg8::gemm_phase<epi::Resid>(lds, g, SO, E2, wave); SO.init(T, D, G, bid); }
#endif
            epi::Resid E{XBc, ssq + (size_t)(v0 + 1) * SSQ_ARR};
            pg8::gemm_phase<epi::Resid>(lds, g, SO, E, wave);
            PHASE_END(base + 3);
        }
        if (EN(5) && IN_PH(base + 4)) { PH_VARS; XB_VARS;
#if MK_PROBE & 4
            { pg8::Gemm g{XBc, (const bf16*)(ws + W_WEFF) + (size_t)layer * 2048 * D, T, 2048, D, D, D, 0}; SO.init(T, 2048, G, bid);
              epi::Score E{(unsigned short*)(ws + WS_S), 2048, ssq + (size_t)(v0 + 1) * SSQ_ARR};
              pg8::gemm_phase<epi::Score>(lds, g, SO, E, wave); }
#endif
#if MK_PROBE & 65536
            { pg8::Gemm g{(const bf16*)(ws + WS_PB), (const bf16*)(ws + W_WP) + (size_t)layer * D * PLE, T, D, PLE, PLE, PLE, 0}; SO.init(T, D, G, bid);
              epi::Bf16Row E{(bf16*)(ws + WS_PP), D, nullptr, 0.f};
              pg8::gemm_phase<epi::Bf16Row>(lds, g, SO, E, wave); }
#endif
            {
            { pg8::Gemm g{XBc, (const bf16*)(ws + W_WEFF) + (size_t)layer * 2048 * D, T, 2048, D, D, D, 0}; SO.init(T, 2048, G, bid);
              epi::Score E{(unsigned short*)(ws + WS_S), 2048, ssq + (size_t)(v0 + 1) * SSQ_ARR};
              pg8::gemm_phase<epi::Score>(lds, g, SO, E, wave); }
            if (!(layer >= 2 && G % 2 == 0 && ((T / 256) * (((layer == 2) ? 1280 : 768) / 256)) % G == G / 2))
            { pg8::Gemm g{(const bf16*)(ws + WS_PB), (const bf16*)(ws + W_WP) + (size_t)layer * D * PLE, T, D, PLE, PLE, PLE, 0}; SO.init(T, D, G, bid);
              epi::Bf16Row E{(bf16*)(ws + WS_PP), D, nullptr, 0.f};
              pg8::gemm_phase<epi::Bf16Row>(lds, g, SO, E, wave); }
            }
            PHASE_END(base + 4);
        }
        if (EN(6) && EN(9) && IN_PH(base + 5)) { PH_VARS; XB_VARS;
            const int nl = layer + 1 < DEPTH ? layer + 1 : layer, ns = nl & 1;
            const ConvNext cvn{in.peer_u + (size_t)nl * NEXP * D, in.peer_v + (size_t)nl * NEXP * D, in.ffn_norm + nl * D, in.p + (size_t)nl * T * PLE,
                               ws + tab_off(ns), ws + tab_off(ns) + (size_t)NEXP * D, (float*)(ws + tabs_off(ns)), (float*)(ws + tabs_off(ns)) + NEXP, (bf16*)(ws + WS_PB), layer + 1 < DEPTH ? 1 : 0};
#if MK_PROBE & 64
            peer_topk_phase((const unsigned short*)(ws + WS_S), ssq + (size_t)(v0 + 1) * SSQ_ARR, (const float*)(ws + tabs_off(layer & 1)), (const float*)(ws + tabs_off(layer & 1)) + NEXP,
                            (unsigned short*)(ws + WS_IDX), (float*)(ws + WS_GW), (float*)(ws + WS_MU), cvn, lds, vcu, G, wave);
#endif
            peer_topk_phase((const unsigned short*)(ws + WS_S), ssq + (size_t)(v0 + 1) * SSQ_ARR, (const float*)(ws + tabs_off(layer & 1)), (const float*)(ws + tabs_off(layer & 1)) + NEXP,
                            (unsigned short*)(ws + WS_IDX), (float*)(ws + WS_GW), (float*)(ws + WS_MU), cvn, lds, vcu, G, wave);
            PHASE_END(base + 5);
        }
        if (EN(6) && EN(10) && IN_PH(base + 6)) { PH_VARS; XB_VARS;
#if MK_PROBE & 32
            peer_u_phase<0>((const unsigned short*)(ws + WS_IDX), XBc, ws + tab_off(layer & 1), (unsigned short*)(ws + WS_PART), bid, G, wave);
#endif
#if MK_PROBE & 128
            peer_u_phase<1>((const unsigned short*)(ws + WS_IDX), XBc, ws + tab_off(layer & 1), (unsigned short*)(ws + WS_WW), bid, G, wave);
#endif
            peer_u_phase<0>((const unsigned short*)(ws + WS_IDX), XBc, ws + tab_off(layer & 1), (unsigned short*)(ws + WS_PART), bid, G, wave);
            PHASE_END(base + 6);
        }
        if (EN(6) && EN(11) && IN_PH(base + 7)) { PH_VARS; XB_VARS;
#if MK_PROBE & 2048
            peer_w_phase((const unsigned short*)(ws + WS_PART), (const float*)(ws + WS_GW), (const float*)(ws + WS_MU), (const unsigned short*)(ws + WS_IDX), (unsigned*)(ws + WS_WW), bid, G, wave);
#endif
            peer_w_phase((const unsigned short*)(ws + WS_PART), (const float*)(ws + WS_GW), (const float*)(ws + WS_MU), (const unsigned short*)(ws + WS_IDX), (unsigned*)(ws + WS_WW), bid, G, wave);
            PHASE_END(base + 7);
        }
        if (EN(6) && EN(12) && IN_PH(base + 8)) { PH_VARS; XB_VARS;
#if MK_PROBE & 1024
            peer_v_phase((const unsigned*)(ws + WS_WW), ws + tab_off(layer & 1) + (size_t)NEXP * D, XBc, (bf16*)(ws + WS_END), (float*)(ws + WS_END + 64 * MiB), bid, G, wave);
#endif
            peer_v_phase((const unsigned*)(ws + WS_WW), ws + tab_off(layer & 1) + (size_t)NEXP * D, XBc, XBc, ssq + (size_t)(v0 + 2) * SSQ_ARR, bid, G, wave);
            PHASE_END(base + 8);
        }
        if (EN(7) && IN_PH(base + 9)) { PH_VARS; XB_VARS;
            pg8::Gemm g{XBc, (const bf16*)(ws + W_WG) + (size_t)layer * D * D, T, D, D, D, D, 0}; SO.init(T, D, G, bid);
#if MK_PROBE & 512
            { epi::Null EN_{(float*)(ws + WS_END)}; pg8::gemm_phase<epi::Null>(lds, g, SO, EN_, wave); }
#endif
#if MK_PROBE & 8192
            { epi::Gate E2{XBc, XBn, (const bf16*)(ws + WS_PP), ssq + (size_t)(v0 + 2) * SSQ_ARR, ssq + (size_t)(v0 + 3) * SSQ_ARR}; pg8::gemm_phase<epi::Gate>(lds, g, SO, E2, wave); SO.init(T, D, G, bid); }
#endif
            epi::Gate E{XBc, XBn, (const bf16*)(ws + WS_PP), ssq + (size_t)(v0 + 2) * SSQ_ARR, ssq + (size_t)(v0 + 3) * SSQ_ARR};
            pg8::gemm_phase<epi::Gate>(lds, g, SO, E, wave);
            PHASE_END(base + 9);
        }
    }
#if MK_PROBE & 32768
    if (EN(8) && IN_PH(41)) { PH_VARS; final_phase((const bf16*)(ws + WS_XBA), ssq + (size_t)12 * SSQ_ARR, in.final_norm, q->out, bid, G, wave); }
#endif
    if (EN(8) && IN_PH(41)) { PH_VARS; final_phase((const bf16*)(ws + WS_XBA), ssq + (size_t)12 * SSQ_ARR, in.final_norm, q->out, bid, G, wave); }
#undef IN_PH
#undef PHASE_END
}

extern "C" void kernel_launch(void* const* d_in, const int* in_sizes, int n_in, void* d_out, int out_size, void* d_ws, size_t ws_size, hipStream_t stream) {
    static int grid = 0;
    if (grid == 0) {
        if (n_in != 23 || out_size != T * D || ws_size < WS_END) { fprintf(stderr, "kernel_launch: unexpected problem (n_in %d, out %d, ws %zu < %zu)\n", n_in, out_size, ws_size, (size_t)WS_END); grid = -1; return; }
        int dev = 0, cus = 0, per_cu = 0;
        if (hipGetDevice(&dev) != hipSuccess || hipDeviceGetAttribute(&cus, hipDeviceAttributeMultiprocessorCount, dev) != hipSuccess) { grid = -1; return; }
        if (hipFuncSetAttribute((const void*)mk_fwd, hipFuncAttributeMaxDynamicSharedMemorySize, LDS_BYTES) != hipSuccess) { fprintf(stderr, "kernel_launch: hipFuncSetAttribute failed\n"); grid = -1; return; }
        if (hipOccupancyMaxActiveBlocksPerMultiprocessor(&per_cu, (const void*)mk_fwd, NTHR, LDS_BYTES) != hipSuccess || per_cu < 1) { fprintf(stderr, "kernel_launch: occupancy query says %d\n", per_cu); }
        (void)hipGetLastError();
        grid = cus;
    }
    if (grid < 0) return;
    (void)hipMemsetAsync((char*)d_ws + WS_CTL, 0, CTL_ZERO_BYTES, stream);
    Args a{};
    const void** ip = (const void**)&a.in;
    for (int i = 0; i < 23; ++i) ip[i] = d_in[i];
    a.out = (float*)d_out; a.ws = (unsigned char*)d_ws;
#if MK_ONE_LAUNCH
    a.ph_lo = 0; a.ph_hi = N_PHASES;
    hipLaunchKernelGGL(mk_fwd, dim3(grid), dim3(NTHR), LDS_BYTES, stream, a);
#else
    for (int k = 0; k < N_PHASES; ++k) {
        if (k >= 1 && k <= 40) { const int layer = (k - 1) / 10, slot = (k - 1) % 10; if (layer < 2 && (slot == 2 || slot == 3)) continue; }
        a.ph_lo = k; a.ph_hi = k + 1;
        hipLaunchKernelGGL(mk_fwd, dim3(grid), dim3(NTHR), LDS_BYTES, stream, a);
    }
#endif
}
```

```cpp
#include <hip/hip_runtime.h>
#include <cstdio>
#include <cstdint>
#if defined(__HIP_DEVICE_COMPILE__)
#pragma clang attribute push(__attribute__((target("no-packed-fp32-ops"))), apply_to = function)
#endif
__device__ __forceinline__ void mk_sync() { __builtin_amdgcn_fence(__ATOMIC_RELEASE, "workgroup"); __builtin_amdgcn_s_barrier(); __builtin_amdgcn_fence(__ATOMIC_ACQUIRE, "workgroup"); }
__device__ __forceinline__ unsigned mk_atomic_add(unsigned* p, unsigned v) { return __hip_atomic_fetch_add(p, v, __ATOMIC_RELAXED, __HIP_MEMORY_SCOPE_AGENT); }
#define __syncthreads() mk_sync()
#define atomicAdd(p, v) mk_atomic_add((p), (v))

#ifndef MK_PROBE
#define MK_PROBE 0
#endif
#ifndef MK_ONE_LAUNCH
#define MK_ONE_LAUNCH 1
#endif


__device__ __forceinline__ int lane_id_fresh() { int l; asm volatile("v_mbcnt_lo_u32_b32 %0, -1, 0\n\tv_mbcnt_hi_u32_b32 %0, -1, %0" : "=v"(l)); return l; }
template <int M> __device__ __forceinline__ float shx(float v, int lane) {
    if constexpr (M < 32) return __builtin_bit_cast(float, __builtin_amdgcn_ds_swizzle(__builtin_bit_cast(int, v), (M << 10) | 0x1f));
    else return __builtin_bit_cast(float, __builtin_amdgcn_ds_bpermute((lane ^ 32) << 2, __builtin_bit_cast(int, v)));
}

namespace pg8 {
#define PG8_LAS __attribute__((address_space(3)))
typedef unsigned short bf16_t;
typedef short bf16x8 __attribute__((ext_vector_type(8)));
typedef float f32x4 __attribute__((ext_vector_type(4)));
typedef unsigned u32x4 __attribute__((ext_vector_type(4)));
typedef unsigned u32x2 __attribute__((ext_vector_type(2)));
constexpr int BM = 256, BK = 64, HALF = 128, HTB = HALF * BK * 2, STAGE_BYTES = 8 * HTB, NXCD = 8, WGM = 8;

__host__ __device__ __forceinline__ int lds_byte(int r, int c) { const int st = (r >> 4) * 2 + (c >> 5), rr = r & 15, cc = c & 31, ob = rr * 64 + cc * 2; return st * 1024 + (ob ^ (((ob >> 9) & 1) << 5)); }
__host__ __device__ __forceinline__ void stage_rc(int b, int& R, int& C) { const int st = b / 1024, sb = b % 1024, swz = sb ^ (((sb >> 9) & 1) << 5); R = (st >> 1) * 16 + swz / 64; C = (st & 1) * 32 + (swz % 64) / 2; }
__host__ __device__ __forceinline__ int perm32(int rho) { const int n = rho >> 4, i = rho & 15; return 8 * (i >> 2) + 4 * n + (i & 3); }

struct Unit { int pm, pn; };
struct Gemm { const bf16_t* A; const bf16_t* Bt; int M, N, K, lda, ldb, acs; };

struct StaticOrder {
    int nM, nN, nwg, G, c, skew;
    __host__ __device__ void init(int M, int N, int G_, int c_, int skew_ = 0) { nM = M / BM; nN = N / BM; nwg = nM * nN; G = G_; c = c_; skew = skew_; }
    __host__ __device__ bool next(int i, Unit& u) const {
        long L = (long)i * G + c;
        if (skew && i > 0) { if (2 * c < G) return false; L = (long)G + (long)(i - 1) * (G - G / 2) + (c - G / 2); }
        if (L >= nwg) return false;
        int wgid = (int)L; { const int q = nwg / NXCD, r = nwg % NXCD, xcd = wgid % NXCD, off = wgid / NXCD; wgid = (xcd < r ? xcd * (q + 1) : r * (q + 1) + (xcd - r) * q) + off; }
        const int nig = WGM * nN, gid = wgid / nig, fm = gid * WGM, gsz = (nM - fm) < WGM ? (nM - fm) : WGM;
        u.pm = fm + ((wgid % nig) % gsz); u.pn = (wgid % nig) / gsz; return true;
    }
};

__device__ __forceinline__ unsigned cvt_pk_bf16(float lo, float hi) { unsigned r; asm volatile("v_cvt_pk_bf16_f32 %0, %1, %2" : "=v"(r) : "v"(lo), "v"(hi)); return r; }

template <class Epi>
__device__ __forceinline__ void gemm_phase(PG8_LAS unsigned char* lds, const Gemm g, const StaticOrder& S, const Epi& E, const int wid) {
    const int lane = lane_id_fresh(), tid = wid * 64 + lane;
    const int wr = wid >> 2, wc = wid & 3, fr = lane & 15, fq = lane >> 4;
    const int K = g.K, nt = K / BK;
    unsigned voffA, voffB;
    { int R, C; stage_rc(tid * 16, R, C); const int Rb = Epi::PERM ? ((R & ~31) + perm32(R & 31)) : R;
      voffA = (unsigned)(R * g.lda + C) * 2u; voffB = (unsigned)(Rb * g.ldb + C) * 2u; }
    const unsigned d64A = 64u * g.lda * 2u, d64B = 64u * g.ldb * 2u;
    constexpr unsigned kstep = BK * 2;
    const unsigned hstepA = (unsigned)HALF * g.lda * 2u, hstepB = (unsigned)HALF * g.ldb * 2u;
    const unsigned tstepA = 2u * hstepA, tstepB = 2u * hstepB;
    const unsigned acsb = (unsigned)g.acs * 2u;
    const unsigned ldsw = (unsigned)wid * 1024u, ldsbase = (unsigned)(size_t)lds;
    const int aoff = lds_byte(wr * 64 + fr, fq * 8), boff = lds_byte(wc * 32 + fr, fq * 8);
#define PG8_SA(b, h) (((b) * 2 + (h)) * HTB)
#define PG8_SB(b, h) ((4 + (b) * 2 + (h)) * HTB)
#define PG8_DMA(sbase, voff, ldsdst) do { unsigned _keep; asm volatile("s_mov_b32 %0, m0\n\ts_mov_b32 m0, %3\n\ts_nop 4\n\tglobal_load_lds_dwordx4 %1, %2\n\ts_mov_b32 m0, %0" \
        : "=&s"(_keep) : "v"(voff), "s"(sbase), "s"(ldsdst) : "memory"); } while (0)
#define PG8_STAGE(bufoff, gbase, voff) do { const char* _b0 = (const char*)(gbase); const char* _b1 = _b0 + (&(voff) == &voffA ? d64A : d64B); \
        PG8_DMA(_b0, voff, ldsbase + (unsigned)(bufoff) + ldsw); PG8_DMA(_b1, voff, ldsbase + (unsigned)(bufoff) + ldsw + 8192u); } while (0)
#define PG8_LDA(dst, b, h) do { _Pragma("unroll") for (int m = 0; m < 4; ++m) _Pragma("unroll") for (int k = 0; k < 2; ++k) dst[m][k] = *(const PG8_LAS bf16x8*)(lds + PG8_SA(b, h) + aoff + m * 2048 + k * 1024); } while (0)
#define PG8_LDB(dst, b, h) do { _Pragma("unroll") for (int n = 0; n < 2; ++n) _Pragma("unroll") for (int k = 0; k < 2; ++k) dst[n][k] = *(const PG8_LAS bf16x8*)(lds + PG8_SB(b, h) + boff + n * 2048 + k * 1024); } while (0)
#define PG8_MMA(ai, bj, At, Bt) do { __builtin_amdgcn_s_setprio(1); _Pragma("unroll") for (int m = 0; m < 4; ++m) _Pragma("unroll") for (int n = 0; n < 2; ++n) _Pragma("unroll") for (int k = 0; k < 2; ++k) \
        acc[ai][bj][m][n] = __builtin_amdgcn_mfma_f32_16x16x32_bf16(Bt[n][k], At[m][k], acc[ai][bj][m][n], 0, 0, 0); __builtin_amdgcn_s_setprio(0); } while (0)
#define PG8_WAIT_V(n) asm volatile("s_waitcnt vmcnt(" #n ")" ::: "memory")
#define PG8_WAIT_L(n) asm volatile("s_waitcnt lgkmcnt(" #n ")" ::: "memory")
#define PG8_BAR __builtin_amdgcn_s_barrier()
#define PG8_SCHED __builtin_amdgcn_sched_barrier(0)
    Unit cur, nxt; int ui = 0;
    if (!S.next(0, cur)) return;
    f32x4 acc[2][2][4][2];
#pragma unroll
    for (int a = 0; a < 2; ++a)
#pragma unroll
        for (int b = 0; b < 2; ++b)
#pragma unroll
            for (int m = 0; m < 4; ++m)
#pragma unroll
                for (int n = 0; n < 2; ++n) acc[a][b][m][n] = (f32x4){0.f, 0.f, 0.f, 0.f};
    bf16x8 At[4][2], B0[2][2], B1[2][2];
    const char* cA = (const char*)g.A + ((unsigned)cur.pm * tstepA + (unsigned)cur.pn * acsb); const char* cB = (const char*)g.Bt + (unsigned)cur.pn * tstepB;
    PG8_STAGE(PG8_SB(0, 0), cB, voffB); PG8_STAGE(PG8_SB(0, 1), cB + hstepB, voffB); PG8_STAGE(PG8_SA(0, 0), cA, voffA); PG8_STAGE(PG8_SA(0, 1), cA + hstepA, voffA);
    if (wr == 1) PG8_BAR;
    PG8_WAIT_V(2); PG8_BAR;
    PG8_STAGE(PG8_SB(1, 0), cB + kstep, voffB); PG8_STAGE(PG8_SA(1, 0), cA + kstep, voffA); PG8_STAGE(PG8_SB(1, 1), cB + hstepB + kstep, voffB);
    PG8_WAIT_V(6); PG8_BAR;
    for (;;) {
        const bool has_next = S.next(ui + 1, nxt);
        const char* nA = has_next ? (const char*)g.A + ((unsigned)nxt.pm * tstepA + (unsigned)nxt.pn * acsb) : cA; const char* nB = has_next ? (const char*)g.Bt + (unsigned)nxt.pn * tstepB : cB;
        for (int t = 0; t < nt; t += 2) {
            const bool last = (t == nt - 2);
            const char* a1 = cA + (unsigned)(t + 1) * kstep;
            const char* a2 = last ? nA : cA + (unsigned)(t + 2) * kstep; const char* b2 = last ? nB : cB + (unsigned)(t + 2) * kstep;
            const char* a3 = a2 + kstep; const char* b3 = b2 + kstep;
            PG8_LDB(B0, 0, 0); PG8_LDB(B1, 0, 1); PG8_SCHED; PG8_LDA(At, 0, 0); PG8_STAGE(PG8_SA(1, 1), a1 + hstepA, voffA);
            PG8_WAIT_V(8); PG8_WAIT_L(0); PG8_BAR; PG8_MMA(0, 0, At, B0); PG8_MMA(0, 1, At, B1); PG8_BAR; PG8_SCHED;
            PG8_LDA(At, 0, 1); PG8_STAGE(PG8_SB(0, 0), b2, voffB); PG8_STAGE(PG8_SB(0, 1), b2 + hstepB, voffB); PG8_STAGE(PG8_SA(0, 0), a2, voffA);
            PG8_WAIT_V(8); PG8_WAIT_L(0); PG8_BAR; PG8_MMA(1, 0, At, B0); PG8_MMA(1, 1, At, B1); PG8_BAR; PG8_SCHED;
            PG8_LDB(B0, 1, 0); PG8_LDB(B1, 1, 1); PG8_SCHED; PG8_LDA(At, 1, 0); PG8_STAGE(PG8_SA(0, 1), a2 + hstepA, voffA);
            PG8_WAIT_V(8); PG8_WAIT_L(0); PG8_BAR; PG8_MMA(0, 0, At, B0); PG8_MMA(0, 1, At, B1); PG8_BAR; PG8_SCHED;
            PG8_LDA(At, 1, 1); PG8_STAGE(PG8_SB(1, 0), b3, voffB); PG8_STAGE(PG8_SB(1, 1), b3 + hstepB, voffB); PG8_STAGE(PG8_SA(1, 0), a3, voffA);
            PG8_WAIT_V(8); PG8_WAIT_L(0); PG8_BAR; PG8_MMA(1, 0, At, B0); PG8_MMA(1, 1, At, B1); PG8_BAR; PG8_SCHED;
        }
        if (wr == 0) PG8_BAR;
        { const int l2 = lane_id_fresh(); E(acc, cur, wr, wc, l2 & 15, l2 >> 4); }
        if (!has_next) break;
#pragma unroll
        for (int a = 0; a < 2; ++a)
#pragma unroll
            for (int b = 0; b < 2; ++b)
#pragma unroll
                for (int m = 0; m < 4; ++m)
#pragma unroll
                    for (int n = 0; n < 2; ++n) acc[a][b][m][n] = (f32x4){0.f, 0.f, 0.f, 0.f};
        cur = nxt; cA = nA; cB = nB; ++ui;
        if (wr == 1) PG8_BAR;
    }
    PG8_WAIT_V(0);
    PG8_BAR;
#undef PG8_SA
#undef PG8_SB
#undef PG8_STAGE
#undef PG8_LDA
#undef PG8_LDB
#undef PG8_MMA
#undef PG8_WAIT_V
#undef PG8_WAIT_L
#undef PG8_BAR
#undef PG8_SCHED
}
}

#define GAS __attribute__((address_space(1)))
#define LAS __attribute__((address_space(3)))
typedef unsigned short bf16;
typedef unsigned v4u __attribute__((ext_vector_type(4)));
typedef unsigned v2u __attribute__((ext_vector_type(2)));
typedef float f32x4 __attribute__((ext_vector_type(4)));
typedef float f32x2 __attribute__((ext_vector_type(2)));
typedef float f32x16 __attribute__((ext_vector_type(16)));
typedef short bf16x8 __attribute__((ext_vector_type(8)));
typedef __bf16 bf16x2_t __attribute__((ext_vector_type(2)));
typedef _Float16 half2_t __attribute__((ext_vector_type(2)));
__device__ __forceinline__ unsigned pkh2(float lo, float hi) { f32x2 v = {lo, hi}; half2_t h = __builtin_convertvector(v, half2_t); return __builtin_bit_cast(unsigned, h); }
__device__ __forceinline__ float hlo(unsigned u) { return (float)__builtin_bit_cast(half2_t, u)[0]; }
__device__ __forceinline__ float hhi(unsigned u) { return (float)__builtin_bit_cast(half2_t, u)[1]; }
typedef GAS unsigned gu32;
#define RLX_AGENT __ATOMIC_RELAXED, __HIP_MEMORY_SCOPE_AGENT
#define SWZ(o) (((o) << 10) | 0x1f)
#define LDS_WAIT() asm volatile("s_waitcnt lgkmcnt(0)" ::: "memory")
#define VM_WAIT() asm volatile("s_waitcnt vmcnt(0)" ::: "memory")
__device__ __forceinline__ unsigned pk2(float lo, float hi) { f32x2 v = {lo, hi}; bf16x2_t b = __builtin_convertvector(v, bf16x2_t); return __builtin_bit_cast(unsigned, b); }
__device__ __forceinline__ float bflo(unsigned u) { return __builtin_bit_cast(float, u << 16); }
__device__ __forceinline__ float bfhi(unsigned u) { return __builtin_bit_cast(float, u & 0xffff0000u); }
__device__ __forceinline__ float dot2bf(unsigned a, unsigned b, float acc) { return __builtin_amdgcn_fdot2_f32_bf16(__builtin_bit_cast(bf16x2_t, a), __builtin_bit_cast(bf16x2_t, b), acc, false); }
template <int CTRL> __device__ __forceinline__ float dppf(float v) { return __builtin_bit_cast(float, __builtin_amdgcn_update_dpp(0, __builtin_bit_cast(int, v), CTRL, 0xf, 0xf, true)); }
__device__ __forceinline__ float wave_sum(float v, int lane) {
    v += shx<1>(v, lane); v += shx<2>(v, lane); v += shx<4>(v, lane); v += shx<8>(v, lane); v += shx<16>(v, lane); v += shx<32>(v, lane);
    return v;
}


__device__ __forceinline__ float row_rinv(const float* ssq16, int r, float invdim) {
    const f32x4* p = (const f32x4*)(ssq16 + (size_t)r * 16); const f32x4 a = p[0], b = p[1], c = p[2], d = p[3];
    const float s = ((a[0] + a[1]) + (a[2] + a[3])) + ((b[0] + b[1]) + (b[2] + b[3])) + (((c[0] + c[1]) + (c[2] + c[3])) + ((d[0] + d[1]) + (d[2] + d[3])));
    return __builtin_amdgcn_rsqf(s * invdim + 1e-6f);
}

#define XB_TMO      128
#define XB_XCNT(j)  (256  + 64 * (j))
#define XB_XSUB(j)  (1280 + 64 * (j))
#define XB_XGEN(j)  (2304 + 64 * (j))
#define XB_TOP      3328
#define XB_TOPGEN   3392
#define XCD_BAR_WORDS 3456
#define XB_SPIN_CAP (1u << 18)

__device__ __forceinline__ unsigned xb_ld(unsigned* p)              { return __hip_atomic_load(p, __ATOMIC_RELAXED, __HIP_MEMORY_SCOPE_AGENT); }
__device__ __forceinline__ unsigned xb_add(unsigned* p, unsigned v) { return __hip_atomic_fetch_add(p, v, __ATOMIC_RELAXED, __HIP_MEMORY_SCOPE_AGENT); }
__device__ __forceinline__ unsigned xb_xcc_id() { return (unsigned)__builtin_amdgcn_s_getreg((3 << 11) | 20) & 0xFu; }
#define XB_SPIN(cond, bar) do { unsigned _sp = 0; while (cond) { __builtin_amdgcn_s_sleep(1); \
    if ((++_sp & 255u) == 0u) { if (xb_ld(&(bar)[XB_TMO])) break; if (_sp > XB_SPIN_CAP) { atomicAdd(&(bar)[XB_TMO], 1u); break; } } } } while (0)

struct XcdBarrier {
    unsigned* bar; unsigned x;
    volatile LAS unsigned* st;
};
__device__ __forceinline__ XcdBarrier xcd_barrier_post(unsigned* bar, volatile LAS unsigned* st, bool t0) {
    XcdBarrier b; b.bar = bar; b.x = xb_xcc_id(); b.st = st;
    if (t0) (void)xb_add(&bar[XB_XCNT(b.x)], 1u);
    return b;
}
__device__ __forceinline__ void xcd_barrier_complete(unsigned* bar, unsigned x, unsigned& nloc, unsigned& nx) {
    const unsigned G = gridDim.x * gridDim.y * gridDim.z;
    unsigned sum, cnt, mine, sp = 0u;
    for (;;) {
        sum = 0u; cnt = 0u; mine = 0u;
#pragma unroll
        for (unsigned j = 0; j < 16; ++j) { const unsigned c = xb_ld(&bar[XB_XCNT(j)]); sum += c; cnt += (c > 0u) ? 1u : 0u; mine = (j == x) ? c : mine; }
        if (sum == G) break;
        __builtin_amdgcn_s_sleep(1);
        if ((++sp & 255u) == 0u) { if (xb_ld(&bar[XB_TMO])) break; if (sp > XB_SPIN_CAP) { atomicAdd(&bar[XB_TMO], 1u); break; } }
    }
    nloc = mine > 0u ? mine : 1u; nx = cnt > 0u ? cnt : 1u;
}
__device__ __forceinline__ void xcd_barrier(const XcdBarrier& b, bool t0) {
    asm volatile("s_waitcnt vmcnt(0)" ::: "memory");
    __syncthreads();
    if (t0) {
        unsigned* bar = b.bar;
        __builtin_amdgcn_s_waitcnt(0);
        unsigned nloc = b.st[0], nx = b.st[1];
        if (nloc == 0u) { xcd_barrier_complete(bar, b.x, nloc, nx); b.st[0] = nloc; b.st[1] = nx; }
        const unsigned old = xb_add(&bar[XB_XSUB(b.x)], 1u);
        const unsigned gen = old / nloc;
        if (old + 1u == (gen + 1u) * nloc) {
            __builtin_amdgcn_fence(__ATOMIC_RELEASE, "agent");
            asm volatile("s_waitcnt vmcnt(0)" ::: "memory");
            const unsigned og = xb_add(&bar[XB_TOP], 1u);
            const unsigned tg = og / nx;
            if (og + 1u == (tg + 1u) * nx) xb_add(&bar[XB_TOPGEN], 1u);
            else XB_SPIN(xb_ld(&bar[XB_TOPGEN]) == tg, bar);
            __builtin_amdgcn_fence(__ATOMIC_ACQUIRE, "agent");
            xb_add(&bar[XB_XGEN(b.x)], 1u);
            asm volatile("s_waitcnt vmcnt(0)" ::: "memory");
        } else {
            XB_SPIN(xb_ld(&bar[XB_XGEN(b.x)]) == gen, bar);
            __builtin_amdgcn_fence(__ATOMIC_ACQUIRE, "agent");
            asm volatile("s_waitcnt vmcnt(0)" ::: "memory");
        }
    }
    __syncthreads();
}

constexpr int NWAVES = 8, NTHR = 512;
constexpr int T = 32768, D = 1024, NBATCH = 8, SEQ = 4096, DEPTH = 4;
constexpr int NHEAD = 8, QKN = 128, QKR = 64, DQK = 192, VH = 128, QRANK = 768, KVRANK = 256;
constexpr int NKEYS = 128, NEXP = 16384, PTOPK = 16, PLE = 256;
constexpr float EPS = 1e-6f;
constexpr float C2 = 0.07216878364870322f * 1.4426950408889634f;

constexpr size_t MiB = 1u << 20;
constexpr size_t WS_CTL = 0, CTL_ZERO_BYTES = 64 * 1024;
constexpr size_t WS_SSQ = 840 * MiB;
constexpr size_t WS_COS = 3 * MiB, WS_SIN = 7 * MiB;
constexpr size_t WS_W = 11 * MiB;
constexpr size_t W_WEFF = WS_W;
constexpr size_t W_WG = W_WEFF + 16 * MiB;
constexpr size_t W_WP = W_WG + 8 * MiB;
constexpr size_t W_POOL = W_WP + 2 * MiB;
constexpr size_t W_DOWN2 = W_POOL + 1 * MiB;
constexpr size_t W_DOWN3 = W_DOWN2 + 2560 * 1024;
constexpr size_t W_KNW = W_DOWN3 + 1536 * 1024;
constexpr size_t W_VW = W_KNW + 512 * 1024;
constexpr size_t W_UQ = W_VW + 512 * 1024;
constexpr size_t W_WO = W_UQ + 4608 * 1024;
constexpr size_t WS_WEND = W_WO + 4 * MiB;
constexpr size_t WS_X = 52 * MiB;
constexpr size_t WS_XBA = 180 * MiB, WS_XBB = 244 * MiB;
constexpr size_t WS_UV = 308 * MiB;
constexpr size_t WS_UVS = 340 * MiB;
constexpr size_t WS_UV2 = 52 * MiB, WS_UVS2 = 84 * MiB;
__host__ __device__ constexpr size_t tab_off(int set) { return set ? WS_UV2 : WS_UV; }
__host__ __device__ constexpr size_t tabs_off(int set) { return set ? WS_UVS2 : WS_UVS; }
constexpr size_t WS_PB = 372 * MiB;
constexpr size_t WS_PP = 388 * MiB;
constexpr size_t WS_KN = 452 * MiB;
constexpr size_t WS_VT = 516 * MiB;
constexpr size_t WS_KPE = 580 * MiB;
constexpr size_t WS_R1 = 584 * MiB;
constexpr size_t WS_S = WS_R1;
constexpr size_t WS_POOLED = WS_R1;
constexpr size_t WS_Q = WS_R1;
constexpr size_t WS_AO = WS_R1 + 96 * MiB;
constexpr size_t WS_CQ = WS_R1 + 160 * MiB;
constexpr size_t WS_CKV = WS_R1 + 208 * MiB;
constexpr size_t WS_IDX = 872 * MiB;
constexpr size_t WS_GW = 880 * MiB, WS_MU = 896 * MiB;
constexpr size_t WS_PART = WS_R1;
constexpr size_t WS_WW = WS_R1 + 128 * MiB;
constexpr size_t WS_END = 912 * MiB;
constexpr size_t SSQ_ARR = (size_t)32768 * 16;
static_assert(WS_WEND <= WS_X, "weights");

constexpr int RING_BYTES = 139264;
constexpr int MISC_OFF = RING_BYTES + 320;
constexpr int LDS_BYTES = 147456;

namespace epi {
using pg8::Unit; using pg8::cvt_pk_bf16;
typedef float f32x4 __attribute__((ext_vector_type(4)));
typedef unsigned u32x4 __attribute__((ext_vector_type(4)));
typedef unsigned u32x2 __attribute__((ext_vector_type(2)));
__device__ __forceinline__ float dot4(f32x4 v) { return (v[0] * v[0] + v[1] * v[1]) + (v[2] * v[2] + v[3] * v[3]); }
__device__ __forceinline__ void rinv8(const float* ssq, int rbase, int fr, int fq, float invdim, float (&ri)[8]) {
    f32x4 q[8];
#pragma unroll
    for (int k = 0; k < 8; ++k) q[k] = *(const f32x4*)(ssq + (size_t)(rbase + (k >> 2) * 128 + (k & 3) * 16) * 16 + 4 * fq);
#pragma unroll
    for (int k = 0; k < 8; ++k) { float s = (q[k][0] + q[k][1]) + (q[k][2] + q[k][3]); s += shx<16>(s, fq * 16 + fr); s += shx<32>(s, fq * 16 + fr); ri[k] = __builtin_amdgcn_rsqf(s * invdim + 1e-6f); }
}

struct Resid {
    static constexpr bool PERM = true;
    bf16* XB; float* ssq_out;
    __device__ __forceinline__ void operator()(const f32x4 (&acc)[2][2][4][2], const Unit& u, int wr, int wc, int fr, int fq) const {
        const int col0 = u.pn * 256 + wc * 32 + 8 * fq;
        float sv[8]; u32x4 xo[8][2];
        bf16* const b0 = XB + (size_t)(u.pm * 256 + wr * 64 + fr) * D + col0;
#define EPI_ROW(k) (b0 + (size_t)(((k) >> 2) * 128 + ((k) & 3) * 16) * D)
#define EPI_LOAD(k) do { xo[k][0] = *(const u32x4*)EPI_ROW(k); xo[k][1] = *(const u32x4*)(EPI_ROW(k) + 128); } while (0)
        EPI_LOAD(0); EPI_LOAD(1); EPI_LOAD(2);
#pragma unroll
        for (int k = 0; k < 8; ++k) { const int ai = k >> 2, m = k & 3; float s = 0.f;
            if (k + 3 < 8) EPI_LOAD(k + 3);
#pragma unroll
            for (int bj = 0; bj < 2; ++bj) { const u32x4 x = xo[k][bj];
                const f32x4 v0 = (f32x4){bflo(x.x), bfhi(x.x), bflo(x.y), bfhi(x.y)} + acc[ai][bj][m][0], v1 = (f32x4){bflo(x.z), bfhi(x.z), bflo(x.w), bfhi(x.w)} + acc[ai][bj][m][1];
                u32x4 w; w.x = cvt_pk_bf16(v0[0], v0[1]); w.y = cvt_pk_bf16(v0[2], v0[3]); w.z = cvt_pk_bf16(v1[0], v1[1]); w.w = cvt_pk_bf16(v1[2], v1[3]); *(u32x4*)(EPI_ROW(k) + bj * 128) = w;
                s += dot4(v0) + dot4(v1); }
            s += shx<16>(s, fq * 16 + fr); s += shx<32>(s, fq * 16 + fr); sv[k] = s;
        }
#undef EPI_LOAD
#undef EPI_ROW
        if (fq == 0) {
#pragma unroll
            for (int k = 0; k < 8; ++k) ssq_out[(size_t)(u.pm * 256 + (k >> 2) * 128 + wr * 64 + (k & 3) * 16 + fr) * 16 + u.pn * 4 + wc] = sv[k]; }
    }
};
struct Score {
    static constexpr bool PERM = true;
    unsigned short* S; int ldc; const float* ssq;
    __device__ __forceinline__ void operator()(const f32x4 (&acc)[2][2][4][2], const Unit& u, int wr, int wc, int fr, int fq) const {
        const int col0 = u.pn * 256 + wc * 32 + 8 * fq;
        float ri8[8]; rinv8(ssq, u.pm * 256 + wr * 64 + fr, fr, fq, 1.f / D, ri8);
#pragma unroll
        for (int ai = 0; ai < 2; ++ai)
#pragma unroll
            for (int m = 0; m < 4; ++m) {
                const int r = u.pm * 256 + ai * 128 + wr * 64 + m * 16 + fr; const float ri = ri8[ai * 4 + m];
                unsigned short* sr = S + (size_t)r * ldc + col0;
#pragma unroll
                for (int bj = 0; bj < 2; ++bj) { const f32x4 v0 = acc[ai][bj][m][0] * ri, v1 = acc[ai][bj][m][1] * ri; u32x4 w;
                    w.x = pkh2(v0[0], v0[1]); w.y = pkh2(v0[2], v0[3]); w.z = pkh2(v1[0], v1[1]); w.w = pkh2(v1[2], v1[3]); *(u32x4*)(sr + bj * 128) = w; }
            }
    }
};
struct Bf16Row {
    static constexpr bool PERM = true;
    bf16* O; int ldc; const float* ssq; float invdim;
    __device__ __forceinline__ void operator()(const f32x4 (&acc)[2][2][4][2], const Unit& u, int wr, int wc, int fr, int fq) const {
        const int col0 = u.pn * 256 + wc * 32 + 8 * fq;
        float ri8[8];
        if (ssq) rinv8(ssq, u.pm * 256 + wr * 64 + fr, fr, fq, invdim, ri8);
        else {
#pragma unroll
            for (int k = 0; k < 8; ++k) ri8[k] = 1.f; }
#pragma unroll
        for (int ai = 0; ai < 2; ++ai)
#pragma unroll
            for (int m = 0; m < 4; ++m) {
                const int r = u.pm * 256 + ai * 128 + wr * 64 + m * 16 + fr; const float ri = ri8[ai * 4 + m];
                bf16* orow = O + (size_t)r * ldc + col0;
#pragma unroll
                for (int bj = 0; bj < 2; ++bj) { const f32x4 v0 = acc[ai][bj][m][0] * ri, v1 = acc[ai][bj][m][1] * ri; u32x4 w;
                    w.x = cvt_pk_bf16(v0[0], v0[1]); w.y = cvt_pk_bf16(v0[2], v0[3]); w.z = cvt_pk_bf16(v1[0], v1[1]); w.w = cvt_pk_bf16(v1[2], v1[3]); *(u32x4*)(orow + bj * 128) = w; }
            }
    }
};
struct VTCol {
    static constexpr bool PERM = true;
    bf16* O; const float* ssq; float invdim;
    __device__ __forceinline__ void operator()(const f32x4 (&acc)[2][2][4][2], const Unit& u, int wr, int wc, int fr, int fq) const {
        const int col0 = u.pn * 256 + wc * 32 + 8 * fq;
#pragma unroll
        for (int bj = 0; bj < 2; ++bj) {
            f32x4 sc0, sc1;
#pragma unroll
            for (int j = 0; j < 4; ++j) { sc0[j] = row_rinv(ssq, col0 + bj * 128 + j, invdim); sc1[j] = row_rinv(ssq, col0 + bj * 128 + 4 + j, invdim); }
#pragma unroll
            for (int ai = 0; ai < 2; ++ai)
#pragma unroll
                for (int m = 0; m < 4; ++m) {
                    const int r = u.pm * 256 + ai * 128 + wr * 64 + m * 16 + fr;
                    const f32x4 v0 = acc[ai][bj][m][0] * sc0, v1 = acc[ai][bj][m][1] * sc1; u32x4 w;
                    w.x = cvt_pk_bf16(v0[0], v0[1]); w.y = cvt_pk_bf16(v0[2], v0[3]); w.z = cvt_pk_bf16(v1[0], v1[1]); w.w = cvt_pk_bf16(v1[2], v1[3]);
                    *(u32x4*)(O + (size_t)r * T + col0 + bj * 128) = w;
                }
        }
    }
};
struct Gate {
    static constexpr bool PERM = true;
    const bf16* XBc; bf16* XBn; const bf16* PP; const float* ssq; float* ssq_out;
    __device__ __forceinline__ void operator()(const f32x4 (&acc)[2][2][4][2], const Unit& u, int wr, int wc, int fr, int fq) const {
        const int col0 = u.pn * 256 + wc * 32 + 8 * fq;
        float ri8[8], sv[8]; rinv8(ssq, u.pm * 256 + wr * 64 + fr, fr, fq, 1.f / D, ri8);
        u32x4 xo[8][2], pw[8][2];
        const size_t o0 = (size_t)(u.pm * 256 + wr * 64 + fr) * D + col0;
#define EPI_OFF(k) (o0 + (size_t)(((k) >> 2) * 128 + ((k) & 3) * 16) * D)
#define EPI_LOAD(k) do { xo[k][0] = *(const u32x4*)(XBc + EPI_OFF(k)); pw[k][0] = *(const u32x4*)(PP + EPI_OFF(k)); xo[k][1] = *(const u32x4*)(XBc + EPI_OFF(k) + 128); pw[k][1] = *(const u32x4*)(PP + EPI_OFF(k) + 128); } while (0)
        EPI_LOAD(0); EPI_LOAD(1); EPI_LOAD(2);
#pragma unroll
        for (int k = 0; k < 8; ++k) { const int ai = k >> 2, m = k & 3; const float ri = ri8[k]; float s = 0.f;
            if (k + 3 < 8) EPI_LOAD(k + 3);
#pragma unroll
            for (int bj = 0; bj < 2; ++bj) { const u32x4 x = xo[k][bj], p = pw[k][bj];
                const f32x4 z0 = acc[ai][bj][m][0] * ri, z1 = acc[ai][bj][m][1] * ri; f32x4 g0, g1;
#pragma unroll
                for (int j = 0; j < 4; ++j) { g0[j] = __builtin_amdgcn_rcpf(1.f + __builtin_amdgcn_exp2f(-1.4426950408889634f * z0[j])); g1[j] = __builtin_amdgcn_rcpf(1.f + __builtin_amdgcn_exp2f(-1.4426950408889634f * z1[j])); }
                const f32x4 v0 = (f32x4){bflo(x.x), bfhi(x.x), bflo(x.y), bfhi(x.y)} + g0 * (f32x4){bflo(p.x), bfhi(p.x), bflo(p.y), bfhi(p.y)};
                const f32x4 v1 = (f32x4){bflo(x.z), bfhi(x.z), bflo(x.w), bfhi(x.w)} + g1 * (f32x4){bflo(p.z), bfhi(p.z), bflo(p.w), bfhi(p.w)};
                u32x4 w; w.x = cvt_pk_bf16(v0[0], v0[1]); w.y = cvt_pk_bf16(v0[2], v0[3]); w.z = cvt_pk_bf16(v1[0], v1[1]); w.w = cvt_pk_bf16(v1[2], v1[3]); *(u32x4*)(XBn + EPI_OFF(k) + bj * 128) = w;
                s += dot4(v0) + dot4(v1); }
            s += shx<16>(s, fq * 16 + fr); s += shx<32>(s, fq * 16 + fr); sv[k] = s;
        }
#undef EPI_LOAD
#undef EPI_OFF
        if (fq == 0) {
#pragma unroll
            for (int k = 0; k < 8; ++k) ssq_out[(size_t)(u.pm * 256 + (k >> 2) * 128 + wr * 64 + (k & 3) * 16 + fr) * 16 + u.pn * 4 + wc] = sv[k]; }
    }
};
struct Down {
    static constexpr bool PERM = true;
    bf16* CQ; bf16* CKV; bf16* KPE; const float* ssq; float* ssq_q; float* ssq_kv; const float* COS; const float* SIN;
    __device__ __forceinline__ void operator()(const f32x4 (&acc)[2][2][4][2], const Unit& u, int wr, int wc, int fr, int fq) const {
        const int tc0 = wc * 32 + 8 * fq;
        float ri8[8], sv[8]; rinv8(ssq, u.pm * 256 + wr * 64 + fr, fr, fq, 1.f / D, ri8);
#pragma unroll
        for (int k = 0; k < 8; ++k) sv[k] = 0.f;
#pragma unroll
        for (int ai = 0; ai < 2; ++ai)
#pragma unroll
            for (int m = 0; m < 4; ++m) {
                const int r = u.pm * 256 + ai * 128 + wr * 64 + m * 16 + fr; const float ri = ri8[ai * 4 + m];
                if (u.pn < 4) {
                    bf16* orow = (u.pn < 3) ? CQ + (size_t)r * QRANK + u.pn * 256 + tc0 : CKV + (size_t)r * KVRANK + tc0; float s = 0.f;
#pragma unroll
                    for (int bj = 0; bj < 2; ++bj) { const f32x4 v0 = acc[ai][bj][m][0] * ri, v1 = acc[ai][bj][m][1] * ri; u32x4 w;
                        w.x = cvt_pk_bf16(v0[0], v0[1]); w.y = cvt_pk_bf16(v0[2], v0[3]); w.z = cvt_pk_bf16(v1[0], v1[1]); w.w = cvt_pk_bf16(v1[2], v1[3]); *(u32x4*)(orow + bj * 128) = w;
                        s += dot4(v0) + dot4(v1); }
                    s += shx<16>(s, fq * 16 + fr); s += shx<32>(s, fq * 16 + fr); sv[ai * 4 + m] = s;
                } else if (wc < 2) {
                    const f32x4 cs = *(const f32x4*)(COS + (size_t)r * 32 + wc * 16 + 4 * fq), sn = *(const f32x4*)(SIN + (size_t)r * 32 + wc * 16 + 4 * fq);
                    const f32x4 v0 = acc[ai][0][m][0] * ri, v1 = acc[ai][0][m][1] * ri; u32x4 w;
                    w.x = cvt_pk_bf16(v0[0] * cs[0] - v0[1] * sn[0], v0[1] * cs[0] + v0[0] * sn[0]);
                    w.y = cvt_pk_bf16(v0[2] * cs[1] - v0[3] * sn[1], v0[3] * cs[1] + v0[2] * sn[1]);
                    w.z = cvt_pk_bf16(v1[0] * cs[2] - v1[1] * sn[2], v1[1] * cs[2] + v1[0] * sn[2]);
                    w.w = cvt_pk_bf16(v1[2] * cs[3] - v1[3] * sn[3], v1[3] * cs[3] + v1[2] * sn[3]);
                    *(u32x4*)(KPE + (size_t)r * QKR + tc0) = w;
                }
            }
        if (u.pn < 4 && fq == 0) {
            float* const so = (u.pn < 3) ? ssq_q + u.pn * 4 + wc : ssq_kv + wc;
#pragma unroll
            for (int k = 0; k < 8; ++k) so[(size_t)(u.pm * 256 + (k >> 2) * 128 + wr * 64 + (k & 3) * 16 + fr) * 16] = sv[k]; }
    }
};
struct QUp {
    static constexpr bool PERM = true;
    bf16* Q; const float* ssq_q; const float* COS; const float* SIN;
    __device__ __forceinline__ void operator()(const f32x4 (&acc)[2][2][4][2], const Unit& u, int wr, int wc, int fr, int fq) const {
        float ri8[8]; rinv8(ssq_q, u.pm * 256 + wr * 64 + fr, fr, fq, 1.f / QRANK, ri8);
        const int r0 = u.pm * 256 + wr * 64 + fr;
#pragma unroll
        for (int bj = 0; bj < 2; ++bj) {
            const int c0w = u.pn * 256 + bj * 128 + wc * 32, c8 = c0w + 8 * fq;
            if ((c0w % DQK) >= QKN) {
                const int pb = ((c8 % DQK) - QKN) >> 1;
                f32x4 cs[8], sn[8];
#pragma unroll
                for (int k = 0; k < 8; ++k) { const size_t ro = (size_t)(r0 + (k >> 2) * 128 + (k & 3) * 16) * 32 + pb; cs[k] = *(const f32x4*)(COS + ro); sn[k] = *(const f32x4*)(SIN + ro); }
#pragma unroll
                for (int k = 0; k < 8; ++k) { const int ai = k >> 2, m = k & 3; const float ri = ri8[k];
                    const f32x4 v0 = acc[ai][bj][m][0] * ri, v1 = acc[ai][bj][m][1] * ri; u32x4 w;
                    w.x = cvt_pk_bf16(v0[0] * cs[k][0] - v0[1] * sn[k][0], v0[1] * cs[k][0] + v0[0] * sn[k][0]);
                    w.y = cvt_pk_bf16(v0[2] * cs[k][1] - v0[3] * sn[k][1], v0[3] * cs[k][1] + v0[2] * sn[k][1]);
                    w.z = cvt_pk_bf16(v1[0] * cs[k][2] - v1[1] * sn[k][2], v1[1] * cs[k][2] + v1[0] * sn[k][2]);
                    w.w = cvt_pk_bf16(v1[2] * cs[k][3] - v1[3] * sn[k][3], v1[3] * cs[k][3] + v1[2] * sn[k][3]);
                    *(u32x4*)(Q + (size_t)(r0 + ai * 128 + m * 16) * (NHEAD * DQK) + c8) = w; }
            } else {
#pragma unroll
                for (int k = 0; k < 8; ++k) { const int ai = k >> 2, m = k & 3; const float ri = ri8[k];
                    const f32x4 v0 = acc[ai][bj][m][0] * ri, v1 = acc[ai][bj][m][1] * ri; u32x4 w;
                    w.x = cvt_pk_bf16(v0[0], v0[1]); w.y = cvt_pk_bf16(v0[2], v0[3]); w.z = cvt_pk_bf16(v1[0], v1[1]); w.w = cvt_pk_bf16(v1[2], v1[3]);
                    *(u32x4*)(Q + (size_t)(r0 + ai * 128 + m * 16) * (NHEAD * DQK) + c8) = w; }
            }
        }
    }
};
struct Null {
    static constexpr bool PERM = true;
    float* O;
    __device__ __forceinline__ void operator()(const f32x4 (&acc)[2][2][4][2], const Unit& u, int wr, int wc, int fr, int fq) const {
        f32x4 s = {0.f, 0.f, 0.f, 0.f};
#pragma unroll
        for (int ai = 0; ai < 2; ++ai)
#pragma unroll
            for (int bj = 0; bj < 2; ++bj)
#pragma unroll
                for (int m = 0; m < 4; ++m) s += acc[ai][bj][m][0] + acc[ai][bj][m][1];
        O[(size_t)(u.pm * 8 + u.pn) * 512 + (wr * 4 + wc) * 64 + fq * 16 + fr] = (s[0] + s[1]) + (s[2] + s[3]);
    }
};
}

struct TJob { const float* W; int ldw; int K; int Nout; bf16* out; int mode; const float* rs; const float* cs; float cmul; };
__device__ __forceinline__ int tj_src(int mode, int n) {
    if (mode == 1) { if (n < KVRANK) return n; const int rr = n - KVRANK; return KVRANK + (rr >> 1) + 32 * (rr & 1); }
    if (mode == 2) { const int hd = n / DQK, r = n % DQK; if (r < QKN) return n; const int rr = r - QKN; return hd * DQK + QKN + (rr >> 1) + 32 * (rr & 1); }
    if (mode == 3) return (n >> 7) * 256 + (n & 127);
    if (mode == 4) return (n >> 7) * 256 + 128 + (n & 127);
    return n;
}
__device__ __forceinline__ void transpose_tile(const TJob& j, LAS float* scr, int tile, int tid) {
    const int nkt = j.K >> 6, n0 = (tile / nkt) * 64, k0 = (tile % nkt) * 64;
    { const int nn = tid & 63; const int src = (j.mode == 5) ? -1 : tj_src(j.mode, n0 + nn);
      const float csv = (j.cs ? j.cs[n0 + nn] : 1.f) * j.cmul;
#pragma unroll
      for (int i = 0; i < 8; ++i) { const int kk = (tid >> 6) + 8 * i; float v = 0.f;
          if (src >= 0) v = j.W[(size_t)(k0 + kk) * j.ldw + src] * (j.rs ? j.rs[k0 + kk] : 1.f) * csv;
          scr[kk * 65 + nn] = v; } }
    __syncthreads();
    { const int kk2 = (tid & 31) * 2;
#pragma unroll
      for (int i = 0; i < 4; ++i) { const int nn2 = (tid >> 5) + 16 * i;
          *(unsigned*)(j.out + (size_t)(n0 + nn2) * j.K + k0 + kk2) = pk2(scr[kk2 * 65 + nn2], scr[(kk2 + 1) * 65 + nn2]); } }
    __syncthreads();
}
__device__ __forceinline__ void transpose_tile2(const TJob& ja, int tileA, const TJob& jb, int tileB, LAS float* scr, int tid) {
    LAS float* scr2 = scr + 64 * 65 + 32;
    const int nkA = ja.K >> 6, nkB = jb.K >> 6;
    const int nA = (tileA / nkA) * 64, kA = (tileA % nkA) * 64, nB = (tileB / nkB) * 64, kB = (tileB % nkB) * 64;
    { const int nn = tid & 63; const bool zA = ja.mode == 5, zB = jb.mode == 5; const int sA = zA ? 0 : tj_src(ja.mode, nA + nn), sB = zB ? 0 : tj_src(jb.mode, nB + nn);
      const float cA = zA ? 0.f : (ja.cs ? ja.cs[nA + nn] : 1.f) * ja.cmul, cB = zB ? 0.f : (jb.cs ? jb.cs[nB + nn] : 1.f) * jb.cmul;
      float va[8], vb[8], ra[8], rb[8];
#pragma unroll
      for (int i = 0; i < 8; ++i) { const int kk = (tid >> 6) + 8 * i; va[i] = ja.W[(size_t)(kA + kk) * ja.ldw + sA]; vb[i] = jb.W[(size_t)(kB + kk) * jb.ldw + sB];
          ra[i] = ja.rs ? ja.rs[kA + kk] : 1.f; rb[i] = jb.rs ? jb.rs[kB + kk] : 1.f; }
#pragma unroll
      for (int i = 0; i < 8; ++i) { const int kk = (tid >> 6) + 8 * i; scr[kk * 65 + nn] = va[i] * ra[i] * cA; scr2[kk * 65 + nn] = vb[i] * rb[i] * cB; } }
    __syncthreads();
    { const int kk2 = (tid & 31) * 2;
#pragma unroll
      for (int i = 0; i < 4; ++i) { const int nn2 = (tid >> 5) + 16 * i;
          *(unsigned*)(ja.out + (size_t)(nA + nn2) * ja.K + kA + kk2) = pk2(scr[kk2 * 65 + nn2], scr[(kk2 + 1) * 65 + nn2]);
          *(unsigned*)(jb.out + (size_t)(nB + nn2) * jb.K + kB + kk2) = pk2(scr2[kk2 * 65 + nn2], scr2[(kk2 + 1) * 65 + nn2]); } }
    __syncthreads();
}
struct In {
    const float *x, *p; const int* pos; const float *mix_norm, *ffn_norm, *pool_w, *pool_scale, *kv_in_norm, *w_dkv, *kv_norm, *w_ukv, *w_dq, *q_norm, *w_uq, *w_o,
                *peer_wq, *peer_keys, *peer_u, *peer_v, *ple_norm, *ple_wg, *ple_wp, *final_norm;
};
typedef const __attribute__((address_space(4))) In CIn;
__device__ __forceinline__ TJob get_job(int id, CIn& in, unsigned char* ws) {
    TJob j; j.mode = 0; j.rs = nullptr; j.cs = nullptr; j.cmul = 1.f;
    if (id < 4) { j.W = in.ple_wg + (size_t)id * D * D; j.ldw = D; j.K = D; j.Nout = D; j.out = (bf16*)(ws + W_WG) + (size_t)id * D * D; j.rs = in.ple_norm + id * D; }
    else if (id < 8) { const int i = id - 4; j.W = in.ple_wp + (size_t)i * PLE * D; j.ldw = D; j.K = PLE; j.Nout = D; j.out = (bf16*)(ws + W_WP) + (size_t)i * D * PLE; }
    else if (id < 16) { const int i = (id - 8) >> 2, g = (id - 8) & 3; j.W = in.pool_w + (size_t)(i * 4 + g) * 65536; j.ldw = 256; j.K = 256; j.Nout = 256;
        j.out = (bf16*)(ws + W_POOL) + (size_t)(i * 1024 + g * 256) * 256; j.cs = in.pool_scale + i * D + g * 256; }
    else if (id == 16) { j.W = in.w_dq; j.ldw = QRANK; j.K = D; j.Nout = QRANK; j.out = (bf16*)(ws + W_DOWN2); j.rs = in.mix_norm + 2 * D; }
    else if (id == 17) { j.W = in.w_dkv; j.ldw = KVRANK + QKR; j.K = D; j.Nout = KVRANK + QKR; j.out = (bf16*)(ws + W_DOWN2) + (size_t)QRANK * D; j.mode = 1; j.rs = in.kv_in_norm; }
    else if (id == 18) { j.W = in.w_dkv; j.ldw = KVRANK + QKR; j.K = D; j.Nout = 192; j.out = (bf16*)(ws + W_DOWN2) + (size_t)(QRANK + KVRANK + QKR) * D; j.mode = 5; }
    else if (id == 19) { j.W = in.w_dq + (size_t)D * QRANK; j.ldw = QRANK; j.K = D; j.Nout = QRANK; j.out = (bf16*)(ws + W_DOWN3); j.rs = in.mix_norm + 3 * D; }
    else if (id == 20) { j.W = in.w_ukv; j.ldw = 2048; j.K = KVRANK; j.Nout = 1024; j.out = (bf16*)(ws + W_KNW); j.mode = 3; j.rs = in.kv_norm; }
    else if (id == 21) { j.W = in.w_ukv; j.ldw = 2048; j.K = KVRANK; j.Nout = 1024; j.out = (bf16*)(ws + W_VW); j.mode = 4; j.rs = in.kv_norm; }
    else if (id < 24) { const int jj = id - 22; j.W = in.w_uq + (size_t)jj * QRANK * 1536; j.ldw = 1536; j.K = QRANK; j.Nout = 1536; j.out = (bf16*)(ws + W_UQ) + (size_t)jj * 1536 * QRANK;
        j.mode = 2; j.rs = in.q_norm + jj * QRANK; j.cmul = C2; }
    else { const int jj = id - 24; j.W = in.w_o + (size_t)jj * D * D; j.ldw = D; j.K = D; j.Nout = D; j.out = (bf16*)(ws + W_WO) + (size_t)jj * D * D; }
    return j;
}
constexpr int N_TJOBS = 26;
__host__ __device__ constexpr int tj_tiles(int id) {
    return id < 4 ? (D >> 6) * (D >> 6) : id < 8 ? (PLE >> 6) * (D >> 6) : id < 16 ? 16 : id == 16 ? (D >> 6) * (QRANK >> 6) : id == 17 ? (D >> 6) * ((KVRANK + QKR) >> 6)
         : id == 18 ? (D >> 6) * 3 : id == 19 ? (D >> 6) * (QRANK >> 6) : id < 22 ? (KVRANK >> 6) * 16 : id < 24 ? (QRANK >> 6) * 24 : (D >> 6) * (D >> 6);
}

__device__ __forceinline__ void weff_item(const float* wq, const float* keys, const float* gain, bf16* out, int hp, int kt, LAS float* lds, int tid) {
    constexpr int RS = 136;
    LAS unsigned short* Wh = (LAS unsigned short*)lds; LAS unsigned short* Wl = Wh + 64 * RS; LAS unsigned short* Kh = Wl + 64 * RS; LAS unsigned short* Kl = Kh + 128 * RS;
    const int k0 = kt * 64;
#define WEFF_SPLIT(v, ph, pl) do { v2u h_, l_; h_.x = pk2((v)[0], (v)[1]); h_.y = pk2((v)[2], (v)[3]); \
        l_.x = pk2((v)[0] - bflo(h_.x), (v)[1] - bfhi(h_.x)); l_.y = pk2((v)[2] - bflo(h_.y), (v)[3] - bfhi(h_.y)); *(LAS v2u*)(ph) = h_; *(LAS v2u*)(pl) = l_; } while (0)
#pragma unroll
    for (int i = 0; i < 4; ++i) { const int idx = tid + 512 * i, row = idx >> 5, c4 = idx & 31;
        const f32x4 v = *(const f32x4*)(wq + (size_t)(k0 + row) * 2048 + hp * 128 + c4 * 4) * gain[k0 + row]; WEFF_SPLIT(v, Wh + row * RS + c4 * 4, Wl + row * RS + c4 * 4); }
#pragma unroll
    for (int i = 0; i < 8; ++i) { const int idx = tid + 512 * i, row = idx >> 5, c4 = idx & 31;
        const f32x4 v = *(const f32x4*)(keys + (size_t)(hp * 128 + row) * 128 + c4 * 4); WEFF_SPLIT(v, Kh + row * RS + c4 * 4, Kl + row * RS + c4 * 4); }
#undef WEFF_SPLIT
    __syncthreads();
    const int w = tid >> 6, l = tid & 63, tk = w & 1, tn = w >> 1, r32 = l & 31, g = l >> 5;
    f32x16 acc;
#pragma unroll
    for (int r = 0; r < 16; ++r) acc[r] = 0.f;
    const int ao = (32 * tk + r32) * RS + 8 * g, bo = (32 * tn + r32) * RS + 8 * g;
#pragma unroll
    for (int s8 = 0; s8 < 8; ++s8) {
        const bf16x8 ah = *(const LAS bf16x8*)(Wh + ao + 16 * s8), al = *(const LAS bf16x8*)(Wl + ao + 16 * s8);
        const bf16x8 bh = *(const LAS bf16x8*)(Kh + bo + 16 * s8), bl = *(const LAS bf16x8*)(Kl + bo + 16 * s8);
        acc = __builtin_amdgcn_mfma_f32_32x32x16_bf16(ah, bh, acc, 0, 0, 0);
        acc = __builtin_amdgcn_mfma_f32_32x32x16_bf16(ah, bl, acc, 0, 0, 0);
        acc = __builtin_amdgcn_mfma_f32_32x32x16_bf16(al, bh, acc, 0, 0, 0);
    }
#pragma unroll
    for (int gq = 0; gq < 4; ++gq) { v2u o_; o_.x = pk2(acc[4 * gq + 0], acc[4 * gq + 1]); o_.y = pk2(acc[4 * gq + 2], acc[4 * gq + 3]);
        *(v2u*)(out + (size_t)(hp * 128 + 32 * tn + r32) * D + k0 + 32 * tk + 8 * gq + 4 * g) = o_; }
    __syncthreads();
}

__device__ __forceinline__ void p0_prologue(CIn& in, unsigned char* ws, LAS unsigned char* lds, int bid, int G, int wave) {
    const int tid = wave * 64 + lane_id_fresh();
    const int gtid = bid * NTHR + tid, NT = G * NTHR;
    for (int i = gtid + (int)(SSQ_ARR / 4); i < (int)(16 * SSQ_ARR / 4); i += NT) ((f32x4*)(ws + WS_SSQ))[i] = (f32x4){0.f, 0.f, 0.f, 0.f};
    {
      int total = 0;
#pragma unroll
      for (int id = 0; id < N_TJOBS; ++id) total += tj_tiles(id);
      for (int g = bid; g < total; g += 2 * G) {
          int idA = 0, tA = g; while (tA >= tj_tiles(idA)) { tA -= tj_tiles(idA); ++idA; }
          const TJob ja = get_job(idA, in, ws);
          if (g + G < total) { int idB = idA, tB = tA + G; while (tB >= tj_tiles(idB)) { tB -= tj_tiles(idB); ++idB; }
              const TJob jb = get_job(idB, in, ws); transpose_tile2(ja, tA, jb, tB, (LAS float*)lds, tid); }
          else transpose_tile(ja, (LAS float*)lds, tA, tid); } }
    for (int it = bid; it < 4 * 16 * 16; it += G) { const int l = it >> 8, hp = (it >> 4) & 15, kt = it & 15;
        weff_item(in.peer_wq + (size_t)l * D * 2048, in.peer_keys + (size_t)l * 2048 * 128, in.ffn_norm + l * D, (bf16*)(ws + W_WEFF) + (size_t)l * 2048 * D, hp, kt, (LAS float*)lds, tid); }
    for (int i = gtid; i < T * 32; i += NT) { const int t = i >> 5, c = i & 31;
        double inv = 0.15915494309189535; for (int k = 0; k < c; ++k) inv *= 0.7498942093324559;
        double rd = (double)in.pos[t] * inv; rd -= __builtin_floor(rd); const float rr = (float)rd;
        ((float*)(ws + WS_COS))[i] = __builtin_amdgcn_cosf(rr); ((float*)(ws + WS_SIN))[i] = __builtin_amdgcn_sinf(rr); }
    { const int lane = tid & 63, gw = gtid >> 6, NW = NT >> 6; bf16* XB = (bf16*)(ws + WS_XBA); float* ssq = (float*)(ws + WS_SSQ);
      for (int r = gw; r < T; r += 2 * NW) { const int r2 = (r + NW < T) ? r + NW : r; f32x4 va[4], vb[4];
#pragma unroll
          for (int j = 0; j < 4; ++j) { va[j] = *(const f32x4*)(in.x + (size_t)r * D + j * 256 + 4 * lane); vb[j] = *(const f32x4*)(in.x + (size_t)r2 * D + j * 256 + 4 * lane); }
          float s = 0.f, s2 = 0.f;
#pragma unroll
          for (int j = 0; j < 4; ++j) { const size_t o = (size_t)r * D + j * 256 + 4 * lane, o2 = (size_t)r2 * D + j * 256 + 4 * lane;
              v2u w; w.x = pk2(va[j][0], va[j][1]); w.y = pk2(va[j][2], va[j][3]); *(v2u*)(XB + o) = w; s += (va[j][0] * va[j][0] + va[j][1] * va[j][1]) + (va[j][2] * va[j][2] + va[j][3] * va[j][3]);
              v2u y; y.x = pk2(vb[j][0], vb[j][1]); y.y = pk2(vb[j][2], vb[j][3]); *(v2u*)(XB + o2) = y; s2 += (vb[j][0] * vb[j][0] + vb[j][1] * vb[j][1]) + (vb[j][2] * vb[j][2] + vb[j][3] * vb[j][3]); }
          s = wave_sum(s, lane); s2 = wave_sum(s2, lane);
          if (lane < 16) { ssq[(size_t)r * 16 + lane] = (lane == 0) ? s : 0.f; ssq[(size_t)r2 * 16 + lane] = (lane == 0) ? s2 : 0.f; } } }
}
typedef float f2_t __attribute__((ext_vector_type(2)));
template <int CTRL> __device__ __forceinline__ int dppi(int v) { return __builtin_amdgcn_update_dpp(0, v, CTRL, 0xf, 0xf, true); }
__device__ __forceinline__ unsigned wave_max_dpp(unsigned v) {
    v = max(v, (unsigned)dppi<0xB1>((int)v)); v = max(v, (unsigned)dppi<0x4E>((int)v)); v = max(v, (unsigned)dppi<0x141>((int)v)); v = max(v, (unsigned)dppi<0x140>((int)v));
    { unsigned p = v, q = v; asm volatile("s_nop 1\n\tv_permlane16_swap_b32 %0, %1" : "+v"(p), "+v"(q)); v = max(p, q); }
    { unsigned p = v, q = v; asm volatile("s_nop 1\n\tv_permlane32_swap_b32 %0, %1" : "+v"(p), "+v"(q)); v = max(p, q); }
    return v;
}
__device__ __forceinline__ unsigned pack_i8x4(f32x4 v, float inv) {
    const unsigned y0 = __builtin_bit_cast(unsigned, __builtin_fmaf(v[0], inv, 12582912.f)), y1 = __builtin_bit_cast(unsigned, __builtin_fmaf(v[1], inv, 12582912.f));
    const unsigned y2 = __builtin_bit_cast(unsigned, __builtin_fmaf(v[2], inv, 12582912.f)), y3 = __builtin_bit_cast(unsigned, __builtin_fmaf(v[3], inv, 12582912.f));
    return __builtin_amdgcn_perm(y1, y0, 0x0c0c0400u) | (__builtin_amdgcn_perm(y3, y2, 0x0c0c0400u) << 16);
}
__device__ __forceinline__ void quant_store_i8(const f32x4 (&v)[4], unsigned char* tab, int row, float* scale_out, int lane) {
    unsigned amb = 0u;
#pragma unroll
    for (int j = 0; j < 4; ++j)
#pragma unroll
        for (int i = 0; i < 4; ++i) { const float f_ = v[j][i]; amb = max(amb, __builtin_bit_cast(unsigned, f_) & 0x7fffffffu); }
    const float am = __builtin_bit_cast(float, wave_max_dpp(amb));
    const float inv = am > 0.f ? 126.99f * __builtin_amdgcn_rcpf(am) : 0.f;
    v4u w;
#pragma unroll
    for (int j = 0; j < 4; ++j) w[j] = pack_i8x4(v[j], inv);
    *(v4u*)(tab + (size_t)((unsigned)(lane >> 3) * (unsigned)(NEXP * 128) + (unsigned)row * 128u + (unsigned)(lane & 7) * 16u)) = w;
    *scale_out = am * (1.f / 126.99f);
}
__device__ __forceinline__ void convert_layer(CIn& in, unsigned char* ws, int layer, int bid, int G, int wave) {
    const int set = layer & 1;
    const int lane = lane_id_fresh(), tid = wave * 64 + lane;
    const int gtid = bid * NTHR + tid, NT = G * NTHR, gw = gtid >> 6, NW = NT >> 6;
    const float* u = in.peer_u + (size_t)layer * NEXP * D; const float* v = in.peer_v + (size_t)layer * NEXP * D; const float* gn = in.ffn_norm + layer * D;
    unsigned char* U8 = ws + tab_off(set); unsigned char* V8 = U8 + (size_t)NEXP * D; float* SU = (float*)(ws + tabs_off(set)); float* SV = SU + NEXP;
    f32x4 gv[4];
#pragma unroll
    for (int j = 0; j < 4; ++j) gv[j] = *(const f32x4*)(gn + 16 * lane + 4 * j);
    for (int r = gw; r < NEXP; r += 2 * NW) {
        const int r2 = r + NW; const bool ok2 = r2 < NEXP; const int rb = ok2 ? r2 : r;
        f32x4 ua[4], va[4], ub[4], vb[4];
#pragma unroll
        for (int j = 0; j < 4; ++j) { ua[j] = *(const f32x4*)(u + (size_t)r * D + 16 * lane + 4 * j); va[j] = *(const f32x4*)(v + (size_t)r * D + 16 * lane + 4 * j);
            ub[j] = *(const f32x4*)(u + (size_t)rb * D + 16 * lane + 4 * j); vb[j] = *(const f32x4*)(v + (size_t)rb * D + 16 * lane + 4 * j); }
#pragma unroll
        for (int j = 0; j < 4; ++j) { ua[j] = ua[j] * gv[j]; ub[j] = ub[j] * gv[j]; }
        quant_store_i8(ua, U8, r, SU + r, lane); quant_store_i8(va, V8, r, SV + r, lane);
        if (ok2) { quant_store_i8(ub, U8, r2, SU + r2, lane); quant_store_i8(vb, V8, r2, SV + r2, lane); }
    }
    const float* p = in.p + (size_t)layer * T * PLE; bf16* PB = (bf16*)(ws + WS_PB);
    for (int i = gtid; i < T * PLE / 8; i += NT) { const size_t o = (size_t)i * 8; const f32x4 a0 = *(const f32x4*)(p + o), a1 = *(const f32x4*)(p + o + 4);
        v4u w; w.x = pk2(a0[0], a0[1]); w.y = pk2(a0[2], a0[3]); w.z = pk2(a1[0], a1[1]); w.w = pk2(a1[2], a1[3]); *(v4u*)(PB + o) = w; }
}
template <int W>
__device__ __forceinline__ void pooled_strip(const bf16* XB, const LAS float* rinv, const float* gain, bf16* P, int t0, int s0, int tid) {
    const int c0 = 2 * tid; const f32x2 gv = *(const f32x2*)(gain + c0);
    f32x2 ring[W]; f32x2 sum = {0.f, 0.f};
    { unsigned xw[W];
#pragma unroll
      for (int j = 0; j < W; ++j) xw[j] = (s0 - W + j >= 0) ? *(const unsigned*)(XB + (size_t)(t0 - W + j) * D + c0) : 0u;
#pragma unroll
      for (int j = 0; j < W; ++j) { const float ri = (s0 - W + j >= 0) ? rinv[16 - W + j] : 0.f; const f32x2 hv = (f32x2){bflo(xw[j]), bfhi(xw[j])} * ri * gv; ring[j] = hv; sum += hv; } }
    for (int sb = 0; sb < 64; sb += 16) {
        unsigned xw[16];
#pragma unroll
        for (int j = 0; j < 16; ++j) xw[j] = *(const unsigned*)(XB + (size_t)(t0 + sb + j) * D + c0);
#pragma unroll
        for (int j = 0; j < 16; ++j) { const int t = t0 + sb + j, s = s0 + sb + j; const float ri = rinv[16 + sb + j];
            const f32x2 hv = (f32x2){bflo(xw[j]), bfhi(xw[j])} * ri * gv; sum += hv - ring[j % W]; ring[j % W] = hv;
            const float ic = 1.f / (float)((s + 1 < W) ? s + 1 : W); const f32x2 pv = sum * ic - hv;
            *(unsigned*)(P + (size_t)t * D + c0) = pk2(pv[0], pv[1]); }
    }
}
__device__ __forceinline__ void pooled_phase(const bf16* XB, const float* ssq, const float* gain, bf16* P, LAS unsigned char* lds, int vcu, int G, int wave) {
    const int tid = wave * 64 + lane_id_fresh();
    const int g = wave >> 1;
    LAS float* rinv = (LAS float*)lds;
    for (int strip = vcu; strip < T / 64; strip += G) { const int t0 = strip * 64, s0 = t0 & (SEQ - 1);
        __syncthreads();
        if (tid < 80) { const int t = t0 - 16 + tid; rinv[tid] = (s0 - 16 + tid >= 0) ? row_rinv(ssq, t, 1.f / D) : 0.f; }
        __syncthreads();
        if (g == 0) pooled_strip<2>(XB, rinv, gain, P, t0, s0, tid); else if (g == 1) pooled_strip<4>(XB, rinv, gain, P, t0, s0, tid);
        else if (g == 2) pooled_strip<8>(XB, rinv, gain, P, t0, s0, tid); else pooled_strip<16>(XB, rinv, gain, P, t0, s0, tid); }
}
__device__ __forceinline__ void final_phase(const bf16* XB, const float* ssq, const float* gain, float* out, int bid, int G, int wave) {
    const int tid = wave * 64 + lane_id_fresh();
    const int lane = tid & 63, gw = (bid * NTHR + tid) >> 6, NW = (G * NTHR) >> 6;
    f32x4 gv[4];
#pragma unroll
    for (int j = 0; j < 4; ++j) gv[j] = *(const f32x4*)(gain + j * 256 + 4 * lane);
    int r = gw;
    for (; r + 3 * NW < T; r += 4 * NW) {
        f32x4 sq[4]; v2u xw[4][4];
#pragma unroll
        for (int k = 0; k < 4; ++k) { const int rr = r + k * NW; sq[k] = *(const f32x4*)(ssq + (size_t)rr * 16 + 4 * (lane & 3));
#pragma unroll
            for (int j = 0; j < 4; ++j) xw[k][j] = *(const v2u*)(XB + (size_t)rr * D + j * 256 + 4 * lane); }
#pragma unroll
        for (int k = 0; k < 4; ++k) { const int rr = r + k * NW;
            float sv = (sq[k][0] + sq[k][1]) + (sq[k][2] + sq[k][3]); sv += dppf<0xB1>(sv); sv += dppf<0x4E>(sv);
            const float ri = __builtin_amdgcn_rsqf(sv * (1.f / D) + 1e-6f);
#pragma unroll
            for (int j = 0; j < 4; ++j) *(f32x4*)(out + (size_t)rr * D + j * 256 + 4 * lane) = (f32x4){bflo(xw[k][j].x), bfhi(xw[k][j].x), bflo(xw[k][j].y), bfhi(xw[k][j].y)} * ri * gv[j]; }
    }
    for (; r < T; r += NW) { const float ri = row_rinv(ssq, r, 1.f / D);
#pragma unroll
        for (int j = 0; j < 4; ++j) { const size_t o = (size_t)r * D + j * 256 + 4 * lane; const v2u x1 = *(const v2u*)(XB + o); *(f32x4*)(out + o) = (f32x4){bflo(x1.x), bfhi(x1.x), bflo(x1.y), bfhi(x1.y)} * ri * gv[j]; } }
}

__device__ __forceinline__ unsigned fkey(float f) { const unsigned u = __builtin_bit_cast(unsigned, f); return u ^ ((unsigned)((int)u >> 31) | 0x80000000u); }
__device__ __forceinline__ unsigned mbcnt64(unsigned long long m) { return __builtin_amdgcn_mbcnt_hi((unsigned)(m >> 32), __builtin_amdgcn_mbcnt_lo((unsigned)m, 0u)); }
template <int N>
__device__ __forceinline__ void select16(const unsigned (&key)[N], unsigned (&pos)[N]) {
    unsigned prefix = 0u;
    for (int bit = 31; bit >= 0; --bit) {
        const unsigned cand = prefix | (1u << bit); int cnt = 0;
#pragma unroll
        for (int i = 0; i < N; ++i) cnt += __builtin_popcountll(__ballot(key[i] >= cand));
        if (cnt >= 16) prefix = cand;
        if (cnt == 16) break;
    }
    unsigned long long mg[N], me[N]; int cgt = 0;
#pragma unroll
    for (int i = 0; i < N; ++i) { mg[i] = __ballot(key[i] > prefix); me[i] = __ballot(key[i] == prefix); cgt += __builtin_popcountll(mg[i]); }
    int bg = 0, be = cgt;
#pragma unroll
    for (int i = 0; i < N; ++i) { const unsigned rg = mbcnt64(mg[i]), re = mbcnt64(me[i]);
        pos[i] = (key[i] > prefix) ? (unsigned)bg + rg : ((key[i] == prefix) ? (unsigned)be + re : 64u);
        bg += __builtin_popcountll(mg[i]); be += __builtin_popcountll(me[i]); }
}
__device__ __forceinline__ float gelu_tanh(float a) {
    const float u = 0.7978845608028654f * (a + 0.044715f * a * a * a);
    const float e = __builtin_amdgcn_exp2f(2.885390081777927f * u);
    const float th = 1.f - 2.f * __builtin_amdgcn_rcpf(1.f + e);
    return 0.5f * a * (1.f + th);
}
typedef short s16x2_t __attribute__((ext_vector_type(2)));
__device__ __forceinline__ unsigned hkey2(unsigned w) { const s16x2_t sg = __builtin_bit_cast(s16x2_t, w) >> 15; return w ^ (__builtin_bit_cast(unsigned, sg) | 0x80008000u); }
__device__ __forceinline__ float fkey_inv(unsigned k) { const unsigned u = (k & 0x80000000u) ? (k ^ 0x80000000u) : ~k; return __builtin_bit_cast(float, u); }
__device__ __forceinline__ void bit_transpose32(unsigned (&A)[32]) {
#define BT_STAGE(J, M) _Pragma("unroll") for (int k = 0; k < 32; ++k) if ((k & (J)) == 0) { const unsigned t = (A[k] ^ (A[k + (J)] >> (J))) & (M); A[k] ^= t; A[k + (J)] ^= t << (J); }
    BT_STAGE(16, 0x0000FFFFu) BT_STAGE(8, 0x00FF00FFu) BT_STAGE(4, 0x0F0F0F0Fu) BT_STAGE(2, 0x33333333u) BT_STAGE(1, 0x55555555u)
#undef BT_STAGE
}
template <int GL>
__device__ __forceinline__ void topk_select(unsigned (&key)[32], unsigned& Gm, unsigned& Em, int& ng) {
    bit_transpose32(key);
    unsigned A = 0xFFFFFFFFu, G = 0u; int n = 0;
#pragma unroll
    for (int i = 0; i < 32; ++i) {
        const unsigned x = A & key[i]; int c = __builtin_popcount(x);
        c += dppi<0xB1>(c); c += dppi<0x4E>(c);
        if (GL == 8) c += dppi<0x141>(c);
        const bool take = (n + c >= 16);
        A = take ? x : (A ^ x); G = take ? G : (G | x); n = take ? n : n + c;
    }
    Gm = G; Em = A; ng = n;
}
__device__ __forceinline__ void bit_transpose16x2(unsigned (&A)[16]) {
#define BT_STAGE(J, M) _Pragma("unroll") for (int k = 0; k < 16; ++k) if ((k & (J)) == 0) { const unsigned t = (A[k] ^ (A[k + (J)] >> (J))) & (M); A[k] ^= t; A[k + (J)] ^= t << (J); }
    _Pragma("unroll") for (int k = 0; k < 8; ++k) { const unsigned a = A[k], b = A[k + 8]; A[k] = __builtin_amdgcn_perm(b, a, 0x03070105u); A[k + 8] = __builtin_amdgcn_perm(b, a, 0x02060004u); }
    BT_STAGE(4, 0x0F0F0F0Fu) BT_STAGE(2, 0x33333333u) BT_STAGE(1, 0x55555555u)
#undef BT_STAGE
}
template <int GL>
__device__ __forceinline__ void topk_select16(unsigned (&key)[16], unsigned& Gm, unsigned& Em, int& ng) {
    bit_transpose16x2(key);
    unsigned A = 0xFFFFFFFFu, G = 0u; int n = 0;
#pragma unroll
    for (int i = 0; i < 16; ++i) {
        const unsigned x = A & key[i]; int c = __builtin_popcount(x);
        c += dppi<0xB1>(c); c += dppi<0x4E>(c);
        if (GL == 8) c += dppi<0x141>(c);
        const bool take = (n + c >= 16);
        A = take ? x : (A ^ x); G = take ? G : (G | x); n = take ? n : n + c;
    }
    Gm = G; Em = A; ng = n;
}
__device__ __forceinline__ float rs32(float p, float q) { asm volatile("s_nop 1\n\tv_permlane32_swap_b32 %0, %1" : "+v"(p), "+v"(q)); return p + q; }
__device__ __forceinline__ float rs16(float p, float q) { asm volatile("s_nop 1\n\tv_permlane16_swap_b32 %0, %1" : "+v"(p), "+v"(q)); return p + q; }
__device__ __forceinline__ float wave_sum_dpp(float v) {
    v += dppf<0xB1>(v); v += dppf<0x4E>(v); v += dppf<0x141>(v); v += dppf<0x140>(v); v = rs16(v, v); v = rs32(v, v); return v;
}
struct ConvNext { const float* u; const float* v; const float* gain; const float* p; unsigned char* U8; unsigned char* V8; float* SU; float* SV; bf16* PB; int on; };
template <int GL>
__device__ __forceinline__ void topk_select16x2(unsigned (&kA)[16], unsigned (&kB)[16], unsigned& GmA, unsigned& EmA, int& ngA, unsigned& GmB, unsigned& EmB, int& ngB) {
    bit_transpose16x2(kA); bit_transpose16x2(kB);
    unsigned AA = 0xFFFFFFFFu, GA = 0u, AB = 0xFFFFFFFFu, GB = 0u; int nA = 0, nB = 0;
#pragma unroll
    for (int i = 0; i < 16; ++i) {
        const unsigned xA = AA & kA[i], xB = AB & kB[i]; int cA = __builtin_popcount(xA), cB = __builtin_popcount(xB);
        cA += dppi<0xB1>(cA); cB += dppi<0xB1>(cB); cA += dppi<0x4E>(cA); cB += dppi<0x4E>(cB);
        if (GL == 8) { cA += dppi<0x141>(cA); cB += dppi<0x141>(cB); }
        const bool tA = (nA + cA >= 16), tB = (nB + cB >= 16);
        AA = tA ? xA : (AA ^ xA); GA = tA ? GA : (GA | xA); nA = tA ? nA : nA + cA;
        AB = tB ? xB : (AB ^ xB); GB = tB ? GB : (GB | xB); nB = tB ? nB : nB + cB;
    }
    GmA = GA; EmA = AA; ngA = nA; GmB = GB; EmB = AB; ngB = nB;
}
struct KTok { LAS unsigned char* s1i; LAS unsigned char* s2c; LAS unsigned char* scratch; LAS unsigned short* rowc; };
__device__ __forceinline__ KTok ktok(LAS unsigned char* lw, int lane) { KTok k; k.s1i = lw; k.s2c = lw + 256; k.scratch = lw + 512 + lane; k.rowc = (LAS unsigned short*)(lw + 2048); return k; }
__device__ __forceinline__ void k_compact(unsigned M, LAS unsigned char* wp, LAS unsigned char* scratch, int base) {
    while (__builtin_amdgcn_ballot_w64(M != 0u) != 0ull) {
#pragma unroll
        for (int u4 = 0; u4 < 4; ++u4) { const bool act = M != 0u; const int bp = __builtin_ctz(M | 0x80000000u); M &= M - 1u;
            LAS unsigned char* const p = act ? wp : scratch; *p = (unsigned char)(base + 30 - 2 * (bp & 15) + (bp >> 4)); wp += act ? 1 : 0; }
    }
}
__device__ __forceinline__ unsigned k_trim(unsigned Em, int ke) {
    unsigned Et = Em;
    while (__builtin_amdgcn_ballot_w64(__builtin_popcount(Et) > ke) != 0ull) { if (__builtin_popcount(Et) > ke) Et &= Et - 1u; asm volatile("" : "+v"(Et)); }
    return Et;
}
__device__ __forceinline__ void k_compact2(unsigned MA, LAS unsigned char* wpA, LAS unsigned char* scrA, unsigned MB, LAS unsigned char* wpB, LAS unsigned char* scrB, int base) {
    while (__builtin_amdgcn_ballot_w64((MA | MB) != 0u) != 0ull) {
#pragma unroll
        for (int u4 = 0; u4 < 4; ++u4) {
            { const bool act = MA != 0u; const int bp = __builtin_ctz(MA | 0x80000000u); MA &= MA - 1u;
              LAS unsigned char* const p = act ? wpA : scrA; *p = (unsigned char)(base + 30 - 2 * (bp & 15) + (bp >> 4)); wpA += act ? 1 : 0; }
            { const bool act = MB != 0u; const int bp = __builtin_ctz(MB | 0x80000000u); MB &= MB - 1u;
              LAS unsigned char* const p = act ? wpB : scrB; *p = (unsigned char)(base + 30 - 2 * (bp & 15) + (bp >> 4)); wpB += act ? 1 : 0; } }
    }
}
__device__ __forceinline__ void k_trim2(unsigned& EA, int keA, unsigned& EB, int keB) {
    while (__builtin_amdgcn_ballot_w64(__builtin_popcount(EA) > keA || __builtin_popcount(EB) > keB) != 0ull) {
        if (__builtin_popcount(EA) > keA) EA &= EA - 1u; if (__builtin_popcount(EB) > keB) EB &= EB - 1u; asm volatile("" : "+v"(EA), "+v"(EB)); }
}
__device__ __forceinline__ void k_l1_keys(const v4u (&cw)[4], const KTok& k, int lane, unsigned (&key)[16]) {
#pragma unroll
    for (int q = 0; q < 4; ++q) { const v4u w = cw[q]; *(LAS v4u*)(k.rowc + lane * 32 + q * 8) = w;
#pragma unroll
        for (int c = 0; c < 4; ++c) key[4 * q + c] = hkey2(w[c]); }
}
__device__ __forceinline__ void k_l1_post(unsigned Gm, unsigned Em, int ntot, const KTok& k, int lane) {
    const int g1 = lane >> 2, sub = lane & 3;
    const int neq = __builtin_popcount(Em);
    const int e0 = dppi<0x00>(neq), e1 = dppi<0x55>(neq), e2 = dppi<0xAA>(neq);
    const int pe = ntot + (sub > 0 ? e0 : 0) + (sub > 1 ? e1 : 0) + (sub > 2 ? e2 : 0);
    const unsigned M = Gm | k_trim(Em, min(max(16 - pe, 0), neq));
    const int cnt = __builtin_popcount(M);
    const int c0 = dppi<0x00>(cnt), c1 = dppi<0x55>(cnt), c2 = dppi<0xAA>(cnt);
    k_compact(M, k.s1i + g1 * 16 + (sub > 0 ? c0 : 0) + (sub > 1 ? c1 : 0) + (sub > 2 ? c2 : 0), k.scratch, sub * 32);
}
__device__ __forceinline__ void k_l1_post2(unsigned GmA, unsigned EmA, int ntA, const KTok& kA, unsigned GmB, unsigned EmB, int ntB, const KTok& kB, int lane) {
    const int g1 = lane >> 2, sub = lane & 3;
    const int neqA = __builtin_popcount(EmA), neqB = __builtin_popcount(EmB);
    const int eA0 = dppi<0x00>(neqA), eA1 = dppi<0x55>(neqA), eA2 = dppi<0xAA>(neqA), eB0 = dppi<0x00>(neqB), eB1 = dppi<0x55>(neqB), eB2 = dppi<0xAA>(neqB);
    const int peA = ntA + (sub > 0 ? eA0 : 0) + (sub > 1 ? eA1 : 0) + (sub > 2 ? eA2 : 0), peB = ntB + (sub > 0 ? eB0 : 0) + (sub > 1 ? eB1 : 0) + (sub > 2 ? eB2 : 0);
    unsigned EA = EmA, EB = EmB; k_trim2(EA, min(max(16 - peA, 0), neqA), EB, min(max(16 - peB, 0), neqB));
    const unsigned MA = GmA | EA, MB = GmB | EB;
    const int cntA = __builtin_popcount(MA), cntB = __builtin_popcount(MB);
    const int cA0 = dppi<0x00>(cntA), cA1 = dppi<0x55>(cntA), cA2 = dppi<0xAA>(cntA), cB0 = dppi<0x00>(cntB), cB1 = dppi<0x55>(cntB), cB2 = dppi<0xAA>(cntB);
    k_compact2(MA, kA.s1i + g1 * 16 + (sub > 0 ? cA0 : 0) + (sub > 1 ? cA1 : 0) + (sub > 2 ? cA2 : 0), kA.scratch,
               MB, kB.s1i + g1 * 16 + (sub > 0 ? cB0 : 0) + (sub > 1 ? cB1 : 0) + (sub > 2 ? cB2 : 0), kB.scratch, sub * 32);
}
__device__ __forceinline__ int k_scan8(int v, int sub8) {
    { const int t2 = dppi<0x111>(v); if (sub8 >= 1) v += t2; }
    { const int t2 = dppi<0x112>(v); if (sub8 >= 2) v += t2; }
    { const int t2 = dppi<0x114>(v); if (sub8 >= 4) v += t2; }
    return v;
}
__device__ __forceinline__ void k_l2_post2(unsigned GmA, unsigned EmA, int ntA, const KTok& kA, unsigned GmB, unsigned EmB, int ntB, const KTok& kB, int lane) {
    const int h = lane >> 3, sub8 = lane & 7;
    const int neqA = __builtin_popcount(EmA), neqB = __builtin_popcount(EmB);
    const int peA = ntA + (k_scan8(neqA, sub8) - neqA), peB = ntB + (k_scan8(neqB, sub8) - neqB);
    unsigned EA = EmA, EB = EmB; k_trim2(EA, min(max(16 - peA, 0), neqA), EB, min(max(16 - peB, 0), neqB));
    const unsigned MA = GmA | EA, MB = GmB | EB;
    const int cntA = __builtin_popcount(MA), cntB = __builtin_popcount(MB);
    k_compact2(MA, kA.s2c + h * 16 + (k_scan8(cntA, sub8) - cntA), kA.scratch, MB, kB.s2c + h * 16 + (k_scan8(cntB, sub8) - cntB), kB.scratch, sub8 * 32);
}
__device__ __forceinline__ void k_l2_keys(const KTok& k, int lane, unsigned (&key)[16]) {
    const int h = lane >> 3, sub8 = lane & 7;
    const unsigned aib = *(const LAS unsigned short*)(k.s1i + (2 * h) * 16 + 2 * sub8);
    const v4u bib = *(const LAS v4u*)(k.s1i + (2 * h + 1) * 16);
    LAS const unsigned short* ra = k.rowc + (2 * h) * 128; LAS const unsigned short* rb = ra + 128;
    const unsigned a0 = ra[aib & 0xffu], a1 = ra[aib >> 8];
    const half2_t a0x2 = __builtin_bit_cast(half2_t, a0 | (a0 << 16)), a1x2 = __builtin_bit_cast(half2_t, a1 | (a1 << 16));
    half2_t bp[8];
#pragma unroll
    for (int q = 0; q < 8; ++q) { const unsigned blo = rb[(bib[q >> 1] >> (16 * (q & 1))) & 0xffu], bhi = rb[(bib[q >> 1] >> (16 * (q & 1) + 8)) & 0xffu]; bp[q] = __builtin_bit_cast(half2_t, blo | (bhi << 16)); }
#pragma unroll
    for (int i = 0; i < 16; ++i) key[i] = hkey2(__builtin_bit_cast(unsigned, ((i < 8) ? a0x2 : a1x2) + bp[i & 7]));
}
__device__ __forceinline__ void k_l2_post(unsigned Gm, unsigned Em, int ntot, const KTok& k, int lane) {
    const int h = lane >> 3, sub8 = lane & 7;
    const int neq = __builtin_popcount(Em);
    int se = neq;
    { const int t2 = dppi<0x111>(se); if (sub8 >= 1) se += t2; }
    { const int t2 = dppi<0x112>(se); if (sub8 >= 2) se += t2; }
    { const int t2 = dppi<0x114>(se); if (sub8 >= 4) se += t2; }
    const int pe = ntot + (se - neq);
    const unsigned M = Gm | k_trim(Em, min(max(16 - pe, 0), neq));
    const int cnt = __builtin_popcount(M); int sc = cnt;
    { const int t1 = dppi<0x111>(sc); if (sub8 >= 1) sc += t1; }
    { const int t1 = dppi<0x112>(sc); if (sub8 >= 2) sc += t1; }
    { const int t1 = dppi<0x114>(sc); if (sub8 >= 4) sc += t1; }
    k_compact(M, k.s2c + h * 16 + (sc - cnt), k.scratch, sub8 * 32);
}
__device__ __forceinline__ void k_gates(int t, f32x4 rq, const KTok& k, int lane, const float* SU, const float* SV, unsigned short* IDX, float* GW, float* MU) {
    float rinv; { float sv_ = (rq[0] + rq[1]) + (rq[2] + rq[3]); sv_ += dppf<0xB1>(sv_); sv_ += dppf<0x4E>(sv_); rinv = __builtin_amdgcn_rsqf(sv_ * (1.f / D) + 1e-6f); }
#pragma unroll
    for (int kk = 0; kk < 2; ++kk) { const int kx = lane + 64 * kk, hh = kx >> 4; const unsigned cand = k.s2c[kx];
        const unsigned ia = k.s1i[(2 * hh) * 16 + (cand >> 4)], ib = k.s1i[(2 * hh + 1) * 16 + (cand & 15u)];
        const float sv = hlo((unsigned)k.rowc[(2 * hh) * 128 + ia]) + hlo((unsigned)k.rowc[(2 * hh + 1) * 128 + ib]); float mx = sv;
        mx = fmaxf(mx, dppf<0xB1>(mx)); mx = fmaxf(mx, dppf<0x4E>(mx)); mx = fmaxf(mx, dppf<0x141>(mx)); mx = fmaxf(mx, dppf<0x140>(mx));
        const float ex = __builtin_amdgcn_exp2f((sv - mx) * 1.4426950408889634f); float sum = ex;
        sum += dppf<0xB1>(sum); sum += dppf<0x4E>(sum); sum += dppf<0x141>(sum); sum += dppf<0x140>(sum);
        const unsigned ee = ia * 128u + ib; const size_t o = (size_t)t * 128 + (kx & 7) * 16 + (kx >> 3);
        IDX[o] = (unsigned short)ee; GW[o] = ex * __builtin_amdgcn_rcpf(sum) * SV[ee]; MU[o] = rinv * SU[ee]; }
}
struct KConv { f32x4 cr[4], cg[4], cp0; };
__device__ __forceinline__ void k_conv_load(const ConvNext& cv, int t, int lane, KConv& c) {
    const bool cu = t < NEXP; const float* rp = cu ? cv.u + (size_t)t * D : cv.v + (size_t)(t - NEXP) * D;
#pragma unroll
    for (int j = 0; j < 4; ++j) { c.cr[j] = *(const f32x4*)(rp + 16 * lane + 4 * j); c.cg[j] = *(const f32x4*)(cv.gain + 16 * lane + 4 * j); }
    c.cp0 = *(const f32x4*)(cv.p + ((size_t)t * 64 + lane) * 4);
}
__device__ __forceinline__ void k_conv_store(const ConvNext& cv, int t, int lane, KConv& c) {
    if (t < NEXP) {
#pragma unroll
        for (int j = 0; j < 4; ++j) c.cr[j] = c.cr[j] * c.cg[j];
        quant_store_i8(c.cr, cv.U8, t, cv.SU + t, lane); }
    else quant_store_i8(c.cr, cv.V8, t - NEXP, cv.SV + (t - NEXP), lane);
    { v2u w; w.x = pk2(c.cp0[0], c.cp0[1]); w.y = pk2(c.cp0[2], c.cp0[3]); *(v2u*)(cv.PB + ((size_t)t * 64 + lane) * 4) = w; }
}
__device__ __forceinline__ void peer_topk_phase(const unsigned short* S, const float* ssq_in, const float* SU, const float* SV, unsigned short* IDX, float* GW, float* MU,
                                                const ConvNext cv, LAS unsigned char* lds, int vcu, int G, int wave) {
    const int lane = lane_id_fresh();
    const KTok kA = ktok(lds + wave * 12288, lane), kB = ktok(lds + wave * 12288 + 6144, lane);
    const int gw = vcu * NWAVES + wave, NW = G * NWAVES;
    v4u nxA[4], nxB[4];
#define K_SROW(dst, tt) do { const v4u* sp_ = (const v4u*)(S + (size_t)min((tt), T - 1) * 2048 + lane * 32); _Pragma("unroll") for (int q = 0; q < 4; ++q) dst[q] = sp_[q]; } while (0)
    K_SROW(nxA, gw); K_SROW(nxB, gw + NW);
    for (int t = gw; t < T; t += 2 * NW) {
        const int tB = (t + NW < T) ? t + NW : t;
        v4u cwA[4], cwB[4];
#pragma unroll
        for (int q = 0; q < 4; ++q) { cwA[q] = nxA[q]; cwB[q] = nxB[q]; }
        const f32x4 rqA = *(const f32x4*)(ssq_in + (size_t)t * 16 + 4 * (lane & 3)), rqB = *(const f32x4*)(ssq_in + (size_t)tB * 16 + 4 * (lane & 3));
        K_SROW(nxA, t + 2 * NW); K_SROW(nxB, t + 3 * NW);
        KConv cA, cB; if (cv.on) { k_conv_load(cv, t, lane, cA); k_conv_load(cv, tB, lane, cB); }
        { unsigned keyA[16], keyB[16]; k_l1_keys(cwA, kA, lane, keyA); k_l1_keys(cwB, kB, lane, keyB);
          unsigned GmA, EmA, GmB, EmB; int nA, nB; topk_select16x2<4>(keyA, keyB, GmA, EmA, nA, GmB, EmB, nB);
          k_l1_post2(GmA, EmA, nA, kA, GmB, EmB, nB, kB, lane); }
        LDS_WAIT();
        { unsigned keyA[16], keyB[16]; k_l2_keys(kA, lane, keyA); k_l2_keys(kB, lane, keyB);
          unsigned GmA, EmA, GmB, EmB; int nA, nB; topk_select16x2<8>(keyA, keyB, GmA, EmA, nA, GmB, EmB, nB);
          k_l2_post2(GmA, EmA, nA, kA, GmB, EmB, nB, kB, lane); }
        LDS_WAIT();
        k_gates(t, rqA, kA, lane, SU, SV, IDX, GW, MU); k_gates(tB, rqB, kB, lane, SU, SV, IDX, GW, MU);
        if (cv.on) {
            if ((t < NEXP) == (tB < NEXP)) {
                if (t < NEXP) {
#pragma unroll
                    for (int j = 0; j < 4; ++j) { cA.cr[j] = cA.cr[j] * cA.cg[j]; cB.cr[j] = cB.cr[j] * cB.cg[j]; }
                    quant_store_i8(cA.cr, cv.U8, t, cv.SU + t, lane); quant_store_i8(cB.cr, cv.U8, tB, cv.SU + tB, lane); }
                else { quant_store_i8(cA.cr, cv.V8, t - NEXP, cv.SV + (t - NEXP), lane); quant_store_i8(cB.cr, cv.V8, tB - NEXP, cv.SV + (tB - NEXP), lane); }
                { v2u w; w.x = pk2(cA.cp0[0], cA.cp0[1]); w.y = pk2(cA.cp0[2], cA.cp0[3]); *(v2u*)(cv.PB + ((size_t)t * 64 + lane) * 4) = w; }
                { v2u w; w.x = pk2(cB.cp0[0], cB.cp0[1]); w.y = pk2(cB.cp0[2], cB.cp0[3]); *(v2u*)(cv.PB + ((size_t)tB * 64 + lane) * 4) = w; }
            } else { k_conv_store(cv, t, lane, cA); k_conv_store(cv, tB, lane, cB); } }
        LDS_WAIT();
    }
#undef K_SROW
}
__device__ __forceinline__ int dot4_first(int a, int b) { int r; asm("v_dot4_i32_i8 %0, %1, %2, 0" : "=v"(r) : "v"(a), "v"(b)); return r; }
__device__ __forceinline__ unsigned peer_off_lo(unsigned w, unsigned m, unsigned a) { unsigned r; asm("v_mad_u32_u16 %0, %1, %2, %3" : "=v"(r) : "v"(w), "s"(m), "v"(a)); return r; }
__device__ __forceinline__ unsigned peer_off_hi(unsigned w, unsigned m, unsigned a) { unsigned r; asm("v_mad_u32_u16 %0, %1, %2, %3 op_sel:[1,0,0,0]" : "=v"(r) : "v"(w), "s"(m), "v"(a)); return r; }
#define PEER_ISSUE8(buf, o, idw, TAB) do { _Pragma("unroll") for (int b = 0; b < 8; ++b) { \
        const unsigned off = (b & 1) ? peer_off_hi((idw)[b >> 1], 128u, taboff) : peer_off_lo((idw)[b >> 1], 128u, taboff); \
        buf[(o) + b] = *(const v4u*)((TAB) + (size_t)off); } } while (0)
#define PEER_ISSUE16(buf, i0, i1, TAB) do { PEER_ISSUE8(buf, 0, i0, TAB); PEER_ISSUE8(buf, 8, i1, TAB); } while (0)
template <int M> __device__ __forceinline__ unsigned swz8(unsigned v) { return (unsigned)__builtin_amdgcn_ds_swizzle((int)v, 0x18 | (M << 5)); }
#define SWZ8(v, m) swz8<m>(v)
#define PEER_ISSUE_U1(buf, iw, TAB, p) do { const unsigned w_ = swz8<p>(iw); \
        buf[2 * (p)] = *(const v4u*)((TAB) + (size_t)peer_off_lo(w_, 128u, taboff)); buf[2 * (p) + 1] = *(const v4u*)((TAB) + (size_t)peer_off_hi(w_, 128u, taboff)); } while (0)
#define PEER_ISSUE_U(buf, iw, TAB) do { PEER_ISSUE_U1(buf, iw, TAB, 0); PEER_ISSUE_U1(buf, iw, TAB, 1); PEER_ISSUE_U1(buf, iw, TAB, 2); PEER_ISSUE_U1(buf, iw, TAB, 3); \
        PEER_ISSUE_U1(buf, iw, TAB, 4); PEER_ISSUE_U1(buf, iw, TAB, 5); PEER_ISSUE_U1(buf, iw, TAB, 6); PEER_ISSUE_U1(buf, iw, TAB, 7); } while (0)
#define PEER_ISSUE_V1(buf, r, TAB, m) do { const unsigned w0_ = swz8<m>((r).x), w1_ = swz8<m>((r).y); \
        buf[4 * (m)] = *(const v4u*)((TAB) + (size_t)peer_off_lo(w0_, 128u, taboff)); buf[4 * (m) + 1] = *(const v4u*)((TAB) + (size_t)peer_off_hi(w0_, 128u, taboff)); \
        buf[4 * (m) + 2] = *(const v4u*)((TAB) + (size_t)peer_off_lo(w1_, 128u, taboff)); buf[4 * (m) + 3] = *(const v4u*)((TAB) + (size_t)peer_off_hi(w1_, 128u, taboff)); } while (0)
#define PEER_ISSUE_V(buf, r, TAB) do { PEER_ISSUE_V1(buf, r, TAB, 0); PEER_ISSUE_V1(buf, r, TAB, 1); PEER_ISSUE_V1(buf, r, TAB, 2); PEER_ISSUE_V1(buf, r, TAB, 3); } while (0)
#define PEER_PIN4(v) asm volatile("" : "+v"((v).x), "+v"((v).y), "+v"((v).z), "+v"((v).w))
#define VPTR(base, rowbytes, tt, off) ((const char*)(base) + (size_t)(tt) * (rowbytes) + (off))
template <int LIGHT>
__device__ __forceinline__ void peer_u_phase(const unsigned short* IDX, const bf16* XB, const unsigned char* U8, unsigned short* PART, int bid, int G, int wave) {
    const int lane = lane_id_fresh(), j = lane >> 3, c = lane & 7;
    const int NS = G < 8 ? G : 8, rank = bid / NS, nrank = (G - (bid % NS) + NS - 1) / NS;
    for (int s = bid % NS; s < 8; s += NS) {
        const unsigned coloff = (unsigned)(s * 128 + c * 16), taboff = (unsigned)(s * (NEXP * 128) + c * 16);
        const int stride = nrank * NWAVES;
        unsigned short* part = PART + (size_t)s * T * 128;
        unsigned o_idx = (unsigned)(j * 32 + c * 4), o_x = coloff * 2u + (unsigned)((j & 1) * 16), o_p = (unsigned)(j * 32 + c * 4); const bool xhalf = (j & 1) != 0;
#define PEER_U_TOKEN(buf, xh, tt) do { \
              \
            v4u xa, xb; { v4u ph; _Pragma("unroll") for (int k = 0; k < 4; ++k) ph[k] = (unsigned)dppi<0x128>((int)(xh)[k]); \
                _Pragma("unroll") for (int k = 0; k < 4; ++k) { xa[k] = xhalf ? ph[k] : (xh)[k]; xb[k] = xhalf ? (xh)[k] : ph[k]; } } \
            const float xv[16] = {bflo(xa.x), bfhi(xa.x), bflo(xa.y), bfhi(xa.y), bflo(xa.z), bfhi(xa.z), bflo(xa.w), bfhi(xa.w), bflo(xb.x), bfhi(xb.x), bflo(xb.y), bfhi(xb.y), bflo(xb.z), bfhi(xb.z), bflo(xb.w), bfhi(xb.w)}; \
              \
            float am = 0.f; _Pragma("unroll") for (int i = 0; i < 16; ++i) am = fmaxf(am, fabsf(xv[i])); \
            { unsigned ab = __builtin_bit_cast(unsigned, am); ab = max(ab, (unsigned)dppi<0xB1>((int)ab)); ab = max(ab, (unsigned)dppi<0x4E>((int)ab)); ab = max(ab, (unsigned)dppi<0x141>((int)ab)); am = __builtin_bit_cast(float, ab); }   \
            const float xinv = am > 0.f ? 127.f / am : 0.f, xsc = am * (0.015625f / 127.f)  ; \
            int xq[4]; _Pragma("unroll") for (int q = 0; q < 4; ++q) xq[q] = (int)pack_i8x4((f32x4){xv[4 * q], xv[4 * q + 1], xv[4 * q + 2], xv[4 * q + 3]}, xinv); \
            int dd[16]; \
            _Pragma("unroll") for (int b = 0; b < 16; ++b) { PEER_PIN4(buf[b]); \
                if (LIGHT) { dd[b] = (int)((buf[b].x ^ buf[b].y) ^ (buf[b].z ^ buf[b].w)) + xq[b & 3]; continue; } \
                int d = dot4_first((int)buf[b].x, xq[0]); d = __builtin_amdgcn_sdot4((int)buf[b].y, xq[1], d, false); \
                d = __builtin_amdgcn_sdot4((int)buf[b].z, xq[2], d, false); dd[b] = __builtin_amdgcn_sdot4((int)buf[b].w, xq[3], d, false); } \
              \
            const bool cb2 = (c & 4) != 0, cb1 = (c & 2) != 0, cb0 = (c & 1) != 0; \
            int e8[8], e4[4], e2[2]; \
            _Pragma("unroll") for (int k = 0; k < 8; ++k) { const int keep = cb2 ? dd[8 + k] : dd[k], send = cb2 ? dd[k] : dd[8 + k]; e8[k] = keep + dppi<0x141>(send); } \
            _Pragma("unroll") for (int k = 0; k < 4; ++k) { const int keep = cb1 ? e8[4 + k] : e8[k], send = cb1 ? e8[k] : e8[4 + k]; e4[k] = keep + dppi<0x1B>(send); } \
            _Pragma("unroll") for (int k = 0; k < 2; ++k) { const int keep = cb0 ? e4[2 + k] : e4[k], send = cb0 ? e4[k] : e4[2 + k]; e2[k] = keep + dppi<0xB1>(send); } \
            *(unsigned*)VPTR(part, 256, tt, o_p) = pkh2((float)e2[0] * xsc, (float)e2[1] * xsc); } while (0)
        v4u bufA[16], bufB[16], xA, xB; unsigned iA = 0u, iB = 0u;
        xA = xB = (v4u){0u, 0u, 0u, 0u};
        int t = rank * NWAVES + wave;
        if (t + 3 * stride < T) {
            { iA = *(const unsigned*)VPTR(IDX, 256, t, o_idx); xA = *(const v4u*)VPTR(XB, 2048, t, o_x); }
            { iB = *(const unsigned*)VPTR(IDX, 256, t + stride, o_idx); }
            PEER_ISSUE_U(bufA, iA, U8);
        do {
            asm volatile("" : "+v"(o_idx), "+v"(o_x), "+v"(o_p));
            const int t1 = t + stride, t2 = t1 + stride, t3 = t2 + stride;
            { iA = *(const unsigned*)VPTR(IDX, 256, t2, o_idx); }
            PEER_ISSUE_U(bufB, iB, U8);
            { xB = *(const v4u*)VPTR(XB, 2048, t1, o_x); }
            PEER_U_TOKEN(bufA, xA, t);
            { iB = *(const unsigned*)VPTR(IDX, 256, t3, o_idx); }
            PEER_ISSUE_U(bufA, iA, U8);
            { xA = *(const v4u*)VPTR(XB, 2048, t2, o_x); }
            PEER_U_TOKEN(bufB, xB, t1);
            t = t2;
        } while (t + 3 * stride < T);
        } else {
        if (t < T) { iA = *(const unsigned*)VPTR(IDX, 256, t, o_idx); xA = *(const v4u*)VPTR(XB, 2048, t, o_x); }
        if (t + stride < T) { iB = *(const unsigned*)VPTR(IDX, 256, t + stride, o_idx); }
        if (t < T) PEER_ISSUE_U(bufA, iA, U8);
        }
        while (t < T) {
            asm volatile("" : "+v"(o_idx), "+v"(o_x), "+v"(o_p));
            const int t1 = t + stride, t2 = t1 + stride, t3 = t2 + stride;
            if (t1 < T) { PEER_ISSUE_U(bufB, iB, U8); xB = *(const v4u*)VPTR(XB, 2048, t1, o_x); }
            if (t2 < T) { iA = *(const unsigned*)VPTR(IDX, 256, t2, o_idx); }
            PEER_U_TOKEN(bufA, xA, t);
            if (t1 < T) {
                if (t2 < T) { PEER_ISSUE_U(bufA, iA, U8); xA = *(const v4u*)VPTR(XB, 2048, t2, o_x); }
                if (t3 < T) { iB = *(const unsigned*)VPTR(IDX, 256, t3, o_idx); }
                PEER_U_TOKEN(bufB, xB, t1);
            }
            t = t2;
        }
#undef PEER_U_TOKEN
    }
}
__device__ __forceinline__ void peer_w_phase(const unsigned short* PART, const float* GW, const float* MU, const unsigned short* IDX, unsigned* VREC, int bid, int G, int wave) {
    const int tid = wave * 64 + lane_id_fresh(), gtid = bid * NTHR + tid, NT = G * NTHR;
#define PEER_W_LOAD(i_, p_, mu0_, mu1_, gw0_, gw1_, ids_) do { const size_t o_ = (size_t)min((i_), T * 16 - 1) * 8; _Pragma("unroll") for (int s = 0; s < 8; ++s) p_[s] = *(const v4u*)(PART + (size_t)s * T * 128 + o_); \
        mu0_ = *(const f32x4*)(MU + o_); mu1_ = *(const f32x4*)(MU + o_ + 4); gw0_ = *(const f32x4*)(GW + o_); gw1_ = *(const f32x4*)(GW + o_ + 4); ids_ = *(const v4u*)(IDX + o_); } while (0)
    v4u np[8]; f32x4 nmu0, nmu1, ngw0, ngw1; v4u nids;
    PEER_W_LOAD(gtid, np, nmu0, nmu1, ngw0, ngw1, nids);
    for (int i = gtid; i < T * 16; i += NT) {
        v4u p[8]; f32x4 mu0 = nmu0, mu1 = nmu1, gw0 = ngw0, gw1 = ngw1; const v4u ids = nids;
#pragma unroll
        for (int s = 0; s < 8; ++s) p[s] = np[s];
        PEER_W_LOAD(i + NT, np, nmu0, nmu1, ngw0, ngw1, nids);
        f32x4 a0 = {0.f, 0.f, 0.f, 0.f}, a1 = {0.f, 0.f, 0.f, 0.f}, w0, w1;
#pragma unroll
        for (int s = 0; s < 8; ++s) { a0 += (f32x4){hlo(p[s].x), hhi(p[s].x), hlo(p[s].y), hhi(p[s].y)}; a1 += (f32x4){hlo(p[s].z), hhi(p[s].z), hlo(p[s].w), hhi(p[s].w)}; }
#pragma unroll
        for (int q = 0; q < 4; ++q) { w0[q] = gw0[q] * gelu_tanh(a0[q] * 64.f * mu0[q]); w1[q] = gw1[q] * gelu_tanh(a1[q] * 64.f * mu1[q]); }
        float am = fmaxf(fmaxf(fmaxf(fabsf(w0[0]), fabsf(w0[1])), fmaxf(fabsf(w0[2]), fabsf(w0[3]))), fmaxf(fmaxf(fabsf(w1[0]), fabsf(w1[1])), fmaxf(fabsf(w1[2]), fabsf(w1[3]))));
        { unsigned ab = __builtin_bit_cast(unsigned, am); ab = max(ab, (unsigned)dppi<0xB1>((int)ab)); ab = max(ab, (unsigned)dppi<0x4E>((int)ab)); ab = max(ab, (unsigned)dppi<0x141>((int)ab)); ab = max(ab, (unsigned)dppi<0x140>((int)ab));
          am = __builtin_bit_cast(float, ab); }
        const float winv = am > 0.f ? 127.f / am : 0.f; const unsigned sc = __builtin_bit_cast(unsigned, am * (1.f / 127.f));
        unsigned* rec = VREC + (size_t)(i >> 1) * 16; const int h8 = i & 1;
        *(v4u*)(rec + 4 * h8) = ids; *(v2u*)(rec + 8 + 2 * h8) = (v2u){pack_i8x4(w0, winv), pack_i8x4(w1, winv)}; *(v2u*)(rec + 12 + 2 * h8) = (v2u){sc, sc}; }
#undef PEER_W_LOAD
}
__device__ __forceinline__ void peer_v_phase(const unsigned* VREC, const unsigned char* V8, const bf16* XB, bf16* XBo, float* ssq_out, int bid, int G, int wave) {
    const int lane = lane_id_fresh(), j = lane >> 3, c = lane & 7;
    const int NS = G < 8 ? G : 8, rank = bid / NS, nrank = (G - (bid % NS) + NS - 1) / NS;
    for (int s = bid % NS; s < 8; s += NS) {
        const unsigned coloff = (unsigned)(s * 128 + c * 16), taboff = (unsigned)(s * (NEXP * 128) + c * 16);
        const int stride = nrank * NWAVES;
        unsigned o_rec = (unsigned)(j * 64 + c * 8), o_xb = (coloff + 2u * j) * 2u;
#define PEER_V_TOKEN(buf, w, xr, tt) do { \
              \
            const float wsc = __builtin_bit_cast(float, SWZ8((w).x, 6)); const int wq[4] = {(int)SWZ8((w).x, 4), (int)SWZ8((w).y, 4), (int)SWZ8((w).x, 5), (int)SWZ8((w).y, 5)}; \
            int ia[16]; \
            _Pragma("unroll") for (int B = 0; B < 4; ++B) { PEER_PIN4(buf[4 * B]); PEER_PIN4(buf[4 * B + 1]); PEER_PIN4(buf[4 * B + 2]); PEER_PIN4(buf[4 * B + 3]); \
                _Pragma("unroll") for (int q = 0; q < 4; ++q) { const unsigned D0 = buf[4 * B][q], D1 = buf[4 * B + 1][q], D2 = buf[4 * B + 2][q], D3 = buf[4 * B + 3][q]; \
                    const unsigned P0 = __builtin_amdgcn_perm(D1, D0, 0x05010400u), P1 = __builtin_amdgcn_perm(D1, D0, 0x07030602u), Q0 = __builtin_amdgcn_perm(D3, D2, 0x05010400u), Q1 = __builtin_amdgcn_perm(D3, D2, 0x07030602u); \
                    ia[4 * q + 0] = (B == 0) ? dot4_first((int)__builtin_amdgcn_perm(Q0, P0, 0x05040100u), wq[0]) : __builtin_amdgcn_sdot4((int)__builtin_amdgcn_perm(Q0, P0, 0x05040100u), wq[B], ia[4 * q + 0], false); \
                    ia[4 * q + 1] = (B == 0) ? dot4_first((int)__builtin_amdgcn_perm(Q0, P0, 0x07060302u), wq[0]) : __builtin_amdgcn_sdot4((int)__builtin_amdgcn_perm(Q0, P0, 0x07060302u), wq[B], ia[4 * q + 1], false); \
                    ia[4 * q + 2] = (B == 0) ? dot4_first((int)__builtin_amdgcn_perm(Q1, P1, 0x05040100u), wq[0]) : __builtin_amdgcn_sdot4((int)__builtin_amdgcn_perm(Q1, P1, 0x05040100u), wq[B], ia[4 * q + 2], false); \
                    ia[4 * q + 3] = (B == 0) ? dot4_first((int)__builtin_amdgcn_perm(Q1, P1, 0x07060302u), wq[0]) : __builtin_amdgcn_sdot4((int)__builtin_amdgcn_perm(Q1, P1, 0x07060302u), wq[B], ia[4 * q + 3], false); } } \
              \
            int e2a, e2b, e2c, e2d; const bool b3 = (lane & 8) != 0; \
            { int p0 = ia[0], q0 = ia[8], p1 = ia[1], q1 = ia[9], p2 = ia[2], q2 = ia[10], p3 = ia[3], q3 = ia[11], p4 = ia[4], q4 = ia[12], p5 = ia[5], q5 = ia[13], p6 = ia[6], q6 = ia[14], p7 = ia[7], q7 = ia[15]; \
              asm volatile("s_nop 1\n\tv_permlane32_swap_b32 %0, %1\n\tv_permlane32_swap_b32 %2, %3\n\tv_permlane32_swap_b32 %4, %5\n\tv_permlane32_swap_b32 %6, %7\n\t" \
                           "v_permlane32_swap_b32 %8, %9\n\tv_permlane32_swap_b32 %10, %11\n\tv_permlane32_swap_b32 %12, %13\n\tv_permlane32_swap_b32 %14, %15" \
                           : "+v"(p0), "+v"(q0), "+v"(p1), "+v"(q1), "+v"(p2), "+v"(q2), "+v"(p3), "+v"(q3), "+v"(p4), "+v"(q4), "+v"(p5), "+v"(q5), "+v"(p6), "+v"(q6), "+v"(p7), "+v"(q7)); \
              int s0 = p0 + q0, s1 = p1 + q1, s2 = p2 + q2, s3 = p3 + q3, s4_ = p4 + q4, s5 = p5 + q5, s6 = p6 + q6, s7 = p7 + q7; \
              asm volatile("s_nop 1\n\tv_permlane16_swap_b32 %0, %1\n\tv_permlane16_swap_b32 %2, %3\n\tv_permlane16_swap_b32 %4, %5\n\tv_permlane16_swap_b32 %6, %7" \
                           : "+v"(s0), "+v"(s4_), "+v"(s1), "+v"(s5), "+v"(s2), "+v"(s6), "+v"(s3), "+v"(s7)); \
              e2a = s0 + s4_; e2b = s1 + s5; e2c = s2 + s6; e2d = s3 + s7; } \
            int r1x, r1y; { const int kx = b3 ? e2c : e2a, ky = b3 ? e2d : e2b, sx = b3 ? e2a : e2c, sy = b3 ? e2b : e2d; r1x = kx + dppi<0x128>(sx); r1y = ky + dppi<0x128>(sy); } \
            struct { float x, y; } r1 = {(float)r1x * wsc, (float)r1y * wsc}; \
            f32x2 xn = {bflo(xr) + r1.x, bfhi(xr) + r1.y}; \
            *(unsigned*)VPTR(XBo, 2048, tt, o_xb) = pk2(xn[0], xn[1]); \
            const float sq = wave_sum_dpp(xn[0] * xn[0] + xn[1] * xn[1]); SQOUT(sq, tt); } while (0)
        v4u bufA[16], bufB[16]; v2u rA = {0u, 0u}, rB = {0u, 0u}, rC = {0u, 0u};
        unsigned xrA = 0u, xrB = 0u;
#define PEER_V_REC(tt) (*(const v2u*)VPTR(VREC, 512, tt, o_rec))
#define PEER_V_XR(tt) (*(const unsigned*)VPTR(XB, 2048, tt, o_xb))
        int t = rank * NWAVES + wave;
        if (t + 3 * stride < T) {
            rA = PEER_V_REC(t); xrA = PEER_V_XR(t); rB = PEER_V_REC(t + stride);
            PEER_ISSUE_V(bufA, rA, V8);
        float sqA = 0.f;
#define SQOUT(v, tt) do { if ((tt) == t) sqA = (v); else if (lane < 2) ssq_out[(size_t)(lane ? (tt) : t) * 16 + s] = lane ? (v) : sqA; } while (0)
        do {
            asm volatile("" : "+v"(o_rec), "+v"(o_xb));
            const int t1 = t + stride, t2 = t1 + stride, t3 = t2 + stride;
            rC = PEER_V_REC(t2);
            PEER_ISSUE_V(bufB, rB, V8); xrB = PEER_V_XR(t1);
            PEER_V_TOKEN(bufA, rA, xrA, t);
            rA = rC; rC = PEER_V_REC(t3);
            PEER_ISSUE_V(bufA, rA, V8); xrA = PEER_V_XR(t2);
            PEER_V_TOKEN(bufB, rB, xrB, t1);
            rB = rC;
            t = t2;
        } while (t + 3 * stride < T);
#undef SQOUT
        } else {
        if (t < T) { rA = PEER_V_REC(t); xrA = PEER_V_XR(t); }
        if (t + stride < T) rB = PEER_V_REC(t + stride);
        if (t < T) PEER_ISSUE_V(bufA, rA, V8);
        }
#define SQOUT(v, tt) do { if (lane == 0) ssq_out[(size_t)(tt) * 16 + s] = (v); } while (0)
        while (t < T) {
            asm volatile("" : "+v"(o_rec), "+v"(o_xb));
            const int t1 = t + stride, t2 = t1 + stride, t3 = t2 + stride;
            if (t2 < T) rC = PEER_V_REC(t2);
            if (t1 < T) { PEER_ISSUE_V(bufB, rB, V8); xrB = PEER_V_XR(t1); }
            PEER_V_TOKEN(bufA, rA, xrA, t);
            if (t1 < T) {
                rA = rC; if (t3 < T) rC = PEER_V_REC(t3);
                if (t2 < T) { PEER_ISSUE_V(bufA, rA, V8); xrA = PEER_V_XR(t2); }
                PEER_V_TOKEN(bufB, rB, xrB, t1);
                rB = rC;
            }
            t = t2;
        }
#undef SQOUT
#undef PEER_V_REC
#undef PEER_V_XR
#undef PEER_V_TOKEN
    }
}
#undef PEER_ISSUE8
#undef PEER_ISSUE16
#undef PEER_PIN4
#undef VPTR

constexpr int AT_KST = 24576, AT_KPE = 16384, AT_VBASE = 3 * AT_KST, AT_VST = 16384;
constexpr int ATTN_LDS = AT_VBASE + 4 * AT_VST;
__device__ __forceinline__ void attn_phase(const bf16* Q, const bf16* KN, const bf16* KPE, const bf16* VT, bf16* AO, LAS unsigned char* lds, int vcu, int G, int wave) {
    const int lane = lane_id_fresh(), tid = wave * 64 + lane;
    const int rho = lane & 31, hh = lane >> 5;
    const int krow = (rho & 0x13) | ((rho & 4) << 1) | ((rho & 8) >> 1);
    const bool lag = wave >= 4;
    for (int it = vcu; it < 1024; it += G) {
        const int c = it & 255, kq = it >> 8, bh = c >> 2, q4 = c & 3;
        const int qb = (kq == 0) ? 15 - q4 : (kq == 1) ? q4 : (kq == 2) ? 8 + q4 : 7 - q4;
        const int b = bh >> 3, h = bh & 7;
        const int q0 = qb * 256, qlo = q0 + wave * 32, trow0 = b * SEQ + qlo;
        f32x16 o[4];
#pragma unroll
        for (int d = 0; d < 4; ++d)
#pragma unroll
            for (int r = 0; r < 16; ++r) o[d][r] = 0.f;
        float m_run = -1e30f, l_run = 0.f;
        const int nkt = 4 * (qb + 1);
        unsigned vk[2], vp, vv[2];
#pragma unroll
        for (int i = 0; i < 2; ++i) { const int id = tid + 512 * i; { const int row = id >> 4, cc = (id & 15) ^ (row & 15); vk[i] = (unsigned)(row * (D * 2) + cc * 16); }
            { const int row = id >> 3, cc = (id & 7) ^ ((row >> 1) & 7); vv[i] = (unsigned)row * (unsigned)(T * 2) + (unsigned)(cc * 16); } }
        { const int row = tid >> 3, cc = (tid & 7) ^ ((row >> 1) & 7); vp = (unsigned)(row * (QKR * 2) + cc * 16); }
        const unsigned ldsb = (unsigned)(size_t)lds + (unsigned)wave * 1024u;
#define AT_DMA(sbase, voff, ldsdst) do { unsigned _keep; asm volatile("s_mov_b32 %0, m0\n\ts_mov_b32 m0, %3\n\ts_nop 4\n\tglobal_load_lds_dwordx4 %1, %2\n\ts_mov_b32 m0, %0" \
            : "=&s"(_keep) : "v"(voff), "s"(sbase), "s"(ldsdst) : "memory"); } while (0)
#define AT_STAGE_TILE(kt, ks, vs) do { const int tk0 = b * SEQ + (kt) * 64; const unsigned kb2 = ldsb + (unsigned)(ks) * AT_KST, vb2 = ldsb + AT_VBASE + (unsigned)(vs) * AT_VST; \
            const bf16* kb_ = KN + (size_t)tk0 * D + h * QKN; const bf16* pb_ = KPE + (size_t)tk0 * QKR; const bf16* vb_ = VT + (size_t)(h * VH) * T + tk0; \
            AT_DMA(kb_, vk[0], kb2); AT_DMA(kb_, vk[1], kb2 + 8192u); AT_DMA(pb_, vp, kb2 + AT_KPE); AT_DMA(vb_, vv[0], vb2); AT_DMA(vb_, vv[1], vb2 + 8192u); } while (0)
#define AT_SYNC() asm volatile("s_waitcnt vmcnt(0) lgkmcnt(0)\n\ts_barrier" ::: "memory")
#define AT_SYNC5() asm volatile("s_waitcnt vmcnt(5) lgkmcnt(0)\n\ts_barrier" ::: "memory")
#define AT_KADDR(kb, s) ((s) < 8 ? st + ((kb) * 32 + krow) * 256 + (((2 * (s) + hh) ^ (krow & 15)) << 4) : st + AT_KPE + ((kb) * 32 + krow) * 128 + (((2 * ((s) - 8) + hh) ^ ((((kb) * 32 + krow) >> 1) & 7)) << 4))
#define AT_KREAD(dst, kb, s0) do { _Pragma("unroll") for (int i = 0; i < 6; ++i) dst[i] = *(const LAS bf16x8*)AT_KADDR(kb, (s0) + i); } while (0)
#define AT_KMMA(src_, kb, s0) do { _Pragma("unroll") for (int i = 0; i < 6; ++i) sacc[kb] = __builtin_amdgcn_mfma_f32_32x32x16_bf16(src_[i], qf[(s0) + i], sacc[kb], 0, 0, 0); } while (0)
#define AT_KREAD4(dst, kb, s0) do { _Pragma("unroll") for (int i = 0; i < 4; ++i) dst[i] = *(const LAS bf16x8*)AT_KADDR(kb, (s0) + i); } while (0)
#define AT_KMMA4(src_, kb, s0) do { _Pragma("unroll") for (int i = 0; i < 4; ++i) sacc[kb] = __builtin_amdgcn_mfma_f32_32x32x16_bf16(src_[i], qf[(s0) + i], sacc[kb], 0, 0, 0); } while (0)
#define AT_QK(ks) do { const LAS unsigned char* st = lds + (ks) * AT_KST; bf16x8 fx[4], fy[4]; __builtin_amdgcn_s_setprio(1); \
            _Pragma("unroll") for (int kb = 0; kb < 2; ++kb) _Pragma("unroll") for (int r = 0; r < 16; ++r) sacc[kb][r] = 0.f; \
            AT_KREAD4(fx, 0, 0); AT_KREAD4(fy, 0, 4); \
            AT_KMMA4(fx, 0, 0); __builtin_amdgcn_sched_barrier(0); AT_KREAD4(fx, 0, 8); \
            AT_KMMA4(fy, 0, 4); __builtin_amdgcn_sched_barrier(0); AT_KREAD4(fy, 1, 0); \
            AT_KMMA4(fx, 0, 8); __builtin_amdgcn_sched_barrier(0); AT_KREAD4(fx, 1, 4); \
            AT_KMMA4(fy, 1, 0); __builtin_amdgcn_sched_barrier(0); AT_KREAD4(fy, 1, 8); \
            AT_KMMA4(fx, 1, 4); AT_KMMA4(fy, 1, 8); __builtin_amdgcn_s_setprio(0); } while (0)
#define AT_SM(key0v) do { \
            if ((key0v) + 63 > qlo) { const int qpos = qlo + rho; \
                _Pragma("unroll") for (int kb = 0; kb < 2; ++kb) \
                    _Pragma("unroll") for (int r = 0; r < 16; ++r) { const int kpos = (key0v) + 32 * kb + (r & 3) + 4 * ((r >> 2) & 1) + 8 * hh + 16 * (r >> 3); if (kpos > qpos) sacc[kb][r] = -1e30f; } } \
            AT_SM_NM(); } while (0)
#define AT_SM_NM() do { \
            float mx = sacc[0][0]; \
            _Pragma("unroll") for (int kb = 0; kb < 2; ++kb) \
                _Pragma("unroll") for (int r = 0; r < 16; ++r) mx = fmaxf(mx, sacc[kb][r]); \
            mx = fmaxf(mx, shx<32>(mx, lane)); \
            const float m_new = fmaxf(m_run, mx), alpha = __builtin_amdgcn_exp2f(m_run - m_new); m_run = m_new; \
            float lsum = 0.f; \
            _Pragma("unroll") for (int kb = 0; kb < 2; ++kb) \
                _Pragma("unroll") for (int r = 0; r < 16; ++r) { const float p = __builtin_amdgcn_exp2f(sacc[kb][r] - m_new); sacc[kb][r] = p; lsum += p; } \
            l_run = l_run * alpha + lsum; \
            _Pragma("unroll") for (int d = 0; d < 4; ++d) \
                _Pragma("unroll") for (int r = 0; r < 16; ++r) o[d][r] *= alpha; \
            _Pragma("unroll") for (int s2 = 0; s2 < 4; ++s2) { const int kb = s2 >> 1, r0 = 8 * (s2 & 1); v4u w; \
                w.x = pk2(sacc[kb][r0 + 0], sacc[kb][r0 + 1]); w.y = pk2(sacc[kb][r0 + 2], sacc[kb][r0 + 3]); w.z = pk2(sacc[kb][r0 + 4], sacc[kb][r0 + 5]); w.w = pk2(sacc[kb][r0 + 6], sacc[kb][r0 + 7]); \
                pf[s2] = __builtin_bit_cast(bf16x8, w); } } while (0)
#define AT_VREAD(dst, d) do { const int row = (d) * 32 + rho; _Pragma("unroll") for (int s2 = 0; s2 < 4; ++s2) dst[s2] = *(const LAS bf16x8*)(sv + row * 128 + (((2 * s2 + hh) ^ ((row >> 1) & 7)) << 4)); } while (0)
#define AT_VMMA(src_, d) do { __builtin_amdgcn_s_setprio(1); _Pragma("unroll") for (int s2 = 0; s2 < 4; ++s2) o[d] = __builtin_amdgcn_mfma_f32_32x32x16_bf16(src_[s2], pf[s2], o[d], 0, 0, 0); __builtin_amdgcn_s_setprio(0); } while (0)
#define AT_PV(vs) do { const LAS unsigned char* sv = lds + AT_VBASE + (vs) * AT_VST; bf16x8 gx[4], gy[4]; \
            AT_VREAD(gx, 0); AT_VREAD(gy, 1); \
            AT_VMMA(gx, 0); __builtin_amdgcn_sched_barrier(0); AT_VREAD(gx, 2); \
            AT_VMMA(gy, 1); __builtin_amdgcn_sched_barrier(0); AT_VREAD(gy, 3); \
            AT_VMMA(gx, 2); AT_VMMA(gy, 3); } while (0)
#define AT_VPRE(vs) do { const LAS unsigned char* sv = lds + AT_VBASE + (vs) * AT_VST; AT_VREAD(gxp, 0); } while (0)
#define AT_PV_P(vs) do { const LAS unsigned char* sv = lds + AT_VBASE + (vs) * AT_VST; bf16x8 gy[4]; \
            AT_VREAD(gy, 1); \
            AT_VMMA(gxp, 0); __builtin_amdgcn_sched_barrier(0); AT_VREAD(gxp, 2); \
            AT_VMMA(gy, 1); __builtin_amdgcn_sched_barrier(0); AT_VREAD(gy, 3); \
            AT_VMMA(gxp, 2); AT_VMMA(gy, 3); } while (0)
        bf16x8 gxp[4];
        AT_SYNC();
        AT_STAGE_TILE(0, 0, 0); AT_STAGE_TILE(1, 1, 1);
        bf16x8 qf[12];
        { const bf16* qp = Q + (size_t)(trow0 + rho) * (NHEAD * DQK) + h * DQK + hh * 8;
#pragma unroll
          for (int s = 0; s < 12; ++s) qf[s] = *(const bf16x8*)(qp + 16 * s);
#pragma unroll
          for (int s = 0; s < 12; ++s) asm volatile("" : "+v"(qf[s])); }
        AT_SYNC5();
        bf16x8 pf[4];
#pragma unroll
        for (int s2 = 0; s2 < 4; ++s2) pf[s2] = (bf16x8){0, 0, 0, 0, 0, 0, 0, 0};
        int ks = 0, vs = 0;
        bool have = false; int pvs = 0;
        int kt = 0;
        const int nfull = 4 * qb;
        if (!lag) {
            for (; kt < nfull; ++kt) {
                AT_STAGE_TILE(kt + 2, (ks == 0 ? 2 : ks - 1), ((vs + 2) & 3));
                { f32x16 sacc[2]; AT_QK(ks); AT_VPRE(vs); AT_SM_NM(); }
                AT_PV_P(vs);
                AT_SYNC5();
                ks = (ks == 2) ? 0 : ks + 1; vs = (vs + 1) & 3;
            }
        } else if (nfull > 0) {
            { AT_STAGE_TILE(2, 2, 2); { f32x16 sacc[2]; AT_QK(0); AT_SM_NM(); } have = true; pvs = 0; AT_SYNC5(); ks = 1; vs = 1; kt = 1; }
            for (; kt < nfull; ++kt) {
                AT_STAGE_TILE(kt + 2, (ks == 0 ? 2 : ks - 1), ((vs + 2) & 3));
                AT_PV(pvs);
                { f32x16 sacc[2]; AT_QK(ks); AT_SM_NM(); }
                pvs = vs;
                AT_SYNC5();
                ks = (ks == 2) ? 0 : ks + 1; vs = (vs + 1) & 3;
            }
        }
        for (; kt < nkt; ++kt) {
            if (kt + 2 < nkt) AT_STAGE_TILE(kt + 2, (ks == 0 ? 2 : ks - 1), ((vs + 2) & 3));
            const int key0 = kt * 64;
            const bool vis = key0 <= qlo + 31;
            if (have) AT_PV(pvs);
            if (vis) { f32x16 sacc[2]; AT_QK(ks); AT_SM(key0); }
            if (lag) { have = vis; pvs = vs; } else if (vis) AT_PV(vs);
            if (kt + 2 < nkt) AT_SYNC5(); else AT_SYNC();
            ks = (ks == 2) ? 0 : ks + 1; vs = (vs + 1) & 3;
        }
        if (lag && have) AT_PV(pvs);
#undef AT_DMA
#undef AT_STAGE_TILE
#undef AT_SYNC
#undef AT_SYNC5
#undef AT_QK
#undef AT_SM
#undef AT_SM_NM
#undef AT_PV
#undef AT_KADDR
#undef AT_KREAD
#undef AT_KMMA
#undef AT_VREAD
#undef AT_VMMA
#undef AT_VPRE
#undef AT_PV_P
        const float ltot = l_run + shx<32>(l_run, lane), inv = 1.f / ltot;
        bf16* orow = AO + (size_t)(trow0 + rho) * D + h * VH + 8 * hh;
#pragma unroll
        for (int d = 0; d < 4; ++d)
#pragma unroll
            for (int k = 0; k < 2; ++k) {
                unsigned ax = pk2(o[d][8 * k + 0] * inv, o[d][8 * k + 1] * inv), ay = pk2(o[d][8 * k + 2] * inv, o[d][8 * k + 3] * inv);
                unsigned bx = pk2(o[d][8 * k + 4] * inv, o[d][8 * k + 5] * inv), by = pk2(o[d][8 * k + 6] * inv, o[d][8 * k + 7] * inv);
                asm volatile("s_nop 1\n\tv_permlane32_swap_b32 %0, %1" : "+v"(ax), "+v"(bx)); asm volatile("s_nop 1\n\tv_permlane32_swap_b32 %0, %1" : "+v"(ay), "+v"(by));
                *(v4u*)(orow + 32 * d + 16 * k) = (v4u){ax, ay, bx, by}; }
    }
}

constexpr int N_PHASES = 42;
struct Args { In in; float* out; unsigned char* ws; int ph_lo, ph_hi; };
__global__ void __launch_bounds__(NTHR, 2) mk_fwd(Args a) {
    extern __shared__ __attribute__((aligned(16))) unsigned char lds_raw[];
    LAS unsigned char* lds = (LAS unsigned char*)lds_raw;
    const int wave = __builtin_amdgcn_readfirstlane(threadIdx.x >> 6);
    const int G = gridDim.x, bid = blockIdx.x, vcu = (G % 8 == 0) ? (bid % 8) * (G / 8) + bid / 8 : bid;
    typedef const __attribute__((address_space(4))) Args* KArgs;
#define KARGS(q) KArgs q = (KArgs)__builtin_amdgcn_kernarg_segment_ptr(); asm volatile("" : "+s"(q))
    const int lo = a.ph_lo, hi = a.ph_hi;
    { volatile LAS unsigned* MISC0 = (volatile LAS unsigned*)(lds + MISC_OFF); if (threadIdx.x < 32) MISC0[threadIdx.x] = 0u; }
    __syncthreads();
    XcdBarrier bar; bar.bar = (unsigned*)(a.ws + WS_CTL); bar.x = 0; bar.st = nullptr;
    if (hi - lo > 1) bar = xcd_barrier_post((unsigned*)(a.ws + WS_CTL), (volatile LAS unsigned*)(lds + MISC_OFF) + 8, threadIdx.x == 0);
#ifndef MK_MASK
#define MK_MASK 0xFFFF
#endif
#define IN_PH(k) (lo <= (k) && (k) < hi)
#define EN(b) ((MK_MASK >> (b)) & 1)
#if MK_PROBE & 256
#define PHASE_END(k) do { if ((k) + 1 < hi) { xcd_barrier(bar, wave == 0 && lane_id_fresh() == 0); xcd_barrier(bar, wave == 0 && lane_id_fresh() == 0); } } while (0)
#else
#define PHASE_END(k) do { if ((k) + 1 < hi) xcd_barrier(bar, wave == 0 && lane_id_fresh() == 0); } while (0)
#endif
#define PH_VARS KARGS(q); unsigned char* ws = q->ws; CIn& in = q->in; float* ssq = (float*)(ws + WS_SSQ); \
    const float* COS = (const float*)(ws + WS_COS); const float* SIN = (const float*)(ws + WS_SIN); (void)in; (void)ssq; (void)COS; (void)SIN

    if (EN(0) && IN_PH(0)) { PH_VARS;
#if MK_PROBE & 8
        p0_prologue(in, ws, lds, bid, G, wave); __syncthreads();
#endif
        p0_prologue(in, ws, lds, bid, G, wave); PHASE_END(0); }

#pragma unroll 1
    for (int layer = 0; layer < DEPTH; ++layer) {
        const int base = 1 + 10 * layer, v0 = 3 * layer;
#define XB_VARS bf16* XBc = (bf16*)(ws + ((layer & 1) ? WS_XBB : WS_XBA)); bf16* XBn = (bf16*)(ws + ((layer & 1) ? WS_XBA : WS_XBB)); pg8::StaticOrder SO; (void)XBc; (void)XBn; (void)SO
        if (EN(1) && IN_PH(base + 0)) { PH_VARS; XB_VARS;
#if MK_PROBE & 4096
#pragma unroll 1
            for (int rep = 0; rep < 2; ++rep)
#endif
            {
            if (layer == 0) convert_layer(in, ws, layer, bid, G, wave);
            if (layer < 2) pooled_phase(XBc, ssq + (size_t)v0 * SSQ_ARR, in.mix_norm + layer * D, (bf16*)(ws + WS_POOLED), lds, vcu, G, wave);
            else {
                const int N = (layer == 2) ? 1280 : 768;
                pg8::Gemm g{XBc, (const bf16*)(ws + ((layer == 2) ? W_DOWN2 : W_DOWN3)), T, N, D, D, D, 0}; SO.init(T, N, G, bid);
                epi::Down E{(bf16*)(ws + WS_CQ), (bf16*)(ws + WS_CKV), (bf16*)(ws + WS_KPE), ssq + (size_t)v0 * SSQ_ARR, ssq + (size_t)(13 + layer - 2) * SSQ_ARR, ssq + (size_t)15 * SSQ_ARR, COS, SIN};
                pg8::gemm_phase<epi::Down>(lds, g, SO, E, wave);
                if (G % 2 == 0 && ((T / 256) * (N / 256)) % G == G / 2) {
                    pg8::Gemm gp{(const bf16*)(ws + WS_PB), (const bf16*)(ws + W_WP) + (size_t)layer * D * PLE, T, D, PLE, PLE, PLE, 0}; SO.init(T, D, G, bid, 1);
                    epi::Bf16Row EP{(bf16*)(ws + WS_PP), D, nullptr, 0.f};
                    pg8::gemm_phase<epi::Bf16Row>(lds, gp, SO, EP, wave);
                }
            }
            }
            PHASE_END(base + 0);
        }
        if (EN(2) && IN_PH(base + 1)) { PH_VARS; XB_VARS;
#if MK_PROBE & 16
            if (layer < 2) {
                pg8::Gemm g{(const bf16*)(ws + WS_POOLED), (const bf16*)(ws + W_POOL) + (size_t)layer * 1024 * 256, T, D, 256, D, 256, 256}; SO.init(T, D, G, bid);
                epi::Resid E{(bf16*)(ws + WS_END), (float*)(ws + WS_END + 64 * MiB)};
                pg8::gemm_phase<epi::Resid>(lds, g, SO, E, wave);
            } else {
                pg8::Gemm g{(const bf16*)(ws + WS_CQ), (const bf16*)(ws + W_UQ) + (size_t)(layer - 2) * 1536 * QRANK, T, 1536, QRANK, QRANK, QRANK, 0}; SO.init(T, 1536, G, bid);
                epi::QUp E{(bf16*)(ws + WS_Q), ssq + (size_t)(13 + layer - 2) * SSQ_ARR, COS, SIN};
                pg8::gemm_phase<epi::QUp>(lds, g, SO, E, wave);
            }
#endif
            if (layer < 2) {
                pg8::Gemm g{(const bf16*)(ws + WS_POOLED), (const bf16*)(ws + W_POOL) + (size_t)layer * 1024 * 256, T, D, 256, D, 256, 256}; SO.init(T, D, G, bid);
                epi::Resid E{XBc, ssq + (size_t)(v0 + 1) * SSQ_ARR};
                pg8::gemm_phase<epi::Resid>(lds, g, SO, E, wave);
            } else {
                if (layer == 2) {
                    { pg8::Gemm g{(const bf16*)(ws + WS_CKV), (const bf16*)(ws + W_KNW), T, 1024, KVRANK, KVRANK, KVRANK, 0}; SO.init(T, 1024, G, bid);
                      epi::Bf16Row E{(bf16*)(ws + WS_KN), 1024, ssq + (size_t)15 * SSQ_ARR, 1.f / KVRANK};
                      pg8::gemm_phase<epi::Bf16Row>(lds, g, SO, E, wave); }
                    { pg8::Gemm g{(const bf16*)(ws + W_VW), (const bf16*)(ws + WS_CKV), 1024, T, KVRANK, KVRANK, KVRANK, 0}; SO.init(1024, T, G, bid);
                      epi::VTCol E{(bf16*)(ws + WS_VT), ssq + (size_t)15 * SSQ_ARR, 1.f / KVRANK};
                      pg8::gemm_phase<epi::VTCol>(lds, g, SO, E, wave); }
                }
                pg8::Gemm g{(const bf16*)(ws + WS_CQ), (const bf16*)(ws + W_UQ) + (size_t)(layer - 2) * 1536 * QRANK, T, 1536, QRANK, QRANK, QRANK, 0}; SO.init(T, 1536, G, bid);
                epi::QUp E{(bf16*)(ws + WS_Q), ssq + (size_t)(13 + layer - 2) * SSQ_ARR, COS, SIN};
                pg8::gemm_phase<epi::QUp>(lds, g, SO, E, wave);
            }
            PHASE_END(base + 1);
        }
        if (EN(3) && layer >= 2 && IN_PH(base + 2)) { PH_VARS; XB_VARS;
#if MK_PROBE & 2
            attn_phase((const bf16*)(ws + WS_Q), (const bf16*)(ws + WS_KN), (const bf16*)(ws + WS_KPE), (const bf16*)(ws + WS_VT), (bf16*)(ws + WS_AO), lds, vcu, G, wave);
#endif
            attn_phase((const bf16*)(ws + WS_Q), (const bf16*)(ws + WS_KN), (const bf16*)(ws + WS_KPE), (const bf16*)(ws + WS_VT), (bf16*)(ws + WS_AO), lds, vcu, G, wave);
            PHASE_END(base + 2);
        }
        if (EN(4) && layer >= 2 && IN_PH(base + 3)) { PH_VARS; XB_VARS;
            pg8::Gemm g{(const bf16*)(ws + WS_AO), (const bf16*)(ws + W_WO) + (size_t)(layer - 2) * D * D, T, D, D, D, D, 0}; SO.init(T, D, G, bid);
#if MK_PROBE & 16384
            { epi::Resid E2{(bf16*)(ws + WS_END), (float*)(ws + WS_END + 64 * MiB)}; pg8::gemm_phase<epi::Resid>(lds, g, SO, E2, wave); SO.init(T, D, G, bid); }
#endif
            epi::Resid E{XBc, ssq + (size_t)(v0 + 1) * SSQ_ARR};
            pg8::gemm_phase<epi::Resid>(lds, g, SO, E, wave);
            PHASE_END(base + 3);
        }
        if (EN(5) && IN_PH(base + 4)) { PH_VARS; XB_VARS;
#if MK_PROBE & 4
            { pg8::Gemm g{XBc, (const bf16*)(ws + W_WEFF) + (size_t)layer * 2048 * D, T, 2048, D, D, D, 0}; SO.init(T, 2048, G, bid);
              epi::Score E{(unsigned short*)(ws + WS_S), 2048, ssq + (size_t)(v0 + 1) * SSQ_ARR};
              pg8::gemm_phase<epi::Score>(lds, g, SO, E, wave); }
#endif
#if MK_PROBE & 65536
            { pg8::Gemm g{(const bf16*)(ws + WS_PB), (const bf16*)(ws + W_WP) + (size_t)layer * D * PLE, T, D, PLE, PLE, PLE, 0}; SO.init(T, D, G, bid);
              epi::Bf16Row E{(bf16*)(ws + WS_PP), D, nullptr, 0.f};
              pg8::gemm_phase<epi::Bf16Row>(lds, g, SO, E, wave); }
#endif
            {
            { pg8::Gemm g{XBc, (const bf16*)(ws + W_WEFF) + (size_t)layer * 2048 * D, T, 2048, D, D, D, 0}; SO.init(T, 2048, G, bid);
              epi::Score E{(unsigned short*)(ws + WS_S), 2048, ssq + (size_t)(v0 + 1) * SSQ_ARR};
              pg8::gemm_phase<epi::Score>(lds, g, SO, E, wave); }
            if (!(layer >= 2 && G % 2 == 0 && ((T / 256) * (((layer == 2) ? 1280 : 768) / 256)) % G == G / 2))
            { pg8::Gemm g{(const bf16*)(ws + WS_PB), (const bf16*)(ws + W_WP) + (size_t)layer * D * PLE, T, D, PLE, PLE, PLE, 0}; SO.init(T, D, G, bid);
              epi::Bf16Row E{(bf16*)(ws + WS_PP), D, nullptr, 0.f};
              pg8::gemm_phase<epi::Bf16Row>(lds, g, SO, E, wave); }
            }
            PHASE_END(base + 4);
        }
        if (EN(6) && EN(9) && IN_PH(base + 5)) { PH_VARS; XB_VARS;
            const int nl = layer + 1 < DEPTH ? layer + 1 : layer, ns = nl & 1;
            const ConvNext cvn{in.peer_u + (size_t)nl * NEXP * D, in.peer_v + (size_t)nl * NEXP * D, in.ffn_norm + nl * D, in.p + (size_t)nl * T * PLE,
                               ws + tab_off(ns), ws + tab_off(ns) + (size_t)NEXP * D, (float*)(ws + tabs_off(ns)), (float*)(ws + tabs_off(ns)) + NEXP, (bf16*)(ws + WS_PB), layer + 1 < DEPTH ? 1 : 0};
#if MK_PROBE & 64
            peer_topk_phase((const unsigned short*)(ws + WS_S), ssq + (size_t)(v0 + 1) * SSQ_ARR, (const float*)(ws + tabs_off(layer & 1)), (const float*)(ws + tabs_off(layer & 1)) + NEXP,
                            (unsigned short*)(ws + WS_IDX), (float*)(ws + WS_GW), (float*)(ws + WS_MU), cvn, lds, vcu, G, wave);
#endif
            peer_topk_phase((const unsigned short*)(ws + WS_S), ssq + (size_t)(v0 + 1) * SSQ_ARR, (const float*)(ws + tabs_off(layer & 1)), (const float*)(ws + tabs_off(layer & 1)) + NEXP,
                            (unsigned short*)(ws + WS_IDX), (float*)(ws + WS_GW), (float*)(ws + WS_MU), cvn, lds, vcu, G, wave);
            PHASE_END(base + 5);
        }
        if (EN(6) && EN(10) && IN_PH(base + 6)) { PH_VARS; XB_VARS;
#if MK_PROBE & 32
            peer_u_phase<0>((const unsigned short*)(ws + WS_IDX), XBc, ws + tab_off(layer & 1), (unsigned short*)(ws + WS_PART), bid, G, wave);
#endif
#if MK_PROBE & 128
            peer_u_phase<1>((const unsigned short*)(ws + WS_IDX), XBc, ws + tab_off(layer & 1), (unsigned short*)(ws + WS_WW), bid, G, wave);
#endif
            peer_u_phase<0>((const unsigned short*)(ws + WS_IDX), XBc, ws + tab_off(layer & 1), (unsigned short*)(ws + WS_PART), bid, G, wave);
            PHASE_END(base + 6);
        }
        if (EN(6) && EN(11) && IN_PH(base + 7)) { PH_VARS; XB_VARS;
#if MK_PROBE & 2048
            peer_w_phase((const unsigned short*)(ws + WS_PART), (const float*)(ws + WS_GW), (const float*)(ws + WS_MU), (const unsigned short*)(ws + WS_IDX), (unsigned*)(ws + WS_WW), bid, G, wave);
#endif
            peer_w_phase((const unsigned short*)(ws + WS_PART), (const float*)(ws + WS_GW), (const float*)(ws + WS_MU), (const unsigned short*)(ws + WS_IDX), (unsigned*)(ws + WS_WW), bid, G, wave);
            PHASE_END(base + 7);
        }
        if (EN(6) && EN(12) && IN_PH(base + 8)) { PH_VARS; XB_VARS;
#if MK_PROBE & 1024
            peer_v_phase((const unsigned*)(ws + WS_WW), ws + tab_off(layer & 1) + (size_t)NEXP * D, XBc, (bf16*)(ws + WS_END), (float*)(ws + WS_END + 64 * MiB), bid, G, wave);
#endif
            peer_v_phase((const unsigned*)(ws + WS_WW), ws + tab_off(layer & 1) + (size_t)NEXP * D, XBc, XBc, ssq + (size_t)(v0 + 2) * SSQ_ARR, bid, G, wave);
            PHASE_END(base + 8);
        }
        if (EN(7) && IN_PH(base + 9)) { PH_VARS; XB_VARS;
            pg8::Gemm g{XBc, (const bf16*)(ws + W_WG) + (size_t)layer * D * D, T, D, D, D, D, 0}; SO.init(T, D, G, bid);
#if MK_PROBE & 512
            { epi::Null EN_{(float*)(ws + WS_END)}; pg8::gemm_phase<epi::Null>(lds, g, SO, EN_, wave); }
#endif
#if MK_PROBE & 8192
            { epi::Gate E2{XBc, XBn, (const bf16*)(ws + WS_PP), ssq + (size_t)(v0 + 2) * SSQ_ARR, ssq + (size_t)(v0 + 3) * SSQ_ARR}; pg8::gemm_phase<epi::Gate>(lds, g, SO, E2, wave); SO.init(T, D, G, bid); }
#endif
            epi::Gate E{XBc, XBn, (const bf16*)(ws + WS_PP), ssq + (size_t)(v0 + 2) * SSQ_ARR, ssq + (size_t)(v0 + 3) * SSQ_ARR};
            pg8::gemm_phase<epi::Gate>(lds, g, SO, E, wave);
            PHASE_END(base + 9);
        }
    }
#if MK_PROBE & 32768
    if (EN(8) && IN_PH(41)) { PH_VARS; final_phase((const bf16*)(ws + WS_XBA), ssq + (size_t)12 * SSQ_ARR, in.final_norm, q->out, bid, G, wave); }
#endif
    if (EN(8) && IN_PH(41)) { PH_VARS; final_phase((const bf16*)(ws + WS_XBA), ssq + (size_t)12 * SSQ_ARR, in.final_norm, q->out, bid, G, wave); }
#undef IN_PH
#undef PHASE_END
}

extern "C" void kernel_launch(void* const* d_in, const int* in_sizes, int n_in, void* d_out, int out_size, void* d_ws, size_t ws_size, hipStream_t stream) {
    static int grid = 0;
    if (grid == 0) {
        if (n_in != 23 || out_size != T * D || ws_size < WS_END) { fprintf(stderr, "kernel_launch: unexpected problem (n_in %d, out %d, ws %zu < %zu)\n", n_in, out_size, ws_size, (size_t)WS_END); grid = -1; return; }
        int dev = 0, cus = 0, per_cu = 0;
        if (hipGetDevice(&dev) != hipSuccess || hipDeviceGetAttribute(&cus, hipDeviceAttributeMultiprocessorCount, dev) != hipSuccess) { grid = -1; return; }
        if (hipFuncSetAttribute((const void*)mk_fwd, hipFuncAttributeMaxDynamicSharedMemorySize, LDS_BYTES) != hipSuccess) { fprintf(stderr, "kernel_launch: hipFuncSetAttribute failed\n"); grid = -1; return; }
        if (hipOccupancyMaxActiveBlocksPerMultiprocessor(&per_cu, (const void*)mk_fwd, NTHR, LDS_BYTES) != hipSuccess || per_cu < 1) { fprintf(stderr, "kernel_launch: occupancy query says %d\n", per_cu); }
        (void)hipGetLastError();
        grid = cus;
    }
    if (grid < 0) return;
    (void)hipMemsetAsync((char*)d_ws + WS_CTL, 0, CTL_ZERO_BYTES, stream);
    Args a{};
    const void** ip = (const void**)&a.in;
    for (int i = 0; i < 23; ++i) ip[i] = d_in[i];
    a.out = (float*)d_out; a.ws = (unsigned char*)d_ws;
#if MK_ONE_LAUNCH
    a.ph_lo = 0; a.ph_hi = N_PHASES;
    hipLaunchKernelGGL(mk_fwd, dim3(grid), dim3(NTHR), LDS_BYTES, stream, a);
#else
    for (int k = 0; k < N_PHASES; ++k) {
        if (k >= 1 && k <= 40) { const int layer = (k - 1) / 10, slot = (k - 1) % 10; if (layer < 2 && (slot == 2 || slot == 3)) continue; }
        a.ph_lo = k; a.ph_hi = k + 1;
        hipLaunchKernelGGL(mk_fwd, dim3(grid), dim3(NTHR), LDS_BYTES, stream, a);
    }
#endif
}
#if defined(__HIP_DEVICE_COMPILE__)
#pragma clang attribute pop
#endif
```
